# Optimizing an MI355X kernel written in HIP

```python
import math
import jax
import jax.numpy as jnp
from jax import lax
import numpy as np

D_MODEL = 2048
BATCH = 4
SEQ = 2048
DEPTH = 2
DEC_BATCH = 128
DEC_SEQ = 8
PAST_LEN = 16384
PAGE_SIZE = 128

N_AB = (DEPTH + 1) // 2
N_C = DEPTH // 2

GDN_HEADS = 8
GDN_DK = D_MODEL // 16
GDN_DV = D_MODEL // 16
GDN_CONV = 4
GDN_CHUNK = 64
RET_HEADS = 4
RET_DK = D_MODEL // 16
RET_DV = D_MODEL // 8
RET_CHUNK = 64
ROPE_BASE = 10000.0
S5_GROUP = 16
S5_GROUPS = D_MODEL // S5_GROUP
S5_P = 64
D_FF = ((8 * D_MODEL // 3 + 255) // 256) * 256
FFN_CONV = 3
EPS = 1e-6

GDN_QK_W = GDN_HEADS * GDN_DK
GDN_V_W = GDN_HEADS * GDN_DV
GDN_CONV_W = 2 * GDN_QK_W + GDN_V_W
RET_QK_W = RET_HEADS * RET_DK
RET_V_W = RET_HEADS * RET_DV
IN_SIZES = (GDN_CONV_W, GDN_V_W, GDN_HEADS, GDN_HEADS, RET_QK_W, RET_QK_W, RET_V_W, RET_V_W)
IN_SPLITS = tuple(int(s) for s in np.cumsum(IN_SIZES)[:-1])
D_IN = sum(IN_SIZES)
MIX_W = GDN_V_W + RET_V_W

kernel_name = 'hybrid_gdn_retention_s5_convffn_step'


def rmsnorm(x, w):
    xf = x.astype(jnp.float32)
    y = xf * lax.rsqrt(jnp.mean(xf * xf, axis=-1, keepdims=True) + EPS)
    return (y * w.astype(jnp.float32)).astype(x.dtype)


def l2norm(x):
    return x * lax.rsqrt(jnp.sum(x * x, axis=-1, keepdims=True) + EPS)


def causal_dwconv(x, buf, w):
    k_taps = w.shape[0]
    L = x.shape[1]
    xp = jnp.concatenate([buf.astype(x.dtype), x], axis=1)
    out = xp[:, 0:L] * w[0]
    for j in range(1, k_taps):
        out = out + xp[:, j:j + L] * w[j]
    return out, xp[:, L:]


def rotary(t, pos):
    half = t.shape[-1] // 2
    inv = ROPE_BASE ** (-jnp.arange(half, dtype=jnp.float32) / half)
    ang = pos[:, None] * inv[None, :]
    cos = jnp.cos(ang)[None, :, None, :]
    sin = jnp.sin(ang)[None, :, None, :]
    t1, t2 = t[..., :half], t[..., half:]
    return jnp.concatenate([t1 * cos - t2 * sin, t1 * sin + t2 * cos], axis=-1)


def to_chunks(t, c):
    b, l = t.shape[:2]
    t = t.reshape((b, l // c, c) + t.shape[2:])
    return t.transpose((1, 0, 3, 2) + tuple(range(4, t.ndim)))


def from_chunks(t):
    n, b, h, c = t.shape[:4]
    t = t.transpose((1, 0, 3, 2) + tuple(range(4, t.ndim)))
    return t.reshape((b, n * c, h) + t.shape[4:])


def gated_delta_chunked(q, k, v, log_a, beta, s0):
    L = q.shape[1]
    dv = v.shape[-1]
    c = math.gcd(L, GDN_CHUNK)
    qc, kc, vc = to_chunks(q, c), to_chunks(k, c), to_chunks(v, c)
    g = jnp.cumsum(to_chunks(log_a, c), axis=-1)
    bc = to_chunks(beta, c)
    incl = jnp.tril(jnp.ones((c, c), dtype=bool))
    strict = jnp.tril(jnp.ones((c, c), dtype=bool), -1)
    diff = g[..., :, None] - g[..., None, :]
    decay = jnp.where(incl, jnp.exp(jnp.where(incl, diff, 0.0)), 0.0)
    kk = jnp.einsum('nbhid,nbhjd->nbhij', kc, kc)
    a_mat = jnp.where(strict, bc[..., :, None] * kk * decay, 0.0) + jnp.eye(c, dtype=q.dtype)
    rhs = jnp.concatenate([vc * bc[..., None], kc * (bc * jnp.exp(g))[..., None]], axis=-1)
    sol = lax.linalg.triangular_solve(a_mat, rhs, left_side=True, lower=True, unit_diagonal=True)
    u, w = sol[..., :dv], sol[..., dv:]
    qk = jnp.einsum('nbhid,nbhjd->nbhij', qc, kc) * decay
    q_dec = qc * jnp.exp(g)[..., None]
    k_dec = kc * jnp.exp(g[..., -1:] - g)[..., None]
    g_last = jnp.exp(g[..., -1])

    def step(s, inp):
        u_n, w_n, qk_n, qd_n, kd_n, gl_n = inp
        v_new = u_n - jnp.einsum('bhcd,bhde->bhce', w_n, s)
        o = jnp.einsum('bhcd,bhde->bhce', qd_n, s) + jnp.einsum('bhij,bhje->bhie', qk_n, v_new)
        s = s * gl_n[..., None, None] + jnp.einsum('bhcd,bhce->bhde', kd_n, v_new)
        return s, o

    s_fin, o = lax.scan(step, s0, (u, w, qk, q_dec, k_dec, g_last))
    return from_chunks(o), s_fin


def retention_chunked(q, k, v, s0):
    L = q.shape[1]
    c = math.gcd(L, RET_CHUNK)
    log_g = jnp.log1p(-jnp.exp2(-5.0 - jnp.arange(RET_HEADS, dtype=jnp.float32)))
    qc, kc, vc = to_chunks(q, c), to_chunks(k, c), to_chunks(v, c)
    idx = jnp.arange(c, dtype=jnp.float32)
    diff = idx[:, None] - idx[None, :]
    causal = diff >= 0
    decay = jnp.where(causal, jnp.exp(log_g[:, None, None] * jnp.where(causal, diff, 0.0)), 0.0)
    q_dec = jnp.exp(log_g[:, None] * (idx + 1.0))[..., None]
    k_dec = jnp.exp(log_g[:, None] * (c - 1.0 - idx))[..., None]
    g_chunk = jnp.exp(log_g * c)[:, None, None]
    o = jnp.einsum('nbhij,nbhje->nbhie', jnp.einsum('nbhid,nbhjd->nbhij', qc, kc) * decay, vc)
    kv = jnp.einsum('nbhjd,nbhje->nbhde', kc * k_dec, vc)

    def step(s, kv_n):
        return s * g_chunk + kv_n, s

    s_fin, s_prev = lax.scan(step, s0, kv)
    o = o + jnp.einsum('nbhid,nbhde->nbhie', qc * q_dec, s_prev)
    return from_chunks(o), s_fin


def ab_mixer(h, pos, gdn_s, gdn_cb, ret_s, w_in, gdn_conv_w, gdn_a_log, gdn_dt_bias,
             gdn_norm_w, ret_gn_w, ret_gn_b, w_out):
    f32 = jnp.float32
    bn, L, _ = h.shape
    proj = h @ w_in
    qkv_a, z_a, a_a, b_a, q_b, k_b, v_b, g_b = jnp.split(proj, IN_SPLITS, axis=-1)
    qkv_a, new_cb = causal_dwconv(qkv_a, gdn_cb, gdn_conv_w)
    qkv_a = jax.nn.silu(qkv_a.astype(f32))
    q_a, k_a, v_a = jnp.split(qkv_a, [GDN_QK_W, 2 * GDN_QK_W], axis=-1)
    q_a = l2norm(q_a.reshape(bn, L, GDN_HEADS, GDN_DK)) * (GDN_DK ** -0.5)
    k_a = l2norm(k_a.reshape(bn, L, GDN_HEADS, GDN_DK))
    v_a = v_a.reshape(bn, L, GDN_HEADS, GDN_DV)
    log_alpha = -jnp.exp(gdn_a_log.astype(f32)) * jax.nn.softplus(a_a.astype(f32) + gdn_dt_bias.astype(f32))
    beta = jax.nn.sigmoid(b_a.astype(f32))
    o_a, s_a = gated_delta_chunked(q_a, k_a, v_a, log_alpha, beta, gdn_s.astype(f32))
    o_a = (o_a * lax.rsqrt(jnp.mean(o_a * o_a, axis=-1, keepdims=True) + EPS) * gdn_norm_w.astype(f32)
           * jax.nn.silu(z_a.astype(f32).reshape(bn, L, GDN_HEADS, GDN_DV)))
    qb = rotary(q_b.astype(f32).reshape(bn, L, RET_HEADS, RET_DK), pos)
    kb = rotary(k_b.astype(f32).reshape(bn, L, RET_HEADS, RET_DK), pos) * (RET_DK ** -0.5)
    vb = v_b.astype(f32).reshape(bn, L, RET_HEADS, RET_DV)
    o_b, s_b = retention_chunked(qb, kb, vb, ret_s.astype(f32))
    mu = jnp.mean(o_b, axis=-1, keepdims=True)
    var = jnp.mean(jnp.square(o_b - mu), axis=-1, keepdims=True)
    o_b = ((o_b - mu) * lax.rsqrt(var + EPS)).reshape(bn, L, RET_V_W)
    o_b = (o_b * ret_gn_w.astype(f32) + ret_gn_b.astype(f32)) * jax.nn.silu(g_b.astype(f32))
    mixed = jnp.concatenate([o_a.reshape(bn, L, GDN_V_W), o_b], axis=-1).astype(h.dtype)
    return mixed @ w_out, s_a, new_cb, s_b


def s5_combine(e1, e2):
    a1r, a1i, b1r, b1i = e1
    a2r, a2i, b2r, b2i = e2
    return (a2r * a1r - a2i * a1i, a2r * a1i + a2i * a1r,
            a2r * b1r - a2i * b1i + b2r, a2r * b1i + a2i * b1r + b2i)


def s5_mixer(h, h0_re, h0_im, lam_re, lam_im, log_dt, b_re, b_im, c_re, c_im, d, w_glu):
    f32 = jnp.float32
    u = h.astype(f32)
    bn, L, _ = u.shape
    ug = u.reshape(bn, L, S5_GROUPS, S5_GROUP)
    lam_re = lam_re.astype(f32)
    lam_im = lam_im.astype(f32)
    dt = jnp.exp(log_dt.astype(f32))[:, None]
    mag = jnp.exp(lam_re * dt)
    ph = lam_im * dt
    ab_re, ab_im = mag * jnp.cos(ph), mag * jnp.sin(ph)
    den = lam_re * lam_re + lam_im * lam_im
    cf_re = ((ab_re - 1.0) * lam_re + ab_im * lam_im) / den
    cf_im = (ab_im * lam_re - (ab_re - 1.0) * lam_im) / den
    b_re = b_re.astype(f32)
    b_im = b_im.astype(f32)
    bb_re = cf_re[..., None] * b_re - cf_im[..., None] * b_im
    bb_im = cf_re[..., None] * b_im + cf_im[..., None] * b_re
    bu_re = jnp.einsum('blgc,gpc->blgp', ug, bb_re)
    bu_im = jnp.einsum('blgc,gpc->blgp', ug, bb_im)
    h0_re = h0_re.astype(f32)
    h0_im = h0_im.astype(f32)
    bu_re = bu_re.at[:, 0].add(ab_re * h0_re - ab_im * h0_im)
    bu_im = bu_im.at[:, 0].add(ab_re * h0_im + ab_im * h0_re)
    a_re = jnp.broadcast_to(ab_re, bu_re.shape)
    a_im = jnp.broadcast_to(ab_im, bu_im.shape)
    _, _, x_re, x_im = lax.associative_scan(s5_combine, (a_re, a_im, bu_re, bu_im), axis=1)
    y = (jnp.einsum('blgp,gcp->blgc', x_re, c_re.astype(f32))
         - jnp.einsum('blgp,gcp->blgc', x_im, c_im.astype(f32)))
    y = y.reshape(bn, L, D_MODEL) + d.astype(f32) * u
    g = jax.nn.gelu(y).astype(h.dtype)
    val, gate = jnp.split(g @ w_glu, 2, axis=-1)
    return val * jax.nn.sigmoid(gate), x_re[:, -1], x_im[:, -1]


def conv_ffn(h, buf, w_up, conv_w, conv_b, w_down):
    up = h @ w_up
    up, new_buf = causal_dwconv(up, buf, conv_w)
    up = up + conv_b
    val, gate = jnp.split(up, 2, axis=-1)
    return (jax.nn.silu(gate) * val) @ w_down, new_buf


def trunk(x, pos, gdn_s, gdn_cb, ret_s, s5_re, s5_im, ffn_cb, p):
    gdn_new, gcb_new, ret_new, s5r_new, s5i_new, fcb_new = [], [], [], [], [], []
    for layer in range(DEPTH):
        i = layer // 2
        h = rmsnorm(x, p['norm_mix_w'][layer])
        if layer % 2 == 0:
            mix, s_a, cb_a, s_b = ab_mixer(h, pos, gdn_s[i], gdn_cb[i], ret_s[i], p['w_in'][i],
                                           p['gdn_conv_w'][i], p['gdn_a_log'][i], p['gdn_dt_bias'][i],
                                           p['gdn_norm_w'][i], p['ret_gn_w'][i], p['ret_gn_b'][i],
                                           p['w_out'][i])
            gdn_new.append(s_a)
            gcb_new.append(cb_a)
            ret_new.append(s_b)
        else:
            mix, hr, hi = s5_mixer(h, s5_re[i], s5_im[i], p['s5_lam_re'][i], p['s5_lam_im'][i],
                                   p['s5_log_dt'][i], p['s5_b_re'][i], p['s5_b_im'][i],
                                   p['s5_c_re'][i], p['s5_c_im'][i], p['s5_d'][i], p['w_glu'][i])
            s5r_new.append(hr)
            s5i_new.append(hi)
        x = x + mix.astype(x.dtype)
        h = rmsnorm(x, p['norm_ffn_w'][layer])
        f, cb = conv_ffn(h, ffn_cb[layer], p['w_up'][layer], p['ffn_conv_w'][layer],
                         p['ffn_conv_b'][layer], p['w_down'][layer])
        fcb_new.append(cb)
        x = x + f.astype(x.dtype)
    y = rmsnorm(x, p['norm_final_w'])
    return (y, jnp.stack(gdn_new), jnp.stack(gcb_new), jnp.stack(ret_new),
            jnp.stack(s5r_new), jnp.stack(s5i_new), jnp.stack(fcb_new))


def setup_inputs(seed: int = 0) -> dict:
    key = jax.random.key(seed)
    ks = iter(jax.random.split(key, 40))
    f32 = jnp.float32

    def nrm(shape, scale):
        return scale * jax.random.normal(next(ks), shape, f32)

    x_prompt = nrm((BATCH, SEQ, D_MODEL), 1.0)
    x_sample = nrm((DEC_BATCH, DEC_SEQ, D_MODEL), 1.0)
    state_gdn = nrm((N_AB, DEC_BATCH, GDN_HEADS, GDN_DK, GDN_DV), 0.1)
    state_gdn_conv = nrm((N_AB, DEC_BATCH, GDN_CONV - 1, GDN_CONV_W), 1.0)
    state_ret = nrm((N_AB, DEC_BATCH, RET_HEADS, RET_DK, RET_DV), 1.0)
    state_s5_re = nrm((N_C, DEC_BATCH, S5_GROUPS, S5_P), 0.3)
    state_s5_im = nrm((N_C, DEC_BATCH, S5_GROUPS, S5_P), 0.3)
    state_ffn_conv = nrm((DEPTH, DEC_BATCH, FFN_CONV - 1, 2 * D_FF), 1.0)
    norm_mix_w = 1.0 + nrm((DEPTH, D_MODEL), 0.02)
    norm_ffn_w = 1.0 + nrm((DEPTH, D_MODEL), 0.02)
    norm_final_w = 1.0 + nrm((D_MODEL,), 0.02)
    w_in = nrm((N_AB, D_MODEL, D_IN), D_MODEL ** -0.5)
    gdn_conv_w = nrm((N_AB, GDN_CONV, GDN_CONV_W), GDN_CONV ** -0.5)
    gdn_a_log = jnp.log(jax.random.uniform(next(ks), (N_AB, GDN_HEADS), f32, 1.0, 16.0))
    dt = jnp.exp(jax.random.uniform(next(ks), (N_AB, GDN_HEADS), f32, math.log(1e-3), math.log(1e-1)))
    gdn_dt_bias = dt + jnp.log(-jnp.expm1(-dt))
    gdn_norm_w = 1.0 + nrm((N_AB, GDN_DV), 0.02)
    ret_gn_w = 1.0 + nrm((N_AB, RET_V_W), 0.02)
    ret_gn_b = nrm((N_AB, RET_V_W), 0.02)
    w_out = nrm((N_AB, MIX_W, D_MODEL), MIX_W ** -0.5)
    s5_lam_re = -0.5 + nrm((N_C, S5_GROUPS, S5_P), 0.01)
    s5_lam_im = math.pi * jnp.arange(S5_P, dtype=f32) + nrm((N_C, S5_GROUPS, S5_P), 0.01)
    s5_log_dt = jax.random.uniform(next(ks), (N_C, S5_GROUPS), f32, math.log(1e-3), math.log(1e-1))
    s5_b_re = nrm((N_C, S5_GROUPS, S5_P, S5_GROUP), (2 * S5_GROUP) ** -0.5)
    s5_b_im = nrm((N_C, S5_GROUPS, S5_P, S5_GROUP), (2 * S5_GROUP) ** -0.5)
    s5_c_re = nrm((N_C, S5_GROUPS, S5_GROUP, S5_P), S5_P ** -0.5)
    s5_c_im = nrm((N_C, S5_GROUPS, S5_GROUP, S5_P), S5_P ** -0.5)
    s5_d = nrm((N_C, D_MODEL), 1.0)
    w_glu = nrm((N_C, D_MODEL, 2 * D_MODEL), D_MODEL ** -0.5)
    w_up = nrm((DEPTH, D_MODEL, 2 * D_FF), D_MODEL ** -0.5)
    ffn_conv_w = nrm((DEPTH, FFN_CONV, 2 * D_FF), FFN_CONV ** -0.5)
    ffn_conv_b = nrm((DEPTH, 2 * D_FF), 0.01)
    w_down = nrm((DEPTH, D_FF, D_MODEL), D_FF ** -0.5)
    return {'x_prompt': x_prompt, 'x_sample': x_sample,
            'state_gdn': state_gdn, 'state_gdn_conv': state_gdn_conv, 'state_ret': state_ret,
            'state_s5_re': state_s5_re, 'state_s5_im': state_s5_im, 'state_ffn_conv': state_ffn_conv,
            'norm_mix_w': norm_mix_w, 'norm_ffn_w': norm_ffn_w, 'norm_final_w': norm_final_w,
            'w_in': w_in, 'gdn_conv_w': gdn_conv_w, 'gdn_a_log': gdn_a_log, 'gdn_dt_bias': gdn_dt_bias,
            'gdn_norm_w': gdn_norm_w, 'ret_gn_w': ret_gn_w, 'ret_gn_b': ret_gn_b, 'w_out': w_out,
            's5_lam_re': s5_lam_re, 's5_lam_im': s5_lam_im, 's5_log_dt': s5_log_dt,
            's5_b_re': s5_b_re, 's5_b_im': s5_b_im, 's5_c_re': s5_c_re, 's5_c_im': s5_c_im,
            's5_d': s5_d, 'w_glu': w_glu,
            'w_up': w_up, 'ffn_conv_w': ffn_conv_w, 'ffn_conv_b': ffn_conv_b, 'w_down': w_down}


def reference(x_prompt, x_sample, state_gdn, state_gdn_conv, state_ret, state_s5_re, state_s5_im,
              state_ffn_conv, norm_mix_w, norm_ffn_w, norm_final_w,
              w_in, gdn_conv_w, gdn_a_log, gdn_dt_bias, gdn_norm_w, ret_gn_w, ret_gn_b, w_out,
              s5_lam_re, s5_lam_im, s5_log_dt, s5_b_re, s5_b_im, s5_c_re, s5_c_im, s5_d, w_glu,
              w_up, ffn_conv_w, ffn_conv_b, w_down):
    f32 = jnp.float32
    p = dict(norm_mix_w=norm_mix_w, norm_ffn_w=norm_ffn_w, norm_final_w=norm_final_w,
             w_in=w_in, gdn_conv_w=gdn_conv_w, gdn_a_log=gdn_a_log, gdn_dt_bias=gdn_dt_bias,
             gdn_norm_w=gdn_norm_w, ret_gn_w=ret_gn_w, ret_gn_b=ret_gn_b, w_out=w_out,
             s5_lam_re=s5_lam_re, s5_lam_im=s5_lam_im, s5_log_dt=s5_log_dt,
             s5_b_re=s5_b_re, s5_b_im=s5_b_im, s5_c_re=s5_c_re, s5_c_im=s5_c_im,
             s5_d=s5_d, w_glu=w_glu, w_up=w_up, ffn_conv_w=ffn_conv_w,
             ffn_conv_b=ffn_conv_b, w_down=w_down)
    bp = x_prompt.shape[0]
    z_gdn = jnp.zeros((N_AB, bp, GDN_HEADS, GDN_DK, GDN_DV), f32)
    z_gcb = jnp.zeros((N_AB, bp, GDN_CONV - 1, GDN_CONV_W), x_prompt.dtype)
    z_ret = jnp.zeros((N_AB, bp, RET_HEADS, RET_DK, RET_DV), f32)
    z_s5 = jnp.zeros((N_C, bp, S5_GROUPS, S5_P), f32)
    z_fcb = jnp.zeros((DEPTH, bp, FFN_CONV - 1, 2 * D_FF), x_prompt.dtype)
    pos_p = jnp.arange(x_prompt.shape[1], dtype=f32)
    pos_s = PAST_LEN + jnp.arange(x_sample.shape[1], dtype=f32)
    y_prompt, gdn_p, gcb_p, ret_p, s5r_p, s5i_p, fcb_p = trunk(
        x_prompt, pos_p, z_gdn, z_gcb, z_ret, z_s5, z_s5, z_fcb, p)
    y_sample, gdn_s, gcb_s, ret_s, s5r_s, s5i_s, fcb_s = trunk(
        x_sample, pos_s, state_gdn, state_gdn_conv, state_ret, state_s5_re, state_s5_im,
        state_ffn_conv, p)
    return (y_prompt, y_sample, gdn_p, gdn_s, gcb_p, gcb_s, ret_p, ret_s,
            s5r_p, s5r_s, s5i_p, s5i_s, fcb_p, fcb_s)
```

```cpp
#include <hip/hip_runtime.h>
#include <hip/hip_cooperative_groups.h>
#include <cstdio>
#include <cstdint>
#include <cmath>
namespace cg = cooperative_groups;
namespace pg8 {
#define PG8_LAS __attribute__((address_space(3)))
typedef unsigned short bf16_t;
typedef short bf16x8 __attribute__((ext_vector_type(8)));
typedef float f32x4 __attribute__((ext_vector_type(4)));
typedef unsigned u32x4 __attribute__((ext_vector_type(4)));
constexpr int BM = 256, BK = 64, HALF = 128, HTB = HALF * BK * 2  , STAGE_BYTES = 8 * HTB, NXCD = 8, WGM = 4;

__host__ __device__ __forceinline__ int lds_byte(int r, int c) { const int st = (r >> 4) * 2 + (c >> 5), rr = r & 15, cc = c & 31, ob = rr * 64 + cc * 2; return st * 1024 + (ob ^ (((ob >> 9) & 1) << 5)); }
__host__ __device__ __forceinline__ void stage_rc(int b, int& R, int& C) { const int st = b / 1024, sb = b % 1024, swz = sb ^ (((sb >> 9) & 1) << 5); R = (st >> 1) * 16 + swz / 64; C = (st & 1) * 32 + (swz % 64) / 2; }
__host__ __device__ __forceinline__ int perm32(int rho) { const int n = rho >> 4, i = rho & 15; return 8 * (i >> 2) + 4 * n + (i & 3); }

struct Unit { int pm, pn; };
struct Gemm { const bf16_t* A; const bf16_t* Bt; int M, N, K, ldk; };

struct StaticOrder {
    int nM, nN, nwg, G, c;
    __host__ __device__ void init(int M, int N, int G_, int c_) { nM = M / BM; nN = N / BM; nwg = nM * nN; G = G_; c = c_; }
    __host__ __device__ bool next(int i, Unit& u) const {
        const long L = (long)i * G + c; if (L >= nwg) return false;
        int wgid = (int)L; { const int q = nwg / NXCD, r = nwg % NXCD, xcd = wgid % NXCD, off = wgid / NXCD; wgid = (xcd < r ? xcd * (q + 1) : r * (q + 1) + (xcd - r) * q) + off; }
        const int nig = WGM * nN, gid = wgid / nig, fm = gid * WGM, gsz = (nM - fm) < WGM ? (nM - fm) : WGM;
        u.pm = fm + ((wgid % nig) % gsz); u.pn = (wgid % nig) / gsz; return true;
    }
    __device__ __forceinline__ void a_ready(const Unit&) const {}
    __device__ __forceinline__ void done(const Unit&) const {}
};

__device__ __forceinline__ unsigned cvt_pk_bf16(float lo, float hi) { unsigned r; asm volatile("v_cvt_pk_bf16_f32 %0, %1, %2" : "=v"(r) : "v"(lo), "v"(hi)); return r; }

struct EpiBf16Plain {
    static constexpr bool PERM = true, AFTER_DRAIN = false;
    bf16_t* O; int ldc;
    __device__ __forceinline__ void operator()(const f32x4 (&acc)[2][2][4][2], const Unit& u, int wr, int wc, int fr, int fq) const {
        const int row0 = u.pm * BM + wr * 64 + fr, col0 = u.pn * BM + wc * 32 + 8 * fq;
#pragma unroll
        for (int ai = 0; ai < 2; ++ai)
#pragma unroll
            for (int m = 0; m < 4; ++m) { bf16_t* rowp = O + (size_t)(row0 + ai * HALF + m * 16) * ldc + col0;
#pragma unroll
                for (int bj = 0; bj < 2; ++bj) { const f32x4 v0 = acc[ai][bj][m][0], v1 = acc[ai][bj][m][1];
                    u32x4 w; w.x = cvt_pk_bf16(v0[0], v0[1]); w.y = cvt_pk_bf16(v0[2], v0[3]); w.z = cvt_pk_bf16(v1[0], v1[1]); w.w = cvt_pk_bf16(v1[2], v1[3]);
                    *(u32x4*)(rowp + bj * HALF) = w; } }
    }
};
struct EpiResF32 {
    static constexpr bool PERM = false, AFTER_DRAIN = false;
    float* X; int ldc;
    __device__ __forceinline__ void operator()(const f32x4 (&acc)[2][2][4][2], const Unit& u, int wr, int wc, int fr, int fq) const {
        const int row0 = u.pm * BM + wr * 64 + fr, col0 = u.pn * BM + wc * 32 + 4 * fq;
#pragma unroll
        for (int ai = 0; ai < 2; ++ai)
#pragma unroll
            for (int m = 0; m < 4; ++m) { float* rowp = X + (size_t)(row0 + ai * HALF + m * 16) * ldc + col0;
#pragma unroll
                for (int bj = 0; bj < 2; ++bj)
#pragma unroll
                    for (int n = 0; n < 2; ++n) { f32x4* p = (f32x4*)(rowp + bj * HALF + n * 16); *p = *p + acc[ai][bj][m][n]; }
                asm volatile("" ::: "memory"); }
    }
};
struct PlusOne : StaticOrder {
    Unit extra; bool has_extra;
    __device__ bool next(int i, Unit& u) const {
        if (StaticOrder::next(i, u)) return true;
        const int np = (nwg - c + G - 1) / G;
        if (has_extra && i == np) { u = extra; return true; }
        return false;
    }
};
struct OneUnit {
    Unit u; bool valid;
    __device__ bool next(int i, Unit& o) const { if (i != 0 || !valid) return false; o = u; return true; }
    __device__ __forceinline__ void a_ready(const Unit&) const {}
    __device__ __forceinline__ void done(const Unit&) const {}
};
struct EpiSlab {
    static constexpr bool PERM = false, AFTER_DRAIN = false;
    float* S; int ldc;
    __device__ __forceinline__ void operator()(const f32x4 (&acc)[2][2][4][2], const Unit& u, int wr, int wc, int fr, int fq) const {
        const int row0 = (u.pm - 32) * BM + wr * 64 + fr, col0 = u.pn * BM + wc * 32 + 4 * fq;
#pragma unroll
        for (int ai = 0; ai < 2; ++ai)
#pragma unroll
            for (int m = 0; m < 4; ++m) { float* rowp = S + (size_t)(row0 + ai * HALF + m * 16) * ldc + col0;
#pragma unroll
                for (int bj = 0; bj < 2; ++bj)
#pragma unroll
                    for (int n = 0; n < 2; ++n) *(f32x4*)(rowp + bj * HALF + n * 16) = acc[ai][bj][m][n]; }
    }
};
struct EpiResNorm {
    static constexpr bool PERM = false, AFTER_DRAIN = false;
    float* X; bf16_t* XB; float* SS; int ldc; const float* R0; const float* R1;
    __device__ __forceinline__ void operator()(const f32x4 (&acc)[2][2][4][2], const Unit& u, int wr, int wc, int fr, int fq) const {
        const int row0 = u.pm * BM + wr * 64 + fr, col0 = u.pn * BM + wc * 32 + 4 * fq;
        const float* Rb = (u.pm < 32) ? R0 : R1 - (size_t)8192 * ldc;
#pragma unroll
        for (int ap = 0; ap < 4; ++ap) {
            const int ai = ap >> 1, m0 = (ap & 1) * 2;
            f32x4 res[2][4];
#pragma unroll
            for (int mm = 0; mm < 2; ++mm) { const float* rp = Rb + (size_t)(row0 + ai * HALF + (m0 + mm) * 16) * ldc + col0;
#pragma unroll
                for (int i = 0; i < 4; ++i) res[mm][i] = *(const f32x4*)(rp + (i >> 1) * HALF + (i & 1) * 16); }
#pragma unroll
            for (int mm = 0; mm < 2; ++mm) { const int m = m0 + mm, row = row0 + ai * HALF + m * 16; float* rowp = X + (size_t)row * ldc + col0; bf16_t* rowb = XB + (size_t)row * ldc + col0; float ss = 0.f;
#pragma unroll
                for (int i = 0; i < 4; ++i) { const int bj = i >> 1, n = i & 1; const f32x4 v = res[mm][i] + acc[ai][bj][m][n]; *(f32x4*)(rowp + bj * HALF + n * 16) = v;
                    ss += (v[0] * v[0] + v[1] * v[1]) + (v[2] * v[2] + v[3] * v[3]);
                    unsigned lo = cvt_pk_bf16(v[0], v[1]), hi = cvt_pk_bf16(v[2], v[3]); *(unsigned long long*)(rowb + bj * HALF + n * 16) = ((unsigned long long)hi << 32) | lo; }
                ss += __shfl_xor(ss, 16); ss += __shfl_xor(ss, 32);
                if (fq == 0) atomicAdd(SS + row, ss); }
            asm volatile("" ::: "memory"); }
    }
};
struct EpiBf16Rstd {
    static constexpr bool PERM = true, AFTER_DRAIN = false;
    bf16_t* O; int ldc; const float* SS;
    __device__ __forceinline__ void operator()(const f32x4 (&acc)[2][2][4][2], const Unit& u, int wr, int wc, int fr, int fq) const {
        const int row0 = u.pm * BM + wr * 64 + fr, col0 = u.pn * BM + wc * 32 + 8 * fq;
        float ssv[8];
#pragma unroll
        for (int g = 0; g < 8; ++g) ssv[g] = SS[row0 + (g >> 2) * HALF + (g & 3) * 16];
#pragma unroll
        for (int ai = 0; ai < 2; ++ai)
#pragma unroll
            for (int m = 0; m < 4; ++m) { const int row = row0 + ai * HALF + m * 16; bf16_t* rowp = O + (size_t)row * ldc + col0; const float rs = 1.0f / sqrtf(ssv[ai * 4 + m] * (1.0f / 2048.0f) + 1e-6f);
#pragma unroll
                for (int bj = 0; bj < 2; ++bj) { const f32x4 v0 = acc[ai][bj][m][0] * rs, v1 = acc[ai][bj][m][1] * rs;
                    u32x4 w; w.x = cvt_pk_bf16(v0[0], v0[1]); w.y = cvt_pk_bf16(v0[2], v0[3]); w.z = cvt_pk_bf16(v1[0], v1[1]); w.w = cvt_pk_bf16(v1[2], v1[3]);
                    *(u32x4*)(rowp + bj * HALF) = w; } }
    }
};
struct EpiGluRes {
    static constexpr bool PERM = false, AFTER_DRAIN = false;
    float* X; bf16_t* XB; float* SS; int ldc;
    __device__ __forceinline__ void operator()(const f32x4 (&acc)[2][2][4][2], const Unit& u, int wr, int wc, int fr, int fq) const {
        const int row0 = u.pm * BM + wr * 64 + fr, col0 = u.pn * HALF + wc * 32 + 4 * fq;
        f32x4 res[8][2];
#pragma unroll
        for (int g = 0; g < 8; ++g)
#pragma unroll
            for (int n = 0; n < 2; ++n) res[g][n] = *(const f32x4*)(X + (size_t)(row0 + (g >> 2) * HALF + (g & 3) * 16) * ldc + col0 + n * 16);
#pragma unroll
        for (int g = 0; g < 8; ++g) { const int ai = g >> 2, m = g & 3, row = row0 + ai * HALF + m * 16; float* rowp = X + (size_t)row * ldc + col0; bf16_t* rowb = XB + (size_t)row * ldc + col0; float ss = 0.f;
#pragma unroll
            for (int n = 0; n < 2; ++n) { const f32x4 v = acc[ai][0][m][n], gt = acc[ai][1][m][n]; f32x4 o = res[g][n];
#pragma unroll
                for (int j = 0; j < 4; ++j) o[j] += v[j] / (1.0f + __expf(-gt[j]));
                *(f32x4*)(rowp + n * 16) = o; ss += (o[0] * o[0] + o[1] * o[1]) + (o[2] * o[2] + o[3] * o[3]);
                unsigned lo = cvt_pk_bf16(o[0], o[1]), hi = cvt_pk_bf16(o[2], o[3]); *(unsigned long long*)(rowb + n * 16) = ((unsigned long long)hi << 32) | lo; }
            ss += __shfl_xor(ss, 16); ss += __shfl_xor(ss, 32);
            if (fq == 0) atomicAdd(SS + row, ss); }
    }
};

template <class Epi, class Sched, bool ALIGN_EPI = false, bool SP2 = false>
__device__ __forceinline__ void gemm_phase(PG8_LAS unsigned char* lds, const Gemm g, const Sched& S, const Epi& E) {
    const int tid = threadIdx.x, wid = __builtin_amdgcn_readfirstlane(tid >> 6), lane = tid & 63, wr = wid >> 2, wc = wid & 3, fr = lane & 15, fq = lane >> 4;
    const int K = g.ldk, nt = g.K / BK;
    unsigned voffA[2], voffB[2];
#pragma unroll
    for (int i = 0; i < 2; ++i) { int R, C; stage_rc(tid * 16 + i * 8192, R, C); const int Rb = Epi::PERM ? ((R & ~31) + perm32(R & 31)) : R;
        voffA[i] = (unsigned)(R * K + C) * 2u; voffB[i] = (unsigned)(Rb * K + C) * 2u; }
    const size_t kstep = (size_t)(BK * 2);
    const size_t hstep = (size_t)HALF * K * 2;
    const size_t tstep = 2 * hstep;
    const unsigned ldsw = (unsigned)wid * 1024u;
    const int aoff = lds_byte(wr * 64 + fr, fq * 8), boff = lds_byte(wc * 32 + fr, fq * 8);
#define PG8_SA(b, h) (((b) * 2 + (h)) * HTB)
#define PG8_SB(b, h) ((4 + (b) * 2 + (h)) * HTB)
#define PG8_STAGE(bufoff, gbase, voff) do { _Pragma("unroll") for (int _i = 0; _i < 2; ++_i) \
        __builtin_amdgcn_global_load_lds((const unsigned*)((const char*)(gbase) + (voff)[_i]), (PG8_LAS unsigned*)(lds + (bufoff) + ldsw + _i * 8192), 16, 0, 0); } while (0)
#define PG8_LDA(dst, b, h) do { _Pragma("unroll") for (int m = 0; m < 4; ++m) _Pragma("unroll") for (int k = 0; k < 2; ++k) dst[m][k] = *(const PG8_LAS bf16x8*)(lds + PG8_SA(b, h) + aoff + m * 2048 + k * 1024); } while (0)
#define PG8_LDB(dst, b, h) do { _Pragma("unroll") for (int n = 0; n < 2; ++n) _Pragma("unroll") for (int k = 0; k < 2; ++k) dst[n][k] = *(const PG8_LAS bf16x8*)(lds + PG8_SB(b, h) + boff + n * 2048 + k * 1024); } while (0)
#define PG8_MMA(ai, bj, At, Bt) do { __builtin_amdgcn_s_setprio(1); _Pragma("unroll") for (int m = 0; m < 4; ++m) _Pragma("unroll") for (int n = 0; n < 2; ++n) _Pragma("unroll") for (int k = 0; k < 2; ++k) \
        acc[ai][bj][m][n] = __builtin_amdgcn_mfma_f32_16x16x32_bf16(Bt[n][k], At[m][k], acc[ai][bj][m][n], 0, 0, 0); __builtin_amdgcn_s_setprio(0); } while (0)
#define PG8_WAIT_V(n) asm volatile("s_waitcnt vmcnt(" #n ")" ::: "memory")
#define PG8_WAIT_L(n) asm volatile("s_waitcnt lgkmcnt(" #n ")" ::: "memory")
#define PG8_BAR __builtin_amdgcn_s_barrier()
#define PG8_SCHED __builtin_amdgcn_sched_barrier(0)
    Unit cur, nxt; int ui = 0;
    if (!S.next(0, cur)) return;
    f32x4 acc[2][2][4][2];
#pragma unroll
    for (int a = 0; a < 2; ++a)
#pragma unroll
        for (int b = 0; b < 2; ++b)
#pragma unroll
            for (int m = 0; m < 4; ++m)
#pragma unroll
                for (int n = 0; n < 2; ++n) acc[a][b][m][n] = (f32x4){0.f, 0.f, 0.f, 0.f};
    bf16x8 At[4][2], B0[2][2], B1[2][2];
    const char* cA = (const char*)g.A + (size_t)cur.pm * tstep; const char* cB = (const char*)g.Bt + (size_t)cur.pn * tstep;
    S.a_ready(cur);
    if constexpr (SP2) {
        PG8_STAGE(PG8_SB(0, 0), cB, voffB); PG8_STAGE(PG8_SB(0, 1), cB + hstep, voffB); PG8_STAGE(PG8_SA(0, 0), cA, voffA); PG8_STAGE(PG8_SA(0, 1), cA + hstep, voffA);
        if (wr == 1) PG8_BAR;
        PG8_WAIT_V(2); PG8_BAR;
        PG8_STAGE(PG8_SB(1, 0), cB + kstep, voffB); PG8_STAGE(PG8_SA(1, 0), cA + kstep, voffA); PG8_STAGE(PG8_SB(1, 1), cB + hstep + kstep, voffB);
        PG8_WAIT_V(6); PG8_BAR;
    } else {
        PG8_STAGE(PG8_SB(0, 0), cB, voffB); PG8_STAGE(PG8_SA(0, 0), cA, voffA); PG8_STAGE(PG8_SB(0, 1), cB + hstep, voffB); PG8_STAGE(PG8_SA(0, 1), cA + hstep, voffA);
        if (wr == 1) PG8_BAR;
        PG8_WAIT_V(4); PG8_BAR;
        PG8_STAGE(PG8_SB(1, 0), cB + kstep, voffB); PG8_STAGE(PG8_SA(1, 0), cA + kstep, voffA); PG8_STAGE(PG8_SB(1, 1), cB + hstep + kstep, voffB);
        PG8_WAIT_V(6); PG8_BAR;
    }
    for (;;) {
        const bool has_next = S.next(ui + 1, nxt);
        const char* nA = has_next ? (const char*)g.A + (size_t)nxt.pm * tstep : cA; const char* nB = has_next ? (const char*)g.Bt + (size_t)nxt.pn * tstep : cB;
        for (int t = 0; t < nt; t += 2) {
            const bool last = (t == nt - 2);
            const char* a1 = cA + (size_t)(t + 1) * kstep;
            const char* a2 = last ? nA : cA + (size_t)(t + 2) * kstep; const char* b2 = last ? nB : cB + (size_t)(t + 2) * kstep;
            const char* a3 = a2 + kstep; const char* b3 = b2 + kstep;
            if (last && has_next) S.a_ready(nxt);
            if constexpr (SP2) {
            PG8_LDB(B0, 0, 0); PG8_LDB(B1, 0, 1); PG8_SCHED; PG8_LDA(At, 0, 0); PG8_STAGE(PG8_SA(1, 1), a1 + hstep, voffA);
            PG8_WAIT_V(8); PG8_WAIT_L(0); PG8_BAR; PG8_MMA(0, 0, At, B0); PG8_MMA(0, 1, At, B1); PG8_BAR; PG8_SCHED;
            PG8_LDA(At, 0, 1); PG8_STAGE(PG8_SB(0, 0), b2, voffB); PG8_STAGE(PG8_SB(0, 1), b2 + hstep, voffB); PG8_STAGE(PG8_SA(0, 0), a2, voffA);
            PG8_WAIT_V(8); PG8_WAIT_L(0); PG8_BAR; PG8_MMA(1, 0, At, B0); PG8_MMA(1, 1, At, B1); PG8_BAR; PG8_SCHED;
            PG8_LDB(B0, 1, 0); PG8_LDB(B1, 1, 1); PG8_SCHED; PG8_LDA(At, 1, 0); PG8_STAGE(PG8_SA(0, 1), a2 + hstep, voffA);
            PG8_WAIT_V(8); PG8_WAIT_L(0); PG8_BAR; PG8_MMA(0, 0, At, B0); PG8_MMA(0, 1, At, B1); PG8_BAR; PG8_SCHED;
            PG8_LDA(At, 1, 1); PG8_STAGE(PG8_SB(1, 0), b3, voffB); PG8_STAGE(PG8_SB(1, 1), b3 + hstep, voffB); PG8_STAGE(PG8_SA(1, 0), a3, voffA);
            PG8_WAIT_V(8); PG8_WAIT_L(0); PG8_BAR; PG8_MMA(1, 0, At, B0); PG8_MMA(1, 1, At, B1); PG8_BAR; PG8_SCHED;
            } else {
            PG8_LDB(B0, 0, 0); PG8_SCHED; PG8_LDA(At, 0, 0); PG8_STAGE(PG8_SA(1, 1), a1 + hstep, voffA);
            PG8_WAIT_L(8); PG8_BAR; PG8_WAIT_L(0); PG8_MMA(0, 0, At, B0); PG8_BAR; PG8_SCHED;
            PG8_LDB(B1, 0, 1); PG8_STAGE(PG8_SB(0, 0), b2, voffB);
            PG8_BAR; PG8_WAIT_L(0); PG8_MMA(0, 1, At, B1); PG8_BAR;
            PG8_LDA(At, 0, 1); PG8_STAGE(PG8_SA(0, 0), a2, voffA);
            PG8_BAR; PG8_WAIT_L(0); PG8_MMA(1, 0, At, B0); PG8_BAR; PG8_SCHED;
            PG8_STAGE(PG8_SB(0, 1), b2 + hstep, voffB);
            PG8_WAIT_V(6); PG8_BAR; PG8_MMA(1, 1, At, B1); PG8_BAR;
            PG8_LDB(B0, 1, 0); PG8_SCHED; PG8_LDA(At, 1, 0); PG8_STAGE(PG8_SA(0, 1), a2 + hstep, voffA);
            PG8_WAIT_L(8); PG8_BAR; PG8_WAIT_L(0); PG8_MMA(0, 0, At, B0); PG8_BAR; PG8_SCHED;
            PG8_LDB(B1, 1, 1); PG8_STAGE(PG8_SB(1, 0), b3, voffB);
            PG8_BAR; PG8_WAIT_L(0); PG8_MMA(0, 1, At, B1); PG8_BAR;
            PG8_LDA(At, 1, 1); PG8_STAGE(PG8_SA(1, 0), a3, voffA);
            PG8_BAR; PG8_WAIT_L(0); PG8_MMA(1, 0, At, B0); PG8_BAR; PG8_SCHED;
            PG8_STAGE(PG8_SB(1, 1), b3 + hstep, voffB);
            PG8_WAIT_V(6); PG8_BAR; PG8_MMA(1, 1, At, B1); PG8_BAR;
            }
        }
        if constexpr (ALIGN_EPI) { if (wr == 0) PG8_BAR; }
        if constexpr (!Epi::AFTER_DRAIN) { E(acc, cur, wr, wc, fr, fq); S.done(cur); }
        if (!has_next) break;
#pragma unroll
        for (int a = 0; a < 2; ++a)
#pragma unroll
            for (int b = 0; b < 2; ++b)
#pragma unroll
                for (int m = 0; m < 4; ++m)
#pragma unroll
                    for (int n = 0; n < 2; ++n) acc[a][b][m][n] = (f32x4){0.f, 0.f, 0.f, 0.f};
        cur = nxt; cA = nA; cB = nB; ++ui;
        if constexpr (ALIGN_EPI) { if (wr == 1) PG8_BAR; }
    }
    PG8_WAIT_V(0);
    if constexpr (!ALIGN_EPI) { if (wr == 0) PG8_BAR; }
    PG8_BAR;
    if constexpr (Epi::AFTER_DRAIN) { E.fused(acc, cur, wr, wc, fr, fq, lds, wid, lane); S.done(cur); }
#undef PG8_SA
#undef PG8_SB
#undef PG8_STAGE
#undef PG8_LDA
#undef PG8_LDB
#undef PG8_MMA
#undef PG8_WAIT_V
#undef PG8_WAIT_L
#undef PG8_BAR
#undef PG8_SCHED
}
}

constexpr int NWAVES = 8, NTHR = 512;
constexpr int MP = 8192, MS = 1024, MTOT = 9216, DM = 2048;
constexpr int SEQ = 2048, DECS = 8, DECB = 128;
constexpr int NPROJ = 7168, DIN = 7184, DFF = 5632, NUP = 11264, NGLU = 4096;
constexpr int C_QA = 0, C_KA = 1024, C_VA = 2048, C_ZA = 3072, C_QB = 4096, C_KB = 4608, C_VB = 5120, C_GB = 6144;
constexpr float EPS = 1e-6f;
constexpr size_t MiB = 1u << 20;
constexpr size_t WS_CTL = 0;
constexpr size_t WS_WIN = 1 * MiB;
constexpr size_t WS_WOUT = WS_WIN + 28 * MiB;
constexpr size_t WS_WUP = WS_WOUT + 8 * MiB;
constexpr size_t WS_WDN = WS_WUP + 88 * MiB;
constexpr size_t WS_WGLU = WS_WDN + 44 * MiB;
constexpr size_t WS_X = WS_WGLU + 16 * MiB;
constexpr size_t WS_H = WS_X + 72 * MiB;
constexpr size_t WS_G2 = WS_H + 36 * MiB;
constexpr size_t WS_GATE = WS_G2 + 36 * MiB;
constexpr size_t WS_TAB = WS_GATE + 1 * MiB;
constexpr size_t WS_BIG = WS_TAB + 2 * MiB;
constexpr size_t WS_OA = WS_BIG + 126 * MiB, WS_OB = WS_OA + 36 * MiB;
constexpr size_t WS_ACT = WS_BIG + 198 * MiB;
constexpr size_t WS_END = WS_ACT + 99 * MiB;
constexpr size_t WS_UG0 = WS_BIG + 64 * MiB;
constexpr size_t O_Y = 0, O_GDN_P = 18874368, O_GDN_S = O_GDN_P + 524288, O_GCB_P = O_GDN_S + 16777216, O_GCB_S = O_GCB_P + 36864,
                 O_RET_P = O_GCB_S + 1179648, O_RET_S = O_RET_P + 524288, O_S5R_P = O_RET_S + 16777216, O_S5R_S = O_S5R_P + 32768,
                 O_S5I_P = O_S5R_S + 1048576, O_S5I_S = O_S5I_P + 32768, O_FCB_P = O_S5I_S + 1048576, O_FCB_S = O_FCB_P + 180224, O_END = O_FCB_S + 5767168;

constexpr int LDS_BYTES = 148480 + 512;
constexpr int MISC_OFF = 148480;
#define LAS __attribute__((address_space(3)))
typedef unsigned short bf16;
typedef float f32x4 __attribute__((ext_vector_type(4)));
typedef unsigned u32x4 __attribute__((ext_vector_type(4)));
typedef unsigned u32x2 __attribute__((ext_vector_type(2)));
#define LDS_WAIT() asm volatile("s_waitcnt lgkmcnt(0)" ::: "memory")

struct Args { const float* in[32]; float* out; unsigned char* ws; int ph_lo, ph_hi; };
enum { I_XP = 0, I_XS, I_SGDN, I_SGCB, I_SRET, I_S5RE, I_S5IM, I_SFCB, I_NMIX, I_NFFN, I_NFIN, I_WIN, I_GCW, I_GALOG, I_GDTB, I_GNW, I_RGW, I_RGB, I_WOUT,
       I_LRE, I_LIM, I_LDT, I_BRE, I_BIM, I_CRE, I_CIM, I_S5D, I_WGLU, I_WUP, I_FCW, I_FCBIAS, I_WDN };

__device__ __forceinline__ float wave_sum(float v) {
#pragma unroll
    for (int o = 1; o < 64; o <<= 1) v += __shfl_xor(v, o);
    return v;
}
__device__ __forceinline__ unsigned f2bf(float f) { unsigned u = __builtin_bit_cast(unsigned, f); return (u + 0x7fffu + ((u >> 16) & 1u)) >> 16; }
__device__ __forceinline__ unsigned pk2(float lo, float hi) { return f2bf(lo) | (f2bf(hi) << 16); }
__device__ __forceinline__ float bf2f(unsigned short b) { return __builtin_bit_cast(float, (unsigned)b << 16); }
__device__ __forceinline__ void unpack8(const u32x4 w, float (&f)[8]) {
    f[0] = __builtin_bit_cast(float, w.x << 16); f[1] = __builtin_bit_cast(float, w.x & 0xffff0000u);
    f[2] = __builtin_bit_cast(float, w.y << 16); f[3] = __builtin_bit_cast(float, w.y & 0xffff0000u);
    f[4] = __builtin_bit_cast(float, w.z << 16); f[5] = __builtin_bit_cast(float, w.z & 0xffff0000u);
    f[6] = __builtin_bit_cast(float, w.w << 16); f[7] = __builtin_bit_cast(float, w.w & 0xffff0000u);
}
__device__ __forceinline__ void ld_bf8(const bf16* p, float (&f)[8]) { unpack8(*(const u32x4*)p, f); }
__device__ __forceinline__ void ld_f8(const float* p, float (&f)[8]) { const f32x4 a = *(const f32x4*)p, b = *(const f32x4*)(p + 4); f[0] = a[0]; f[1] = a[1]; f[2] = a[2]; f[3] = a[3]; f[4] = b[0]; f[5] = b[1]; f[6] = b[2]; f[7] = b[3]; }
__device__ __forceinline__ void st_bf8(bf16* p, const float (&f)[8]) { u32x4 w; w.x = pk2(f[0], f[1]); w.y = pk2(f[2], f[3]); w.z = pk2(f[4], f[5]); w.w = pk2(f[6], f[7]); *(u32x4*)p = w; }
__device__ __forceinline__ float silu_f(float x) { return x / (1.0f + expf(-x)); }
__device__ __forceinline__ float sigmoid_f(float x) { return 1.0f / (1.0f + expf(-x)); }
__device__ __forceinline__ float softplus_f(float x) { return x > 20.f ? x : log1pf(expf(x)); }
__device__ __forceinline__ float gelu_tanh_fast(float y) { const float z = 0.7978845608028654f * (y + 0.044715f * y * y * y); const float e = __builtin_amdgcn_exp2f(z * 2.8853900817779268f); return y * (1.0f - __builtin_amdgcn_rcpf(e + 1.0f)); }
__device__ __forceinline__ float gelu_tanh(float y) { const float z = 0.7978845608028654f * (y + 0.044715f * y * y * y); const float th = 1.0f - 2.0f / (expf(2.0f * z) + 1.0f); return 0.5f * y * (1.0f + th); }
__device__ __forceinline__ void sincos_d(double a, double& s, double& c) {
    const double n = rint(a * 0.63661977236758134308);
    double r = fma(-n, 1.57079632679489655800e+00, a); r = fma(-n, 6.12323399573676603587e-17, r);
    const double r2 = r * r;
    double ps = 1.0 / 6227020800.0; ps = fma(ps, r2, -1.0 / 39916800.0); ps = fma(ps, r2, 1.0 / 362880.0); ps = fma(ps, r2, -1.0 / 5040.0); ps = fma(ps, r2, 1.0 / 120.0); ps = fma(ps, r2, -1.0 / 6.0); ps = fma(ps * r2, r, r);
    double pc = 1.0 / 479001600.0; pc = fma(pc, r2, -1.0 / 3628800.0); pc = fma(pc, r2, 1.0 / 40320.0); pc = fma(pc, r2, -1.0 / 720.0); pc = fma(pc, r2, 1.0 / 24.0); pc = fma(pc, r2, -0.5); pc = fma(pc, r2, 1.0);
    const int q = (int)(long long)n & 3;
    s = (q == 0) ? ps : (q == 1) ? pc : (q == 2) ? -ps : -pc;
    c = (q == 0) ? pc : (q == 1) ? -ps : (q == 2) ? -pc : ps;
}

#define GAS __attribute__((address_space(1)))
constexpr int CW_BAR = 4096;
constexpr size_t CTL_ZERO_BYTES = 524288;
constexpr size_t WS_SS = WS_CTL + 262144;
#define XB_TMO      128
#define XB_XCNT(j)  (256  + 64 * (j))
#define XB_XSUB(j)  (1280 + 64 * (j))
#define XB_XGEN(j)  (2304 + 64 * (j))
#define XB_TOP      3328
#define XB_TOPGEN   3392
#define XCD_BAR_WORDS 3456
#define XB_SPIN_CAP (1u << 18)

__device__ __forceinline__ unsigned xb_ld(unsigned* p)              { return __hip_atomic_load(p, __ATOMIC_RELAXED, __HIP_MEMORY_SCOPE_AGENT); }
__device__ __forceinline__ unsigned xb_add(unsigned* p, unsigned v) { return __hip_atomic_fetch_add(p, v, __ATOMIC_RELAXED, __HIP_MEMORY_SCOPE_AGENT); }
__device__ __forceinline__ unsigned xb_xcc_id() { return (unsigned)__builtin_amdgcn_s_getreg((3 << 11) | 20) & 0xFu; }
#define XB_SPIN(cond, bar) do { unsigned _sp = 0; while (cond) { __builtin_amdgcn_s_sleep(1); \
    if ((++_sp & 255u) == 0u) { if (xb_ld(&(bar)[XB_TMO])) break; if (_sp > XB_SPIN_CAP) { atomicAdd(&(bar)[XB_TMO], 1u); break; } } } } while (0)

struct XcdBarrier {
    unsigned* bar; unsigned x;
    volatile LAS unsigned* st;
};

__device__ __forceinline__ XcdBarrier xcd_barrier_post(unsigned* bar, volatile LAS unsigned* st) {
    XcdBarrier b; b.bar = bar; b.x = xb_xcc_id(); b.st = st;
    if (threadIdx.x == 0) (void)xb_add(&bar[XB_XCNT(b.x)], 1u);
    return b;
}
__device__ __forceinline__ void xcd_barrier_complete(unsigned* bar, unsigned x, unsigned& nloc, unsigned& nx) {
    const unsigned G = gridDim.x * gridDim.y * gridDim.z;
    unsigned sum, cnt, mine, sp = 0u;
    for (;;) {
        sum = 0u; cnt = 0u; mine = 0u;
#pragma unroll
        for (unsigned j = 0; j < 16; ++j) { const unsigned c = xb_ld(&bar[XB_XCNT(j)]); sum += c; cnt += (c > 0u) ? 1u : 0u; mine = (j == x) ? c : mine; }
        if (sum == G) break;
        __builtin_amdgcn_s_sleep(1);
        if ((++sp & 255u) == 0u) { if (xb_ld(&bar[XB_TMO])) break; if (sp > XB_SPIN_CAP) { atomicAdd(&bar[XB_TMO], 1u); break; } }
    }
    nloc = mine > 0u ? mine : 1u; nx = cnt > 0u ? cnt : 1u;
}

__device__ __forceinline__ void xcd_barrier(const XcdBarrier& b) {
    asm volatile("s_waitcnt vmcnt(0)" ::: "memory");
    __syncthreads();
    if (threadIdx.x == 0) {
        unsigned* bar = b.bar;
        __builtin_amdgcn_s_waitcnt(0);
        unsigned nloc = b.st[0], nx = b.st[1];
        if (nloc == 0u) { xcd_barrier_complete(bar, b.x, nloc, nx); b.st[0] = nloc; b.st[1] = nx; }
        const unsigned old = xb_add(&bar[XB_XSUB(b.x)], 1u);
        const unsigned gen = old / nloc;
        if (old + 1u == (gen + 1u) * nloc) {
            __builtin_amdgcn_fence(__ATOMIC_RELEASE, "agent");
            asm volatile("s_waitcnt vmcnt(0)" ::: "memory");
            const unsigned og = xb_add(&bar[XB_TOP], 1u);
            const unsigned tg = og / nx;
            if (og + 1u == (tg + 1u) * nx) xb_add(&bar[XB_TOPGEN], 1u);
            else XB_SPIN(xb_ld(&bar[XB_TOPGEN]) == tg, bar);
            __builtin_amdgcn_fence(__ATOMIC_ACQUIRE, "agent");
            xb_add(&bar[XB_XGEN(b.x)], 1u);
            asm volatile("s_waitcnt vmcnt(0)" ::: "memory");
        } else {
            XB_SPIN(xb_ld(&bar[XB_XGEN(b.x)]) == gen, bar);
            __builtin_amdgcn_fence(__ATOMIC_ACQUIRE, "agent");
            asm volatile("s_waitcnt vmcnt(0)" ::: "memory");
        }
    }
    __syncthreads();
}


__device__ __forceinline__ void transpose_item(const float* W, int ldw, int src_col0, int k0, bf16* WT, int K, int dst_row0, LAS float* scr, int lane, const float* ksc = nullptr) {
    float wv[32];
    { const float* wp = W + (size_t)(k0 + (lane >> 5)) * ldw + src_col0 + (lane & 31);
#pragma unroll
      for (int i = 0; i < 32; ++i) wv[i] = __builtin_nontemporal_load(wp + (size_t)(2 * i) * ldw); }
#pragma unroll
    for (int i = 0; i < 32; ++i) scr[(2 * i + (lane >> 5)) * 33 + (lane & 31)] = wv[i];
    const int c = lane & 7;
    f32x4 s0 = {1.f, 1.f, 1.f, 1.f}, s1 = {1.f, 1.f, 1.f, 1.f};
    if (ksc) { s0 = *(const f32x4*)(ksc + k0 + 8 * c); s1 = *(const f32x4*)(ksc + k0 + 8 * c + 4); }
    LDS_WAIT(); asm volatile("" ::: "memory");
#pragma unroll
    for (int j = 0; j < 4; ++j) { const int n = (lane >> 3) + 8 * j; const LAS float* s = scr + (8 * c) * 33 + n;
        u32x4 o; o.x = pk2(s[0 * 33] * s0[0], s[1 * 33] * s0[1]); o.y = pk2(s[2 * 33] * s0[2], s[3 * 33] * s0[3]); o.z = pk2(s[4 * 33] * s1[0], s[5 * 33] * s1[1]); o.w = pk2(s[6 * 33] * s1[2], s[7 * 33] * s1[3]);
        *(u32x4*)(WT + (size_t)(dst_row0 + n) * K + k0 + 8 * c) = o; }
    LDS_WAIT(); asm volatile("" ::: "memory");
}
__device__ __forceinline__ int ileave_src(int n0, int half) { const int t = n0 >> 8, w = n0 & 255; return (w < 128) ? t * 128 + w : half + t * 128 + (w - 128); }

__device__ __forceinline__ void convert_group(const Args& a, int group, LAS float* scr, int lane, int w, int nw) {
    unsigned char* ws = a.ws;
    constexpr int I_IN = 32 * 224, I_OUT = 32 * 64, I_UP = 32 * 352, I_DN = 88 * 64, I_GLU = 32 * 128;
    if (group == 0) {
        for (int r = w; r < I_IN; r += nw) { const int kb = r / 224, n0 = 32 * (r % 224); transpose_item(a.in[I_WIN], DIN, n0 < 4096 ? n0 : n0 + 16, 64 * kb, (bf16*)(ws + WS_WIN), 2048, n0, scr, lane); }
    } else {
        const int l = (group == 2) ? 1 : 0, I_A = (l == 0) ? I_OUT : I_GLU;
        const int lo_ = (group == 3) ? I_A : 0, hi_ = (group == 1) ? I_A : I_A + I_UP + I_DN;
        for (int it = lo_ + w; it < hi_; it += nw) {
            int r = it;
            if (r < I_A) { if (l == 0) { const int kb = r / 64, n0 = 32 * (r % 64); transpose_item(a.in[I_WOUT], 2048, n0, 64 * kb, (bf16*)(ws + WS_WOUT), 2048, n0, scr, lane); }
                           else { const int kb = r / 128, n0 = 32 * (r % 128); transpose_item(a.in[I_WGLU], NGLU, ileave_src(n0, 2048), 64 * kb, (bf16*)(ws + WS_WGLU), 2048, n0, scr, lane); }
                           continue; } r -= I_A;
            if (r < I_UP) { const int kb = r / 352, n0 = 32 * (r % 352);
                transpose_item(a.in[I_WUP] + (size_t)l * 2048 * NUP, NUP, ileave_src(n0, DFF), 64 * kb, (bf16*)(ws + WS_WUP) + (size_t)l * NUP * 2048, 2048, n0, scr, lane, a.in[I_NFFN] + l * DM); continue; } r -= I_UP;
            { const int kb = r / 64, n0 = 32 * (r % 64); transpose_item(a.in[I_WDN] + (size_t)l * DFF * 2048, 2048, n0, 64 * kb, (bf16*)(ws + WS_WDN) + (size_t)l * 2048 * DFF, DFF, n0, scr, lane); }
        }
    }
}
constexpr int PRO_REP = 0;
__device__ __forceinline__ void ph_prologue(const Args& a, LAS unsigned char* lds, int tid, int lane, int wave, int gw, int NGW, int G) {
    unsigned char* ws = a.ws;
    for (int rp = 0; rp < (PRO_REP == 1 ? 2 : 1); ++rp)
    {   LAS float* scr = (LAS float*)(lds + wave * 8704);
        convert_group(a, 0, scr, lane, gw, NGW);
        if (G != 256) { convert_group(a, 1, scr, lane, gw, NGW); convert_group(a, 3, scr, lane, gw, NGW); convert_group(a, 2, scr, lane, gw, NGW); }
    }
    for (int rp = 0; rp < (PRO_REP == 2 ? 2 : 1); ++rp)
    {
        float* tab = (float*)(ws + WS_TAB);
        for (int idx = gw * 64 + lane; idx < 2056 * 64; idx += NGW * 64) { const int i = idx & 63, slot = idx >> 6; const int pos = slot < 2048 ? slot : 16384 + (slot - 2048);
            double s, c; sincos_d((double)pos * exp(-(double)i * (9.210340371976184 / 64.0)), s, c); tab[slot * 128 + i] = (float)c; tab[slot * 128 + 64 + i] = (float)s; }
    }
    __syncthreads();
    LAS float* WgT = (LAS float*)lds;
    {   f32x4 wg[4][4];
#pragma unroll
        for (int i = 0; i < 4; ++i)
#pragma unroll
            for (int j = 0; j < 4; ++j) wg[i][j] = *(const f32x4*)(a.in[I_WIN] + (size_t)(tid + 512 * i) * DIN + 4096 + 4 * j);
#pragma unroll
        for (int i = 0; i < 4; ++i)
#pragma unroll
            for (int j = 0; j < 4; ++j)
#pragma unroll
                for (int e = 0; e < 4; ++e) WgT[(4 * j + e) * 2048 + tid + 512 * i] = wg[i][j][e]; }
    __syncthreads();
    bf16* H = (bf16*)(ws + WS_H); float* GATE = (float*)(ws + WS_GATE);
    const float* nw = a.in[I_NMIX];
    const bool b5 = lane & 32, b4 = lane & 16, b3 = lane & 8, b2 = lane & 4;
    const int hme = (b5 ? 8 : 0) + (b4 ? 4 : 0) + (b3 ? 2 : 0) + (b2 ? 1 : 0);
    const float galog = a.in[I_GALOG][hme & 7], gdtb = a.in[I_GDTB][hme & 7];
    f32x4 nwr[8];
#pragma unroll
    for (int j = 0; j < 8; ++j) nwr[j] = ((const f32x4*)nw)[lane + 64 * j];
    for (int rp = 0; rp < (PRO_REP == 3 ? 2 : 1); ++rp) {
    f32x4 vn[8];
    { const int m = gw; const float* xr = (m < MP) ? a.in[I_XP] + (size_t)m * DM : a.in[I_XS] + (size_t)(m - MP) * DM;
#pragma unroll
      for (int j = 0; j < 8; ++j) vn[j] = ((const f32x4*)xr)[lane + 64 * j]; }
    for (int m = gw; m < MTOT; m += NGW) {
        f32x4 v[8]; float ss = 0.f;
#pragma unroll
        for (int j = 0; j < 8; ++j) { v[j] = vn[j]; ss += (v[j][0] * v[j][0] + v[j][1] * v[j][1]) + (v[j][2] * v[j][2] + v[j][3] * v[j][3]); }
        { const int mn = (m + NGW < MTOT) ? m + NGW : m;
          const float* xr = (mn < MP) ? a.in[I_XP] + (size_t)mn * DM : a.in[I_XS] + (size_t)(mn - MP) * DM;
#pragma unroll
          for (int j = 0; j < 8; ++j) vn[j] = ((const f32x4*)xr)[lane + 64 * j]; }
        const float rstd = 1.0f / sqrtf(wave_sum(ss) * (1.0f / DM) + EPS);
#pragma unroll
        for (int j = 0; j < 8; ++j) { v[j] = v[j] * rstd * nwr[j];
            u32x2 o; o.x = pk2(v[j][0], v[j][1]); o.y = pk2(v[j][2], v[j][3]); ((u32x2*)(H + (size_t)m * DM))[lane + 64 * j] = o; }
        float gs_[16];
#pragma unroll
        for (int h = 0; h < 16; ++h) { float s = 0.f;
#pragma unroll
            for (int j = 0; j < 8; ++j) { const f32x4 w4 = *(const LAS f32x4*)(WgT + h * 2048 + 4 * lane + 256 * j); s += (v[j][0] * w4[0] + v[j][1] * w4[1]) + (v[j][2] * w4[2] + v[j][3] * w4[3]); }
            gs_[h] = s; if (h & 1) asm volatile("" ::: "memory"); }
        {   float k8[8], k4[4], k2[2], y;
#pragma unroll
            for (int i = 0; i < 8; ++i) { const float send = b5 ? gs_[i] : gs_[8 + i], keep = b5 ? gs_[8 + i] : gs_[i]; k8[i] = keep + __shfl_xor(send, 32); }
#pragma unroll
            for (int i = 0; i < 4; ++i) { const float send = b4 ? k8[i] : k8[4 + i], keep = b4 ? k8[4 + i] : k8[i]; k4[i] = keep + __shfl_xor(send, 16); }
#pragma unroll
            for (int i = 0; i < 2; ++i) { const float send = b3 ? k4[i] : k4[2 + i], keep = b3 ? k4[2 + i] : k4[i]; k2[i] = keep + __shfl_xor(send, 8); }
            { const float send = b2 ? k2[0] : k2[1], keep = b2 ? k2[1] : k2[0]; y = keep + __shfl_xor(send, 4); }
            y += __shfl_xor(y, 2); y += __shfl_xor(y, 1);
            if ((lane & 3) == 0) { float o; if (hme < 8) o = -expf(galog) * softplus_f(y + gdtb); else o = sigmoid_f(y); GATE[m * 16 + hme] = o; } }
    }
    }
    __syncthreads();
}

__device__ __forceinline__ void ph_rms_rows(const float* X, const float* nw, bf16* H, int lane, int gw, int NGW) {
    for (int m = gw; m < MTOT; m += NGW) {
        f32x4 v[8]; float ss = 0.f;
#pragma unroll
        for (int j = 0; j < 8; ++j) { v[j] = ((const f32x4*)(X + (size_t)m * DM))[lane + 64 * j]; ss += (v[j][0] * v[j][0] + v[j][1] * v[j][1]) + (v[j][2] * v[j][2] + v[j][3] * v[j][3]); }
        const float rstd = 1.0f / sqrtf(wave_sum(ss) * (1.0f / DM) + EPS);
#pragma unroll
        for (int j = 0; j < 8; ++j) { const f32x4 w4 = ((const f32x4*)nw)[lane + 64 * j]; v[j] = v[j] * rstd * w4;
            u32x2 o; o.x = pk2(v[j][0], v[j][1]); o.y = pk2(v[j][2], v[j][3]); ((u32x2*)(H + (size_t)m * DM))[lane + 64 * j] = o; }
    }
}
__device__ __forceinline__ void ph_rms_out(const float* X, const float* SS, const float* SLAB, const float* nw, float* Y, int lane, int gw, int NGW) {
    f32x4 w[8];
#pragma unroll
    for (int j = 0; j < 8; ++j) w[j] = ((const f32x4*)nw)[lane + 64 * j];
    for (int m = gw; m < MTOT; m += NGW) {
        f32x4 v[8];
#pragma unroll
        for (int j = 0; j < 8; ++j) v[j] = ((const f32x4*)(X + (size_t)m * DM))[lane + 64 * j];
        float rstd;
        if (m < MP) rstd = 1.0f / sqrtf(SS[m] * (1.0f / DM) + EPS);
        else {
            f32x4 sl[8][4];
#pragma unroll
            for (int j = 0; j < 8; ++j)
#pragma unroll
                for (int k = 0; k < 4; ++k) sl[j][k] = ((const f32x4*)(SLAB + ((size_t)k * MS + (m - MP)) * DM))[lane + 64 * j];
            float ss = 0.f;
#pragma unroll
            for (int j = 0; j < 8; ++j) { v[j] = v[j] + ((sl[j][0] + sl[j][1]) + (sl[j][2] + sl[j][3]));
                ss += (v[j][0] * v[j][0] + v[j][1] * v[j][1]) + (v[j][2] * v[j][2] + v[j][3] * v[j][3]); }
            rstd = 1.0f / sqrtf(wave_sum(ss) * (1.0f / DM) + EPS);
        }
#pragma unroll
        for (int j = 0; j < 8; ++j) ((f32x4*)(Y + (size_t)m * DM))[lane + 64 * j] = v[j] * rstd * w[j];
    }
}

template <bool GLU>
__device__ __forceinline__ void ph_combine(float* X, bf16* XB, float* SS, const float* SLAB, int lane, int gw, int NGW, bf16* UGW = nullptr, const float* NW = nullptr) {
    constexpr int LDS_ = GLU ? NGLU : DM;
    for (int mr = gw; mr < MS; mr += NGW) {
        const size_t m = (size_t)MP + mr; float ss = 0.f;
        f32x4 xk[8];
#pragma unroll
        for (int jh = 0; jh < 2; ++jh) {
            f32x4 sv[4][4], sg[4][4];
#pragma unroll
            for (int jj = 0; jj < 4; ++jj) { const int j = 4 * jh + jj, c = 4 * (lane + 64 * j);
                xk[j] = *(const f32x4*)(X + m * DM + c);
                const int sc = GLU ? ((c >> 7) << 8) + (c & 127) : c;
#pragma unroll
                for (int k = 0; k < 4; ++k) { const float* sp = SLAB + ((size_t)k * MS + mr) * LDS_ + sc; sv[jj][k] = *(const f32x4*)sp; if (GLU) sg[jj][k] = *(const f32x4*)(sp + 128); } }
#pragma unroll
            for (int jj = 0; jj < 4; ++jj) { const int j = 4 * jh + jj, c = 4 * (lane + 64 * j);
                f32x4 x = xk[j];
                if (GLU) { const f32x4 v = (sv[jj][0] + sv[jj][1]) + (sv[jj][2] + sv[jj][3]), g = (sg[jj][0] + sg[jj][1]) + (sg[jj][2] + sg[jj][3]);
#pragma unroll
                    for (int e = 0; e < 4; ++e) x[e] += v[e] / (1.0f + __expf(-g[e]));
                } else x = x + ((sv[jj][0] + sv[jj][1]) + (sv[jj][2] + sv[jj][3]));
                xk[j] = x; ss += (x[0] * x[0] + x[1] * x[1]) + (x[2] * x[2] + x[3] * x[3]);
                *(f32x4*)(X + m * DM + c) = x;
                u32x2 o; o.x = pk2(x[0], x[1]); o.y = pk2(x[2], x[3]); *(u32x2*)(XB + m * DM + c) = o; }
        }
        ss = wave_sum(ss);
        if (lane == 0) SS[m] = ss;
        if (UGW) {
            const float rs = __builtin_amdgcn_rsqf(ss * (1.0f / DM) + EPS);
            f32x4 w4[8];
#pragma unroll
            for (int j = 0; j < 8; ++j) w4[j] = *(const f32x4*)(NW + 4 * (lane + 64 * j));
#pragma unroll
            for (int j = 0; j < 8; ++j) { const int c = 4 * (lane + 64 * j); const f32x4 x = xk[j];
                u32x2 o; o.x = pk2(x[0] * rs * w4[j][0], x[1] * rs * w4[j][1]); o.y = pk2(x[2] * rs * w4[j][2], x[3] * rs * w4[j][3]);
                *(u32x2*)(UGW + ((size_t)(c >> 4) * MTOT + m) * 16 + (c & 15)) = o; }
        }
    }
}
__device__ __forceinline__ void ph_ug_prompt(const bf16* XB, const float* SS, const float* NW, bf16* UG, int lane, int gw, int NGW) {
    float wv[32];
#pragma unroll
    for (int i = 0; i < 8; ++i) { const f32x4 w4 = *(const f32x4*)(NW + 32 * lane + 4 * i); wv[4 * i] = w4[0]; wv[4 * i + 1] = w4[1]; wv[4 * i + 2] = w4[2]; wv[4 * i + 3] = w4[3]; }
    for (int m = gw; m < MP; m += NGW) {
        u32x4 raw[4];
#pragma unroll
        for (int i = 0; i < 4; ++i) raw[i] = *(const u32x4*)(XB + (size_t)m * DM + 32 * lane + 8 * i);
        const float rs = __builtin_amdgcn_rsqf(SS[m] * (1.0f / DM) + EPS);
#pragma unroll
        for (int i = 0; i < 4; ++i) { float x[8]; unpack8(raw[i], x);
#pragma unroll
            for (int j = 0; j < 8; ++j) x[j] = x[j] * rs * wv[8 * i + j];
            st_bf8(UG + ((size_t)(2 * lane + (i >> 1)) * MTOT + m) * 16 + 8 * (i & 1), x); }
    }
}

typedef short bf16x8 __attribute__((ext_vector_type(8)));
constexpr int GREC_WN = 0, GREC_QD = 16384, GREC_QK = 32768, GREC_KD = 40960, GREC_IMG = 57344, GREC_UT = 57344, GREC_BYTES = 90112;
constexpr int RREC_QD = 0, RREC_QK = 16384, RREC_KD = 24576, RREC_IMG = 40960, RREC_VT = 40960, RREC_BYTES = 73728;
constexpr size_t WS_GREC = WS_ACT, WS_RREC = WS_G2, WS_GL = WS_CTL + 131072;
constexpr size_t WS_QKS = WS_H, WS_VAS = WS_H + 8 * MiB;
__device__ __forceinline__ int kpos(int k) { return (k & ~31) | (((k >> 2) & 3) << 3) | (((k >> 4) & 1) << 2) | (k & 3); }
__device__ __forceinline__ int addr256(int row, int chunk) { return row * 256 + ((chunk ^ (row & 15)) << 4); }
__device__ __forceinline__ int addr128(int row, int chunk) { return row * 128 + ((chunk ^ ((row >> 1) & 7)) << 4); }
__device__ __forceinline__ unsigned cvtpk(float lo, float hi) { unsigned r; asm volatile("v_cvt_pk_bf16_f32 %0, %1, %2" : "=v"(r) : "v"(lo), "v"(hi)); return r; }
__device__ __forceinline__ bf16x8 pack_tiles(const f32x4 lo, const f32x4 hi) { u32x4 w; w.x = cvtpk(lo[0], lo[1]); w.y = cvtpk(lo[2], lo[3]); w.z = cvtpk(hi[0], hi[1]); w.w = cvtpk(hi[2], hi[3]); return __builtin_bit_cast(bf16x8, w); }
#define MFMA16(a, b, c) __builtin_amdgcn_mfma_f32_16x16x32_bf16((a), (b), (c), 0, 0, 0)

__device__ __forceinline__ void img256_put8(unsigned char* img, int row, int grp, const float (&v)[8]) {
    const int s = grp >> 2, t = (grp >> 1) & 1, qq0 = (grp & 1) * 2;
    u32x2 p0, p1; p0.x = pk2(v[0], v[1]); p0.y = pk2(v[2], v[3]); p1.x = pk2(v[4], v[5]); p1.y = pk2(v[6], v[7]);
    *(u32x2*)(img + addr256(row, 4 * s + qq0) + 8 * t) = p0; *(u32x2*)(img + addr256(row, 4 * s + qq0 + 1) + 8 * t) = p1;
}

constexpr int GP_K32 = 0, GP_V32 = 33024, GP_QS = 66048, GP_KS = 82432, GP_LM = 98816, GP_G = 115200;
__device__ __forceinline__ void gdn_prep_chunk(const Args& a, LAS unsigned char* lds, int b, int h, int n, int tid, int lane, int wave) {
    unsigned char* ws = a.ws;
    const bf16* PROJ = (const bf16*)(ws + WS_BIG); const float* GATE = (const float*)(ws + WS_GATE);
    const int cid = (b * 8 + h) * 32 + n, row0 = b * SEQ + 64 * n;
    unsigned char* rec = ws + WS_GREC + (size_t)cid * GREC_BYTES;
    LAS float* K32 = (LAS float*)(lds + GP_K32); LAS float* V32 = (LAS float*)(lds + GP_V32); LAS float* Lm = (LAS float*)(lds + GP_LM);
    LAS float* gs = (LAS float*)(lds + GP_G);
    __syncthreads();
    if (wave == 0) {
        float v = GATE[(size_t)(row0 + lane) * 16 + h];
#pragma unroll
        for (int o = 1; o < 64; o <<= 1) { const float t = __shfl_up(v, o); if (lane >= o) v += t; }
        const float gl = __shfl(v, 63);
        const float be = GATE[(size_t)(row0 + lane) * 16 + 8 + h], ev = expf(v);
        gs[lane] = v; gs[64 + lane] = be; gs[128 + lane] = ev; gs[192 + lane] = expf(gl - v); gs[256 + lane] = be * ev; gs[320 + lane] = 1.0f;
        if (lane == 63) ((float*)(ws + WS_GL))[cid] = expf(gl);
    }
    __syncthreads();
    {
        const int c = tid >> 3, sub = tid & 7, t = 64 * n + c; const size_t m = (size_t)row0 + c;
        const float egc = gs[128 + c], bec = gs[64 + c];
        float qv[2][8], kv[2][8];
#pragma unroll
        for (int i = 0; i < 6; ++i) {
            const int grp = sub + 8 * (i & 1), typ = i >> 1, col = typ * 1024 + h * 128 + grp * 8;
            float acc[8];
#pragma unroll
            for (int e = 0; e < 8; ++e) acc[e] = 0.f;
            if (n > 0) {
                float x[4][8], w[4][8];
#pragma unroll
                for (int j = 0; j < 4; ++j) { ld_bf8(PROJ + (m - 3 + j) * NPROJ + col, x[j]); ld_f8(a.in[I_GCW] + (size_t)j * 3072 + col, w[j]); }
#pragma unroll
                for (int j = 0; j < 4; ++j)
#pragma unroll
                    for (int e = 0; e < 8; ++e) acc[e] += w[j][e] * x[j][e];
            } else {
#pragma unroll
                for (int j = 0; j < 4; ++j) if (t - 3 + j >= 0) { float x[8], w[8]; ld_bf8(PROJ + (m - 3 + j) * NPROJ + col, x); ld_f8(a.in[I_GCW] + (size_t)j * 3072 + col, w);
#pragma unroll
                    for (int e = 0; e < 8; ++e) acc[e] += w[e] * x[e]; }
            }
#pragma unroll
            for (int e = 0; e < 8; ++e) acc[e] = silu_f(acc[e]);
            if (typ == 0) {
#pragma unroll
                for (int e = 0; e < 8; ++e) qv[i & 1][e] = acc[e];
            } else if (typ == 1) {
#pragma unroll
                for (int e = 0; e < 8; ++e) kv[i & 1][e] = acc[e];
            } else {
#pragma unroll
                for (int e = 0; e < 8; ++e) V32[c * 129 + grp * 8 + e] = acc[e] * bec; }
            if (i & 1) asm volatile("" ::: "memory");
        }
        float sq = 0.f, sk = 0.f;
#pragma unroll
        for (int e = 0; e < 8; ++e) { sq += qv[0][e] * qv[0][e] + qv[1][e] * qv[1][e]; sk += kv[0][e] * kv[0][e] + kv[1][e] * kv[1][e]; }
        sq += __shfl_xor(sq, 1); sq += __shfl_xor(sq, 2); sq += __shfl_xor(sq, 4); sk += __shfl_xor(sk, 1); sk += __shfl_xor(sk, 2); sk += __shfl_xor(sk, 4);
        const float rq = (1.0f / sqrtf(sq + EPS)) * 0.08838834764831845f, rk = 1.0f / sqrtf(sk + EPS);
#pragma unroll
        for (int i = 0; i < 2; ++i) { const int grp = sub + 8 * i; float qd[8];
#pragma unroll
            for (int e = 0; e < 8; ++e) { qv[i][e] *= rq; kv[i][e] *= rk; qd[e] = qv[i][e] * egc; K32[c * 129 + grp * 8 + e] = kv[i][e]; }
            u32x4 wq, wk; wq.x = pk2(qv[i][0], qv[i][1]); wq.y = pk2(qv[i][2], qv[i][3]); wq.z = pk2(qv[i][4], qv[i][5]); wq.w = pk2(qv[i][6], qv[i][7]);
            wk.x = pk2(kv[i][0], kv[i][1]); wk.y = pk2(kv[i][2], kv[i][3]); wk.z = pk2(kv[i][4], kv[i][5]); wk.w = pk2(kv[i][6], kv[i][7]);
            *(LAS u32x4*)(lds + GP_QS + addr256(c, grp)) = wq; *(LAS u32x4*)(lds + GP_KS + addr256(c, grp)) = wk;
            img256_put8(rec + GREC_QD, c, grp, qd); }
    }
    __syncthreads();
    {
        const int r = lane & 15, q = lane >> 4;
#pragma unroll
        for (int ti = 0; ti < 2; ++ti) {
            const int tt = 2 * wave + ti, ct = tt >> 2, cu = tt & 3;
            f32x4 akk = {0.f, 0.f, 0.f, 0.f}, aqk = {0.f, 0.f, 0.f, 0.f};
#pragma unroll
            for (int ks = 0; ks < 4; ++ks) {
                const bf16x8 bk = *(const LAS bf16x8*)(lds + GP_KS + addr256(16 * cu + r, 4 * ks + q));
                const bf16x8 ak = *(const LAS bf16x8*)(lds + GP_KS + addr256(16 * ct + r, 4 * ks + q));
                const bf16x8 aq = *(const LAS bf16x8*)(lds + GP_QS + addr256(16 * ct + r, 4 * ks + q));
                akk = MFMA16(ak, bk, akk); aqk = MFMA16(aq, bk, aqk);
            }
            const int c2 = 16 * cu + r; const float g2 = gs[c2]; const int p2 = kpos(c2);
#pragma unroll
            for (int reg = 0; reg < 4; ++reg) { const int c = 16 * ct + 4 * q + reg; const float dec = (c2 <= c) ? expf(gs[c] - g2) : 0.f;
                Lm[c * 64 + c2] = (c2 < c) ? gs[64 + c] * akk[reg] * dec : 0.f;
                *(bf16*)(rec + GREC_QK + addr128(c, p2 >> 3) + (p2 & 7) * 2) = (bf16)f2bf(aqk[reg] * dec); }
        }
    }
    __syncthreads();
    if (tid < 256) {
        const bool isu = tid < 128; const int col = isu ? tid : tid - 128;
        const LAS float* rb = (const LAS float*)(lds + (isu ? GP_V32 : GP_K32)) + col; const LAS float* scp = gs + (isu ? 320 : 256);
        int zlane; asm volatile("v_mov_b32 %0, 0" : "=v"(zlane));
        const LAS float* Lz = Lm + zlane;
        float sol[64];
#pragma unroll
        for (int c = 0; c < 64; ++c) {
            float pa[4] = {rb[c * 129] * scp[c], 0.f, 0.f, 0.f};
#pragma unroll
            for (int c4 = 0; c4 < (c + 3) / 4; ++c4) { const f32x4 l4 = *(const LAS f32x4*)(Lz + c * 64 + 4 * c4);
#pragma unroll
                for (int j = 0; j < 4; ++j) if (4 * c4 + j < c) pa[j] -= l4[j] * sol[4 * c4 + j]; }
            sol[c] = (pa[0] + pa[1]) + (pa[2] + pa[3]);
            asm volatile("" ::: "memory");
        }
        if (isu) { float* ut = (float*)(rec + GREC_UT) + col * 64;
#pragma unroll
            for (int c4 = 0; c4 < 16; ++c4) *(f32x4*)(ut + 4 * c4) = (f32x4){sol[4 * c4], sol[4 * c4 + 1], sol[4 * c4 + 2], sol[4 * c4 + 3]}; }
        else { const int p = kpos(col), ch = p >> 3, wi = (p & 7) * 2;
            int xo[16];
#pragma unroll
            for (int k = 0; k < 16; ++k) xo[k] = ((ch ^ k) << 4) + wi;
#pragma unroll
            for (int c = 0; c < 64; ++c) *(LAS bf16*)(lds + GP_QS + c * 256 + xo[c & 15]) = (bf16)f2bf(-sol[c]); }
    } else {
        const int c = lane, p = kpos(c), ch = p >> 3, wi = (p & 7) * 2; const float sc = gs[192 + c];
#pragma unroll 2
        for (int i = 0; i < 32; ++i) { const int d = (wave - 4) * 32 + i; *(bf16*)(rec + GREC_KD + addr128(d, ch) + wi) = (bf16)f2bf(K32[c * 129 + d] * sc); }
    }
    __syncthreads();
#pragma unroll
    for (int i = 0; i < 2; ++i) *(u32x4*)(rec + GREC_WN + (i * NTHR + tid) * 16) = *(const LAS u32x4*)(lds + GP_QS + (i * NTHR + tid) * 16);
}

constexpr int RP_K32 = 0, RP_V16 = 33024, RP_QS = 66048, RP_KS = 82432;
__device__ __forceinline__ void ret_prep_chunk(const Args& a, LAS unsigned char* lds, int b, int h, int n, int tid, int lane, int wave) {
    unsigned char* ws = a.ws;
    const bf16* PROJ = (const bf16*)(ws + WS_BIG); const float* tab = (const float*)(ws + WS_TAB);
    const int cid = (b * 4 + h) * 32 + n, row0 = b * SEQ + 64 * n;
    unsigned char* rec = ws + WS_RREC + (size_t)cid * RREC_BYTES;
    LAS float* K32 = (LAS float*)(lds + RP_K32); LAS bf16* V16 = (LAS bf16*)(lds + RP_V16);
    const float l2g = log2f(1.0f - exp2f(-5.0f - (float)h));
    __syncthreads();
    {
        const int c = tid >> 3, sub = tid & 7; const size_t m = (size_t)row0 + c; const bf16* pr = PROJ + m * NPROJ;
        float ql[8], qh[8], kl[8], kh[8], cs[8], sn[8];
        ld_bf8(pr + C_QB + h * 128 + sub * 8, ql); ld_bf8(pr + C_QB + h * 128 + 64 + sub * 8, qh); ld_bf8(pr + C_KB + h * 128 + sub * 8, kl); ld_bf8(pr + C_KB + h * 128 + 64 + sub * 8, kh);
        ld_f8(tab + (size_t)(64 * n + c) * 128 + sub * 8, cs); ld_f8(tab + (size_t)(64 * n + c) * 128 + 64 + sub * 8, sn);
        float q0[8], q1[8], k0[8], k1[8], d0[8], d1[8]; const float qdec = exp2f(l2g * (float)(c + 1));
#pragma unroll
        for (int e = 0; e < 8; ++e) { q0[e] = ql[e] * cs[e] - qh[e] * sn[e]; q1[e] = ql[e] * sn[e] + qh[e] * cs[e];
            k0[e] = (kl[e] * cs[e] - kh[e] * sn[e]) * 0.08838834764831845f; k1[e] = (kl[e] * sn[e] + kh[e] * cs[e]) * 0.08838834764831845f;
            d0[e] = q0[e] * qdec; d1[e] = q1[e] * qdec; K32[c * 129 + sub * 8 + e] = k0[e]; K32[c * 129 + 64 + sub * 8 + e] = k1[e]; }
        u32x4 w; w.x = pk2(q0[0], q0[1]); w.y = pk2(q0[2], q0[3]); w.z = pk2(q0[4], q0[5]); w.w = pk2(q0[6], q0[7]); *(LAS u32x4*)(lds + RP_QS + addr256(c, sub)) = w;
        w.x = pk2(q1[0], q1[1]); w.y = pk2(q1[2], q1[3]); w.z = pk2(q1[4], q1[5]); w.w = pk2(q1[6], q1[7]); *(LAS u32x4*)(lds + RP_QS + addr256(c, 8 + sub)) = w;
        w.x = pk2(k0[0], k0[1]); w.y = pk2(k0[2], k0[3]); w.z = pk2(k0[4], k0[5]); w.w = pk2(k0[6], k0[7]); *(LAS u32x4*)(lds + RP_KS + addr256(c, sub)) = w;
        w.x = pk2(k1[0], k1[1]); w.y = pk2(k1[2], k1[3]); w.z = pk2(k1[4], k1[5]); w.w = pk2(k1[6], k1[7]); *(LAS u32x4*)(lds + RP_KS + addr256(c, 8 + sub)) = w;
        img256_put8(rec + RREC_QD, c, sub, d0); img256_put8(rec + RREC_QD, c, 8 + sub, d1);
#pragma unroll
        for (int i = 0; i < 4; ++i) { const u32x4 v = *(const u32x4*)(pr + C_VB + h * 256 + (sub + 8 * i) * 8); LAS unsigned* dst = (LAS unsigned*)(V16 + c * 258 + (sub + 8 * i) * 8); dst[0] = v.x; dst[1] = v.y; dst[2] = v.z; dst[3] = v.w; }
    }
    __syncthreads();
    {
        const int r = lane & 15, q = lane >> 4;
#pragma unroll
        for (int ti = 0; ti < 2; ++ti) {
            const int tt = 2 * wave + ti, ct = tt >> 2, cu = tt & 3;
            f32x4 aqk = {0.f, 0.f, 0.f, 0.f};
#pragma unroll
            for (int ks = 0; ks < 4; ++ks) {
                const bf16x8 bk = *(const LAS bf16x8*)(lds + RP_KS + addr256(16 * cu + r, 4 * ks + q));
                const bf16x8 aq = *(const LAS bf16x8*)(lds + RP_QS + addr256(16 * ct + r, 4 * ks + q));
                aqk = MFMA16(aq, bk, aqk);
            }
            const int c2 = 16 * cu + r, p2 = kpos(c2);
#pragma unroll
            for (int reg = 0; reg < 4; ++reg) { const int c = 16 * ct + 4 * q + reg; const float dec = (c2 <= c) ? exp2f(l2g * (float)(c - c2)) : 0.f;
                *(bf16*)(rec + RREC_QK + addr128(c, p2 >> 3) + (p2 & 7) * 2) = (bf16)f2bf(aqk[reg] * dec); }
        }
        const int c = lane, p = kpos(c), ch = p >> 3, wi = (p & 7) * 2; const float sc = exp2f(l2g * (float)(63 - c));
#pragma unroll 2
        for (int i = 0; i < 16; ++i) { const int d = wave * 16 + i; *(bf16*)(rec + RREC_KD + addr128(d, ch) + wi) = (bf16)f2bf(K32[c * 129 + d] * sc); }
#pragma unroll 2
        for (int i = 0; i < 32; ++i) { const int e = wave * 32 + i; *(bf16*)(rec + RREC_VT + e * 128 + p * 2) = V16[c * 258 + e]; }
    }
}

template <bool GDN>
__device__ __forceinline__ void chunk_scan(const Args& a, LAS unsigned char* lds, int task, int tid, int lane, int wave) {
    unsigned char* ws = a.ws;
    constexpr int IMG = GDN ? GREC_IMG : RREC_IMG, REC = GDN ? GREC_BYTES : RREC_BYTES, NP = IMG / 16 / NTHR;
    constexpr int O_WN = GREC_WN, O_QD = GDN ? GREC_QD : RREC_QD, O_QK = GDN ? GREC_QK : RREC_QK, O_KD = GDN ? GREC_KD : RREC_KD;
    const int r = lane & 15, q = lane >> 4;
    int b, h, e0, cid0;
    if (GDN) { b = task >> 3; h = task & 7; e0 = 16 * wave; cid0 = (b * 8 + h) * 32; }
    else { b = task >> 3; h = (task >> 1) & 3; e0 = 128 * (task & 1) + 16 * wave; cid0 = (b * 4 + h) * 32; }
    const unsigned char* rec = ws + (GDN ? WS_GREC : WS_RREC) + (size_t)cid0 * REC;
    const float* GL = (const float*)(ws + WS_GL) + cid0;
    float* O = (float*)(ws + (GDN ? WS_OA : WS_OB)) + (size_t)b * SEQ * 1024 + h * (GDN ? 128 : 256) + e0 + r;
    const float gch = GDN ? 0.f : exp2f(64.0f * log2f(1.0f - exp2f(-5.0f - (float)h)));
    f32x4 S[8];
#pragma unroll
    for (int dt = 0; dt < 8; ++dt) S[dt] = (f32x4){0.f, 0.f, 0.f, 0.f};
    __syncthreads();
    constexpr int SLICE = GDN ? 4096 : 2048, SL_OFF = 2 * GREC_IMG;
    LAS unsigned char* slot = lds + SL_OFF + wave * SLICE;
#define STAGE_IMG(recp, bufp) do { _Pragma("unroll") for (int i_ = 0; i_ < NP; ++i_) \
        __builtin_amdgcn_global_load_lds((const unsigned*)((recp) + (size_t)(i_ * NTHR + tid) * 16), (LAS unsigned*)((bufp) + (i_ * NTHR + wave * 64) * 16), 16, 0, 0); } while (0)
#define STAGE_SLICE(recp) do { _Pragma("unroll") for (int i_ = 0; i_ < SLICE / 1024; ++i_) \
        __builtin_amdgcn_global_load_lds((const unsigned*)((recp) + (GDN ? GREC_UT + e0 * 256 : RREC_VT + e0 * 128) + i_ * 1024 + lane * 16), (LAS unsigned*)(slot + i_ * 1024), 16, 0, 0); } while (0)
    STAGE_IMG(rec, lds); STAGE_SLICE(rec);
    for (int n = 0; n < 32; ++n) {
        const unsigned char* nrec = rec + (size_t)(n + 1 < 32 ? n + 1 : n) * REC;
        f32x4 uc[4]; bf16x8 bv[2];
        const float gl = GDN ? GL[n] : gch;
        if (n == 0) asm volatile("s_waitcnt vmcnt(0) lgkmcnt(0)" ::: "memory"); else asm volatile("s_waitcnt vmcnt(16) lgkmcnt(0)" ::: "memory");
        __builtin_amdgcn_s_barrier();
        asm volatile("" ::: "memory");
        if (GDN) {
#pragma unroll
            for (int ct = 0; ct < 4; ++ct) uc[ct] = *(const LAS f32x4*)(slot + r * 256 + (16 * ct + 4 * q) * 4);
        } else {
#pragma unroll
            for (int s = 0; s < 2; ++s) bv[s] = *(const LAS bf16x8*)(slot + r * 128 + (4 * s + q) * 16);
        }
        asm volatile("s_waitcnt lgkmcnt(0)" ::: "memory");
        if (n + 1 < 32) { STAGE_IMG(nrec, lds + ((n + 1) & 1) * IMG); STAGE_SLICE(nrec); }
        asm volatile("" ::: "memory"); __builtin_amdgcn_sched_barrier(0);
        LAS unsigned char* B = lds + (n & 1) * IMG;
        bf16x8 bs[4];
#pragma unroll
        for (int s = 0; s < 4; ++s) bs[s] = pack_tiles(S[2 * s], S[2 * s + 1]);
        f32x4 ao[4];
#pragma unroll
        for (int ct = 0; ct < 4; ++ct) ao[ct] = (f32x4){0.f, 0.f, 0.f, 0.f};
        bf16x8 FA[8], FB[8];
#define LD256(F, off, s0) do { _Pragma("unroll") for (int i_ = 0; i_ < 8; ++i_) F[i_] = *(const LAS bf16x8*)(B + (off) + addr256(16 * (i_ & 3) + r, 4 * ((s0) + (i_ >> 2)) + q)); } while (0)
#define LD128(F, off, t0) do { _Pragma("unroll") for (int i_ = 0; i_ < 8; ++i_) F[i_] = *(const LAS bf16x8*)(B + (off) + addr128(16 * ((t0) + (i_ & 3)) + r, 4 * (i_ >> 2) + q)); } while (0)
#define MM(F, ACC, BOP, s0) do { _Pragma("unroll") for (int i_ = 0; i_ < 8; ++i_) ACC[i_ & 3] = MFMA16(F[i_], BOP[(s0) + (i_ >> 2)], ACC[i_ & 3]); } while (0)
#define SB() __builtin_amdgcn_sched_barrier(0)
        if (GDN) {
            LD256(FA, O_WN, 0); SB();
            LD256(FB, O_WN, 2); SB(); MM(FA, uc, bs, 0); SB();
            LD256(FA, O_QD, 0); SB(); MM(FB, uc, bs, 2); SB();
            bv[0] = pack_tiles(uc[0], uc[1]); bv[1] = pack_tiles(uc[2], uc[3]);
        } else { LD256(FA, O_QD, 0); SB(); }
        LD256(FB, O_QD, 2); SB(); MM(FA, ao, bs, 0); SB();
        LD128(FA, O_QK, 0); SB(); MM(FB, ao, bs, 2); SB();
        LD128(FB, O_KD, 0); SB(); MM(FA, ao, bv, 0); SB();
#pragma unroll
        for (int dt = 0; dt < 8; ++dt) S[dt] = S[dt] * gl;
        LD128(FA, O_KD, 4); SB();
        { f32x4 (&S0)[8] = S; _Pragma("unroll") for (int i_ = 0; i_ < 8; ++i_) S0[i_ & 3] = MFMA16(FB[i_], bv[i_ >> 2], S0[i_ & 3]); } SB();
        { _Pragma("unroll") for (int i_ = 0; i_ < 8; ++i_) S[4 + (i_ & 3)] = MFMA16(FA[i_], bv[i_ >> 2], S[4 + (i_ & 3)]); } SB();
#undef LD256
#undef LD128
#undef MM
#undef SB
#pragma unroll
        for (int ct = 0; ct < 4; ++ct)
#pragma unroll
            for (int reg = 0; reg < 4; ++reg) O[(size_t)(64 * n + 16 * ct + 4 * q + reg) * 1024] = ao[ct][reg];
    }
#undef STAGE_IMG
#undef STAGE_SLICE
    float* so = a.out + (GDN ? O_GDN_P + (size_t)(b * 8 + h) * 128 * 128 : O_RET_P + (size_t)(b * 4 + h) * 128 * 256) + e0 + r;
#pragma unroll
    for (int dt = 0; dt < 8; ++dt)
#pragma unroll
        for (int reg = 0; reg < 4; ++reg) so[(size_t)(16 * dt + 4 * q + reg) * (GDN ? 128 : 256)] = S[dt][reg];
}

__device__ __forceinline__ void ph_gdn_prep(const Args& a, int lane, int gw, int NGW) {
    unsigned char* ws = a.ws;
    const bf16* PROJ = (const bf16*)(ws + WS_BIG);
    for (int idx = gw * 64 + lane; idx < (4 + DECB) * 3 * 3072; idx += NGW * 64) {
        const int c = idx % 3072, j = (idx / 3072) % 3, sb = idx / (3 * 3072);
        if (sb < 4) a.out[O_GCB_P + idx] = bf2f(PROJ[(size_t)(sb * SEQ + SEQ - 3 + j) * NPROJ + c]);
        else { const int b = sb - 4; a.out[O_GCB_S + ((size_t)b * 3 + j) * 3072 + c] = bf2f(PROJ[(size_t)(MP + b * DECS + DECS - 3 + j) * NPROJ + c]); }
    }
}

__device__ __forceinline__ void ph_mix_prep(const Args& a, LAS unsigned char* lds, int tid, int lane, int wave, int gw, int NGW, int G) {
    for (int t = blockIdx.x; t < 1024; t += G) gdn_prep_chunk(a, lds, t >> 8, (t >> 5) & 7, t & 31, tid, lane, wave);
    for (int r = blockIdx.x; r < 512; r += G) ret_prep_chunk(a, lds, r >> 7, (r >> 5) & 3, r & 31, tid, lane, wave);
    ph_gdn_prep(a, lane, gw, NGW);
}
constexpr int SB_Q = 0, SB_K = 4096, SB_V = 8192, SB_G = 12288;
#define LDS_BARRIER() asm volatile("s_waitcnt lgkmcnt(0)\n\ts_barrier" ::: "memory")
__device__ __forceinline__ float oct_sum(float v) {
    v += __builtin_bit_cast(float, __builtin_amdgcn_mov_dpp(__builtin_bit_cast(int, v), 0xB1, 0xF, 0xF, true));
    v += __builtin_bit_cast(float, __builtin_amdgcn_mov_dpp(__builtin_bit_cast(int, v), 0x4E, 0xF, 0xF, true));
    v += __builtin_bit_cast(float, __builtin_amdgcn_mov_dpp(__builtin_bit_cast(int, v), 0x141, 0xF, 0xF, true));
    return v;
}
__device__ __forceinline__ void gdn_sample_pair(const Args& a, LAS unsigned char* lds, int st, int lane, int wave) {
    unsigned char* ws = a.ws;
    const bf16* PROJ = (const bf16*)(ws + WS_BIG); const float* GATE = (const float*)(ws + WS_GATE); float* OA = (float*)(ws + WS_OA);
    const int hb = wave >> 2, w4 = wave & 3, b = st >> 3, h = st & 7;
    LAS unsigned char* L = lds + hb * 16384;
    LAS float* qs = (LAS float*)(L + SB_Q); LAS float* ks = (LAS float*)(L + SB_K); LAS float* vs = (LAS float*)(L + SB_V); LAS float* gt = (LAS float*)(L + SB_G);
    const int dg = lane & 7, ec = lane >> 3, wcol = 32 * w4 + 4 * ec;
    float2 wj[3][4], xs[3][5]; unsigned xp[3][5]; float g0[2], g1[2];
#pragma unroll
    for (int typ = 0; typ < 3; ++typ) { const int col = typ * 1024 + h * 128 + 2 * lane;
#pragma unroll
        for (int j = 0; j < 4; ++j) wj[typ][j] = *(const float2*)(a.in[I_GCW] + (size_t)j * 3072 + col);
#pragma unroll
        for (int jj = 0; jj < 5; ++jj) { const int tq = 2 * w4 + jj; xs[typ][jj] = *(const float2*)(a.in[I_SGCB] + ((size_t)b * 3 + (tq < 3 ? tq : 2)) * 3072 + col);
            xp[typ][jj] = *(const unsigned*)(PROJ + (size_t)(MP + b * DECS + (tq >= 3 ? tq - 3 : 0)) * NPROJ + col); } }
#pragma unroll
    for (int tt = 0; tt < 2; ++tt) { const size_t m = (size_t)MP + b * DECS + 2 * w4 + tt; g0[tt] = GATE[m * 16 + h]; g1[tt] = GATE[m * 16 + 8 + h]; }
    asm volatile("" ::: "memory");
    f32x4 S[16];
    { const float* sp = a.in[I_SGDN] + (((size_t)b * 8 + h) * 128 + dg * 16) * 128 + wcol;
#pragma unroll
      for (int i = 0; i < 16; ++i) S[i] = *(const f32x4*)(sp + (size_t)i * 128); }
    LDS_BARRIER();
#pragma unroll
    for (int typ = 0; typ < 3; ++typ) {
        asm volatile("" : "+v"(wj[typ][0].x), "+v"(wj[typ][0].y), "+v"(wj[typ][1].x), "+v"(wj[typ][1].y), "+v"(wj[typ][2].x), "+v"(wj[typ][2].y), "+v"(wj[typ][3].x), "+v"(wj[typ][3].y));
        asm volatile("" : "+v"(xs[typ][0].x), "+v"(xs[typ][0].y), "+v"(xs[typ][1].x), "+v"(xs[typ][1].y), "+v"(xs[typ][2].x), "+v"(xs[typ][2].y), "+v"(xs[typ][3].x), "+v"(xs[typ][3].y), "+v"(xs[typ][4].x), "+v"(xs[typ][4].y));
        asm volatile("" : "+v"(xp[typ][0]), "+v"(xp[typ][1]), "+v"(xp[typ][2]), "+v"(xp[typ][3]), "+v"(xp[typ][4])); }
    asm volatile("" : "+v"(g0[0]), "+v"(g0[1]), "+v"(g1[0]), "+v"(g1[1]));
#pragma unroll
    for (int tt = 0; tt < 2; ++tt) { const int c = 2 * w4 + tt;
#pragma unroll
        for (int typ = 0; typ < 3; ++typ) { float a0 = 0.f, a1 = 0.f;
#pragma unroll
            for (int j = 0; j < 4; ++j) { const bool st_ = (c + j) < 3; const unsigned w = xp[typ][tt + j]; const float x0 = st_ ? xs[typ][tt + j].x : __builtin_bit_cast(float, w << 16), x1 = st_ ? xs[typ][tt + j].y : __builtin_bit_cast(float, w & 0xffff0000u);
                a0 += wj[typ][j].x * x0; a1 += wj[typ][j].y * x1; }
            a0 = silu_f(a0); a1 = silu_f(a1);
            if (typ < 2) { const float rs = (1.0f / sqrtf(wave_sum(a0 * a0 + a1 * a1) + EPS)) * (typ == 0 ? 0.08838834764831845f : 1.0f); a0 *= rs; a1 *= rs; }
            LAS float* dst = (typ == 0 ? qs : typ == 1 ? ks : vs) + c * 128 + 2 * lane; dst[0] = a0; dst[1] = a1; }
        if (lane == 0) { gt[c] = g0[tt]; gt[8 + c] = g1[tt]; } }
    LDS_BARRIER();
#pragma unroll 1
    for (int c = 0; c < 8; ++c) {
        const float al = expf(gt[c]), be = gt[8 + c];
        float kk[16], qq[16];
#pragma unroll
        for (int i4 = 0; i4 < 4; ++i4) { const f32x4 k4 = *(const LAS f32x4*)(ks + c * 128 + dg * 16 + 4 * i4), q4 = *(const LAS f32x4*)(qs + c * 128 + dg * 16 + 4 * i4);
            kk[4 * i4] = k4[0]; kk[4 * i4 + 1] = k4[1]; kk[4 * i4 + 2] = k4[2]; kk[4 * i4 + 3] = k4[3]; qq[4 * i4] = q4[0]; qq[4 * i4 + 1] = q4[1]; qq[4 * i4 + 2] = q4[2]; qq[4 * i4 + 3] = q4[3]; }
        const f32x4 v4 = *(const LAS f32x4*)(vs + c * 128 + wcol);
        f32x4 r0 = {0.f, 0.f, 0.f, 0.f}, r1 = {0.f, 0.f, 0.f, 0.f};
#pragma unroll
        for (int i = 0; i < 16; i += 2) { r0 = r0 + S[i] * kk[i]; r1 = r1 + S[i + 1] * kk[i + 1]; }
        f32x4 rr = r0 + r1;
#pragma unroll
        for (int j = 0; j < 4; ++j) rr[j] = oct_sum(rr[j]);
        const f32x4 dl = (v4 - rr * al) * be;
        f32x4 o0 = {0.f, 0.f, 0.f, 0.f}, o1 = {0.f, 0.f, 0.f, 0.f};
#pragma unroll
        for (int i = 0; i < 16; i += 2) { S[i] = S[i] * al + dl * kk[i]; S[i + 1] = S[i + 1] * al + dl * kk[i + 1]; o0 = o0 + S[i] * qq[i]; o1 = o1 + S[i + 1] * qq[i + 1]; }
        f32x4 oo = o0 + o1;
#pragma unroll
        for (int j = 0; j < 4; ++j) oo[j] = oct_sum(oo[j]);
        if (dg == 0) *(f32x4*)(OA + (size_t)(MP + b * DECS + c) * 1024 + h * 128 + wcol) = oo;
    }
    { float* so = a.out + O_GDN_S + (((size_t)b * 8 + h) * 128 + dg * 16) * 128 + wcol;
#pragma unroll
      for (int i = 0; i < 16; ++i) *(f32x4*)(so + (size_t)i * 128) = S[i]; }
}
__device__ __forceinline__ void ret_sample_pair(const Args& a, LAS unsigned char* lds, int st, int lane, int wave) {
    unsigned char* ws = a.ws;
    const bf16* PROJ = (const bf16*)(ws + WS_BIG); const float* tab = (const float*)(ws + WS_TAB); float* OB = (float*)(ws + WS_OB);
    const int hb = wave >> 2, w4 = wave & 3, r_ = st - 1024, b = r_ >> 3, h = (r_ >> 1) & 3, half = r_ & 1;
    LAS unsigned char* L = lds + hb * 16384;
    LAS float* qs = (LAS float*)(L + SB_Q); LAS float* ks = (LAS float*)(L + SB_K); LAS float* vs = (LAS float*)(L + SB_V);
    const int dg = lane & 7, ec = lane >> 3, wcol = 32 * w4 + 4 * ec;
    const float gamma = 1.0f - exp2f(-5.0f - (float)h);
    float cs[2], sn[2]; unsigned rq[2][2], rk[2][2], vw[2];
#pragma unroll
    for (int tt = 0; tt < 2; ++tt) { const int c = 2 * w4 + tt; const unsigned short* pr = (const unsigned short*)(PROJ + (size_t)(MP + b * DECS + c) * NPROJ); const float* tp = tab + (size_t)(2048 + c) * 128;
        cs[tt] = tp[lane]; sn[tt] = tp[64 + lane];
        rq[tt][0] = pr[C_QB + h * 128 + lane]; rq[tt][1] = pr[C_QB + h * 128 + 64 + lane]; rk[tt][0] = pr[C_KB + h * 128 + lane]; rk[tt][1] = pr[C_KB + h * 128 + 64 + lane];
        vw[tt] = *(const unsigned*)(pr + C_VB + h * 256 + half * 128 + 2 * lane); }
    asm volatile("" ::: "memory");
    f32x4 S[16];
    { const float* sp = a.in[I_SRET] + (((size_t)b * 4 + h) * 128 + dg * 16) * 256 + half * 128 + wcol;
#pragma unroll
      for (int i = 0; i < 16; ++i) S[i] = *(const f32x4*)(sp + (size_t)i * 256); }
    LDS_BARRIER();
    asm volatile("" : "+v"(cs[0]), "+v"(sn[0]), "+v"(rq[0][0]), "+v"(rq[0][1]), "+v"(rk[0][0]), "+v"(rk[0][1]), "+v"(vw[0]), "+v"(cs[1]), "+v"(sn[1]), "+v"(rq[1][0]), "+v"(rq[1][1]), "+v"(rk[1][0]), "+v"(rk[1][1]), "+v"(vw[1]));
#pragma unroll
    for (int tt = 0; tt < 2; ++tt) { const int c = 2 * w4 + tt;
        const float ql = __builtin_bit_cast(float, rq[tt][0] << 16), qh = __builtin_bit_cast(float, rq[tt][1] << 16), kl = __builtin_bit_cast(float, rk[tt][0] << 16), kh = __builtin_bit_cast(float, rk[tt][1] << 16);
        qs[c * 128 + lane] = ql * cs[tt] - qh * sn[tt]; qs[c * 128 + 64 + lane] = ql * sn[tt] + qh * cs[tt];
        ks[c * 128 + lane] = (kl * cs[tt] - kh * sn[tt]) * 0.08838834764831845f; ks[c * 128 + 64 + lane] = (kl * sn[tt] + kh * cs[tt]) * 0.08838834764831845f;
        vs[c * 128 + 2 * lane] = __builtin_bit_cast(float, vw[tt] << 16); vs[c * 128 + 2 * lane + 1] = __builtin_bit_cast(float, vw[tt] & 0xffff0000u); }
    LDS_BARRIER();
#pragma unroll 1
    for (int c = 0; c < 8; ++c) {
        float kk[16], qq[16];
#pragma unroll
        for (int i4 = 0; i4 < 4; ++i4) { const f32x4 k4 = *(const LAS f32x4*)(ks + c * 128 + dg * 16 + 4 * i4), q4 = *(const LAS f32x4*)(qs + c * 128 + dg * 16 + 4 * i4);
            kk[4 * i4] = k4[0]; kk[4 * i4 + 1] = k4[1]; kk[4 * i4 + 2] = k4[2]; kk[4 * i4 + 3] = k4[3]; qq[4 * i4] = q4[0]; qq[4 * i4 + 1] = q4[1]; qq[4 * i4 + 2] = q4[2]; qq[4 * i4 + 3] = q4[3]; }
        const f32x4 v4 = *(const LAS f32x4*)(vs + c * 128 + wcol);
        f32x4 o0 = {0.f, 0.f, 0.f, 0.f}, o1 = {0.f, 0.f, 0.f, 0.f};
#pragma unroll
        for (int i = 0; i < 16; i += 2) { S[i] = S[i] * gamma + v4 * kk[i]; S[i + 1] = S[i + 1] * gamma + v4 * kk[i + 1]; o0 = o0 + S[i] * qq[i]; o1 = o1 + S[i + 1] * qq[i + 1]; }
        f32x4 oo = o0 + o1;
#pragma unroll
        for (int j = 0; j < 4; ++j) oo[j] = oct_sum(oo[j]);
        if (dg == 0) *(f32x4*)(OB + (size_t)(MP + b * DECS + c) * 1024 + h * 256 + half * 128 + wcol) = oo;
    }
    { float* so = a.out + O_RET_S + (((size_t)b * 4 + h) * 128 + dg * 16) * 256 + half * 128 + wcol;
#pragma unroll
      for (int i = 0; i < 16; ++i) *(f32x4*)(so + (size_t)i * 256) = S[i]; }
}
__device__ __forceinline__ void sample_pairs(const Args& a, LAS unsigned char* lds, int p0, int stride, int cnt, int lane, int wave) {
    const int hb = wave >> 2;
    __builtin_amdgcn_s_waitcnt(0);
#pragma unroll 1
    for (int k = 0; k < cnt; ++k) { const int pr = p0 + k * stride, st = 2 * pr + hb;
        if (pr < 512) gdn_sample_pair(a, lds, st, lane, wave); else ret_sample_pair(a, lds, st, lane, wave); }
}
__device__ __forceinline__ void ph_scans(const Args& a, LAS unsigned char* lds, int tid, int lane, int wave, int G, int mode = 3) {
    const int blk = blockIdx.x;
    if (mode & 1) { if (blk < 32) chunk_scan<true>(a, lds, blk, tid, lane, wave); else if (blk < 64) chunk_scan<false>(a, lds, blk - 32, tid, lane, wave); }
    if ((mode & 2) && blk >= 64) sample_pairs(a, lds, blk - 64, 192, (blk - 64) < 64 ? 6 : 5, lane, wave);
    if (mode == 3 && blk >= 64) convert_group(a, 1, (LAS float*)(lds + 32768 + wave * 8704), lane, (blk - 64) * NWAVES + wave, 192 * NWAVES);
}

__device__ __forceinline__ void ph_mix_norm(const Args& a, int lane, int gw, int NGW) {
    unsigned char* ws = a.ws;
    const bf16* PROJ = (const bf16*)(ws + WS_BIG); const float* OA = (const float*)(ws + WS_OA); const float* OB = (const float*)(ws + WS_OB); bf16* MIX = (bf16*)(ws + WS_G2);
    float wa[2][8], wb[2][8], bb[2][8];
#pragma unroll
    for (int i = 0; i < 2; ++i) { const int col = 8 * (lane + 64 * i); ld_f8(a.in[I_GNW] + (col & 127), wa[i]); ld_f8(a.in[I_RGW] + col, wb[i]); ld_f8(a.in[I_RGB] + col, bb[i]); }
    for (int m = gw; m < MTOT; m += NGW) {
        f32x4 oa[2][2], ob[2][2]; u32x4 zz[2], gg[2];
#pragma unroll
        for (int i = 0; i < 2; ++i) { const int col = 8 * (lane + 64 * i);
            oa[i][0] = *(const f32x4*)(OA + (size_t)m * 1024 + col); oa[i][1] = *(const f32x4*)(OA + (size_t)m * 1024 + col + 4);
            ob[i][0] = *(const f32x4*)(OB + (size_t)m * 1024 + col); ob[i][1] = *(const f32x4*)(OB + (size_t)m * 1024 + col + 4);
            zz[i] = *(const u32x4*)(PROJ + (size_t)m * NPROJ + C_ZA + col); gg[i] = *(const u32x4*)(PROJ + (size_t)m * NPROJ + C_GB + col); }
#pragma unroll
        for (int i = 0; i < 2; ++i) {
            const int col = 8 * (lane + 64 * i);
            float o[8] = {oa[i][0][0], oa[i][0][1], oa[i][0][2], oa[i][0][3], oa[i][1][0], oa[i][1][1], oa[i][1][2], oa[i][1][3]}, z[8]; unpack8(zz[i], z);
            float ss = 0.f;
#pragma unroll
            for (int e = 0; e < 8; ++e) ss += o[e] * o[e];
            ss += __shfl_xor(ss, 1); ss += __shfl_xor(ss, 2); ss += __shfl_xor(ss, 4); ss += __shfl_xor(ss, 8);
            const float rs = 1.0f / sqrtf(ss * (1.0f / 128.0f) + EPS);
#pragma unroll
            for (int e = 0; e < 8; ++e) o[e] = o[e] * rs * wa[i][e] * silu_f(z[e]);
            st_bf8(MIX + (size_t)m * 2048 + col, o);
        }
#pragma unroll
        for (int i = 0; i < 2; ++i) {
            const int col = 8 * (lane + 64 * i);
            float o[8] = {ob[i][0][0], ob[i][0][1], ob[i][0][2], ob[i][0][3], ob[i][1][0], ob[i][1][1], ob[i][1][2], ob[i][1][3]}, g[8]; unpack8(gg[i], g);
            float s_ = 0.f;
#pragma unroll
            for (int e = 0; e < 8; ++e) s_ += o[e];
            s_ += __shfl_xor(s_, 1); s_ += __shfl_xor(s_, 2); s_ += __shfl_xor(s_, 4); s_ += __shfl_xor(s_, 8); s_ += __shfl_xor(s_, 16);
            const float mu = s_ * (1.0f / 256.0f); float q = 0.f;
#pragma unroll
            for (int e = 0; e < 8; ++e) { o[e] -= mu; q += o[e] * o[e]; }
            q += __shfl_xor(q, 1); q += __shfl_xor(q, 2); q += __shfl_xor(q, 4); q += __shfl_xor(q, 8); q += __shfl_xor(q, 16);
            const float rs = 1.0f / sqrtf(q * (1.0f / 256.0f) + EPS);
#pragma unroll
            for (int e = 0; e < 8; ++e) o[e] = (o[e] * rs * wb[i][e] + bb[i][e]) * silu_f(g[e]);
            st_bf8(MIX + (size_t)m * 2048 + 1024 + col, o);
        }
    }
}

__device__ __forceinline__ void ffn_conv_prompt(const Args& a, int layer, int lane, int gw, int NGW) {
    unsigned char* ws = a.ws;
    const bf16* UP = (const bf16*)(ws + WS_BIG); bf16* ACT = (bf16*)(ws + WS_ACT);
    const float* cw = a.in[I_FCW] + (size_t)layer * 3 * NUP; const float* cb = a.in[I_FCBIAS] + (size_t)layer * NUP;
    for (int task = gw; task < 128 * 11; task += NGW) {
        const int run = task / 11, cblk = task % 11, m0 = run * 64, t0 = m0 % SEQ;
        const int j0 = 8 * (lane + 64 * cblk), ucol = ((j0 >> 7) << 8) + (j0 & 127);
        float wv[3][8], wg[3][8], bv_[8], bg_[8]; ld_f8(cb + j0, bv_); ld_f8(cb + DFF + j0, bg_);
#pragma unroll
        for (int jj = 0; jj < 3; ++jj) { ld_f8(cw + (size_t)jj * NUP + j0, wv[jj]); ld_f8(cw + (size_t)jj * NUP + DFF + j0, wg[jj]); }
        float p2v[8], p2g[8], p1v[8], p1g[8];
        if (t0 == 0) {
#pragma unroll
            for (int e = 0; e < 8; ++e) { p2v[e] = 0.f; p2g[e] = 0.f; p1v[e] = 0.f; p1g[e] = 0.f; }
        } else { const bf16* r2 = UP + (size_t)(m0 - 2) * NUP + ucol; ld_bf8(r2, p2v); ld_bf8(r2 + 128, p2g); ld_bf8(r2 + NUP, p1v); ld_bf8(r2 + NUP + 128, p1g); }
        const bf16* rp = UP + (size_t)m0 * NUP + ucol; bf16* op = ACT + (size_t)m0 * DFF + j0;
#pragma unroll 1
        for (int i8 = 0; i8 < 8; ++i8) {
            u32x4 lv[8], lg[8];
#pragma unroll
            for (int k = 0; k < 8; ++k) { lv[k] = *(const u32x4*)(rp + (size_t)k * NUP); lg[k] = *(const u32x4*)(rp + (size_t)k * NUP + 128); }
#pragma unroll
            for (int k = 0; k < 8; ++k) { float xv[8], xg[8], o[8]; unpack8(lv[k], xv); unpack8(lg[k], xg);
#pragma unroll
                for (int e = 0; e < 8; ++e) { const float va = bv_[e] + wv[0][e] * p2v[e] + wv[1][e] * p1v[e] + wv[2][e] * xv[e], ga = bg_[e] + wg[0][e] * p2g[e] + wg[1][e] * p1g[e] + wg[2][e] * xg[e];
                    o[e] = silu_f(ga) * va; p2v[e] = p1v[e]; p2g[e] = p1g[e]; p1v[e] = xv[e]; p1g[e] = xg[e]; }
                st_bf8(op + (size_t)k * DFF, o); }
            rp += (size_t)8 * NUP; op += (size_t)8 * DFF;
        }
    }
}
__device__ __forceinline__ void ffn_conv_sample(const Args& a, int layer, int lane, int gw, int NGW) {
    unsigned char* ws = a.ws;
    const bf16* UP = (const bf16*)(ws + WS_BIG); bf16* ACT = (bf16*)(ws + WS_ACT);
    const float* cw = a.in[I_FCW] + (size_t)layer * 3 * NUP; const float* cb = a.in[I_FCBIAS] + (size_t)layer * NUP; const float* cst = a.in[I_SFCB] + (size_t)layer * DECB * 2 * NUP;
    for (int m = MP + gw; m < MTOT; m += NGW) {
        const int b = (m - MP) / DECS, t = (m - MP) % DECS;
        for (int i = 0; i < 11; ++i) {
            const int j0 = 8 * (lane + 64 * i), ucol = ((j0 >> 7) << 8) + (j0 & 127);
            float va[8], ga[8]; ld_f8(cb + j0, va); ld_f8(cb + DFF + j0, ga);
#pragma unroll
            for (int jj = 0; jj < 3; ++jj) { float xv[8], xg[8], sv[8], sg[8], wv[8], wg[8]; const int tt = t + jj; const bool from_state = tt < 2;
                const bf16* r = UP + (size_t)(MP + b * DECS + (tt >= 2 ? tt - 2 : 0)) * NUP + ucol; ld_bf8(r, xv); ld_bf8(r + 128, xg);
                const float* rs_ = cst + ((size_t)b * 2 + (tt < 2 ? tt : 1)) * NUP + j0; ld_f8(rs_, sv); ld_f8(rs_ + DFF, sg);
                ld_f8(cw + (size_t)jj * NUP + j0, wv); ld_f8(cw + (size_t)jj * NUP + DFF + j0, wg);
#pragma unroll
                for (int e = 0; e < 8; ++e) { va[e] += wv[e] * (from_state ? sv[e] : xv[e]); ga[e] += wg[e] * (from_state ? sg[e] : xg[e]); } }
            float o[8];
#pragma unroll
            for (int e = 0; e < 8; ++e) o[e] = silu_f(ga[e]) * va[e];
            st_bf8(ACT + (size_t)m * DFF + j0, o);
        }
    }
    for (int idx = gw * 64 + lane; idx < (4 + DECB) * 2 * NUP; idx += NGW * 64) {
        const int c = idx % NUP, r = (idx / NUP) & 1, sb = idx / (2 * NUP);
        const int j = c < DFF ? c : c - DFF, ucol = ((j >> 7) << 8) + (j & 127) + (c < DFF ? 0 : 128);
        if (sb < 4) a.out[O_FCB_P + ((size_t)(layer * 4 + sb) * 2 + r) * NUP + c] = bf2f(UP[(size_t)(sb * SEQ + SEQ - 2 + r) * NUP + ucol]);
        else { const int b = sb - 4; a.out[O_FCB_S + ((size_t)(layer * DECB + b) * 2 + r) * NUP + c] = bf2f(UP[(size_t)(MP + b * DECS + DECS - 2 + r) * NUP + ucol]); }
    }
}

__device__ __forceinline__ void s5_task(const Args& a, bool prompt, int b, int g, int lane) {
    unsigned char* ws = a.ws;
    const bf16* H = (const bf16*)(ws + WS_H); bf16* G2 = (bf16*)(ws + WS_G2);
    const int p = lane, gp = g * 64 + p;
    const double lr = (double)a.in[I_LRE][gp], li = (double)a.in[I_LIM][gp], dt = exp((double)a.in[I_LDT][g]);
    const double mag = exp(lr * dt); double sn, cs; sincos_d(li * dt, sn, cs);
    const double abr = mag * cs, abi = mag * sn, den = lr * lr + li * li;
    const double cfr = ((abr - 1.0) * lr + abi * li) / den, cfi = (abi * lr - (abr - 1.0) * li) / den;
    float bbr[16], bbi[16], cr[16], ci[16];
#pragma unroll
    for (int c = 0; c < 16; ++c) { const double br = (double)a.in[I_BRE][(size_t)gp * 16 + c], bi = (double)a.in[I_BIM][(size_t)gp * 16 + c]; bbr[c] = (float)(cfr * br - cfi * bi); bbi[c] = (float)(cfr * bi + cfi * br);
        cr[c] = a.in[I_CRE][((size_t)g * 16 + c) * 64 + p]; ci[c] = a.in[I_CIM][((size_t)g * 16 + c) * 64 + p]; }
    const float ar = (float)abr, ai = (float)abi;
    float xr = 0.f, xi = 0.f;
    if (!prompt) { xr = a.in[I_S5RE][((size_t)b * 128 + g) * 64 + p]; xi = a.in[I_S5IM][((size_t)b * 128 + g) * 64 + p]; }
    const bool b5 = lane & 32, b4 = lane & 16, b3 = lane & 8, b2 = lane & 4;
    const int cme = (b5 ? 8 : 0) + (b4 ? 4 : 0) + (b3 ? 2 : 0) + (b2 ? 1 : 0);
    const float dme = a.in[I_S5D][g * 16 + cme];
    const int L = prompt ? SEQ : DECS, row0 = prompt ? b * SEQ : MP + b * DECS;
    const bf16* hp = H + (size_t)row0 * DM + g * 16;
    u32x4 nu0 = *(const u32x4*)hp, nu1 = *(const u32x4*)(hp + 8); unsigned short nume = hp[cme];
    for (int t = 0; t < L; ++t) {
        float u[16]; { float ua[8], ub[8]; unpack8(nu0, ua); unpack8(nu1, ub);
#pragma unroll
            for (int c = 0; c < 8; ++c) { u[c] = ua[c]; u[8 + c] = ub[c]; } }
        const float ume = bf2f(nume);
        if (t + 1 < L) { hp += DM; nu0 = *(const u32x4*)hp; nu1 = *(const u32x4*)(hp + 8); nume = hp[cme]; }
        float bur = 0.f, bui = 0.f;
#pragma unroll
        for (int c = 0; c < 16; ++c) { bur += bbr[c] * u[c]; bui += bbi[c] * u[c]; }
        const float nxr = ar * xr - ai * xi + bur, nxi = ar * xi + ai * xr + bui; xr = nxr; xi = nxi;
        float vals[16];
#pragma unroll
        for (int c = 0; c < 16; ++c) vals[c] = cr[c] * xr - ci[c] * xi;
        float k8[8], k4[4], k2[2], y;
#pragma unroll
        for (int i = 0; i < 8; ++i) { const float send = b5 ? vals[i] : vals[8 + i], keep = b5 ? vals[8 + i] : vals[i]; k8[i] = keep + __shfl_xor(send, 32); }
#pragma unroll
        for (int i = 0; i < 4; ++i) { const float send = b4 ? k8[i] : k8[4 + i], keep = b4 ? k8[4 + i] : k8[i]; k4[i] = keep + __shfl_xor(send, 16); }
#pragma unroll
        for (int i = 0; i < 2; ++i) { const float send = b3 ? k4[i] : k4[2 + i], keep = b3 ? k4[2 + i] : k4[i]; k2[i] = keep + __shfl_xor(send, 8); }
        { const float send = b2 ? k2[0] : k2[1], keep = b2 ? k2[1] : k2[0]; y = keep + __shfl_xor(send, 4); }
        y += __shfl_xor(y, 2); y += __shfl_xor(y, 1);
        y = gelu_tanh(y + dme * ume);
        if ((lane & 3) == 0) G2[(size_t)(row0 + t) * DM + g * 16 + cme] = (bf16)f2bf(y);
    }
    const size_t so = ((size_t)b * 128 + g) * 64 + p;
    a.out[(prompt ? O_S5R_P : O_S5R_S) + so] = xr; a.out[(prompt ? O_S5I_P : O_S5I_S) + so] = xi;
}
__device__ __forceinline__ bf16x8 pack8(const float (&v)[8]) { u32x4 w; w.x = cvtpk(v[0], v[1]); w.y = cvtpk(v[2], v[3]); w.z = cvtpk(v[4], v[5]); w.w = cvtpk(v[6], v[7]); return __builtin_bit_cast(bf16x8, w); }
__device__ __forceinline__ float bfround(float x) { return __builtin_bit_cast(float, f2bf(x) << 16); }
constexpr int S5_PITCH = 132, S5_WAVE_LDS = 16 * S5_PITCH * 4;
constexpr int S5_SEG = 128, S5_NSEG = SEQ / S5_SEG;
constexpr size_t WS_S5E = WS_ACT;
struct S5C {
    bf16x8 Bf[8];
    bf16x8 Ch[4], Cl[4], Df;
    float nwa[8];
    float ar, ai;
};
__device__ __forceinline__ void s5_first(const bf16* H, const float* SS, int g, int row0, int lane, u32x4& An, float& sn_) {
    const int r = lane & 15, q = lane >> 4, rlast = MTOT - 1 - row0, rr = r < rlast ? r : rlast;
    An = *(const u32x4*)(H + (size_t)(row0 + rr) * DM + g * 16 + 8 * (q & 1)); sn_ = SS[row0 + rr];
}
template <bool FULL>
__device__ __forceinline__ void s5_run(const S5C& C, const bf16* H, const float* SS, bf16* G2, LAS float* T, int g, int row0, int L, float& xr, float& xi, int lane, u32x4 An, float sn_) {
    const int r = lane & 15, q = lane >> 4;
    const bf16* hp = H + (size_t)row0 * DM + g * 16 + 8 * (q & 1);
    for (int t0 = 0; t0 < L; t0 += 16) {
        bf16x8 A; { float xa[8]; unpack8(An, xa); const float rs = 1.0f / sqrtf(sn_ * (1.0f / DM) + EPS);
#pragma unroll
            for (int j = 0; j < 8; ++j) xa[j] = xa[j] * rs * C.nwa[j];
            A = pack8(xa); }
        if (t0 + 16 < L) { An = *(const u32x4*)(hp + (size_t)(t0 + 16 + r) * DM); sn_ = SS[row0 + t0 + 16 + r]; }
#pragma unroll
        for (int nt = 0; nt < 8; ++nt) { const f32x4 d = MFMA16(A, C.Bf[nt], ((f32x4){0.f, 0.f, 0.f, 0.f}));
#pragma unroll
            for (int reg = 0; reg < 4; ++reg) T[(4 * q + reg) * S5_PITCH + 16 * nt + r] = d[reg]; }
        float bur[16], bui[16];
#pragma unroll
        for (int t = 0; t < 16; ++t) { bur[t] = T[t * S5_PITCH + lane]; bui[t] = T[t * S5_PITCH + 64 + lane]; }
#pragma unroll
        for (int t = 0; t < 16; ++t) { if (t0 + t < L) { const float nr = C.ar * xr - C.ai * xi + bur[t], ni = C.ar * xi + C.ai * xr + bui[t]; xr = nr; xi = ni; } bur[t] = xr; bui[t] = xi; }
        if (FULL) {
#pragma unroll
            for (int t = 0; t < 16; ++t) { T[t * S5_PITCH + lane] = bur[t]; T[t * S5_PITCH + 64 + lane] = bui[t]; }
            f32x4 y = MFMA16(A, C.Df, ((f32x4){0.f, 0.f, 0.f, 0.f}));
#pragma unroll
            for (int s = 0; s < 4; ++s) { const f32x4 x0 = *(const LAS f32x4*)(T + r * S5_PITCH + 32 * s + 8 * q), x1 = *(const LAS f32x4*)(T + r * S5_PITCH + 32 * s + 8 * q + 4);
                u32x4 wh; wh[0] = cvtpk(x0[0], x0[1]); wh[1] = cvtpk(x0[2], x0[3]); wh[2] = cvtpk(x1[0], x1[1]); wh[3] = cvtpk(x1[2], x1[3]);
                const bf16x8 xh = __builtin_bit_cast(bf16x8, wh);
                y = MFMA16(xh, C.Ch[s], y); y = MFMA16(xh, C.Cl[s], y); }
#pragma unroll
            for (int reg = 0; reg < 4; ++reg) { const int t = t0 + 4 * q + reg; if (t < L) G2[(size_t)(row0 + t) * DM + g * 16 + r] = (bf16)f2bf(gelu_tanh(y[reg])); }
        }
    }
}
__device__ __forceinline__ void s5_wave(const Args& a, LAS float* T, bool second, int g, int sub, int lane) {
    unsigned char* ws = a.ws;
    const bf16* H = (const bf16*)(ws + WS_H); bf16* G2 = (bf16*)(ws + WS_G2); const float* SS = (const float*)(ws + WS_SS) + MTOT;
    float* E = (float*)(ws + WS_S5E);
    const int r = lane & 15, q = lane >> 4;
    S5C C;
    float cfrf, cfif, a128r, a128i;
    {   const int gp = g * 64 + lane;
        const double lr = (double)a.in[I_LRE][gp], li = (double)a.in[I_LIM][gp], dt = exp((double)a.in[I_LDT][g]);
        const double mag = exp(lr * dt); double sn, cs; sincos_d(li * dt, sn, cs);
        const double abr = mag * cs, abi = mag * sn, den = lr * lr + li * li;
        C.ar = (float)abr; C.ai = (float)abi; cfrf = (float)(((abr - 1.0) * lr + abi * li) / den); cfif = (float)((abi * lr - (abr - 1.0) * li) / den);
        const double m128 = exp(lr * dt * (double)S5_SEG); sincos_d(li * dt * (double)S5_SEG, sn, cs); a128r = (float)(m128 * cs); a128i = (float)(m128 * sn); }
    ld_f8(a.in[I_NMIX] + DM + g * 16 + 8 * (q & 1), C.nwa);
#pragma unroll
    for (int nt = 0; nt < 8; ++nt) { const int p = (16 * nt + r) & 63; const float cr_ = __shfl(cfrf, p), ci_ = __shfl(cfif, p);
        float br[8], bi[8], v[8]; ld_f8(a.in[I_BRE] + ((size_t)g * 64 + p) * 16 + 8 * (q & 1), br); ld_f8(a.in[I_BIM] + ((size_t)g * 64 + p) * 16 + 8 * (q & 1), bi);
#pragma unroll
        for (int j = 0; j < 8; ++j) { const float val = (nt < 4) ? (cr_ * br[j] - ci_ * bi[j]) : (cr_ * bi[j] + ci_ * br[j]); const float hi = bfround(val); v[j] = (q < 2) ? hi : (val - hi); }
        C.Bf[nt] = pack8(v); }
#pragma unroll
    for (int s = 0; s < 4; ++s) { float cv[8], hi[8], lo[8]; ld_f8((s < 2 ? a.in[I_CRE] : a.in[I_CIM]) + ((size_t)g * 16 + r) * 64 + 32 * (s & 1) + 8 * q, cv);
#pragma unroll
        for (int j = 0; j < 8; ++j) { const float val = (s < 2) ? cv[j] : -cv[j]; hi[j] = bfround(val); lo[j] = val - hi[j]; }
        C.Ch[s] = pack8(hi); C.Cl[s] = pack8(lo); }
    {   const float dv = a.in[I_S5D][g * 16 + r], dh = bfround(dv), dl = dv - dh; float v[8];
#pragma unroll
        for (int j = 0; j < 8; ++j) v[j] = ((r & 7) == j && (r >> 3) == (q & 1)) ? (q < 2 ? dh : dl) : 0.f;
        C.Df = pack8(v); }
    const int NT = second ? 4 : 12;
    u32x4 Ap; float sp_, xpr = 0.f, xpi = 0.f;
    s5_first(H, SS, g, sub * S5_SEG, lane, Ap, sp_);
#pragma unroll 1
    for (int ti = 0; ti < NT; ++ti) {
        const u32x4 Ac = Ap; const float sc_ = sp_, xcr = xpr, xci = xpi;
        if (ti + 1 < NT) { const int tn = ti + 1;
            if (tn < 4) s5_first(H, SS, g, tn * SEQ + sub * S5_SEG, lane, Ap, sp_);
            else { const int bn = sub * 8 + (tn - 4); s5_first(H, SS, g, MP + bn * DECS, lane, Ap, sp_); const size_t so = ((size_t)bn * 128 + g) * 64 + lane; xpr = a.in[I_S5RE][so]; xpi = a.in[I_S5IM][so]; } }
        if (ti < 4) { const int b = ti, row0 = b * SEQ + sub * S5_SEG; float* Eb = E + (((size_t)b * 128 + g) * S5_NSEG) * 128;
            if (!second) { float xr = 0.f, xi = 0.f; s5_run<false>(C, H, SS, G2, T, g, row0, S5_SEG, xr, xi, lane, Ac, sc_); Eb[sub * 128 + lane] = xr; Eb[sub * 128 + 64 + lane] = xi; }
            else { float er[15], ei[15];
#pragma unroll
                for (int m = 0; m < 15; ++m) { const int mm = m < sub ? m : 0; er[m] = Eb[mm * 128 + lane]; ei[m] = Eb[mm * 128 + 64 + lane]; }
                float xr = 0.f, xi = 0.f;
#pragma unroll
                for (int m = 0; m < 15; ++m) if (m < sub) { const float nr = a128r * xr - a128i * xi + er[m], ni = a128r * xi + a128i * xr + ei[m]; xr = nr; xi = ni; }
                s5_run<true>(C, H, SS, G2, T, g, row0, S5_SEG, xr, xi, lane, Ac, sc_);
                if (sub == S5_NSEG - 1) { const size_t so = ((size_t)b * 128 + g) * 64 + lane; a.out[O_S5R_P + so] = xr; a.out[O_S5I_P + so] = xi; } }
        } else { const int b = sub * 8 + (ti - 4); const size_t so = ((size_t)b * 128 + g) * 64 + lane;
            float xr = xcr, xi = xci;
            s5_run<true>(C, H, SS, G2, T, g, MP + b * DECS, DECS, xr, xi, lane, Ac, sc_);
            a.out[O_S5R_S + so] = xr; a.out[O_S5I_S + so] = xi; }
    }
}
__device__ __forceinline__ void ph_s5(const Args& a, LAS unsigned char* lds, bool second, int lane, int wave, int gw, int NGW) {
    LAS float* T = (LAS float*)(lds + wave * S5_WAVE_LDS);
    for (int w = gw; w < 2048; w += NGW) s5_wave(a, T, second, w >> 4, w & 15, lane);
}

constexpr int S5MM_REP = 0;
constexpr int SM_WC = 0, SM_WST = 65536, SM_KT = 131072, SM_POW = 139264, SM_CF = 147968;
constexpr size_t WS_S5L = WS_ACT, WS_S5X = WS_ACT + 48 * MiB, WS_UG = WS_BIG + 64 * MiB;
typedef float f32x2_t __attribute__((ext_vector_type(2)));
__device__ __forceinline__ int s5_row(int hb, int col, int t) {
    return col < 256 ? (2 * hb + (col >> 7)) * SEQ + 16 * (col & 127) + t : MP + (64 * hb + (col - 256)) * DECS + t;
}
__device__ __forceinline__ void s5_load_u(const Args& a, int g, int hb, int cb, int lane, bf16x8 (&Uf)[8]) {
    const bf16* UG = (const bf16*)(a.ws + WS_UG0);
    const int r = lane & 15, q = lane >> 4, col = 16 * cb + r; const bool samp = col >= 256;
    const bf16* up = UG + ((size_t)g * MTOT + s5_row(hb, col, 0)) * 16 + 16 * (q >> 1) + 8 * (q & 1);
#pragma unroll
    for (int ks = 0; ks < 8; ++ks) { Uf[ks] = *(const bf16x8*)(up + ((samp && ks >= 4) ? 0 : 32 * ks)); if (samp && ks >= 4) Uf[ks] = (bf16x8){0, 0, 0, 0, 0, 0, 0, 0}; }
}
__device__ __forceinline__ void ph_s5_mm(const Args& a, LAS unsigned char* lds, int task, int tid, int lane, int wave) {
    unsigned char* ws = a.ws;
    const int g = task >> 1, hb = task & 1, r = lane & 15, q = lane >> 4;
    LAS f32x2_t* POW = (LAS f32x2_t*)(lds + SM_POW); LAS f32x2_t* CF = (LAS f32x2_t*)(lds + SM_CF);
    float* LB = (float*)(ws + WS_S5L) + (size_t)task * 320 * 128; float* XB = (float*)(ws + WS_S5X) + (size_t)task * 320 * 128;
    bf16* G2 = (bf16*)(ws + WS_G2);
    for (int rep_t = 0; rep_t < (S5MM_REP == 1 ? 2 : 1); ++rep_t) {
    __syncthreads();
    if (tid < 64) { const int gp = g * 64 + tid;
        const double lr = (double)a.in[I_LRE][gp], li = (double)a.in[I_LIM][gp], dt = exp((double)a.in[I_LDT][g]);
        const double mag = exp(lr * dt); double sn, cs; sincos_d(li * dt, sn, cs);
        const double abr = mag * cs, abi = mag * sn, den = lr * lr + li * li;
        CF[tid] = (f32x2_t){(float)(((abr - 1.0) * lr + abi * li) / den), (float)((abi * lr - (abr - 1.0) * li) / den)};
        double pr = 1.0, pi = 0.0;
#pragma unroll 1
        for (int e = 0; e <= 16; ++e) { POW[tid * 17 + e] = (f32x2_t){(float)pr, (float)pi}; const double nr = pr * abr - pi * abi, ni = pr * abi + pi * abr; pr = nr; pi = ni; } }
    __syncthreads();
    {
        const int kp = tid & 127, p = kp & 63, part = kp >> 6, s0 = 4 * (tid >> 7);
        const f32x2_t cf = CF[p]; float bbr[16], bbi[16];
#pragma unroll
        for (int c4 = 0; c4 < 4; ++c4) { const f32x4 br = *(const f32x4*)(a.in[I_BRE] + ((size_t)g * 64 + p) * 16 + 4 * c4), bi = *(const f32x4*)(a.in[I_BIM] + ((size_t)g * 64 + p) * 16 + 4 * c4);
#pragma unroll
            for (int j = 0; j < 4; ++j) { bbr[4 * c4 + j] = cf.x * br[j] - cf.y * bi[j]; bbi[4 * c4 + j] = cf.x * bi[j] + cf.y * br[j]; } }
#pragma unroll
        for (int si = 0; si < 4; ++si) { const int s = s0 + si; const f32x2_t pw = POW[p * 17 + 15 - s]; float v[16];
#pragma unroll
            for (int c = 0; c < 16; ++c) v[c] = part ? (pw.x * bbi[c] + pw.y * bbr[c]) : (pw.x * bbr[c] - pw.y * bbi[c]);
            u32x4 w0, w1; w0.x = pk2(v[0], v[1]); w0.y = pk2(v[2], v[3]); w0.z = pk2(v[4], v[5]); w0.w = pk2(v[6], v[7]); w1.x = pk2(v[8], v[9]); w1.y = pk2(v[10], v[11]); w1.z = pk2(v[12], v[13]); w1.w = pk2(v[14], v[15]);
            *(LAS u32x4*)(lds + SM_WST + kp * 512 + (((2 * s) ^ (kp & 15)) << 4)) = w0; *(LAS u32x4*)(lds + SM_WST + kp * 512 + (((2 * s + 1) ^ (kp & 15)) << 4)) = w1; }
    }
    {
        const int R = tid & 255, t = R >> 4, c = R & 15, half = tid >> 8;
#pragma unroll 4
        for (int i = 0; i < 8; ++i) { float v[8]; const f32x4 cr0 = *(const f32x4*)(a.in[I_CRE] + ((size_t)g * 16 + c) * 64 + 8 * i), cr1 = *(const f32x4*)(a.in[I_CRE] + ((size_t)g * 16 + c) * 64 + 8 * i + 4),
                                                         ci0 = *(const f32x4*)(a.in[I_CIM] + ((size_t)g * 16 + c) * 64 + 8 * i), ci1 = *(const f32x4*)(a.in[I_CIM] + ((size_t)g * 16 + c) * 64 + 8 * i + 4);
#pragma unroll
            for (int j = 0; j < 8; ++j) { const float cr = j < 4 ? cr0[j] : cr1[j - 4], ci = j < 4 ? ci0[j] : ci1[j - 4]; const f32x2_t pw = POW[(8 * i + j) * 17 + t + 1];
                v[j] = half ? -(cr * pw.y + ci * pw.x) : (cr * pw.x - ci * pw.y); }
            u32x4 w; w.x = pk2(v[0], v[1]); w.y = pk2(v[2], v[3]); w.z = pk2(v[4], v[5]); w.w = pk2(v[6], v[7]);
            *(LAS u32x4*)(lds + SM_WC + addr256(R, 8 * half + i)) = w; }
    }
    __syncthreads();
    {
        bf16x8 Bs[4];
        {   float re8[2][8], im8[2][8];
#pragma unroll
            for (int ks = 0; ks < 2; ++ks)
#pragma unroll
                for (int j = 0; j < 8; ++j) { const int p = 32 * ks + 8 * q + j; const float br = a.in[I_BRE][((size_t)g * 64 + p) * 16 + r], bi = a.in[I_BIM][((size_t)g * 64 + p) * 16 + r]; const f32x2_t cf = CF[p];
                    re8[ks][j] = cf.x * br - cf.y * bi; im8[ks][j] = cf.x * bi + cf.y * br; }
            Bs[0] = pack8(re8[0]); Bs[1] = pack8(re8[1]); Bs[2] = pack8(im8[0]); Bs[3] = pack8(im8[1]); }
#pragma unroll
        for (int di = 0; di < 2; ++di) { const int d = 2 * wave + di; f32x4 acc = {0.f, 0.f, 0.f, 0.f};
            if (d == 0) {
#pragma unroll
                for (int ks = 0; ks < 4; ++ks) { float cv[8]; ld_f8((ks < 2 ? a.in[I_CRE] : a.in[I_CIM]) + ((size_t)g * 16 + r) * 64 + 32 * (ks & 1) + 8 * q, cv);
                    if (ks >= 2) {
#pragma unroll
                        for (int j = 0; j < 8; ++j) cv[j] = -cv[j]; }
                    acc = MFMA16(pack8(cv), Bs[ks], acc); }
#pragma unroll
                for (int reg = 0; reg < 4; ++reg) if (4 * q + reg == r) acc[reg] += a.in[I_S5D][g * 16 + r];
            } else {
#pragma unroll
                for (int ks = 0; ks < 4; ++ks) acc = MFMA16(*(const LAS bf16x8*)(lds + SM_WC + addr256(16 * (d - 1) + r, 4 * ks + q)), Bs[ks], acc); }
#pragma unroll
            for (int reg = 0; reg < 4; ++reg) *(LAS bf16*)(lds + SM_KT + ((d * 16 + 4 * q + reg) * 16 + r) * 2) = (bf16)f2bf(acc[reg]); }
    }
    __syncthreads();
    }
    for (int rep_1 = 0; rep_1 < (S5MM_REP == 2 ? 2 : 1); ++rep_1) {
    for (int cb = wave; cb < 20; cb += NWAVES) {
        bf16x8 Uf[8]; s5_load_u(a, g, hb, cb, lane, Uf);
        bf16x8 Fa[8], Fb[8];
#define LDW(F, mt_) do { _Pragma("unroll") for (int ks = 0; ks < 8; ++ks) { const int row = 16 * (mt_) + r; F[ks] = *(const LAS bf16x8*)(lds + SM_WST + row * 512 + (((4 * ks + q) ^ (row & 15)) << 4)); } } while (0)
#define MMW(F, mt_) do { f32x4 acc = {0.f, 0.f, 0.f, 0.f}; _Pragma("unroll") for (int ks = 0; ks < 8; ++ks) acc = MFMA16(F[ks], Uf[ks], acc); *(f32x4*)(LB + (size_t)(16 * cb + r) * 128 + 16 * (mt_) + 4 * q) = acc; } while (0)
        LDW(Fa, 0);
#pragma unroll
        for (int m2 = 0; m2 < 4; ++m2) { LDW(Fb, 2 * m2 + 1); __builtin_amdgcn_sched_barrier(0); MMW(Fa, 2 * m2); __builtin_amdgcn_sched_barrier(0);
            if (m2 < 3) LDW(Fa, 2 * m2 + 2); __builtin_amdgcn_sched_barrier(0); MMW(Fb, 2 * m2 + 1); __builtin_amdgcn_sched_barrier(0); }
#undef LDW
#undef MMW
    }
    __syncthreads();
    }
    for (int rep_2 = 0; rep_2 < (S5MM_REP == 3 ? 2 : 1); ++rep_2) {
    if (wave < 2) {
        const int b = 2 * hb + wave; const f32x2_t a16 = POW[lane * 17 + 16]; float xr = 0.f, xi = 0.f;
        const float* lp = LB + (size_t)(wave * 128) * 128; float* xp = XB + (size_t)(wave * 128) * 128;
        float lr_[8], li_[8], nr_[8], ni_[8];
#pragma unroll
        for (int k = 0; k < 8; ++k) { lr_[k] = lp[(size_t)k * 128 + lane]; li_[k] = lp[(size_t)k * 128 + 64 + lane]; }
#pragma unroll 1
        for (int n0 = 0; n0 < 128; n0 += 8) {
            const int nn = n0 + 8 < 128 ? n0 + 8 : n0;
#pragma unroll
            for (int k = 0; k < 8; ++k) { nr_[k] = lp[(size_t)(nn + k) * 128 + lane]; ni_[k] = lp[(size_t)(nn + k) * 128 + 64 + lane]; }
#pragma unroll
            for (int k = 0; k < 8; ++k) { xp[(size_t)(n0 + k) * 128 + lane] = xr; xp[(size_t)(n0 + k) * 128 + 64 + lane] = xi;
                const float nr = a16.x * xr - a16.y * xi + lr_[k], ni = a16.x * xi + a16.y * xr + li_[k]; xr = nr; xi = ni; }
#pragma unroll
            for (int k = 0; k < 8; ++k) { lr_[k] = nr_[k]; li_[k] = ni_[k]; } }
        const size_t so = ((size_t)b * 128 + g) * 64 + lane; a.out[O_S5R_P + so] = xr; a.out[O_S5I_P + so] = xi;
    } else if (wave < 6) {
        const f32x2_t a16 = POW[lane * 17 + 16], a8 = POW[lane * 17 + 8]; const float inv = 1.0f / (a8.x * a8.x + a8.y * a8.y), i8r = a8.x * inv, i8i = -a8.y * inv;
#pragma unroll 1
        for (int j = 0; j < 16; ++j) { const int sc = 16 * (wave - 2) + j, col = 256 + sc, bs = 64 * hb + sc; const size_t so = ((size_t)bs * 128 + g) * 64 + lane;
            const float xr = a.in[I_S5RE][so], xi = a.in[I_S5IM][so]; XB[(size_t)col * 128 + lane] = xr; XB[(size_t)col * 128 + 64 + lane] = xi;
            const float zr = a16.x * xr - a16.y * xi + LB[(size_t)col * 128 + lane], zi = a16.x * xi + a16.y * xr + LB[(size_t)col * 128 + 64 + lane];
            a.out[O_S5R_S + so] = zr * i8r - zi * i8i; a.out[O_S5I_S + so] = zr * i8i + zi * i8r; }
    }
    __syncthreads();
    }
    for (int rep_3 = 0; rep_3 < (S5MM_REP == 4 ? 2 : 1); ++rep_3) {
    for (int cb = wave; cb < 20; cb += NWAVES) {
        bf16x8 Uf[8], Xf[4]; s5_load_u(a, g, hb, cb, lane, Uf);
        const int col = 16 * cb + r; const bool samp = col >= 256;
#pragma unroll
        for (int ks = 0; ks < 4; ++ks) { float x[8]; ld_f8(XB + (size_t)col * 128 + 32 * ks + 8 * q, x); Xf[ks] = pack8(x); }
#pragma unroll
        for (int t = 0; t < 16; ++t) { f32x4 acc = {0.f, 0.f, 0.f, 0.f};
            bf16x8 Fk[8], Fw[4];
#pragma unroll
            for (int ks = 0; ks <= t / 2; ++ks) { const int d = t - 2 * ks - (q >> 1);
                Fk[ks] = *(const LAS bf16x8*)(lds + SM_KT + (((d < 0 ? 0 : d) * 16 + r) * 16 + 8 * (q & 1)) * 2); if (d < 0) Fk[ks] = (bf16x8){0, 0, 0, 0, 0, 0, 0, 0}; }
#pragma unroll
            for (int ks = 0; ks < 4; ++ks) Fw[ks] = *(const LAS bf16x8*)(lds + SM_WC + addr256(16 * t + r, 4 * ks + q));
            __builtin_amdgcn_sched_barrier(0);
#pragma unroll
            for (int ks = 0; ks <= t / 2; ++ks) acc = MFMA16(Fk[ks], Uf[ks], acc);
#pragma unroll
            for (int ks = 0; ks < 4; ++ks) acc = MFMA16(Fw[ks], Xf[ks], acc);
            if (!samp || t < 8) { u32x2 o; o.x = cvtpk(gelu_tanh_fast(acc[0]), gelu_tanh_fast(acc[1])); o.y = cvtpk(gelu_tanh_fast(acc[2]), gelu_tanh_fast(acc[3]));
                *(u32x2*)(G2 + (size_t)s5_row(hb, col, t) * DM + g * 16 + 4 * q) = o; }
            asm volatile("" ::: "memory"); }
    }
    }
}

constexpr int N_PHASES = 21;
constexpr unsigned DUPMASK = 0u;
constexpr int P3PROBE = 0;
__global__ void __launch_bounds__(NTHR, 2) fwd_kernel(Args a) {
    extern __shared__ __attribute__((aligned(16))) unsigned char lds_raw[];
    LAS unsigned char* lds = (LAS unsigned char*)lds_raw;
    const int tid = threadIdx.x, lane = tid & 63, wave = __builtin_amdgcn_readfirstlane(tid >> 6);
    constexpr int G = 256;
    const int gw = blockIdx.x * NWAVES + wave, NGW = G * NWAVES;
    unsigned char* ws = a.ws;
    const int lo = a.ph_lo, hi = a.ph_hi;
    volatile LAS unsigned* MISC = (volatile LAS unsigned*)(lds + MISC_OFF);
    if (tid < 64) MISC[tid] = 0u;
    __syncthreads();
    XcdBarrier bar = xcd_barrier_post((unsigned*)(ws + WS_CTL) + CW_BAR, MISC + 8);
#define IN(k) (lo <= (k) && (k) < hi)
#define SEAM(k) do { if (IN(k) && IN((k) + 1)) xcd_barrier(bar); } while (0)
#define PHASE(k, ...) if (IN(k)) { __VA_ARGS__ if ((DUPMASK >> (k)) & 1u) { xcd_barrier(bar); __VA_ARGS__ } } SEAM(k);
#define GEMM_PHASE(EPI, Aop, Bop, N_, K_, E_) do { pg8::Gemm g{(const pg8::bf16_t*)(Aop), (const pg8::bf16_t*)(Bop), MTOT, (N_), (K_), (K_)}; pg8::StaticOrder S; S.init(MTOT, (N_), G, (int)blockIdx.x); \
        pg8::gemm_phase<EPI, pg8::StaticOrder, true, true>(lds, g, S, E_); } while (0)
#define SS ((float*)(ws + WS_SS))
#define X ((float*)(ws + WS_X))
#define H ((bf16*)(ws + WS_H))
#define G2 ((bf16*)(ws + WS_G2))
#define BIG ((bf16*)(ws + WS_BIG))
#define ACT ((bf16*)(ws + WS_ACT))

    PHASE(0, ph_prologue(a, lds, tid, lane, wave, gw, NGW, G);)
    PHASE(1, pg8::EpiBf16Plain E{BIG, NPROJ}; GEMM_PHASE(pg8::EpiBf16Plain, H, ws + WS_WIN, NPROJ, 2048, E);)
    PHASE(2, ph_mix_prep(a, lds, tid, lane, wave, gw, NGW, G);)
    if (IN(3)) { ph_scans(a, lds, tid, lane, wave, G); if (P3PROBE) { xcd_barrier(bar); ph_scans(a, lds, tid, lane, wave, G, P3PROBE); } } SEAM(3);
    PHASE(4, ph_mix_norm(a, lane, gw, NGW);)
    PHASE(5, pg8::EpiResNorm E{X, H, SS, DM, a.in[I_XP], a.in[I_XS]}; GEMM_PHASE(pg8::EpiResNorm, G2, ws + WS_WOUT, 2048, 2048, E);
             if (G == 256 && blockIdx.x >= 32) convert_group(a, 3, (LAS float*)(lds + wave * 8704), lane, ((int)blockIdx.x - 32) * NWAVES + wave, 224 * NWAVES);)
    PHASE(7, if (G == 256) { pg8::EpiBf16Rstd E{BIG, NUP, SS};
                    if (((int)blockIdx.x & 7) < 4) { convert_group(a, 2, (LAS float*)(lds + wave * 8704), lane, (int)blockIdx.x * NWAVES + wave, 256 * NWAVES); __syncthreads(); }
                    { const int L = (int)blockIdx.x - 128; pg8::Gemm g{(const pg8::bf16_t*)H, (const pg8::bf16_t*)(ws + WS_WUP), MTOT, NUP, 2048, 2048}; pg8::PlusOne S; S.init(MP, NUP, G, (int)blockIdx.x); S.extra = pg8::Unit{32 + (L & 3), L >> 2}; S.has_extra = L >= 0;
                      pg8::gemm_phase<pg8::EpiBf16Rstd, pg8::PlusOne, true, true>(lds, g, S, E); }
                    if (((int)blockIdx.x & 7) >= 4) convert_group(a, 2, (LAS float*)(lds + wave * 8704), lane, (int)blockIdx.x * NWAVES + wave, 256 * NWAVES); }
                  else { pg8::EpiBf16Rstd E{BIG, NUP, SS}; GEMM_PHASE(pg8::EpiBf16Rstd, H, ws + WS_WUP, NUP, 2048, E); })
    PHASE(18, if (G == 256) { if (blockIdx.x < 48) { pg8::EpiBf16Rstd E{BIG, NUP, SS};
                        const int L = 128 + (int)blockIdx.x; pg8::Gemm g{(const pg8::bf16_t*)H, (const pg8::bf16_t*)(ws + WS_WUP), MTOT, NUP, 2048, 2048}; pg8::OneUnit S{{32 + (L & 3), L >> 2}, true}; pg8::gemm_phase<pg8::EpiBf16Rstd, pg8::OneUnit, true, true>(lds, g, S, E); }
                      else ffn_conv_prompt(a, 0, lane, ((int)blockIdx.x - 48) * NWAVES + wave, 208 * NWAVES); }
                  else ffn_conv_prompt(a, 0, lane, gw, NGW);)
    PHASE(8, ffn_conv_sample(a, 0, lane, gw, NGW);)
    PHASE(9, { pg8::EpiResNorm E{X, H, SS + MTOT, DM, X, X + (size_t)8192 * DM};
                 pg8::Gemm g{(const pg8::bf16_t*)ACT, (const pg8::bf16_t*)(ws + WS_WDN), MP, 2048, DFF, DFF}; pg8::StaticOrder S; S.init(MP, 2048, G, (int)blockIdx.x);
                 pg8::gemm_phase<pg8::EpiResNorm, pg8::StaticOrder, true, true>(lds, g, S, E); }
               { const int p = (int)blockIdx.x, kq = p & 3, un = p >> 2;
                 pg8::EpiSlab E{(float*)BIG + (size_t)kq * MS * DM, DM};
                 pg8::Gemm g{(const pg8::bf16_t*)ACT + kq * 1408, (const pg8::bf16_t*)(ws + WS_WDN) + kq * 1408, MTOT, 2048, 1408, DFF};
                 pg8::OneUnit S{{32 + (un & 3), un >> 2}, p < 128};
                 pg8::gemm_phase<pg8::EpiSlab, pg8::OneUnit, true, true>(lds, g, S, E); }
               )
    PHASE(10, ph_combine<false>(X, H, SS + MTOT, (const float*)BIG, lane, gw, NGW, (bf16*)(ws + WS_UG0), a.in[I_NMIX] + DM);
              ph_ug_prompt(H, SS + MTOT, a.in[I_NMIX] + DM, (bf16*)(ws + WS_UG0), lane, gw, NGW);)
    PHASE(11, if (G == 256) ph_s5_mm(a, lds, (int)blockIdx.x, tid, lane, wave); else { for (int task = (int)blockIdx.x; task < 256; task += G) ph_s5_mm(a, lds, task, tid, lane, wave); })
    PHASE(12, { pg8::EpiGluRes E{X, H, SS + 2 * MTOT, DM};
                  pg8::Gemm g{(const pg8::bf16_t*)G2, (const pg8::bf16_t*)(ws + WS_WGLU), MP, NGLU, 2048, 2048}; pg8::StaticOrder S; S.init(MP, NGLU, G, (int)blockIdx.x);
                  pg8::gemm_phase<pg8::EpiGluRes, pg8::StaticOrder, true, true>(lds, g, S, E); }
                { const int p = (int)blockIdx.x, kq = p & 3, un = p >> 2;
                  pg8::EpiSlab E{(float*)BIG + (size_t)kq * MS * NGLU, NGLU};
                  pg8::Gemm g{(const pg8::bf16_t*)G2 + kq * 512, (const pg8::bf16_t*)(ws + WS_WGLU) + kq * 512, MTOT, NGLU, 512, 2048};
                  pg8::OneUnit S{{32 + (un & 3), un >> 2}, true};
                  pg8::gemm_phase<pg8::EpiSlab, pg8::OneUnit, true, true>(lds, g, S, E); })
    PHASE(13, ph_combine<true>(X, H, SS + 2 * MTOT, (const float*)BIG, lane, gw, NGW);)
    PHASE(14, if (G == 256) { pg8::EpiBf16Rstd E{BIG, NUP, SS + 2 * MTOT};
                    { const int L = (int)blockIdx.x - 128; pg8::Gemm g{(const pg8::bf16_t*)H, (const pg8::bf16_t*)(ws + WS_WUP + (size_t)NUP * 2048 * 2), MTOT, NUP, 2048, 2048}; pg8::PlusOne S; S.init(MP, NUP, G, (int)blockIdx.x); S.extra = pg8::Unit{32 + (L & 3), L >> 2}; S.has_extra = L >= 0;
                      pg8::gemm_phase<pg8::EpiBf16Rstd, pg8::PlusOne, true, true>(lds, g, S, E); } }
                  else { pg8::EpiBf16Rstd E{BIG, NUP, SS + 2 * MTOT}; GEMM_PHASE(pg8::EpiBf16Rstd, H, ws + WS_WUP + (size_t)NUP * 2048 * 2, NUP, 2048, E); })
    PHASE(19, if (G == 256) { if (blockIdx.x < 48) { pg8::EpiBf16Rstd E{BIG, NUP, SS + 2 * MTOT};
                        const int L = 128 + (int)blockIdx.x; pg8::Gemm g{(const pg8::bf16_t*)H, (const pg8::bf16_t*)(ws + WS_WUP + (size_t)NUP * 2048 * 2), MTOT, NUP, 2048, 2048}; pg8::OneUnit S{{32 + (L & 3), L >> 2}, true}; pg8::gemm_phase<pg8::EpiBf16Rstd, pg8::OneUnit, true, true>(lds, g, S, E); }
                      else ffn_conv_prompt(a, 1, lane, ((int)blockIdx.x - 48) * NWAVES + wave, 208 * NWAVES); }
                  else ffn_conv_prompt(a, 1, lane, gw, NGW);)
    PHASE(15, ffn_conv_sample(a, 1, lane, gw, NGW);)
    PHASE(16, { pg8::EpiResNorm E{X, H, SS + 3 * MTOT, DM, X, X + (size_t)8192 * DM};
                  pg8::Gemm g{(const pg8::bf16_t*)ACT, (const pg8::bf16_t*)(ws + WS_WDN + (size_t)2048 * DFF * 2), MP, 2048, DFF, DFF}; pg8::StaticOrder S; S.init(MP, 2048, G, (int)blockIdx.x);
                  pg8::gemm_phase<pg8::EpiResNorm, pg8::StaticOrder, true, true>(lds, g, S, E); }
                { const int p = (int)blockIdx.x, kq = p & 3, un = p >> 2;
                  pg8::EpiSlab E{(float*)BIG + (size_t)kq * MS * DM, DM};
                  pg8::Gemm g{(const pg8::bf16_t*)ACT + kq * 1408, (const pg8::bf16_t*)(ws + WS_WDN + (size_t)2048 * DFF * 2) + kq * 1408, MTOT, 2048, 1408, DFF};
                  pg8::OneUnit S{{32 + (un & 3), un >> 2}, p < 128};
                  pg8::gemm_phase<pg8::EpiSlab, pg8::OneUnit, true, true>(lds, g, S, E); })
    if (IN(17)) { int t17 = threadIdx.x; asm volatile("" : "+v"(t17));
                  ph_rms_out(X, SS + 3 * MTOT, (const float*)BIG, a.in[I_NFIN], a.out + O_Y, t17 & 63, (int)blockIdx.x * NWAVES + __builtin_amdgcn_readfirstlane(t17 >> 6), NGW); }
#undef IN
#undef SEAM
#undef GEMM_PHASE
#undef SS
#undef X
#undef H
#undef G2
#undef BIG
#undef ACT
}

#ifndef MK_PER_PHASE
#define MK_PER_PHASE 0
#endif
extern "C" void kernel_launch(void* const* d_in, const int* in_sizes, int n_in, void* d_out, int out_size, void* d_ws, size_t ws_size, hipStream_t stream) {
    static int grid = 0;
    if (grid == 0) {
        if (n_in != 32 || out_size != (int)O_END || ws_size < WS_END) { fprintf(stderr, "kernel_launch: unexpected shapes: n_in %d out %d (want %zu) ws %zu (want %zu); nothing launched\n", n_in, out_size, (size_t)O_END, ws_size, (size_t)WS_END); grid = -1; return; }
        int dev = 0, cus = 0, per_cu = 0;
        if (hipGetDevice(&dev) != hipSuccess || hipDeviceGetAttribute(&cus, hipDeviceAttributeMultiprocessorCount, dev) != hipSuccess) { fprintf(stderr, "kernel_launch: device query failed\n"); grid = -1; return; }
        if (hipFuncSetAttribute((const void*)fwd_kernel, hipFuncAttributeMaxDynamicSharedMemorySize, LDS_BYTES) != hipSuccess) { fprintf(stderr, "kernel_launch: hipFuncSetAttribute failed\n"); grid = -1; return; }
        if (hipOccupancyMaxActiveBlocksPerMultiprocessor(&per_cu, (const void*)fwd_kernel, NTHR, LDS_BYTES) != hipSuccess || per_cu < 1) { fprintf(stderr, "kernel_launch: occupancy query says %d blocks per CU\n", per_cu); per_cu = 1; }
        (void)hipGetLastError();
        if (cus < 256) { fprintf(stderr, "kernel_launch: this kernel needs 256 CUs (one resident workgroup each), the device has %d; nothing launched\n", cus); grid = -1; return; }
        grid = 256;
        fprintf(stderr, "kernel_launch: grid %d (occupancy query %d per CU)\n", grid, per_cu);
    }
    if (grid < 0) return;
    if (hipMemsetAsync((char*)d_ws + WS_CTL, 0, CTL_ZERO_BYTES, stream) != hipSuccess) { fprintf(stderr, "kernel_launch: hipMemsetAsync failed\n"); return; }
    Args a{};
    for (int i = 0; i < 32; ++i) a.in[i] = (const float*)d_in[i];
    a.out = (float*)d_out; a.ws = (unsigned char*)d_ws;
#if MK_PER_PHASE
    for (int ph = 0; ph < N_PHASES; ++ph) { a.ph_lo = ph; a.ph_hi = ph + 1; hipLaunchKernelGGL(fwd_kernel, dim3(grid), dim3(NTHR), LDS_BYTES, stream, a); }
#else
    a.ph_lo = 0; a.ph_hi = N_PHASES;
    void* args[] = {&a};
    hipError_t e = hipLaunchCooperativeKernel((const void*)fwd_kernel, dim3(grid), dim3(NTHR), args, LDS_BYTES, stream);
    if (e != hipSuccess) fprintf(stderr, "kernel_launch: cooperative launch failed: %s (grid %d)\n", hipGetErrorString(e), grid);
#endif
}
```

```cpp
#include <hip/hip_runtime.h>
#include <hip/hip_cooperative_groups.h>
#include <cstdio>
#include <cstdint>
#include <cmath>
namespace cg = cooperative_groups;
namespace pg8 {
#define PG8_LAS __attribute__((address_space(3)))
typedef unsigned short bf16_t;
typedef short bf16x8 __attribute__((ext_vector_type(8)));
typedef float f32x4 __attribute__((ext_vector_type(4)));
typedef unsigned u32x4 __attribute__((ext_vector_type(4)));
constexpr int BM = 256, BK = 64, HALF = 128, HTB = HALF * BK * 2  , STAGE_BYTES = 8 * HTB, NXCD = 8, WGM = 4;

__host__ __device__ __forceinline__ int lds_byte(int r, int c) { const int st = (r >> 4) * 2 + (c >> 5), rr = r & 15, cc = c & 31, ob = rr * 64 + cc * 2; return st * 1024 + (ob ^ (((ob >> 9) & 1) << 5)); }
__host__ __device__ __forceinline__ void stage_rc(int b, int& R, int& C) { const int st = b / 1024, sb = b % 1024, swz = sb ^ (((sb >> 9) & 1) << 5); R = (st >> 1) * 16 + swz / 64; C = (st & 1) * 32 + (swz % 64) / 2; }
__host__ __device__ __forceinline__ int perm32(int rho) { const int n = rho >> 4, i = rho & 15; return 8 * (i >> 2) + 4 * n + (i & 3); }

struct Unit { int pm, pn; };
struct Gemm { const bf16_t* A; const bf16_t* Bt; int M, N, K, ldk; };

struct StaticOrder {
    int nM, nN, nwg, G, c;
    __host__ __device__ void init(int M, int N, int G_, int c_) { nM = M / BM; nN = N / BM; nwg = nM * nN; G = G_; c = c_; }
    __host__ __device__ bool next(int i, Unit& u) const {
        const long L = (long)i * G + c; if (L >= nwg) return false;
        int wgid = (int)L; { const int q = nwg / NXCD, r = nwg % NXCD, xcd = wgid % NXCD, off = wgid / NXCD; wgid = (xcd < r ? xcd * (q + 1) : r * (q + 1) + (xcd - r) * q) + off; }
        const int nig = WGM * nN, gid = wgid / nig, fm = gid * WGM, gsz = (nM - fm) < WGM ? (nM - fm) : WGM;
        u.pm = fm + ((wgid % nig) % gsz); u.pn = (wgid % nig) / gsz; return true;
    }
    __device__ __forceinline__ void a_ready(const Unit&) const {}
    __device__ __forceinline__ void done(const Unit&) const {}
};

__device__ __forceinline__ unsigned cvt_pk_bf16(float lo, float hi) { unsigned r; asm volatile("v_cvt_pk_bf16_f32 %0, %1, %2" : "=v"(r) : "v"(lo), "v"(hi)); return r; }

struct EpiBf16Plain {
    static constexpr bool PERM = true, AFTER_DRAIN = false;
    bf16_t* O; int ldc;
    __device__ __forceinline__ void operator()(const f32x4 (&acc)[2][2][4][2], const Unit& u, int wr, int wc, int fr, int fq) const {
        const int row0 = u.pm * BM + wr * 64 + fr, col0 = u.pn * BM + wc * 32 + 8 * fq;
#pragma unroll
        for (int ai = 0; ai < 2; ++ai)
#pragma unroll
            for (int m = 0; m < 4; ++m) { bf16_t* rowp = O + (size_t)(row0 + ai * HALF + m * 16) * ldc + col0;
#pragma unroll
                for (int bj = 0; bj < 2; ++bj) { const f32x4 v0 = acc[ai][bj][m][0], v1 = acc[ai][bj][m][1];
                    u32x4 w; w.x = cvt_pk_bf16(v0[0], v0[1]); w.y = cvt_pk_bf16(v0[2], v0[3]); w.z = cvt_pk_bf16(v1[0], v1[1]); w.w = cvt_pk_bf16(v1[2], v1[3]);
                    *(u32x4*)(rowp + bj * HALF) = w; } }
    }
};
struct EpiResF32 {
    static constexpr bool PERM = false, AFTER_DRAIN = false;
    float* X; int ldc;
    __device__ __forceinline__ void operator()(const f32x4 (&acc)[2][2][4][2], const Unit& u, int wr, int wc, int fr, int fq) const {
        const int row0 = u.pm * BM + wr * 64 + fr, col0 = u.pn * BM + wc * 32 + 4 * fq;
#pragma unroll
        for (int ai = 0; ai < 2; ++ai)
#pragma unroll
            for (int m = 0; m < 4; ++m) { float* rowp = X + (size_t)(row0 + ai * HALF + m * 16) * ldc + col0;
#pragma unroll
                for (int bj = 0; bj < 2; ++bj)
#pragma unroll
                    for (int n = 0; n < 2; ++n) { f32x4* p = (f32x4*)(rowp + bj * HALF + n * 16); *p = *p + acc[ai][bj][m][n]; }
                asm volatile("" ::: "memory"); }
    }
};
struct PlusOne : StaticOrder {
    Unit extra; bool has_extra;
    __device__ bool next(int i, Unit& u) const {
        if (StaticOrder::next(i, u)) return true;
        const int np = (nwg - c + G - 1) / G;
        if (has_extra && i == np) { u = extra; return true; }
        return false;
    }
};
struct OneUnit {
    Unit u; bool valid;
    __device__ bool next(int i, Unit& o) const { if (i != 0 || !valid) return false; o = u; return true; }
    __device__ __forceinline__ void a_ready(const Unit&) const {}
    __device__ __forceinline__ void done(const Unit&) const {}
};
struct EpiSlab {
    static constexpr bool PERM = false, AFTER_DRAIN = false;
    float* S; int ldc;
    __device__ __forceinline__ void operator()(const f32x4 (&acc)[2][2][4][2], const Unit& u, int wr, int wc, int fr, int fq) const {
        const int row0 = (u.pm - 32) * BM + wr * 64 + fr, col0 = u.pn * BM + wc * 32 + 4 * fq;
#pragma unroll
        for (int ai = 0; ai < 2; ++ai)
#pragma unroll
            for (int m = 0; m < 4; ++m) { float* rowp = S + (size_t)(row0 + ai * HALF + m * 16) * ldc + col0;
#pragma unroll
                for (int bj = 0; bj < 2; ++bj)
#pragma unroll
                    for (int n = 0; n < 2; ++n) *(f32x4*)(rowp + bj * HALF + n * 16) = acc[ai][bj][m][n]; }
    }
};
struct EpiResNorm {
    static constexpr bool PERM = false, AFTER_DRAIN = false;
    float* X; bf16_t* XB; float* SS; int ldc; const float* R0; const float* R1;
    __device__ __forceinline__ void operator()(const f32x4 (&acc)[2][2][4][2], const Unit& u, int wr, int wc, int fr, int fq) const {
        const int row0 = u.pm * BM + wr * 64 + fr, col0 = u.pn * BM + wc * 32 + 4 * fq;
        const float* Rb = (u.pm < 32) ? R0 : R1 - (size_t)8192 * ldc;
#pragma unroll
        for (int ap = 0; ap < 4; ++ap) {
            const int ai = ap >> 1, m0 = (ap & 1) * 2;
            f32x4 res[2][4];
#pragma unroll
            for (int mm = 0; mm < 2; ++mm) { const float* rp = Rb + (size_t)(row0 + ai * HALF + (m0 + mm) * 16) * ldc + col0;
#pragma unroll
                for (int i = 0; i < 4; ++i) res[mm][i] = *(const f32x4*)(rp + (i >> 1) * HALF + (i & 1) * 16); }
#pragma unroll
            for (int mm = 0; mm < 2; ++mm) { const int m = m0 + mm, row = row0 + ai * HALF + m * 16; float* rowp = X + (size_t)row * ldc + col0; bf16_t* rowb = XB + (size_t)row * ldc + col0; float ss = 0.f;
#pragma unroll
                for (int i = 0; i < 4; ++i) { const int bj = i >> 1, n = i & 1; const f32x4 v = res[mm][i] + acc[ai][bj][m][n]; *(f32x4*)(rowp + bj * HALF + n * 16) = v;
                    ss += (v[0] * v[0] + v[1] * v[1]) + (v[2] * v[2] + v[3] * v[3]);
                    unsigned lo = cvt_pk_bf16(v[0], v[1]), hi = cvt_pk_bf16(v[2], v[3]); *(unsigned long long*)(rowb + bj * HALF + n * 16) = ((unsigned long long)hi << 32) | lo; }
                ss += __shfl_xor(ss, 16); ss += __shfl_xor(ss, 32);
                if (fq == 0) atomicAdd(SS + row, ss); }
            asm volatile("" ::: "memory"); }
    }
};
struct EpiBf16Rstd {
    static constexpr bool PERM = true, AFTER_DRAIN = false;
    bf16_t* O; int ldc; const float* SS;
    __device__ __forceinline__ void operator()(const f32x4 (&acc)[2][2][4][2], const Unit& u, int wr, int wc, int fr, int fq) const {
        const int row0 = u.pm * BM + wr * 64 + fr, col0 = u.pn * BM + wc * 32 + 8 * fq;
        float ssv[8];
#pragma unroll
        for (int g = 0; g < 8; ++g) ssv[g] = SS[row0 + (g >> 2) * HALF + (g & 3) * 16];
#pragma unroll
        for (int ai = 0; ai < 2; ++ai)
#pragma unroll
            for (int m = 0; m < 4; ++m) { const int row = row0 + ai * HALF + m * 16; bf16_t* rowp = O + (size_t)row * ldc + col0; const float rs = 1.0f / sqrtf(ssv[ai * 4 + m] * (1.0f / 2048.0f) + 1e-6f);
#pragma unroll
                for (int bj = 0; bj < 2; ++bj) { const f32x4 v0 = acc[ai][bj][m][0] * rs, v1 = acc[ai][bj][m][1] * rs;
                    u32x4 w; w.x = cvt_pk_bf16(v0[0], v0[1]); w.y = cvt_pk_bf16(v0[2], v0[3]); w.z = cvt_pk_bf16(v1[0], v1[1]); w.w = cvt_pk_bf16(v1[2], v1[3]);
                    *(u32x4*)(rowp + bj * HALF) = w; } }
    }
};
struct EpiGluRes {
    static constexpr bool PERM = false, AFTER_DRAIN = false;
    float* X; bf16_t* XB; float* SS; int ldc;
    __device__ __forceinline__ void operator()(const f32x4 (&acc)[2][2][4][2], const Unit& u, int wr, int wc, int fr, int fq) const {
        const int row0 = u.pm * BM + wr * 64 + fr, col0 = u.pn * HALF + wc * 32 + 4 * fq;
        f32x4 res[8][2];
#pragma unroll
        for (int g = 0; g < 8; ++g)
#pragma unroll
            for (int n = 0; n < 2; ++n) res[g][n] = *(const f32x4*)(X + (size_t)(row0 + (g >> 2) * HALF + (g & 3) * 16) * ldc + col0 + n * 16);
#pragma unroll
        for (int g = 0; g < 8; ++g) { const int ai = g >> 2, m = g & 3, row = row0 + ai * HALF + m * 16; float* rowp = X + (size_t)row * ldc + col0; bf16_t* rowb = XB + (size_t)row * ldc + col0; float ss = 0.f;
#pragma unroll
            for (int n = 0; n < 2; ++n) { const f32x4 v = acc[ai][0][m][n], gt = acc[ai][1][m][n]; f32x4 o = res[g][n];
#pragma unroll
                for (int j = 0; j < 4; ++j) o[j] += v[j] / (1.0f + __expf(-gt[j]));
                *(f32x4*)(rowp + n * 16) = o; ss += (o[0] * o[0] + o[1] * o[1]) + (o[2] * o[2] + o[3] * o[3]);
                unsigned lo = cvt_pk_bf16(o[0], o[1]), hi = cvt_pk_bf16(o[2], o[3]); *(unsigned long long*)(rowb + n * 16) = ((unsigned long long)hi << 32) | lo; }
            ss += __shfl_xor(ss, 16); ss += __shfl_xor(ss, 32);
            if (fq == 0) atomicAdd(SS + row, ss); }
    }
};

template <class Epi, class Sched, bool ALIGN_EPI = false, bool SP2 = false>
__device__ __forceinline__ void gemm_phase(PG8_LAS unsigned char* lds, const Gemm g, const Sched& S, const Epi& E) {
    const int tid = threadIdx.x, wid = __builtin_amdgcn_readfirstlane(tid >> 6), lane = tid & 63, wr = wid >> 2, wc = wid & 3, fr = lane & 15, fq = lane >> 4;
    const int K = g.ldk, nt = g.K / BK;
    unsigned voffA[2], voffB[2];
#pragma unroll
    for (int i = 0; i < 2; ++i) { int R, C; stage_rc(tid * 16 + i * 8192, R, C); const int Rb = Epi::PERM ? ((R & ~31) + perm32(R & 31)) : R;
        voffA[i] = (unsigned)(R * K + C) * 2u; voffB[i] = (unsigned)(Rb * K + C) * 2u; }
    const size_t kstep = (size_t)(BK * 2);
    const size_t hstep = (size_t)HALF * K * 2;
    const size_t tstep = 2 * hstep;
    const unsigned ldsw = (unsigned)wid * 1024u;
    const int aoff = lds_byte(wr * 64 + fr, fq * 8), boff = lds_byte(wc * 32 + fr, fq * 8);
#define PG8_SA(b, h) (((b) * 2 + (h)) * HTB)
#define PG8_SB(b, h) ((4 + (b) * 2 + (h)) * HTB)
#define PG8_STAGE(bufoff, gbase, voff) do { _Pragma("unroll") for (int _i = 0; _i < 2; ++_i) \
        __builtin_amdgcn_global_load_lds((const unsigned*)((const char*)(gbase) + (voff)[_i]), (PG8_LAS unsigned*)(lds + (bufoff) + ldsw + _i * 8192), 16, 0, 0); } while (0)
#define PG8_LDA(dst, b, h) do { _Pragma("unroll") for (int m = 0; m < 4; ++m) _Pragma("unroll") for (int k = 0; k < 2; ++k) dst[m][k] = *(const PG8_LAS bf16x8*)(lds + PG8_SA(b, h) + aoff + m * 2048 + k * 1024); } while (0)
#define PG8_LDB(dst, b, h) do { _Pragma("unroll") for (int n = 0; n < 2; ++n) _Pragma("unroll") for (int k = 0; k < 2; ++k) dst[n][k] = *(const PG8_LAS bf16x8*)(lds + PG8_SB(b, h) + boff + n * 2048 + k * 1024); } while (0)
#define PG8_MMA(ai, bj, At, Bt) do { __builtin_amdgcn_s_setprio(1); _Pragma("unroll") for (int m = 0; m < 4; ++m) _Pragma("unroll") for (int n = 0; n < 2; ++n) _Pragma("unroll") for (int k = 0; k < 2; ++k) \
        acc[ai][bj][m][n] = __builtin_amdgcn_mfma_f32_16x16x32_bf16(Bt[n][k], At[m][k], acc[ai][bj][m][n], 0, 0, 0); __builtin_amdgcn_s_setprio(0); } while (0)
#define PG8_WAIT_V(n) asm volatile("s_waitcnt vmcnt(" #n ")" ::: "memory")
#define PG8_WAIT_L(n) asm volatile("s_waitcnt lgkmcnt(" #n ")" ::: "memory")
#define PG8_BAR __builtin_amdgcn_s_barrier()
#define PG8_SCHED __builtin_amdgcn_sched_barrier(0)
    Unit cur, nxt; int ui = 0;
    if (!S.next(0, cur)) return;
    f32x4 acc[2][2][4][2];
#pragma unroll
    for (int a = 0; a < 2; ++a)
#pragma unroll
        for (int b = 0; b < 2; ++b)
#pragma unroll
            for (int m = 0; m < 4; ++m)
#pragma unroll
                for (int n = 0; n < 2; ++n) acc[a][b][m][n] = (f32x4){0.f, 0.f, 0.f, 0.f};
    bf16x8 At[4][2], B0[2][2], B1[2][2];
    const char* cA = (const char*)g.A + (size_t)cur.pm * tstep; const char* cB = (const char*)g.Bt + (size_t)cur.pn * tstep;
    S.a_ready(cur);
    if constexpr (SP2) {
        PG8_STAGE(PG8_SB(0, 0), cB, voffB); PG8_STAGE(PG8_SB(0, 1), cB + hstep, voffB); PG8_STAGE(PG8_SA(0, 0), cA, voffA); PG8_STAGE(PG8_SA(0, 1), cA + hstep, voffA);
        if (wr == 1) PG8_BAR;
        PG8_WAIT_V(2); PG8_BAR;
        PG8_STAGE(PG8_SB(1, 0), cB + kstep, voffB); PG8_STAGE(PG8_SA(1, 0), cA + kstep, voffA); PG8_STAGE(PG8_SB(1, 1), cB + hstep + kstep, voffB);
        PG8_WAIT_V(6); PG8_BAR;
    } else {
        PG8_STAGE(PG8_SB(0, 0), cB, voffB); PG8_STAGE(PG8_SA(0, 0), cA, voffA); PG8_STAGE(PG8_SB(0, 1), cB + hstep, voffB); PG8_STAGE(PG8_SA(0, 1), cA + hstep, voffA);
        if (wr == 1) PG8_BAR;
        PG8_WAIT_V(4); PG8_BAR;
        PG8_STAGE(PG8_SB(1, 0), cB + kstep, voffB); PG8_STAGE(PG8_SA(1, 0), cA + kstep, voffA); PG8_STAGE(PG8_SB(1, 1), cB + hstep + kstep, voffB);
        PG8_WAIT_V(6); PG8_BAR;
    }
    for (;;) {
        const bool has_next = S.next(ui + 1, nxt);
        const char* nA = has_next ? (const char*)g.A + (size_t)nxt.pm * tstep : cA; const char* nB = has_next ? (const char*)g.Bt + (size_t)nxt.pn * tstep : cB;
        for (int t = 0; t < nt; t += 2) {
            const bool last = (t == nt - 2);
            const char* a1 = cA + (size_t)(t + 1) * kstep;
            const char* a2 = last ? nA : cA + (size_t)(t + 2) * kstep; const char* b2 = last ? nB : cB + (size_t)(t + 2) * kstep;
            const char* a3 = a2 + kstep; const char* b3 = b2 + kstep;
            if (last && has_next) S.a_ready(nxt);
            if constexpr (SP2) {
            PG8_LDB(B0, 0, 0); PG8_LDB(B1, 0, 1); PG8_SCHED; PG8_LDA(At, 0, 0); PG8_STAGE(PG8_SA(1, 1), a1 + hstep, voffA);
            PG8_WAIT_V(8); PG8_WAIT_L(0); PG8_BAR; PG8_MMA(0, 0, At, B0); PG8_MMA(0, 1, At, B1); PG8_BAR; PG8_SCHED;
            PG8_LDA(At, 0, 1); PG8_STAGE(PG8_SB(0, 0), b2, voffB); PG8_STAGE(PG8_SB(0, 1), b2 + hstep, voffB); PG8_STAGE(PG8_SA(0, 0), a2, voffA);
            PG8_WAIT_V(8); PG8_WAIT_L(0); PG8_BAR; PG8_MMA(1, 0, At, B0); PG8_MMA(1, 1, At, B1); PG8_BAR; PG8_SCHED;
            PG8_LDB(B0, 1, 0); PG8_LDB(B1, 1, 1); PG8_SCHED; PG8_LDA(At, 1, 0); PG8_STAGE(PG8_SA(0, 1), a2 + hstep, voffA);
            PG8_WAIT_V(8); PG8_WAIT_L(0); PG8_BAR; PG8_MMA(0, 0, At, B0); PG8_MMA(0, 1, At, B1); PG8_BAR; PG8_SCHED;
            PG8_LDA(At, 1, 1); PG8_STAGE(PG8_SB(1, 0), b3, voffB); PG8_STAGE(PG8_SB(1, 1), b3 + hstep, voffB); PG8_STAGE(PG8_SA(1, 0), a3, voffA);
            PG8_WAIT_V(8); PG8_WAIT_L(0); PG8_BAR; PG8_MMA(1, 0, At, B0); PG8_MMA(1, 1, At, B1); PG8_BAR; PG8_SCHED;
            } else {
            PG8_LDB(B0, 0, 0); PG8_SCHED; PG8_LDA(At, 0, 0); PG8_STAGE(PG8_SA(1, 1), a1 + hstep, voffA);
            PG8_WAIT_L(8); PG8_BAR; PG8_WAIT_L(0); PG8_MMA(0, 0, At, B0); PG8_BAR; PG8_SCHED;
            PG8_LDB(B1, 0, 1); PG8_STAGE(PG8_SB(0, 0), b2, voffB);
            PG8_BAR; PG8_WAIT_L(0); PG8_MMA(0, 1, At, B1); PG8_BAR;
            PG8_LDA(At, 0, 1); PG8_STAGE(PG8_SA(0, 0), a2, voffA);
            PG8_BAR; PG8_WAIT_L(0); PG8_MMA(1, 0, At, B0); PG8_BAR; PG8_SCHED;
            PG8_STAGE(PG8_SB(0, 1), b2 + hstep, voffB);
            PG8_WAIT_V(6); PG8_BAR; PG8_MMA(1, 1, At, B1); PG8_BAR;
            PG8_LDB(B0, 1, 0); PG8_SCHED; PG8_LDA(At, 1, 0); PG8_STAGE(PG8_SA(0, 1), a2 + hstep, voffA);
            PG8_WAIT_L(8); PG8_BAR; PG8_WAIT_L(0); PG8_MMA(0, 0, At, B0); PG8_BAR; PG8_SCHED;
            PG8_LDB(B1, 1, 1); PG8_STAGE(PG8_SB(1, 0), b3, voffB);
            PG8_BAR; PG8_WAIT_L(0); PG8_MMA(0, 1, At, B1); PG8_BAR;
            PG8_LDA(At, 1, 1); PG8_STAGE(PG8_SA(1, 0), a3, voffA);
            PG8_BAR; PG8_WAIT_L(0); PG8_MMA(1, 0, At, B0); PG8_BAR; PG8_SCHED;
            PG8_STAGE(PG8_SB(1, 1), b3 + hstep, voffB);
            PG8_WAIT_V(6); PG8_BAR; PG8_MMA(1, 1, At, B1); PG8_BAR;
            }
        }
        if constexpr (ALIGN_EPI) { if (wr == 0) PG8_BAR; }
        if constexpr (!Epi::AFTER_DRAIN) { E(acc, cur, wr, wc, fr, fq); S.done(cur); }
        if (!has_next) break;
#pragma unroll
        for (int a = 0; a < 2; ++a)
#pragma unroll
            for (int b = 0; b < 2; ++b)
#pragma unroll
                for (int m = 0; m < 4; ++m)
#pragma unroll
                    for (int n = 0; n < 2; ++n) acc[a][b][m][n] = (f32x4){0.f, 0.f, 0.f, 0.f};
        cur = nxt; cA = nA; cB = nB; ++ui;
        if constexpr (ALIGN_EPI) { if (wr == 1) PG8_BAR; }
    }
    PG8_WAIT_V(0);
    if constexpr (!ALIGN_EPI) { if (wr == 0) PG8_BAR; }
    PG8_BAR;
    if constexpr (Epi::AFTER_DRAIN) { E.fused(acc, cur, wr, wc, fr, fq, lds, wid, lane); S.done(cur); }
#undef PG8_SA
#undef PG8_SB
#undef PG8_STAGE
#undef PG8_LDA
#undef PG8_LDB
#undef PG8_MMA
#undef PG8_WAIT_V
#undef PG8_WAIT_L
#undef PG8_BAR
#undef PG8_SCHED
}
}

constexpr int NWAVES = 8, NTHR = 512;
constexpr int MP = 8192, MS = 1024, MTOT = 9216, DM = 2048;
constexpr int SEQ = 2048, DECS = 8, DECB = 128;
constexpr int NPROJ = 7168, DIN = 7184, DFF = 5632, NUP = 11264, NGLU = 4096;
constexpr int C_QA = 0, C_KA = 1024, C_VA = 2048, C_ZA = 3072, C_QB = 4096, C_KB = 4608, C_VB = 5120, C_GB = 6144;
constexpr float EPS = 1e-6f;
constexpr size_t MiB = 1u << 20;
constexpr size_t WS_CTL = 0;
constexpr size_t WS_WIN = 1 * MiB;
constexpr size_t WS_WOUT = WS_WIN + 28 * MiB;
constexpr size_t WS_WUP = WS_WOUT + 8 * MiB;
constexpr size_t WS_WDN = WS_WUP + 88 * MiB;
constexpr size_t WS_WGLU = WS_WDN + 44 * MiB;
constexpr size_t WS_X = WS_WGLU + 16 * MiB;
constexpr size_t WS_H = WS_X + 72 * MiB;
constexpr size_t WS_G2 = WS_H + 36 * MiB;
constexpr size_t WS_GATE = WS_G2 + 36 * MiB;
constexpr size_t WS_TAB = WS_GATE + 1 * MiB;
constexpr size_t WS_BIG = WS_TAB + 2 * MiB;
constexpr size_t WS_OA = WS_BIG + 126 * MiB, WS_OB = WS_OA + 36 * MiB;
constexpr size_t WS_ACT = WS_BIG + 198 * MiB;
constexpr size_t WS_END = WS_ACT + 99 * MiB;
constexpr size_t WS_UG0 = WS_BIG + 64 * MiB;
constexpr size_t O_Y = 0, O_GDN_P = 18874368, O_GDN_S = O_GDN_P + 524288, O_GCB_P = O_GDN_S + 16777216, O_GCB_S = O_GCB_P + 36864,
                 O_RET_P = O_GCB_S + 1179648, O_RET_S = O_RET_P + 524288, O_S5R_P = O_RET_S + 16777216, O_S5R_S = O_S5R_P + 32768,
                 O_S5I_P = O_S5R_S + 1048576, O_S5I_S = O_S5I_P + 32768, O_FCB_P = O_S5I_S + 1048576, O_FCB_S = O_FCB_P + 180224, O_END = O_FCB_S + 5767168;

constexpr int LDS_BYTES = 148480 + 512;
constexpr int MISC_OFF = 148480;
#define LAS __attribute__((address_space(3)))
typedef unsigned short bf16;
typedef float f32x4 __attribute__((ext_vector_type(4)));
typedef unsigned u32x4 __attribute__((ext_vector_type(4)));
typedef unsigned u32x2 __attribute__((ext_vector_type(2)));
#define LDS_WAIT() asm volatile("s_waitcnt lgkmcnt(0)" ::: "memory")

struct Args { const float* in[32]; float* out; unsigned char* ws; int ph_lo, ph_hi; };
enum { I_XP = 0, I_XS, I_SGDN, I_SGCB, I_SRET, I_S5RE, I_S5IM, I_SFCB, I_NMIX, I_NFFN, I_NFIN, I_WIN, I_GCW, I_GALOG, I_GDTB, I_GNW, I_RGW, I_RGB, I_WOUT,
       I_LRE, I_LIM, I_LDT, I_BRE, I_BIM, I_CRE, I_CIM, I_S5D, I_WGLU, I_WUP, I_FCW, I_FCBIAS, I_WDN };

__device__ __forceinline__ float wave_sum(float v) {
#pragma unroll
    for (int o = 1; o < 64; o <<= 1) v += __shfl_xor(v, o);
    return v;
}
__device__ __forceinline__ unsigned f2bf(float f) { unsigned u = __builtin_bit_cast(unsigned, f); return (u + 0x7fffu + ((u >> 16) & 1u)) >> 16; }
__device__ __forceinline__ unsigned pk2(float lo, float hi) { return f2bf(lo) | (f2bf(hi) << 16); }
__device__ __forceinline__ float bf2f(unsigned short b) { return __builtin_bit_cast(float, (unsigned)b << 16); }
__device__ __forceinline__ void unpack8(const u32x4 w, float (&f)[8]) {
    f[0] = __builtin_bit_cast(float, w.x << 16); f[1] = __builtin_bit_cast(float, w.x & 0xffff0000u);
    f[2] = __builtin_bit_cast(float, w.y << 16); f[3] = __builtin_bit_cast(float, w.y & 0xffff0000u);
    f[4] = __builtin_bit_cast(float, w.z << 16); f[5] = __builtin_bit_cast(float, w.z & 0xffff0000u);
    f[6] = __builtin_bit_cast(float, w.w << 16); f[7] = __builtin_bit_cast(float, w.w & 0xffff0000u);
}
__device__ __forceinline__ void ld_bf8(const bf16* p, float (&f)[8]) { unpack8(*(const u32x4*)p, f); }
__device__ __forceinline__ void ld_f8(const float* p, float (&f)[8]) { const f32x4 a = *(const f32x4*)p, b = *(const f32x4*)(p + 4); f[0] = a[0]; f[1] = a[1]; f[2] = a[2]; f[3] = a[3]; f[4] = b[0]; f[5] = b[1]; f[6] = b[2]; f[7] = b[3]; }
__device__ __forceinline__ void st_bf8(bf16* p, const float (&f)[8]) { u32x4 w; w.x = pk2(f[0], f[1]); w.y = pk2(f[2], f[3]); w.z = pk2(f[4], f[5]); w.w = pk2(f[6], f[7]); *(u32x4*)p = w; }
__device__ __forceinline__ float silu_f(float x) { return x / (1.0f + expf(-x)); }
__device__ __forceinline__ float sigmoid_f(float x) { return 1.0f / (1.0f + expf(-x)); }
__device__ __forceinline__ float softplus_f(float x) { return x > 20.f ? x : log1pf(expf(x)); }
__device__ __forceinline__ float gelu_tanh_fast(float y) { const float z = 0.7978845608028654f * (y + 0.044715f * y * y * y); const float e = __builtin_amdgcn_exp2f(z * 2.8853900817779268f); return y * (1.0f - __builtin_amdgcn_rcpf(e + 1.0f)); }
__device__ __forceinline__ float gelu_tanh(float y) { const float z = 0.7978845608028654f * (y + 0.044715f * y * y * y); const float th = 1.0f - 2.0f / (expf(2.0f * z) + 1.0f); return 0.5f * y * (1.0f + th); }
__device__ __forceinline__ void sincos_d(double a, double& s, double& c) {
    const double n = rint(a * 0.63661977236758134308);
    double r = fma(-n, 1.57079632679489655800e+00, a); r = fma(-n, 6.12323399573676603587e-17, r);
    const double r2 = r * r;
    double ps = 1.0 / 6227020800.0; ps = fma(ps, r2, -1.0 / 39916800.0); ps = fma(ps, r2, 1.0 / 362880.0); ps = fma(ps, r2, -1.0 / 5040.0); ps = fma(ps, r2, 1.0 / 120.0); ps = fma(ps, r2, -1.0 / 6.0); ps = fma(ps * r2, r, r);
    double pc = 1.0 / 479001600.0; pc = fma(pc, r2, -1.0 / 3628800.0); pc = fma(pc, r2, 1.0 / 40320.0); pc = fma(pc, r2, -1.0 / 720.0); pc = fma(pc, r2, 1.0 / 24.0); pc = fma(pc, r2, -0.5); pc = fma(pc, r2, 1.0);
    const int q = (int)(long long)n & 3;
    s = (q == 0) ? ps : (q == 1) ? pc : (q == 2) ? -ps : -pc;
    c = (q == 0) ? pc : (q == 1) ? -ps : (q == 2) ? -pc : ps;
}

#define GAS __attribute__((address_space(1)))
constexpr int CW_BAR = 4096;
constexpr size_t CTL_ZERO_BYTES = 524288;
constexpr size_t WS_SS = WS_CTL + 262144;
#define XB_TMO      128
#define XB_XCNT(j)  (256  + 64 * (j))
#define XB_XSUB(j)  (1280 + 64 * (j))
#define XB_XGEN(j)  (2304 + 64 * (j))
#define XB_TOP      3328
#define XB_TOPGEN   3392
#define XCD_BAR_WORDS 3456
#define XB_SPIN_CAP (1u << 18)

__device__ __forceinline__ unsigned xb_ld(unsigned* p)              { return __hip_atomic_load(p, __ATOMIC_RELAXED, __HIP_MEMORY_SCOPE_AGENT); }
__device__ __forceinline__ unsigned xb_add(unsigned* p, unsigned v) { return __hip_atomic_fetch_add(p, v, __ATOMIC_RELAXED, __HIP_MEMORY_SCOPE_AGENT); }
__device__ __forceinline__ unsigned xb_xcc_id() { return (unsigned)__builtin_amdgcn_s_getreg((3 << 11) | 20) & 0xFu; }
#define XB_SPIN(cond, bar) do { unsigned _sp = 0; while (cond) { __builtin_amdgcn_s_sleep(1); \
    if ((++_sp & 255u) == 0u) { if (xb_ld(&(bar)[XB_TMO])) break; if (_sp > XB_SPIN_CAP) { atomicAdd(&(bar)[XB_TMO], 1u); break; } } } } while (0)

struct XcdBarrier {
    unsigned* bar; unsigned x;
    volatile LAS unsigned* st;
};

__device__ __forceinline__ XcdBarrier xcd_barrier_post(unsigned* bar, volatile LAS unsigned* st) {
    XcdBarrier b; b.bar = bar; b.x = xb_xcc_id(); b.st = st;
    if (threadIdx.x == 0) (void)xb_add(&bar[XB_XCNT(b.x)], 1u);
    return b;
}
__device__ __forceinline__ void xcd_barrier_complete(unsigned* bar, unsigned x, unsigned& nloc, unsigned& nx) {
    const unsigned G = gridDim.x * gridDim.y * gridDim.z;
    unsigned sum, cnt, mine, sp = 0u;
    for (;;) {
        sum = 0u; cnt = 0u; mine = 0u;
#pragma unroll
        for (unsigned j = 0; j < 16; ++j) { const unsigned c = xb_ld(&bar[XB_XCNT(j)]); sum += c; cnt += (c > 0u) ? 1u : 0u; mine = (j == x) ? c : mine; }
        if (sum == G) break;
        __builtin_amdgcn_s_sleep(1);
        if ((++sp & 255u) == 0u) { if (xb_ld(&bar[XB_TMO])) break; if (sp > XB_SPIN_CAP) { atomicAdd(&bar[XB_TMO], 1u); break; } }
    }
    nloc = mine > 0u ? mine : 1u; nx = cnt > 0u ? cnt : 1u;
}

__device__ __forceinline__ void xcd_barrier(const XcdBarrier& b) {
    asm volatile("s_waitcnt vmcnt(0)" ::: "memory");
    __syncthreads();
    if (threadIdx.x == 0) {
        unsigned* bar = b.bar;
        __builtin_amdgcn_s_waitcnt(0);
        unsigned nloc = b.st[0], nx = b.st[1];
        if (nloc == 0u) { xcd_barrier_complete(bar, b.x, nloc, nx); b.st[0] = nloc; b.st[1] = nx; }
        const unsigned old = xb_add(&bar[XB_XSUB(b.x)], 1u);
        const unsigned gen = old / nloc;
        if (old + 1u == (gen + 1u) * nloc) {
            __builtin_amdgcn_fence(__ATOMIC_RELEASE, "agent");
            asm volatile("s_waitcnt vmcnt(0)" ::: "memory");
            const unsigned og = xb_add(&bar[XB_TOP], 1u);
            const unsigned tg = og / nx;
            if (og + 1u == (tg + 1u) * nx) xb_add(&bar[XB_TOPGEN], 1u);
            else XB_SPIN(xb_ld(&bar[XB_TOPGEN]) == tg, bar);
            __builtin_amdgcn_fence(__ATOMIC_ACQUIRE, "agent");
            xb_add(&bar[XB_XGEN(b.x)], 1u);
            asm volatile("s_waitcnt vmcnt(0)" ::: "memory");
        } else {
            XB_SPIN(xb_ld(&bar[XB_XGEN(b.x)]) == gen, bar);
            __builtin_amdgcn_fence(__ATOMIC_ACQUIRE, "agent");
            asm volatile("s_waitcnt vmcnt(0)" ::: "memory");
        }
    }
    __syncthreads();
}


__device__ __forceinline__ void transpose_item(const float* W, int ldw, int src_col0, int k0, bf16* WT, int K, int dst_row0, LAS float* scr, int lane, const float* ksc = nullptr) {
    float wv[32];
    { const float* wp = W + (size_t)(k0 + (lane >> 5)) * ldw + src_col0 + (lane & 31);
#pragma unroll
      for (int i = 0; i < 32; ++i) wv[i] = __builtin_nontemporal_load(wp + (size_t)(2 * i) * ldw); }
#pragma unroll
    for (int i = 0; i < 32; ++i) scr[(2 * i + (lane >> 5)) * 33 + (lane & 31)] = wv[i];
    const int c = lane & 7;
    f32x4 s0 = {1.f, 1.f, 1.f, 1.f}, s1 = {1.f, 1.f, 1.f, 1.f};
    if (ksc) { s0 = *(const f32x4*)(ksc + k0 + 8 * c); s1 = *(const f32x4*)(ksc + k0 + 8 * c + 4); }
    LDS_WAIT(); asm volatile("" ::: "memory");
#pragma unroll
    for (int j = 0; j < 4; ++j) { const int n = (lane >> 3) + 8 * j; const LAS float* s = scr + (8 * c) * 33 + n;
        u32x4 o; o.x = pk2(s[0 * 33] * s0[0], s[1 * 33] * s0[1]); o.y = pk2(s[2 * 33] * s0[2], s[3 * 33] * s0[3]); o.z = pk2(s[4 * 33] * s1[0], s[5 * 33] * s1[1]); o.w = pk2(s[6 * 33] * s1[2], s[7 * 33] * s1[3]);
        *(u32x4*)(WT + (size_t)(dst_row0 + n) * K + k0 + 8 * c) = o; }
    LDS_WAIT(); asm volatile("" ::: "memory");
}
__device__ __forceinline__ int ileave_src(int n0, int half) { const int t = n0 >> 8, w = n0 & 255; return (w < 128) ? t * 128 + w : half + t * 128 + (w - 128); }

__device__ __forceinline__ void convert_group(const Args& a, int group, LAS float* scr, int lane, int w, int nw) {
    unsigned char* ws = a.ws;
    constexpr int I_IN = 32 * 224, I_OUT = 32 * 64, I_UP = 32 * 352, I_DN = 88 * 64, I_GLU = 32 * 128;
    if (group == 0) {
        for (int r = w; r < I_IN; r += nw) { const int kb = r / 224, n0 = 32 * (r % 224); transpose_item(a.in[I_WIN], DIN, n0 < 4096 ? n0 : n0 + 16, 64 * kb, (bf16*)(ws + WS_WIN), 2048, n0, scr, lane); }
    } else {
        const int l = (group == 2) ? 1 : 0, I_A = (l == 0) ? I_OUT : I_GLU;
        const int lo_ = (group == 3) ? I_A : 0, hi_ = (group == 1) ? I_A : I_A + I_UP + I_DN;
        for (int it = lo_ + w; it < hi_; it += nw) {
            int r = it;
            if (r < I_A) { if (l == 0) { const int kb = r / 64, n0 = 32 * (r % 64); transpose_item(a.in[I_WOUT], 2048, n0, 64 * kb, (bf16*)(ws + WS_WOUT), 2048, n0, scr, lane); }
                           else { const int kb = r / 128, n0 = 32 * (r % 128); transpose_item(a.in[I_WGLU], NGLU, ileave_src(n0, 2048), 64 * kb, (bf16*)(ws + WS_WGLU), 2048, n0, scr, lane); }
                           continue; } r -= I_A;
            if (r < I_UP) { const int kb = r / 352, n0 = 32 * (r % 352);
                transpose_item(a.in[I_WUP] + (size_t)l * 2048 * NUP, NUP, ileave_src(n0, DFF), 64 * kb, (bf16*)(ws + WS_WUP) + (size_t)l * NUP * 2048, 2048, n0, scr, lane, a.in[I_NFFN] + l * DM); continue; } r -= I_UP;
            { const int kb = r / 64, n0 = 32 * (r % 64); transpose_item(a.in[I_WDN] + (size_t)l * DFF * 2048, 2048, n0, 64 * kb, (bf16*)(ws + WS_WDN) + (size_t)l * 2048 * DFF, DFF, n0, scr, lane); }
        }
    }
}
constexpr int PRO_REP = 0;
__device__ __forceinline__ void ph_prologue(const Args& a, LAS unsigned char* lds, int tid, int lane, int wave, int gw, int NGW, int G) {
    unsigned char* ws = a.ws;
    for (int rp = 0; rp < (PRO_REP == 1 ? 2 : 1); ++rp)
    {   LAS float* scr = (LAS float*)(lds + wave * 8704);
        convert_group(a, 0, scr, lane, gw, NGW);
        if (G != 256) { convert_group(a, 1, scr, lane, gw, NGW); convert_group(a, 3, scr, lane, gw, NGW); convert_group(a, 2, scr, lane, gw, NGW); }
    }
    for (int rp = 0; rp < (PRO_REP == 2 ? 2 : 1); ++rp)
    {
        float* tab = (float*)(ws + WS_TAB);
        for (int idx = gw * 64 + lane; idx < 2056 * 64; idx += NGW * 64) { const int i = idx & 63, slot = idx >> 6; const int pos = slot < 2048 ? slot : 16384 + (slot - 2048);
            double s, c; sincos_d((double)pos * exp(-(double)i * (9.210340371976184 / 64.0)), s, c); tab[slot * 128 + i] = (float)c; tab[slot * 128 + 64 + i] = (float)s; }
    }
    __syncthreads();
    LAS float* WgT = (LAS float*)lds;
    {   f32x4 wg[4][4];
#pragma unroll
        for (int i = 0; i < 4; ++i)
#pragma unroll
            for (int j = 0; j < 4; ++j) wg[i][j] = *(const f32x4*)(a.in[I_WIN] + (size_t)(tid + 512 * i) * DIN + 4096 + 4 * j);
#pragma unroll
        for (int i = 0; i < 4; ++i)
#pragma unroll
            for (int j = 0; j < 4; ++j)
#pragma unroll
                for (int e = 0; e < 4; ++e) WgT[(4 * j + e) * 2048 + tid + 512 * i] = wg[i][j][e]; }
    __syncthreads();
    bf16* H = (bf16*)(ws + WS_H); float* GATE = (float*)(ws + WS_GATE);
    const float* nw = a.in[I_NMIX];
    const bool b5 = lane & 32, b4 = lane & 16, b3 = lane & 8, b2 = lane & 4;
    const int hme = (b5 ? 8 : 0) + (b4 ? 4 : 0) + (b3 ? 2 : 0) + (b2 ? 1 : 0);
    const float galog = a.in[I_GALOG][hme & 7], gdtb = a.in[I_GDTB][hme & 7];
    f32x4 nwr[8];
#pragma unroll
    for (int j = 0; j < 8; ++j) nwr[j] = ((const f32x4*)nw)[lane + 64 * j];
    for (int rp = 0; rp < (PRO_REP == 3 ? 2 : 1); ++rp) {
    f32x4 vn[8];
    { const int m = gw; const float* xr = (m < MP) ? a.in[I_XP] + (size_t)m * DM : a.in[I_XS] + (size_t)(m - MP) * DM;
#pragma unroll
      for (int j = 0; j < 8; ++j) vn[j] = ((const f32x4*)xr)[lane + 64 * j]; }
    for (int m = gw; m < MTOT; m += NGW) {
        f32x4 v[8]; float ss = 0.f;
#pragma unroll
        for (int j = 0; j < 8; ++j) { v[j] = vn[j]; ss += (v[j][0] * v[j][0] + v[j][1] * v[j][1]) + (v[j][2] * v[j][2] + v[j][3] * v[j][3]); }
        { const int mn = (m + NGW < MTOT) ? m + NGW : m;
          const float* xr = (mn < MP) ? a.in[I_XP] + (size_t)mn * DM : a.in[I_XS] + (size_t)(mn - MP) * DM;
#pragma unroll
          for (int j = 0; j < 8; ++j) vn[j] = ((const f32x4*)xr)[lane + 64 * j]; }
        const float rstd = 1.0f / sqrtf(wave_sum(ss) * (1.0f / DM) + EPS);
#pragma unroll
        for (int j = 0; j < 8; ++j) { v[j] = v[j] * rstd * nwr[j];
            u32x2 o; o.x = pk2(v[j][0], v[j][1]); o.y = pk2(v[j][2], v[j][3]); ((u32x2*)(H + (size_t)m * DM))[lane + 64 * j] = o; }
        float gs_[16];
#pragma unroll
        for (int h = 0; h < 16; ++h) { float s = 0.f;
#pragma unroll
            for (int j = 0; j < 8; ++j) { const f32x4 w4 = *(const LAS f32x4*)(WgT + h * 2048 + 4 * lane + 256 * j); s += (v[j][0] * w4[0] + v[j][1] * w4[1]) + (v[j][2] * w4[2] + v[j][3] * w4[3]); }
            gs_[h] = s; if (h & 1) asm volatile("" ::: "memory"); }
        {   float k8[8], k4[4], k2[2], y;
#pragma unroll
            for (int i = 0; i < 8; ++i) { const float send = b5 ? gs_[i] : gs_[8 + i], keep = b5 ? gs_[8 + i] : gs_[i]; k8[i] = keep + __shfl_xor(send, 32); }
#pragma unroll
            for (int i = 0; i < 4; ++i) { const float send = b4 ? k8[i] : k8[4 + i], keep = b4 ? k8[4 + i] : k8[i]; k4[i] = keep + __shfl_xor(send, 16); }
#pragma unroll
            for (int i = 0; i < 2; ++i) { const float send = b3 ? k4[i] : k4[2 + i], keep = b3 ? k4[2 + i] : k4[i]; k2[i] = keep + __shfl_xor(send, 8); }
            { const float send = b2 ? k2[0] : k2[1], keep = b2 ? k2[1] : k2[0]; y = keep + __shfl_xor(send, 4); }
            y += __shfl_xor(y, 2); y += __shfl_xor(y, 1);
            if ((lane & 3) == 0) { float o; if (hme < 8) o = -expf(galog) * softplus_f(y + gdtb); else o = sigmoid_f(y); GATE[m * 16 + hme] = o; } }
    }
    }
    __syncthreads();
}

__device__ __forceinline__ void ph_rms_rows(const float* X, const float* nw, bf16* H, int lane, int gw, int NGW) {
    for (int m = gw; m < MTOT; m += NGW) {
        f32x4 v[8]; float ss = 0.f;
#pragma unroll
        for (int j = 0; j < 8; ++j) { v[j] = ((const f32x4*)(X + (size_t)m * DM))[lane + 64 * j]; ss += (v[j][0] * v[j][0] + v[j][1] * v[j][1]) + (v[j][2] * v[j][2] + v[j][3] * v[j][3]); }
        const float rstd = 1.0f / sqrtf(wave_sum(ss) * (1.0f / DM) + EPS);
#pragma unroll
        for (int j = 0; j < 8; ++j) { const f32x4 w4 = ((const f32x4*)nw)[lane + 64 * j]; v[j] = v[j] * rstd * w4;
            u32x2 o; o.x = pk2(v[j][0], v[j][1]); o.y = pk2(v[j][2], v[j][3]); ((u32x2*)(H + (size_t)m * DM))[lane + 64 * j] = o; }
    }
}
__device__ __forceinline__ void ph_rms_out(const float* X, const float* SS, const float* SLAB, const float* nw, float* Y, int lane, int gw, int NGW) {
    f32x4 w[8];
#pragma unroll
    for (int j = 0; j < 8; ++j) w[j] = ((const f32x4*)nw)[lane + 64 * j];
    for (int m = gw; m < MTOT; m += NGW) {
        f32x4 v[8];
#pragma unroll
        for (int j = 0; j < 8; ++j) v[j] = ((const f32x4*)(X + (size_t)m * DM))[lane + 64 * j];
        float rstd;
        if (m < MP) rstd = 1.0f / sqrtf(SS[m] * (1.0f / DM) + EPS);
        else {
            f32x4 sl[8][4];
#pragma unroll
            for (int j = 0; j < 8; ++j)
#pragma unroll
                for (int k = 0; k < 4; ++k) sl[j][k] = ((const f32x4*)(SLAB + ((size_t)k * MS + (m - MP)) * DM))[lane + 64 * j];
            float ss = 0.f;
#pragma unroll
            for (int j = 0; j < 8; ++j) { v[j] = v[j] + ((sl[j][0] + sl[j][1]) + (sl[j][2] + sl[j][3]));
                ss += (v[j][0] * v[j][0] + v[j][1] * v[j][1]) + (v[j][2] * v[j][2] + v[j][3] * v[j][3]); }
            rstd = 1.0f / sqrtf(wave_sum(ss) * (1.0f / DM) + EPS);
        }
#pragma unroll
        for (int j = 0; j < 8; ++j) ((f32x4*)(Y + (size_t)m * DM))[lane + 64 * j] = v[j] * rstd * w[j];
    }
}

template <bool GLU>
__device__ __forceinline__ void ph_combine(float* X, bf16* XB, float* SS, const float* SLAB, int lane, int gw, int NGW, bf16* UGW = nullptr, const float* NW = nullptr) {
    constexpr int LDS_ = GLU ? NGLU : DM;
    for (int mr = gw; mr < MS; mr += NGW) {
        const size_t m = (size_t)MP + mr; float ss = 0.f;
        f32x4 xk[8];
#pragma unroll
        for (int jh = 0; jh < 2; ++jh) {
            f32x4 sv[4][4], sg[4][4];
#pragma unroll
            for (int jj = 0; jj < 4; ++jj) { const int j = 4 * jh + jj, c = 4 * (lane + 64 * j);
                xk[j] = *(const f32x4*)(X + m * DM + c);
                const int sc = GLU ? ((c >> 7) << 8) + (c & 127) : c;
#pragma unroll
                for (int k = 0; k < 4; ++k) { const float* sp = SLAB + ((size_t)k * MS + mr) * LDS_ + sc; sv[jj][k] = *(const f32x4*)sp; if (GLU) sg[jj][k] = *(const f32x4*)(sp + 128); } }
#pragma unroll
            for (int jj = 0; jj < 4; ++jj) { const int j = 4 * jh + jj, c = 4 * (lane + 64 * j);
                f32x4 x = xk[j];
                if (GLU) { const f32x4 v = (sv[jj][0] + sv[jj][1]) + (sv[jj][2] + sv[jj][3]), g = (sg[jj][0] + sg[jj][1]) + (sg[jj][2] + sg[jj][3]);
#pragma unroll
                    for (int e = 0; e < 4; ++e) x[e] += v[e] / (1.0f + __expf(-g[e]));
                } else x = x + ((sv[jj][0] + sv[jj][1]) + (sv[jj][2] + sv[jj][3]));
                xk[j] = x; ss += (x[0] * x[0] + x[1] * x[1]) + (x[2] * x[2] + x[3] * x[3]);
                *(f32x4*)(X + m * DM + c) = x;
                u32x2 o; o.x = pk2(x[0], x[1]); o.y = pk2(x[2], x[3]); *(u32x2*)(XB + m * DM + c) = o; }
        }
        ss = wave_sum(ss);
        if (lane == 0) SS[m] = ss;
        if (UGW) {
            const float rs = __builtin_amdgcn_rsqf(ss * (1.0f / DM) + EPS);
            f32x4 w4[8];
#pragma unroll
            for (int j = 0; j < 8; ++j) w4[j] = *(const f32x4*)(NW + 4 * (lane + 64 * j));
#pragma unroll
            for (int j = 0; j < 8; ++j) { const int c = 4 * (lane + 64 * j); const f32x4 x = xk[j];
                u32x2 o; o.x = pk2(x[0] * rs * w4[j][0], x[1] * rs * w4[j][1]); o.y = pk2(x[2] * rs * w4[j][2], x[3] * rs * w4[j][3]);
                *(u32x2*)(UGW + ((size_t)(c >> 4) * MTOT + m) * 16 + (c & 15)) = o; }
        }
    }
}
__device__ __forceinline__ void ph_ug_prompt(const bf16* XB, const float* SS, const float* NW, bf16* UG, int lane, int gw, int NGW) {
    float wv[32];
#pragma unroll
    for (int i = 0; i < 8; ++i) { const f32x4 w4 = *(const f32x4*)(NW + 32 * lane + 4 * i); wv[4 * i] = w4[0]; wv[4 * i + 1] = w4[1]; wv[4 * i + 2] = w4[2]; wv[4 * i + 3] = w4[3]; }
    for (int m = gw; m < MP; m += NGW) {
        u32x4 raw[4];
#pragma unroll
        for (int i = 0; i < 4; ++i) raw[i] = *(const u32x4*)(XB + (size_t)m * DM + 32 * lane + 8 * i);
        const float rs = __builtin_amdgcn_rsqf(SS[m] * (1.0f / DM) + EPS);
#pragma unroll
        for (int i = 0; i < 4; ++i) { float x[8]; unpack8(raw[i], x);
#pragma unroll
            for (int j = 0; j < 8; ++j) x[j] = x[j] * rs * wv[8 * i + j];
            st_bf8(UG + ((size_t)(2 * lane + (i >> 1)) * MTOT + m) * 16 + 8 * (i & 1), x); }
    }
}

typedef short bf16x8 __attribute__((ext_vector_type(8)));
constexpr int GREC_WN = 0, GREC_QD = 16384, GREC_QK = 32768, GREC_KD = 40960, GREC_IMG = 57344, GREC_UT = 57344, GREC_BYTES = 90112;
constexpr int RREC_QD = 0, RREC_QK = 16384, RREC_KD = 24576, RREC_IMG = 40960, RREC_VT = 40960, RREC_BYTES = 73728;
constexpr size_t WS_GREC = WS_ACT, WS_RREC = WS_G2, WS_GL = WS_CTL + 131072;
constexpr size_t WS_QKS = WS_H, WS_VAS = WS_H + 8 * MiB;
__device__ __forceinline__ int kpos(int k) { return (k & ~31) | (((k >> 2) & 3) << 3) | (((k >> 4) & 1) << 2) | (k & 3); }
__device__ __forceinline__ int addr256(int row, int chunk) { return row * 256 + ((chunk ^ (row & 15)) << 4); }
__device__ __forceinline__ int addr128(int row, int chunk) { return row * 128 + ((chunk ^ ((row >> 1) & 7)) << 4); }
__device__ __forceinline__ unsigned cvtpk(float lo, float hi) { unsigned r; asm volatile("v_cvt_pk_bf16_f32 %0, %1, %2" : "=v"(r) : "v"(lo), "v"(hi)); return r; }
__device__ __forceinline__ bf16x8 pack_tiles(const f32x4 lo, const f32x4 hi) { u32x4 w; w.x = cvtpk(lo[0], lo[1]); w.y = cvtpk(lo[2], lo[3]); w.z = cvtpk(hi[0], hi[1]); w.w = cvtpk(hi[2], hi[3]); return __builtin_bit_cast(bf16x8, w); }
#define MFMA16(a, b, c) __builtin_amdgcn_mfma_f32_16x16x32_bf16((a), (b), (c), 0, 0, 0)

__device__ __forceinline__ void img256_put8(unsigned char* img, int row, int grp, const float (&v)[8]) {
    const int s = grp >> 2, t = (grp >> 1) & 1, qq0 = (grp & 1) * 2;
    u32x2 p0, p1; p0.x = pk2(v[0], v[1]); p0.y = pk2(v[2], v[3]); p1.x = pk2(v[4], v[5]); p1.y = pk2(v[6], v[7]);
    *(u32x2*)(img + addr256(row, 4 * s + qq0) + 8 * t) = p0; *(u32x2*)(img + addr256(row, 4 * s + qq0 + 1) + 8 * t) = p1;
}

constexpr int GP_K32 = 0, GP_V32 = 33024, GP_QS = 66048, GP_KS = 82432, GP_LM = 98816, GP_G = 115200;
__device__ __forceinline__ void gdn_prep_chunk(const Args& a, LAS unsigned char* lds, int b, int h, int n, int tid, int lane, int wave) {
    unsigned char* ws = a.ws;
    const bf16* PROJ = (const bf16*)(ws + WS_BIG); const float* GATE = (const float*)(ws + WS_GATE);
    const int cid = (b * 8 + h) * 32 + n, row0 = b * SEQ + 64 * n;
    unsigned char* rec = ws + WS_GREC + (size_t)cid * GREC_BYTES;
    LAS float* K32 = (LAS float*)(lds + GP_K32); LAS float* V32 = (LAS float*)(lds + GP_V32); LAS float* Lm = (LAS float*)(lds + GP_LM);
    LAS float* gs = (LAS float*)(lds + GP_G);
    __syncthreads();
    if (wave == 0) {
        float v = GATE[(size_t)(row0 + lane) * 16 + h];
#pragma unroll
        for (int o = 1; o < 64; o <<= 1) { const float t = __shfl_up(v, o); if (lane >= o) v += t; }
        const float gl = __shfl(v, 63);
        const float be = GATE[(size_t)(row0 + lane) * 16 + 8 + h], ev = expf(v);
        gs[lane] = v; gs[64 + lane] = be; gs[128 + lane] = ev; gs[192 + lane] = expf(gl - v); gs[256 + lane] = be * ev; gs[320 + lane] = 1.0f;
        if (lane == 63) ((float*)(ws + WS_GL))[cid] = expf(gl);
    }
    __syncthreads();
    {
        const int c = tid >> 3, sub = tid & 7, t = 64 * n + c; const size_t m = (size_t)row0 + c;
        const float egc = gs[128 + c], bec = gs[64 + c];
        float qv[2][8], kv[2][8];
#pragma unroll
        for (int i = 0; i < 6; ++i) {
            const int grp = sub + 8 * (i & 1), typ = i >> 1, col = typ * 1024 + h * 128 + grp * 8;
            float acc[8];
#pragma unroll
            for (int e = 0; e < 8; ++e) acc[e] = 0.f;
            if (n > 0) {
                float x[4][8], w[4][8];
#pragma unroll
                for (int j = 0; j < 4; ++j) { ld_bf8(PROJ + (m - 3 + j) * NPROJ + col, x[j]); ld_f8(a.in[I_GCW] + (size_t)j * 3072 + col, w[j]); }
#pragma unroll
                for (int j = 0; j < 4; ++j)
#pragma unroll
                    for (int e = 0; e < 8; ++e) acc[e] += w[j][e] * x[j][e];
            } else {
#pragma unroll
                for (int j = 0; j < 4; ++j) if (t - 3 + j >= 0) { float x[8], w[8]; ld_bf8(PROJ + (m - 3 + j) * NPROJ + col, x); ld_f8(a.in[I_GCW] + (size_t)j * 3072 + col, w);
#pragma unroll
                    for (int e = 0; e < 8; ++e) acc[e] += w[e] * x[e]; }
            }
#pragma unroll
            for (int e = 0; e < 8; ++e) acc[e] = silu_f(acc[e]);
            if (typ == 0) {
#pragma unroll
                for (int e = 0; e < 8; ++e) qv[i & 1][e] = acc[e];
            } else if (typ == 1) {
#pragma unroll
                for (int e = 0; e < 8; ++e) kv[i & 1][e] = acc[e];
            } else {
#pragma unroll
                for (int e = 0; e < 8; ++e) V32[c * 129 + grp * 8 + e] = acc[e] * bec; }
            if (i & 1) asm volatile("" ::: "memory");
        }
        float sq = 0.f, sk = 0.f;
#pragma unroll
        for (int e = 0; e < 8; ++e) { sq += qv[0][e] * qv[0][e] + qv[1][e] * qv[1][e]; sk += kv[0][e] * kv[0][e] + kv[1][e] * kv[1][e]; }
        sq += __shfl_xor(sq, 1); sq += __shfl_xor(sq, 2); sq += __shfl_xor(sq, 4); sk += __shfl_xor(sk, 1); sk += __shfl_xor(sk, 2); sk += __shfl_xor(sk, 4);
        const float rq = (1.0f / sqrtf(sq + EPS)) * 0.08838834764831845f, rk = 1.0f / sqrtf(sk + EPS);
#pragma unroll
        for (int i = 0; i < 2; ++i) { const int grp = sub + 8 * i; float qd[8];
#pragma unroll
            for (int e = 0; e < 8; ++e) { qv[i][e] *= rq; kv[i][e] *= rk; qd[e] = qv[i][e] * egc; K32[c * 129 + grp * 8 + e] = kv[i][e]; }
            u32x4 wq, wk; wq.x = pk2(qv[i][0], qv[i][1]); wq.y = pk2(qv[i][2], qv[i][3]); wq.z = pk2(qv[i][4], qv[i][5]); wq.w = pk2(qv[i][6], qv[i][7]);
            wk.x = pk2(kv[i][0], kv[i][1]); wk.y = pk2(kv[i][2], kv[i][3]); wk.z = pk2(kv[i][4], kv[i][5]); wk.w = pk2(kv[i][6], kv[i][7]);
            *(LAS u32x4*)(lds + GP_QS + addr256(c, grp)) = wq; *(LAS u32x4*)(lds + GP_KS + addr256(c, grp)) = wk;
            img256_put8(rec + GREC_QD, c, grp, qd); }
    }
    __syncthreads();
    {
        const int r = lane & 15, q = lane >> 4;
#pragma unroll
        for (int ti = 0; ti < 2; ++ti) {
            const int tt = 2 * wave + ti, ct = tt >> 2, cu = tt & 3;
            f32x4 akk = {0.f, 0.f, 0.f, 0.f}, aqk = {0.f, 0.f, 0.f, 0.f};
#pragma unroll
            for (int ks = 0; ks < 4; ++ks) {
                const bf16x8 bk = *(const LAS bf16x8*)(lds + GP_KS + addr256(16 * cu + r, 4 * ks + q));
                const bf16x8 ak = *(const LAS bf16x8*)(lds + GP_KS + addr256(16 * ct + r, 4 * ks + q));
                const bf16x8 aq = *(const LAS bf16x8*)(lds + GP_QS + addr256(16 * ct + r, 4 * ks + q));
                akk = MFMA16(ak, bk, akk); aqk = MFMA16(aq, bk, aqk);
            }
            const int c2 = 16 * cu + r; const float g2 = gs[c2]; const int p2 = kpos(c2);
#pragma unroll
            for (int reg = 0; reg < 4; ++reg) { const int c = 16 * ct + 4 * q + reg; const float dec = (c2 <= c) ? expf(gs[c] - g2) : 0.f;
                Lm[c * 64 + c2] = (c2 < c) ? gs[64 + c] * akk[reg] * dec : 0.f;
                *(bf16*)(rec + GREC_QK + addr128(c, p2 >> 3) + (p2 & 7) * 2) = (bf16)f2bf(aqk[reg] * dec); }
        }
    }
    __syncthreads();
    if (tid < 256) {
        const bool isu = tid < 128; const int col = isu ? tid : tid - 128;
        const LAS float* rb = (const LAS float*)(lds + (isu ? GP_V32 : GP_K32)) + col; const LAS float* scp = gs + (isu ? 320 : 256);
        int zlane; asm volatile("v_mov_b32 %0, 0" : "=v"(zlane));
        const LAS float* Lz = Lm + zlane;
        float sol[64];
#pragma unroll
        for (int c = 0; c < 64; ++c) {
            float pa[4] = {rb[c * 129] * scp[c], 0.f, 0.f, 0.f};
#pragma unroll
            for (int c4 = 0; c4 < (c + 3) / 4; ++c4) { const f32x4 l4 = *(const LAS f32x4*)(Lz + c * 64 + 4 * c4);
#pragma unroll
                for (int j = 0; j < 4; ++j) if (4 * c4 + j < c) pa[j] -= l4[j] * sol[4 * c4 + j]; }
            sol[c] = (pa[0] + pa[1]) + (pa[2] + pa[3]);
            asm volatile("" ::: "memory");
        }
        if (isu) { float* ut = (float*)(rec + GREC_UT) + col * 64;
#pragma unroll
            for (int c4 = 0; c4 < 16; ++c4) *(f32x4*)(ut + 4 * c4) = (f32x4){sol[4 * c4], sol[4 * c4 + 1], sol[4 * c4 + 2], sol[4 * c4 + 3]}; }
        else { const int p = kpos(col), ch = p >> 3, wi = (p & 7) * 2;
            int xo[16];
#pragma unroll
            for (int k = 0; k < 16; ++k) xo[k] = ((ch ^ k) << 4) + wi;
#pragma unroll
            for (int c = 0; c < 64; ++c) *(LAS bf16*)(lds + GP_QS + c * 256 + xo[c & 15]) = (bf16)f2bf(-sol[c]); }
    } else {
        const int c = lane, p = kpos(c), ch = p >> 3, wi = (p & 7) * 2; const float sc = gs[192 + c];
#pragma unroll 2
        for (int i = 0; i < 32; ++i) { const int d = (wave - 4) * 32 + i; *(bf16*)(rec + GREC_KD + addr128(d, ch) + wi) = (bf16)f2bf(K32[c * 129 + d] * sc); }
    }
    __syncthreads();
#pragma unroll
    for (int i = 0; i < 2; ++i) *(u32x4*)(rec + GREC_WN + (i * NTHR + tid) * 16) = *(const LAS u32x4*)(lds + GP_QS + (i * NTHR + tid) * 16);
}

constexpr int RP_K32 = 0, RP_V16 = 33024, RP_QS = 66048, RP_KS = 82432;
__device__ __forceinline__ void ret_prep_chunk(const Args& a, LAS unsigned char* lds, int b, int h, int n, int tid, int lane, int wave) {
    unsigned char* ws = a.ws;
    const bf16* PROJ = (const bf16*)(ws + WS_BIG); const float* tab = (const float*)(ws + WS_TAB);
    const int cid = (b * 4 + h) * 32 + n, row0 = b * SEQ + 64 * n;
    unsigned char* rec = ws + WS_RREC + (size_t)cid * RREC_BYTES;
    LAS float* K32 = (LAS float*)(lds + RP_K32); LAS bf16* V16 = (LAS bf16*)(lds + RP_V16);
    const float l2g = log2f(1.0f - exp2f(-5.0f - (float)h));
    __syncthreads();
    {
        const int c = tid >> 3, sub = tid & 7; const size_t m = (size_t)row0 + c; const bf16* pr = PROJ + m * NPROJ;
        float ql[8], qh[8], kl[8], kh[8], cs[8], sn[8];
        ld_bf8(pr + C_QB + h * 128 + sub * 8, ql); ld_bf8(pr + C_QB + h * 128 + 64 + sub * 8, qh); ld_bf8(pr + C_KB + h * 128 + sub * 8, kl); ld_bf8(pr + C_KB + h * 128 + 64 + sub * 8, kh);
        ld_f8(tab + (size_t)(64 * n + c) * 128 + sub * 8, cs); ld_f8(tab + (size_t)(64 * n + c) * 128 + 64 + sub * 8, sn);
        float q0[8], q1[8], k0[8], k1[8], d0[8], d1[8]; const float qdec = exp2f(l2g * (float)(c + 1));
#pragma unroll
        for (int e = 0; e < 8; ++e) { q0[e] = ql[e] * cs[e] - qh[e] * sn[e]; q1[e] = ql[e] * sn[e] + qh[e] * cs[e];
            k0[e] = (kl[e] * cs[e] - kh[e] * sn[e]) * 0.08838834764831845f; k1[e] = (kl[e] * sn[e] + kh[e] * cs[e]) * 0.08838834764831845f;
            d0[e] = q0[e] * qdec; d1[e] = q1[e] * qdec; K32[c * 129 + sub * 8 + e] = k0[e]; K32[c * 129 + 64 + sub * 8 + e] = k1[e]; }
        u32x4 w; w.x = pk2(q0[0], q0[1]); w.y = pk2(q0[2], q0[3]); w.z = pk2(q0[4], q0[5]); w.w = pk2(q0[6], q0[7]); *(LAS u32x4*)(lds + RP_QS + addr256(c, sub)) = w;
        w.x = pk2(q1[0], q1[1]); w.y = pk2(q1[2], q1[3]); w.z = pk2(q1[4], q1[5]); w.w = pk2(q1[6], q1[7]); *(LAS u32x4*)(lds + RP_QS + addr256(c, 8 + sub)) = w;
        w.x = pk2(k0[0], k0[1]); w.y = pk2(k0[2], k0[3]); w.z = pk2(k0[4], k0[5]); w.w = pk2(k0[6], k0[7]); *(LAS u32x4*)(lds + RP_KS + addr256(c, sub)) = w;
        w.x = pk2(k1[0], k1[1]); w.y = pk2(k1[2], k1[3]); w.z = pk2(k1[4], k1[5]); w.w = pk2(k1[6], k1[7]); *(LAS u32x4*)(lds + RP_KS + addr256(c, 8 + sub)) = w;
        img256_put8(rec + RREC_QD, c, sub, d0); img256_put8(rec + RREC_QD, c, 8 + sub, d1);
#pragma unroll
        for (int i = 0; i < 4; ++i) { const u32x4 v = *(const u32x4*)(pr + C_VB + h * 256 + (sub + 8 * i) * 8); LAS unsigned* dst = (LAS unsigned*)(V16 + c * 258 + (sub + 8 * i) * 8); dst[0] = v.x; dst[1] = v.y; dst[2] = v.z; dst[3] = v.w; }
    }
    __syncthreads();
    {
        const int r = lane & 15, q = lane >> 4;
#pragma unroll
        for (int ti = 0; ti < 2; ++ti) {
            const int tt = 2 * wave + ti, ct = tt >> 2, cu = tt & 3;
            f32x4 aqk = {0.f, 0.f, 0.f, 0.f};
#pragma unroll
            for (int ks = 0; ks < 4; ++ks) {
                const bf16x8 bk = *(const LAS bf16x8*)(lds + RP_KS + addr256(16 * cu + r, 4 * ks + q));
                const bf16x8 aq = *(const LAS bf16x8*)(lds + RP_QS + addr256(16 * ct + r, 4 * ks + q));
                aqk = MFMA16(aq, bk, aqk);
            }
            const int c2 = 16 * cu + r, p2 = kpos(c2);
#pragma unroll
            for (int reg = 0; reg < 4; ++reg) { const int c = 16 * ct + 4 * q + reg; const float dec = (c2 <= c) ? exp2f(l2g * (float)(c - c2)) : 0.f;
                *(bf16*)(rec + RREC_QK + addr128(c, p2 >> 3) + (p2 & 7) * 2) = (bf16)f2bf(aqk[reg] * dec); }
        }
        const int c = lane, p = kpos(c), ch = p >> 3, wi = (p & 7) * 2; const float sc = exp2f(l2g * (float)(63 - c));
#pragma unroll 2
        for (int i = 0; i < 16; ++i) { const int d = wave * 16 + i; *(bf16*)(rec + RREC_KD + addr128(d, ch) + wi) = (bf16)f2bf(K32[c * 129 + d] * sc); }
#pragma unroll 2
        for (int i = 0; i < 32; ++i) { const int e = wave * 32 + i; *(bf16*)(rec + RREC_VT + e * 128 + p * 2) = V16[c * 258 + e]; }
    }
}

template <bool GDN>
__device__ __forceinline__ void chunk_scan(const Args& a, LAS unsigned char* lds, int task, int tid, int lane, int wave) {
    unsigned char* ws = a.ws;
    constexpr int IMG = GDN ? GREC_IMG : RREC_IMG, REC = GDN ? GREC_BYTES : RREC_BYTES, NP = IMG / 16 / NTHR;
    constexpr int O_WN = GREC_WN, O_QD = GDN ? GREC_QD : RREC_QD, O_QK = GDN ? GREC_QK : RREC_QK, O_KD = GDN ? GREC_KD : RREC_KD;
    const int r = lane & 15, q = lane >> 4;
    int b, h, e0, cid0;
    if (GDN) { b = task >> 3; h = task & 7; e0 = 16 * wave; cid0 = (b * 8 + h) * 32; }
    else { b = task >> 3; h = (task >> 1) & 3; e0 = 128 * (task & 1) + 16 * wave; cid0 = (b * 4 + h) * 32; }
    const unsigned char* rec = ws + (GDN ? WS_GREC : WS_RREC) + (size_t)cid0 * REC;
    const float* GL = (const float*)(ws + WS_GL) + cid0;
    float* O = (float*)(ws + (GDN ? WS_OA : WS_OB)) + (size_t)b * SEQ * 1024 + h * (GDN ? 128 : 256) + e0 + r;
    const float gch = GDN ? 0.f : exp2f(64.0f * log2f(1.0f - exp2f(-5.0f - (float)h)));
    f32x4 S[8];
#pragma unroll
    for (int dt = 0; dt < 8; ++dt) S[dt] = (f32x4){0.f, 0.f, 0.f, 0.f};
    __syncthreads();
    constexpr int SLICE = GDN ? 4096 : 2048, SL_OFF = 2 * GREC_IMG;
    LAS unsigned char* slot = lds + SL_OFF + wave * SLICE;
#define STAGE_IMG(recp, bufp) do { _Pragma("unroll") for (int i_ = 0; i_ < NP; ++i_) \
        __builtin_amdgcn_global_load_lds((const unsigned*)((recp) + (size_t)(i_ * NTHR + tid) * 16), (LAS unsigned*)((bufp) + (i_ * NTHR + wave * 64) * 16), 16, 0, 0); } while (0)
#define STAGE_SLICE(recp) do { _Pragma("unroll") for (int i_ = 0; i_ < SLICE / 1024; ++i_) \
        __builtin_amdgcn_global_load_lds((const unsigned*)((recp) + (GDN ? GREC_UT + e0 * 256 : RREC_VT + e0 * 128) + i_ * 1024 + lane * 16), (LAS unsigned*)(slot + i_ * 1024), 16, 0, 0); } while (0)
    STAGE_IMG(rec, lds); STAGE_SLICE(rec);
    for (int n = 0; n < 32; ++n) {
        const unsigned char* nrec = rec + (size_t)(n + 1 < 32 ? n + 1 : n) * REC;
        f32x4 uc[4]; bf16x8 bv[2];
        const float gl = GDN ? GL[n] : gch;
        if (n == 0) asm volatile("s_waitcnt vmcnt(0) lgkmcnt(0)" ::: "memory"); else asm volatile("s_waitcnt vmcnt(16) lgkmcnt(0)" ::: "memory");
        __builtin_amdgcn_s_barrier();
        asm volatile("" ::: "memory");
        if (GDN) {
#pragma unroll
            for (int ct = 0; ct < 4; ++ct) uc[ct] = *(const LAS f32x4*)(slot + r * 256 + (16 * ct + 4 * q) * 4);
        } else {
#pragma unroll
            for (int s = 0; s < 2; ++s) bv[s] = *(const LAS bf16x8*)(slot + r * 128 + (4 * s + q) * 16);
        }
        asm volatile("s_waitcnt lgkmcnt(0)" ::: "memory");
        if (n + 1 < 32) { STAGE_IMG(nrec, lds + ((n + 1) & 1) * IMG); STAGE_SLICE(nrec); }
        asm volatile("" ::: "memory"); __builtin_amdgcn_sched_barrier(0);
        LAS unsigned char* B = lds + (n & 1) * IMG;
        bf16x8 bs[4];
#pragma unroll
        for (int s = 0; s < 4; ++s) bs[s] = pack_tiles(S[2 * s], S[2 * s + 1]);
        f32x4 ao[4];
#pragma unroll
        for (int ct = 0; ct < 4; ++ct) ao[ct] = (f32x4){0.f, 0.f, 0.f, 0.f};
        bf16x8 FA[8], FB[8];
#define LD256(F, off, s0) do { _Pragma("unroll") for (int i_ = 0; i_ < 8; ++i_) F[i_] = *(const LAS bf16x8*)(B + (off) + addr256(16 * (i_ & 3) + r, 4 * ((s0) + (i_ >> 2)) + q)); } while (0)
#define LD128(F, off, t0) do { _Pragma("unroll") for (int i_ = 0; i_ < 8; ++i_) F[i_] = *(const LAS bf16x8*)(B + (off) + addr128(16 * ((t0) + (i_ & 3)) + r, 4 * (i_ >> 2) + q)); } while (0)
#define MM(F, ACC, BOP, s0) do { _Pragma("unroll") for (int i_ = 0; i_ < 8; ++i_) ACC[i_ & 3] = MFMA16(F[i_], BOP[(s0) + (i_ >> 2)], ACC[i_ & 3]); } while (0)
#define SB() __builtin_amdgcn_sched_barrier(0)
        if (GDN) {
            LD256(FA, O_WN, 0); SB();
            LD256(FB, O_WN, 2); SB(); MM(FA, uc, bs, 0); SB();
            LD256(FA, O_QD, 0); SB(); MM(FB, uc, bs, 2); SB();
            bv[0] = pack_tiles(uc[0], uc[1]); bv[1] = pack_tiles(uc[2], uc[3]);
        } else { LD256(FA, O_QD, 0); SB(); }
        LD256(FB, O_QD, 2); SB(); MM(FA, ao, bs, 0); SB();
        LD128(FA, O_QK, 0); SB(); MM(FB, ao, bs, 2); SB();
        LD128(FB, O_KD, 0); SB(); MM(FA, ao, bv, 0); SB();
#pragma unroll
        for (int dt = 0; dt < 8; ++dt) S[dt] = S[dt] * gl;
        LD128(FA, O_KD, 4); SB();
        { f32x4 (&S0)[8] = S; _Pragma("unroll") for (int i_ = 0; i_ < 8; ++i_) S0[i_ & 3] = MFMA16(FB[i_], bv[i_ >> 2], S0[i_ & 3]); } SB();
        { _Pragma("unroll") for (int i_ = 0; i_ < 8; ++i_) S[4 + (i_ & 3)] = MFMA16(FA[i_], bv[i_ >> 2], S[4 + (i_ & 3)]); } SB();
#undef LD256
#undef LD128
#undef MM
#undef SB
#pragma unroll
        for (int ct = 0; ct < 4; ++ct)
#pragma unroll
            for (int reg = 0; reg < 4; ++reg) O[(size_t)(64 * n + 16 * ct + 4 * q + reg) * 1024] = ao[ct][reg];
    }
#undef STAGE_IMG
#undef STAGE_SLICE
    float* so = a.out + (GDN ? O_GDN_P + (size_t)(b * 8 + h) * 128 * 128 : O_RET_P + (size_t)(b * 4 + h) * 128 * 256) + e0 + r;
#pragma unroll
    for (int dt = 0; dt < 8; ++dt)
#pragma unroll
        for (int reg = 0; reg < 4; ++reg) so[(size_t)(16 * dt + 4 * q + reg) * (GDN ? 128 : 256)] = S[dt][reg];
}

__device__ __forceinline__ void ph_gdn_prep(const Args& a, int lane, int gw, int NGW) {
    unsigned char* ws = a.ws;
    const bf16* PROJ = (const bf16*)(ws + WS_BIG);
    for (int idx = gw * 64 + lane; idx < (4 + DECB) * 3 * 3072; idx += NGW * 64) {
        const int c = idx % 3072, j = (idx / 3072) % 3, sb = idx / (3 * 3072);
        if (sb < 4) a.out[O_GCB_P + idx] = bf2f(PROJ[(size_t)(sb * SEQ + SEQ - 3 + j) * NPROJ + c]);
        else { const int b = sb - 4; a.out[O_GCB_S + ((size_t)b * 3 + j) * 3072 + c] = bf2f(PROJ[(size_t)(MP + b * DECS + DECS - 3 + j) * NPROJ + c]); }
    }
}

__device__ __forceinline__ void ph_mix_prep(const Args& a, LAS unsigned char* lds, int tid, int lane, int wave, int gw, int NGW, int G) {
    for (int t = blockIdx.x; t < 1024; t += G) gdn_prep_chunk(a, lds, t >> 8, (t >> 5) & 7, t & 31, tid, lane, wave);
    for (int r = blockIdx.x; r < 512; r += G) ret_prep_chunk(a, lds, r >> 7, (r >> 5) & 3, r & 31, tid, lane, wave);
    ph_gdn_prep(a, lane, gw, NGW);
}
constexpr int SB_Q = 0, SB_K = 4096, SB_V = 8192, SB_G = 12288;
#define LDS_BARRIER() asm volatile("s_waitcnt lgkmcnt(0)\n\ts_barrier" ::: "memory")
__device__ __forceinline__ float oct_sum(float v) {
    v += __builtin_bit_cast(float, __builtin_amdgcn_mov_dpp(__builtin_bit_cast(int, v), 0xB1, 0xF, 0xF, true));
    v += __builtin_bit_cast(float, __builtin_amdgcn_mov_dpp(__builtin_bit_cast(int, v), 0x4E, 0xF, 0xF, true));
    v += __builtin_bit_cast(float, __builtin_amdgcn_mov_dpp(__builtin_bit_cast(int, v), 0x141, 0xF, 0xF, true));
    return v;
}
__device__ __forceinline__ void gdn_sample_pair(const Args& a, LAS unsigned char* lds, int st, int lane, int wave) {
    unsigned char* ws = a.ws;
    const bf16* PROJ = (const bf16*)(ws + WS_BIG); const float* GATE = (const float*)(ws + WS_GATE); float* OA = (float*)(ws + WS_OA);
    const int hb = wave >> 2, w4 = wave & 3, b = st >> 3, h = st & 7;
    LAS unsigned char* L = lds + hb * 16384;
    LAS float* qs = (LAS float*)(L + SB_Q); LAS float* ks = (LAS float*)(L + SB_K); LAS float* vs = (LAS float*)(L + SB_V); LAS float* gt = (LAS float*)(L + SB_G);
    const int dg = lane & 7, ec = lane >> 3, wcol = 32 * w4 + 4 * ec;
    float2 wj[3][4], xs[3][5]; unsigned xp[3][5]; float g0[2], g1[2];
#pragma unroll
    for (int typ = 0; typ < 3; ++typ) { const int col = typ * 1024 + h * 128 + 2 * lane;
#pragma unroll
        for (int j = 0; j < 4; ++j) wj[typ][j] = *(const float2*)(a.in[I_GCW] + (size_t)j * 3072 + col);
#pragma unroll
        for (int jj = 0; jj < 5; ++jj) { const int tq = 2 * w4 + jj; xs[typ][jj] = *(const float2*)(a.in[I_SGCB] + ((size_t)b * 3 + (tq < 3 ? tq : 2)) * 3072 + col);
            xp[typ][jj] = *(const unsigned*)(PROJ + (size_t)(MP + b * DECS + (tq >= 3 ? tq - 3 : 0)) * NPROJ + col); } }
#pragma unroll
    for (int tt = 0; tt < 2; ++tt) { const size_t m = (size_t)MP + b * DECS + 2 * w4 + tt; g0[tt] = GATE[m * 16 + h]; g1[tt] = GATE[m * 16 + 8 + h]; }
    asm volatile("" ::: "memory");
    f32x4 S[16];
    { const float* sp = a.in[I_SGDN] + (((size_t)b * 8 + h) * 128 + dg * 16) * 128 + wcol;
#pragma unroll
      for (int i = 0; i < 16; ++i) S[i] = *(const f32x4*)(sp + (size_t)i * 128); }
    LDS_BARRIER();
#pragma unroll
    for (int typ = 0; typ < 3; ++typ) {
        asm volatile("" : "+v"(wj[typ][0].x), "+v"(wj[typ][0].y), "+v"(wj[typ][1].x), "+v"(wj[typ][1].y), "+v"(wj[typ][2].x), "+v"(wj[typ][2].y), "+v"(wj[typ][3].x), "+v"(wj[typ][3].y));
        asm volatile("" : "+v"(xs[typ][0].x), "+v"(xs[typ][0].y), "+v"(xs[typ][1].x), "+v"(xs[typ][1].y), "+v"(xs[typ][2].x), "+v"(xs[typ][2].y), "+v"(xs[typ][3].x), "+v"(xs[typ][3].y), "+v"(xs[typ][4].x), "+v"(xs[typ][4].y));
        asm volatile("" : "+v"(xp[typ][0]), "+v"(xp[typ][1]), "+v"(xp[typ][2]), "+v"(xp[typ][3]), "+v"(xp[typ][4])); }
    asm volatile("" : "+v"(g0[0]), "+v"(g0[1]), "+v"(g1[0]), "+v"(g1[1]));
#pragma unroll
    for (int tt = 0; tt < 2; ++tt) { const int c = 2 * w4 + tt;
#pragma unroll
        for (int typ = 0; typ < 3; ++typ) { float a0 = 0.f, a1 = 0.f;
#pragma unroll
            for (int j = 0; j < 4; ++j) { const bool st_ = (c + j) < 3; const unsigned w = xp[typ][tt + j]; const float x0 = st_ ? xs[typ][tt + j].x : __builtin_bit_cast(float, w << 16), x1 = st_ ? xs[typ][tt + j].y : __builtin_bit_cast(float, w & 0xffff0000u);
                a0 += wj[typ][j].x * x0; a1 += wj[typ][j].y * x1; }
            a0 = silu_f(a0); a1 = silu_f(a1);
            if (typ < 2) { const float rs = (1.0f / sqrtf(wave_sum(a0 * a0 + a1 * a1) + EPS)) * (typ == 0 ? 0.08838834764831845f : 1.0f); a0 *= rs; a1 *= rs; }
            LAS float* dst = (typ == 0 ? qs : typ == 1 ? ks : vs) + c * 128 + 2 * lane; dst[0] = a0; dst[1] = a1; }
        if (lane == 0) { gt[c] = g0[tt]; gt[8 + c] = g1[tt]; } }
    LDS_BARRIER();
#pragma unroll 1
    for (int c = 0; c < 8; ++c) {
        const float al = expf(gt[c]), be = gt[8 + c];
        float kk[16], qq[16];
#pragma unroll
        for (int i4 = 0; i4 < 4; ++i4) { const f32x4 k4 = *(const LAS f32x4*)(ks + c * 128 + dg * 16 + 4 * i4), q4 = *(const LAS f32x4*)(qs + c * 128 + dg * 16 + 4 * i4);
            kk[4 * i4] = k4[0]; kk[4 * i4 + 1] = k4[1]; kk[4 * i4 + 2] = k4[2]; kk[4 * i4 + 3] = k4[3]; qq[4 * i4] = q4[0]; qq[4 * i4 + 1] = q4[1]; qq[4 * i4 + 2] = q4[2]; qq[4 * i4 + 3] = q4[3]; }
        const f32x4 v4 = *(const LAS f32x4*)(vs + c * 128 + wcol);
        f32x4 r0 = {0.f, 0.f, 0.f, 0.f}, r1 = {0.f, 0.f, 0.f, 0.f};
#pragma unroll
        for (int i = 0; i < 16; i += 2) { r0 = r0 + S[i] * kk[i]; r1 = r1 + S[i + 1] * kk[i + 1]; }
        f32x4 rr = r0 + r1;
#pragma unroll
        for (int j = 0; j < 4; ++j) rr[j] = oct_sum(rr[j]);
        const f32x4 dl = (v4 - rr * al) * be;
        f32x4 o0 = {0.f, 0.f, 0.f, 0.f}, o1 = {0.f, 0.f, 0.f, 0.f};
#pragma unroll
        for (int i = 0; i < 16; i += 2) { S[i] = S[i] * al + dl * kk[i]; S[i + 1] = S[i + 1] * al + dl * kk[i + 1]; o0 = o0 + S[i] * qq[i]; o1 = o1 + S[i + 1] * qq[i + 1]; }
        f32x4 oo = o0 + o1;
#pragma unroll
        for (int j = 0; j < 4; ++j) oo[j] = oct_sum(oo[j]);
        if (dg == 0) *(f32x4*)(OA + (size_t)(MP + b * DECS + c) * 1024 + h * 128 + wcol) = oo;
    }
    { float* so = a.out + O_GDN_S + (((size_t)b * 8 + h) * 128 + dg * 16) * 128 + wcol;
#pragma unroll
      for (int i = 0; i < 16; ++i) *(f32x4*)(so + (size_t)i * 128) = S[i]; }
}
__device__ __forceinline__ void ret_sample_pair(const Args& a, LAS unsigned char* lds, int st, int lane, int wave) {
    unsigned char* ws = a.ws;
    const bf16* PROJ = (const bf16*)(ws + WS_BIG); const float* tab = (const float*)(ws + WS_TAB); float* OB = (float*)(ws + WS_OB);
    const int hb = wave >> 2, w4 = wave & 3, r_ = st - 1024, b = r_ >> 3, h = (r_ >> 1) & 3, half = r_ & 1;
    LAS unsigned char* L = lds + hb * 16384;
    LAS float* qs = (LAS float*)(L + SB_Q); LAS float* ks = (LAS float*)(L + SB_K); LAS float* vs = (LAS float*)(L + SB_V);
    const int dg = lane & 7, ec = lane >> 3, wcol = 32 * w4 + 4 * ec;
    const float gamma = 1.0f - exp2f(-5.0f - (float)h);
    float cs[2], sn[2]; unsigned rq[2][2], rk[2][2], vw[2];
#pragma unroll
    for (int tt = 0; tt < 2; ++tt) { const int c = 2 * w4 + tt; const unsigned short* pr = (const unsigned short*)(PROJ + (size_t)(MP + b * DECS + c) * NPROJ); const float* tp = tab + (size_t)(2048 + c) * 128;
        cs[tt] = tp[lane]; sn[tt] = tp[64 + lane];
        rq[tt][0] = pr[C_QB + h * 128 + lane]; rq[tt][1] = pr[C_QB + h * 128 + 64 + lane]; rk[tt][0] = pr[C_KB + h * 128 + lane]; rk[tt][1] = pr[C_KB + h * 128 + 64 + lane];
        vw[tt] = *(const unsigned*)(pr + C_VB + h * 256 + half * 128 + 2 * lane); }
    asm volatile("" ::: "memory");
    f32x4 S[16];
    { const float* sp = a.in[I_SRET] + (((size_t)b * 4 + h) * 128 + dg * 16) * 256 + half * 128 + wcol;
#pragma unroll
      for (int i = 0; i < 16; ++i) S[i] = *(const f32x4*)(sp + (size_t)i * 256); }
    LDS_BARRIER();
    asm volatile("" : "+v"(cs[0]), "+v"(sn[0]), "+v"(rq[0][0]), "+v"(rq[0][1]), "+v"(rk[0][0]), "+v"(rk[0][1]), "+v"(vw[0]), "+v"(cs[1]), "+v"(sn[1]), "+v"(rq[1][0]), "+v"(rq[1][1]), "+v"(rk[1][0]), "+v"(rk[1][1]), "+v"(vw[1]));
#pragma unroll
    for (int tt = 0; tt < 2; ++tt) { const int c = 2 * w4 + tt;
        const float ql = __builtin_bit_cast(float, rq[tt][0] << 16), qh = __builtin_bit_cast(float, rq[tt][1] << 16), kl = __builtin_bit_cast(float, rk[tt][0] << 16), kh = __builtin_bit_cast(float, rk[tt][1] << 16);
        qs[c * 128 + lane] = ql * cs[tt] - qh * sn[tt]; qs[c * 128 + 64 + lane] = ql * sn[tt] + qh * cs[tt];
        ks[c * 128 + lane] = (kl * cs[tt] - kh * sn[tt]) * 0.08838834764831845f; ks[c * 128 + 64 + lane] = (kl * sn[tt] + kh * cs[tt]) * 0.08838834764831845f;
        vs[c * 128 + 2 * lane] = __builtin_bit_cast(float, vw[tt] << 16); vs[c * 128 + 2 * lane + 1] = __builtin_bit_cast(float, vw[tt] & 0xffff0000u); }
    LDS_BARRIER();
#pragma unroll 1
    for (int c = 0; c < 8; ++c) {
        float kk[16], qq[16];
#pragma unroll
        for (int i4 = 0; i4 < 4; ++i4) { const f32x4 k4 = *(const LAS f32x4*)(ks + c * 128 + dg * 16 + 4 * i4), q4 = *(const LAS f32x4*)(qs + c * 128 + dg * 16 + 4 * i4);
            kk[4 * i4] = k4[0]; kk[4 * i4 + 1] = k4[1]; kk[4 * i4 + 2] = k4[2]; kk[4 * i4 + 3] = k4[3]; qq[4 * i4] = q4[0]; qq[4 * i4 + 1] = q4[1]; qq[4 * i4 + 2] = q4[2]; qq[4 * i4 + 3] = q4[3]; }
        const f32x4 v4 = *(const LAS f32x4*)(vs + c * 128 + wcol);
        f32x4 o0 = {0.f, 0.f, 0.f, 0.f}, o1 = {0.f, 0.f, 0.f, 0.f};
#pragma unroll
        for (int i = 0; i < 16; i += 2) { S[i] = S[i] * gamma + v4 * kk[i]; S[i + 1] = S[i + 1] * gamma + v4 * kk[i + 1]; o0 = o0 + S[i] * qq[i]; o1 = o1 + S[i + 1] * qq[i + 1]; }
        f32x4 oo = o0 + o1;
#pragma unroll
        for (int j = 0; j < 4; ++j) oo[j] = oct_sum(oo[j]);
        if (dg == 0) *(f32x4*)(OB + (size_t)(MP + b * DECS + c) * 1024 + h * 256 + half * 128 + wcol) = oo;
    }
    { float* so = a.out + O_RET_S + (((size_t)b * 4 + h) * 128 + dg * 16) * 256 + half * 128 + wcol;
#pragma unroll
      for (int i = 0; i < 16; ++i) *(f32x4*)(so + (size_t)i * 256) = S[i]; }
}
__device__ __forceinline__ void sample_pairs(const Args& a, LAS unsigned char* lds, int p0, int stride, int cnt, int lane, int wave) {
    const int hb = wave >> 2;
    __builtin_amdgcn_s_waitcnt(0);
#pragma unroll 1
    for (int k = 0; k < cnt; ++k) { const int pr = p0 + k * stride, st = 2 * pr + hb;
        if (pr < 512) gdn_sample_pair(a, lds, st, lane, wave); else ret_sample_pair(a, lds, st, lane, wave); }
}
__device__ __forceinline__ void ph_scans(const Args& a, LAS unsigned char* lds, int tid, int lane, int wave, int G, int mode = 3) {
    const int blk = blockIdx.x;
    if (mode & 1) { if (blk < 32) chunk_scan<true>(a, lds, blk, tid, lane, wave); else if (blk < 64) chunk_scan<false>(a, lds, blk - 32, tid, lane, wave); }
    if ((mode & 2) && blk >= 64) sample_pairs(a, lds, blk - 64, 192, (blk - 64) < 64 ? 6 : 5, lane, wave);
    if (mode == 3 && blk >= 64) convert_group(a, 1, (LAS float*)(lds + 32768 + wave * 8704), lane, (blk - 64) * NWAVES + wave, 192 * NWAVES);
}

__device__ __forceinline__ void ph_mix_norm(const Args& a, int lane, int gw, int NGW) {
    unsigned char* ws = a.ws;
    const bf16* PROJ = (const bf16*)(ws + WS_BIG); const float* OA = (const float*)(ws + WS_OA); const float* OB = (const float*)(ws + WS_OB); bf16* MIX = (bf16*)(ws + WS_G2);
    float wa[2][8], wb[2][8], bb[2][8];
#pragma unroll
    for (int i = 0; i < 2; ++i) { const int col = 8 * (lane + 64 * i); ld_f8(a.in[I_GNW] + (col & 127), wa[i]); ld_f8(a.in[I_RGW] + col, wb[i]); ld_f8(a.in[I_RGB] + col, bb[i]); }
    for (int m = gw; m < MTOT; m += NGW) {
        f32x4 oa[2][2], ob[2][2]; u32x4 zz[2], gg[2];
#pragma unroll
        for (int i = 0; i < 2; ++i) { const int col = 8 * (lane + 64 * i);
            oa[i][0] = *(const f32x4*)(OA + (size_t)m * 1024 + col); oa[i][1] = *(const f32x4*)(OA + (size_t)m * 1024 + col + 4);
            ob[i][0] = *(const f32x4*)(OB + (size_t)m * 1024 + col); ob[i][1] = *(const f32x4*)(OB + (size_t)m * 1024 + col + 4);
            zz[i] = *(const u32x4*)(PROJ + (size_t)m * NPROJ + C_ZA + col); gg[i] = *(const u32x4*)(PROJ + (size_t)m * NPROJ + C_GB + col); }
#pragma unroll
        for (int i = 0; i < 2; ++i) {
            const int col = 8 * (lane + 64 * i);
            float o[8] = {oa[i][0][0], oa[i][0][1], oa[i][0][2], oa[i][0][3], oa[i][1][0], oa[i][1][1], oa[i][1][2], oa[i][1][3]}, z[8]; unpack8(zz[i], z);
            float ss = 0.f;
#pragma unroll
            for (int e = 0; e < 8; ++e) ss += o[e] * o[e];
            ss += __shfl_xor(ss, 1); ss += __shfl_xor(ss, 2); ss += __shfl_xor(ss, 4); ss += __shfl_xor(ss, 8);
            const float rs = 1.0f / sqrtf(ss * (1.0f / 128.0f) + EPS);
#pragma unroll
            for (int e = 0; e < 8; ++e) o[e] = o[e] * rs * wa[i][e] * silu_f(z[e]);
            st_bf8(MIX + (size_t)m * 2048 + col, o);
        }
#pragma unroll
        for (int i = 0; i < 2; ++i) {
            const int col = 8 * (lane + 64 * i);
            float o[8] = {ob[i][0][0], ob[i][0][1], ob[i][0][2], ob[i][0][3], ob[i][1][0], ob[i][1][1], ob[i][1][2], ob[i][1][3]}, g[8]; unpack8(gg[i], g);
            float s_ = 0.f;
#pragma unroll
            for (int e = 0; e < 8; ++e) s_ += o[e];
            s_ += __shfl_xor(s_, 1); s_ += __shfl_xor(s_, 2); s_ += __shfl_xor(s_, 4); s_ += __shfl_xor(s_, 8); s_ += __shfl_xor(s_, 16);
            const float mu = s_ * (1.0f / 256.0f); float q = 0.f;
#pragma unroll
            for (int e = 0; e < 8; ++e) { o[e] -= mu; q += o[e] * o[e]; }
            q += __shfl_xor(q, 1); q += __shfl_xor(q, 2); q += __shfl_xor(q, 4); q += __shfl_xor(q, 8); q += __shfl_xor(q, 16);
            const float rs = 1.0f / sqrtf(q * (1.0f / 256.0f) + EPS);
#pragma unroll
            for (int e = 0; e < 8; ++e) o[e] = (o[e] * rs * wb[i][e] + bb[i][e]) * silu_f(g[e]);
            st_bf8(MIX + (size_t)m * 2048 + 1024 + col, o);
        }
    }
}

__device__ __forceinline__ void ffn_conv_prompt(const Args& a, int layer, int lane, int gw, int NGW) {
    unsigned char* ws = a.ws;
    const bf16* UP = (const bf16*)(ws + WS_BIG); bf16* ACT = (bf16*)(ws + WS_ACT);
    const float* cw = a.in[I_FCW] + (size_t)layer * 3 * NUP; const float* cb = a.in[I_FCBIAS] + (size_t)layer * NUP;
    for (int task = gw; task < 128 * 11; task += NGW) {
        const int run = task / 11, cblk = task % 11, m0 = run * 64, t0 = m0 % SEQ;
        const int j0 = 8 * (lane + 64 * cblk), ucol = ((j0 >> 7) << 8) + (j0 & 127);
        float wv[3][8], wg[3][8], bv_[8], bg_[8]; ld_f8(cb + j0, bv_); ld_f8(cb + DFF + j0, bg_);
#pragma unroll
        for (int jj = 0; jj < 3; ++jj) { ld_f8(cw + (size_t)jj * NUP + j0, wv[jj]); ld_f8(cw + (size_t)jj * NUP + DFF + j0, wg[jj]); }
        float p2v[8], p2g[8], p1v[8], p1g[8];
        if (t0 == 0) {
#pragma unroll
            for (int e = 0; e < 8; ++e) { p2v[e] = 0.f; p2g[e] = 0.f; p1v[e] = 0.f; p1g[e] = 0.f; }
        } else { const bf16* r2 = UP + (size_t)(m0 - 2) * NUP + ucol; ld_bf8(r2, p2v); ld_bf8(r2 + 128, p2g); ld_bf8(r2 + NUP, p1v); ld_bf8(r2 + NUP + 128, p1g); }
        const bf16* rp = UP + (size_t)m0 * NUP + ucol; bf16* op = ACT + (size_t)m0 * DFF + j0;
#pragma unroll 1
        for (int i8 = 0; i8 < 8; ++i8) {
            u32x4 lv[8], lg[8];
#pragma unroll
            for (int k = 0; k < 8; ++k) { lv[k] = *(const u32x4*)(rp + (size_t)k * NUP); lg[k] = *(const u32x4*)(rp + (size_t)k * NUP + 128); }
#pragma unroll
            for (int k = 0; k < 8; ++k) { float xv[8], xg[8], o[8]; unpack8(lv[k], xv); unpack8(lg[k], xg);
#pragma unroll
                for (int e = 0; e < 8; ++e) { const float va = bv_[e] + wv[0][e] * p2v[e] + wv[1][e] * p1v[e] + wv[2][e] * xv[e], ga = bg_[e] + wg[0][e] * p2g[e] + wg[1][e] * p1g[e] + wg[2][e] * xg[e];
                    o[e] = silu_f(ga) * va; p2v[e] = p1v[e]; p2g[e] = p1g[e]; p1v[e] = xv[e]; p1g[e] = xg[e]; }
                st_bf8(op + (size_t)k * DFF, o); }
            rp += (size_t)8 * NUP; op += (size_t)8 * DFF;
        }
    }
}
__device__ __forceinline__ void ffn_conv_sample(const Args& a, int layer, int lane, int gw, int NGW) {
    unsigned char* ws = a.ws;
    const bf16* UP = (const bf16*)(ws + WS_BIG); bf16* ACT = (bf16*)(ws + WS_ACT);
    const float* cw = a.in[I_FCW] + (size_t)layer * 3 * NUP; const float* cb = a.in[I_FCBIAS] + (size_t)layer * NUP; const float* cst = a.in[I_SFCB] + (size_t)layer * DECB * 2 * NUP;
    for (int task = gw; task < MS * 11; task += NGW) {
        const int m = MP + task / 11, i = task % 11;
        const int b = (m - MP) / DECS, t = (m - MP) % DECS;
        {
            const int j0 = 8 * (lane + 64 * i), ucol = ((j0 >> 7) << 8) + (j0 & 127);
            float va[8], ga[8]; ld_f8(cb + j0, va); ld_f8(cb + DFF + j0, ga);
#pragma unroll
            for (int jj = 0; jj < 3; ++jj) { float xv[8], xg[8], sv[8], sg[8], wv[8], wg[8]; const int tt = t + jj; const bool from_state = tt < 2;
                const bf16* r = UP + (size_t)(MP + b * DECS + (tt >= 2 ? tt - 2 : 0)) * NUP + ucol; ld_bf8(r, xv); ld_bf8(r + 128, xg);
                const float* rs_ = cst + ((size_t)b * 2 + (tt < 2 ? tt : 1)) * NUP + j0; ld_f8(rs_, sv); ld_f8(rs_ + DFF, sg);
                ld_f8(cw + (size_t)jj * NUP + j0, wv); ld_f8(cw + (size_t)jj * NUP + DFF + j0, wg);
#pragma unroll
                for (int e = 0; e < 8; ++e) { va[e] += wv[e] * (from_state ? sv[e] : xv[e]); ga[e] += wg[e] * (from_state ? sg[e] : xg[e]); } }
            float o[8];
#pragma unroll
            for (int e = 0; e < 8; ++e) o[e] = silu_f(ga[e]) * va[e];
            st_bf8(ACT + (size_t)m * DFF + j0, o);
        }
    }
    for (int idx = gw * 64 + lane; idx < (4 + DECB) * 2 * NUP; idx += NGW * 64) {
        const int c = idx % NUP, r = (idx / NUP) & 1, sb = idx / (2 * NUP);
        const int j = c < DFF ? c : c - DFF, ucol = ((j >> 7) << 8) + (j & 127) + (c < DFF ? 0 : 128);
        if (sb < 4) a.out[O_FCB_P + ((size_t)(layer * 4 + sb) * 2 + r) * NUP + c] = bf2f(UP[(size_t)(sb * SEQ + SEQ - 2 + r) * NUP + ucol]);
        else { const int b = sb - 4; a.out[O_FCB_S + ((size_t)(layer * DECB + b) * 2 + r) * NUP + c] = bf2f(UP[(size_t)(MP + b * DECS + DECS - 2 + r) * NUP + ucol]); }
    }
}

__device__ __forceinline__ void s5_task(const Args& a, bool prompt, int b, int g, int lane) {
    unsigned char* ws = a.ws;
    const bf16* H = (const bf16*)(ws + WS_H); bf16* G2 = (bf16*)(ws + WS_G2);
    const int p = lane, gp = g * 64 + p;
    const double lr = (double)a.in[I_LRE][gp], li = (double)a.in[I_LIM][gp], dt = exp((double)a.in[I_LDT][g]);
    const double mag = exp(lr * dt); double sn, cs; sincos_d(li * dt, sn, cs);
    const double abr = mag * cs, abi = mag * sn, den = lr * lr + li * li;
    const double cfr = ((abr - 1.0) * lr + abi * li) / den, cfi = (abi * lr - (abr - 1.0) * li) / den;
    float bbr[16], bbi[16], cr[16], ci[16];
#pragma unroll
    for (int c = 0; c < 16; ++c) { const double br = (double)a.in[I_BRE][(size_t)gp * 16 + c], bi = (double)a.in[I_BIM][(size_t)gp * 16 + c]; bbr[c] = (float)(cfr * br - cfi * bi); bbi[c] = (float)(cfr * bi + cfi * br);
        cr[c] = a.in[I_CRE][((size_t)g * 16 + c) * 64 + p]; ci[c] = a.in[I_CIM][((size_t)g * 16 + c) * 64 + p]; }
    const float ar = (float)abr, ai = (float)abi;
    float xr = 0.f, xi = 0.f;
    if (!prompt) { xr = a.in[I_S5RE][((size_t)b * 128 + g) * 64 + p]; xi = a.in[I_S5IM][((size_t)b * 128 + g) * 64 + p]; }
    const bool b5 = lane & 32, b4 = lane & 16, b3 = lane & 8, b2 = lane & 4;
    const int cme = (b5 ? 8 : 0) + (b4 ? 4 : 0) + (b3 ? 2 : 0) + (b2 ? 1 : 0);
    const float dme = a.in[I_S5D][g * 16 + cme];
    const int L = prompt ? SEQ : DECS, row0 = prompt ? b * SEQ : MP + b * DECS;
    const bf16* hp = H + (size_t)row0 * DM + g * 16;
    u32x4 nu0 = *(const u32x4*)hp, nu1 = *(const u32x4*)(hp + 8); unsigned short nume = hp[cme];
    for (int t = 0; t < L; ++t) {
        float u[16]; { float ua[8], ub[8]; unpack8(nu0, ua); unpack8(nu1, ub);
#pragma unroll
            for (int c = 0; c < 8; ++c) { u[c] = ua[c]; u[8 + c] = ub[c]; } }
        const float ume = bf2f(nume);
        if (t + 1 < L) { hp += DM; nu0 = *(const u32x4*)hp; nu1 = *(const u32x4*)(hp + 8); nume = hp[cme]; }
        float bur = 0.f, bui = 0.f;
#pragma unroll
        for (int c = 0; c < 16; ++c) { bur += bbr[c] * u[c]; bui += bbi[c] * u[c]; }
        const float nxr = ar * xr - ai * xi + bur, nxi = ar * xi + ai * xr + bui; xr = nxr; xi = nxi;
        float vals[16];
#pragma unroll
        for (int c = 0; c < 16; ++c) vals[c] = cr[c] * xr - ci[c] * xi;
        float k8[8], k4[4], k2[2], y;
#pragma unroll
        for (int i = 0; i < 8; ++i) { const float send = b5 ? vals[i] : vals[8 + i], keep = b5 ? vals[8 + i] : vals[i]; k8[i] = keep + __shfl_xor(send, 32); }
#pragma unroll
        for (int i = 0; i < 4; ++i) { const float send = b4 ? k8[i] : k8[4 + i], keep = b4 ? k8[4 + i] : k8[i]; k4[i] = keep + __shfl_xor(send, 16); }
#pragma unroll
        for (int i = 0; i < 2; ++i) { const float send = b3 ? k4[i] : k4[2 + i], keep = b3 ? k4[2 + i] : k4[i]; k2[i] = keep + __shfl_xor(send, 8); }
        { const float send = b2 ? k2[0] : k2[1], keep = b2 ? k2[1] : k2[0]; y = keep + __shfl_xor(send, 4); }
        y += __shfl_xor(y, 2); y += __shfl_xor(y, 1);
        y = gelu_tanh(y + dme * ume);
        if ((lane & 3) == 0) G2[(size_t)(row0 + t) * DM + g * 16 + cme] = (bf16)f2bf(y);
    }
    const size_t so = ((size_t)b * 128 + g) * 64 + p;
    a.out[(prompt ? O_S5R_P : O_S5R_S) + so] = xr; a.out[(prompt ? O_S5I_P : O_S5I_S) + so] = xi;
}
__device__ __forceinline__ bf16x8 pack8(const float (&v)[8]) { u32x4 w; w.x = cvtpk(v[0], v[1]); w.y = cvtpk(v[2], v[3]); w.z = cvtpk(v[4], v[5]); w.w = cvtpk(v[6], v[7]); return __builtin_bit_cast(bf16x8, w); }
__device__ __forceinline__ float bfround(float x) { return __builtin_bit_cast(float, f2bf(x) << 16); }
constexpr int S5_PITCH = 132, S5_WAVE_LDS = 16 * S5_PITCH * 4;
constexpr int S5_SEG = 128, S5_NSEG = SEQ / S5_SEG;
constexpr size_t WS_S5E = WS_ACT;
struct S5C {
    bf16x8 Bf[8];
    bf16x8 Ch[4], Cl[4], Df;
    float nwa[8];
    float ar, ai;
};
__device__ __forceinline__ void s5_first(const bf16* H, const float* SS, int g, int row0, int lane, u32x4& An, float& sn_) {
    const int r = lane & 15, q = lane >> 4, rlast = MTOT - 1 - row0, rr = r < rlast ? r : rlast;
    An = *(const u32x4*)(H + (size_t)(row0 + rr) * DM + g * 16 + 8 * (q & 1)); sn_ = SS[row0 + rr];
}
template <bool FULL>
__device__ __forceinline__ void s5_run(const S5C& C, const bf16* H, const float* SS, bf16* G2, LAS float* T, int g, int row0, int L, float& xr, float& xi, int lane, u32x4 An, float sn_) {
    const int r = lane & 15, q = lane >> 4;
    const bf16* hp = H + (size_t)row0 * DM + g * 16 + 8 * (q & 1);
    for (int t0 = 0; t0 < L; t0 += 16) {
        bf16x8 A; { float xa[8]; unpack8(An, xa); const float rs = 1.0f / sqrtf(sn_ * (1.0f / DM) + EPS);
#pragma unroll
            for (int j = 0; j < 8; ++j) xa[j] = xa[j] * rs * C.nwa[j];
            A = pack8(xa); }
        if (t0 + 16 < L) { An = *(const u32x4*)(hp + (size_t)(t0 + 16 + r) * DM); sn_ = SS[row0 + t0 + 16 + r]; }
#pragma unroll
        for (int nt = 0; nt < 8; ++nt) { const f32x4 d = MFMA16(A, C.Bf[nt], ((f32x4){0.f, 0.f, 0.f, 0.f}));
#pragma unroll
            for (int reg = 0; reg < 4; ++reg) T[(4 * q + reg) * S5_PITCH + 16 * nt + r] = d[reg]; }
        float bur[16], bui[16];
#pragma unroll
        for (int t = 0; t < 16; ++t) { bur[t] = T[t * S5_PITCH + lane]; bui[t] = T[t * S5_PITCH + 64 + lane]; }
#pragma unroll
        for (int t = 0; t < 16; ++t) { if (t0 + t < L) { const float nr = C.ar * xr - C.ai * xi + bur[t], ni = C.ar * xi + C.ai * xr + bui[t]; xr = nr; xi = ni; } bur[t] = xr; bui[t] = xi; }
        if (FULL) {
#pragma unroll
            for (int t = 0; t < 16; ++t) { T[t * S5_PITCH + lane] = bur[t]; T[t * S5_PITCH + 64 + lane] = bui[t]; }
            f32x4 y = MFMA16(A, C.Df, ((f32x4){0.f, 0.f, 0.f, 0.f}));
#pragma unroll
            for (int s = 0; s < 4; ++s) { const f32x4 x0 = *(const LAS f32x4*)(T + r * S5_PITCH + 32 * s + 8 * q), x1 = *(const LAS f32x4*)(T + r * S5_PITCH + 32 * s + 8 * q + 4);
                u32x4 wh; wh[0] = cvtpk(x0[0], x0[1]); wh[1] = cvtpk(x0[2], x0[3]); wh[2] = cvtpk(x1[0], x1[1]); wh[3] = cvtpk(x1[2], x1[3]);
                const bf16x8 xh = __builtin_bit_cast(bf16x8, wh);
                y = MFMA16(xh, C.Ch[s], y); y = MFMA16(xh, C.Cl[s], y); }
#pragma unroll
            for (int reg = 0; reg < 4; ++reg) { const int t = t0 + 4 * q + reg; if (t < L) G2[(size_t)(row0 + t) * DM + g * 16 + r] = (bf16)f2bf(gelu_tanh(y[reg])); }
        }
    }
}
__device__ __forceinline__ void s5_wave(const Args& a, LAS float* T, bool second, int g, int sub, int lane) {
    unsigned char* ws = a.ws;
    const bf16* H = (const bf16*)(ws + WS_H); bf16* G2 = (bf16*)(ws + WS_G2); const float* SS = (const float*)(ws + WS_SS) + MTOT;
    float* E = (float*)(ws + WS_S5E);
    const int r = lane & 15, q = lane >> 4;
    S5C C;
    float cfrf, cfif, a128r, a128i;
    {   const int gp = g * 64 + lane;
        const double lr = (double)a.in[I_LRE][gp], li = (double)a.in[I_LIM][gp], dt = exp((double)a.in[I_LDT][g]);
        const double mag = exp(lr * dt); double sn, cs; sincos_d(li * dt, sn, cs);
        const double abr = mag * cs, abi = mag * sn, den = lr * lr + li * li;
        C.ar = (float)abr; C.ai = (float)abi; cfrf = (float)(((abr - 1.0) * lr + abi * li) / den); cfif = (float)((abi * lr - (abr - 1.0) * li) / den);
        const double m128 = exp(lr * dt * (double)S5_SEG); sincos_d(li * dt * (double)S5_SEG, sn, cs); a128r = (float)(m128 * cs); a128i = (float)(m128 * sn); }
    ld_f8(a.in[I_NMIX] + DM + g * 16 + 8 * (q & 1), C.nwa);
#pragma unroll
    for (int nt = 0; nt < 8; ++nt) { const int p = (16 * nt + r) & 63; const float cr_ = __shfl(cfrf, p), ci_ = __shfl(cfif, p);
        float br[8], bi[8], v[8]; ld_f8(a.in[I_BRE] + ((size_t)g * 64 + p) * 16 + 8 * (q & 1), br); ld_f8(a.in[I_BIM] + ((size_t)g * 64 + p) * 16 + 8 * (q & 1), bi);
#pragma unroll
        for (int j = 0; j < 8; ++j) { const float val = (nt < 4) ? (cr_ * br[j] - ci_ * bi[j]) : (cr_ * bi[j] + ci_ * br[j]); const float hi = bfround(val); v[j] = (q < 2) ? hi : (val - hi); }
        C.Bf[nt] = pack8(v); }
#pragma unroll
    for (int s = 0; s < 4; ++s) { float cv[8], hi[8], lo[8]; ld_f8((s < 2 ? a.in[I_CRE] : a.in[I_CIM]) + ((size_t)g * 16 + r) * 64 + 32 * (s & 1) + 8 * q, cv);
#pragma unroll
        for (int j = 0; j < 8; ++j) { const float val = (s < 2) ? cv[j] : -cv[j]; hi[j] = bfround(val); lo[j] = val - hi[j]; }
        C.Ch[s] = pack8(hi); C.Cl[s] = pack8(lo); }
    {   const float dv = a.in[I_S5D][g * 16 + r], dh = bfround(dv), dl = dv - dh; float v[8];
#pragma unroll
        for (int j = 0; j < 8; ++j) v[j] = ((r & 7) == j && (r >> 3) == (q & 1)) ? (q < 2 ? dh : dl) : 0.f;
        C.Df = pack8(v); }
    const int NT = second ? 4 : 12;
    u32x4 Ap; float sp_, xpr = 0.f, xpi = 0.f;
    s5_first(H, SS, g, sub * S5_SEG, lane, Ap, sp_);
#pragma unroll 1
    for (int ti = 0; ti < NT; ++ti) {
        const u32x4 Ac = Ap; const float sc_ = sp_, xcr = xpr, xci = xpi;
        if (ti + 1 < NT) { const int tn = ti + 1;
            if (tn < 4) s5_first(H, SS, g, tn * SEQ + sub * S5_SEG, lane, Ap, sp_);
            else { const int bn = sub * 8 + (tn - 4); s5_first(H, SS, g, MP + bn * DECS, lane, Ap, sp_); const size_t so = ((size_t)bn * 128 + g) * 64 + lane; xpr = a.in[I_S5RE][so]; xpi = a.in[I_S5IM][so]; } }
        if (ti < 4) { const int b = ti, row0 = b * SEQ + sub * S5_SEG; float* Eb = E + (((size_t)b * 128 + g) * S5_NSEG) * 128;
            if (!second) { float xr = 0.f, xi = 0.f; s5_run<false>(C, H, SS, G2, T, g, row0, S5_SEG, xr, xi, lane, Ac, sc_); Eb[sub * 128 + lane] = xr; Eb[sub * 128 + 64 + lane] = xi; }
            else { float er[15], ei[15];
#pragma unroll
                for (int m = 0; m < 15; ++m) { const int mm = m < sub ? m : 0; er[m] = Eb[mm * 128 + lane]; ei[m] = Eb[mm * 128 + 64 + lane]; }
                float xr = 0.f, xi = 0.f;
#pragma unroll
                for (int m = 0; m < 15; ++m) if (m < sub) { const float nr = a128r * xr - a128i * xi + er[m], ni = a128r * xi + a128i * xr + ei[m]; xr = nr; xi = ni; }
                s5_run<true>(C, H, SS, G2, T, g, row0, S5_SEG, xr, xi, lane, Ac, sc_);
                if (sub == S5_NSEG - 1) { const size_t so = ((size_t)b * 128 + g) * 64 + lane; a.out[O_S5R_P + so] = xr; a.out[O_S5I_P + so] = xi; } }
        } else { const int b = sub * 8 + (ti - 4); const size_t so = ((size_t)b * 128 + g) * 64 + lane;
            float xr = xcr, xi = xci;
            s5_run<true>(C, H, SS, G2, T, g, MP + b * DECS, DECS, xr, xi, lane, Ac, sc_);
            a.out[O_S5R_S + so] = xr; a.out[O_S5I_S + so] = xi; }
    }
}
__device__ __forceinline__ void ph_s5(const Args& a, LAS unsigned char* lds, bool second, int lane, int wave, int gw, int NGW) {
    LAS float* T = (LAS float*)(lds + wave * S5_WAVE_LDS);
    for (int w = gw; w < 2048; w += NGW) s5_wave(a, T, second, w >> 4, w & 15, lane);
}

constexpr int S5MM_REP = 0;
constexpr int SM_WC = 0, SM_WST = 65536, SM_KT = 131072, SM_POW = 139264, SM_CF = 147968;
constexpr size_t WS_S5L = WS_ACT, WS_S5X = WS_ACT + 48 * MiB, WS_UG = WS_BIG + 64 * MiB;
typedef float f32x2_t __attribute__((ext_vector_type(2)));
__device__ __forceinline__ int s5_row(int hb, int col, int t) {
    return col < 256 ? (2 * hb + (col >> 7)) * SEQ + 16 * (col & 127) + t : MP + (64 * hb + (col - 256)) * DECS + t;
}
__device__ __forceinline__ void s5_load_u(const Args& a, int g, int hb, int cb, int lane, bf16x8 (&Uf)[8]) {
    const bf16* UG = (const bf16*)(a.ws + WS_UG0);
    const int r = lane & 15, q = lane >> 4, col = 16 * cb + r; const bool samp = col >= 256;
    const bf16* up = UG + ((size_t)g * MTOT + s5_row(hb, col, 0)) * 16 + 16 * (q >> 1) + 8 * (q & 1);
#pragma unroll
    for (int ks = 0; ks < 8; ++ks) { Uf[ks] = *(const bf16x8*)(up + ((samp && ks >= 4) ? 0 : 32 * ks)); if (samp && ks >= 4) Uf[ks] = (bf16x8){0, 0, 0, 0, 0, 0, 0, 0}; }
}
__device__ __forceinline__ void ph_s5_mm(const Args& a, LAS unsigned char* lds, int task, int tid, int lane, int wave) {
    unsigned char* ws = a.ws;
    const int g = task >> 1, hb = task & 1, r = lane & 15, q = lane >> 4;
    LAS f32x2_t* POW = (LAS f32x2_t*)(lds + SM_POW); LAS f32x2_t* CF = (LAS f32x2_t*)(lds + SM_CF);
    float* LB = (float*)(ws + WS_S5L) + (size_t)task * 320 * 128; float* XB = (float*)(ws + WS_S5X) + (size_t)task * 320 * 128;
    bf16* G2 = (bf16*)(ws + WS_G2);
    for (int rep_t = 0; rep_t < (S5MM_REP == 1 ? 2 : 1); ++rep_t) {
    __syncthreads();
    if (tid < 64) { const int gp = g * 64 + tid;
        const double lr = (double)a.in[I_LRE][gp], li = (double)a.in[I_LIM][gp], dt = exp((double)a.in[I_LDT][g]);
        const double mag = exp(lr * dt); double sn, cs; sincos_d(li * dt, sn, cs);
        const double abr = mag * cs, abi = mag * sn, den = lr * lr + li * li;
        CF[tid] = (f32x2_t){(float)(((abr - 1.0) * lr + abi * li) / den), (float)((abi * lr - (abr - 1.0) * li) / den)};
        double pr = 1.0, pi = 0.0;
#pragma unroll 1
        for (int e = 0; e <= 16; ++e) { POW[tid * 17 + e] = (f32x2_t){(float)pr, (float)pi}; const double nr = pr * abr - pi * abi, ni = pr * abi + pi * abr; pr = nr; pi = ni; } }
    __syncthreads();
    {
        const int kp = tid & 127, p = kp & 63, part = kp >> 6, s0 = 4 * (tid >> 7);
        const f32x2_t cf = CF[p]; float bbr[16], bbi[16];
#pragma unroll
        for (int c4 = 0; c4 < 4; ++c4) { const f32x4 br = *(const f32x4*)(a.in[I_BRE] + ((size_t)g * 64 + p) * 16 + 4 * c4), bi = *(const f32x4*)(a.in[I_BIM] + ((size_t)g * 64 + p) * 16 + 4 * c4);
#pragma unroll
            for (int j = 0; j < 4; ++j) { bbr[4 * c4 + j] = cf.x * br[j] - cf.y * bi[j]; bbi[4 * c4 + j] = cf.x * bi[j] + cf.y * br[j]; } }
#pragma unroll
        for (int si = 0; si < 4; ++si) { const int s = s0 + si; const f32x2_t pw = POW[p * 17 + 15 - s]; float v[16];
#pragma unroll
            for (int c = 0; c < 16; ++c) v[c] = part ? (pw.x * bbi[c] + pw.y * bbr[c]) : (pw.x * bbr[c] - pw.y * bbi[c]);
            u32x4 w0, w1; w0.x = pk2(v[0], v[1]); w0.y = pk2(v[2], v[3]); w0.z = pk2(v[4], v[5]); w0.w = pk2(v[6], v[7]); w1.x = pk2(v[8], v[9]); w1.y = pk2(v[10], v[11]); w1.z = pk2(v[12], v[13]); w1.w = pk2(v[14], v[15]);
            *(LAS u32x4*)(lds + SM_WST + kp * 512 + (((2 * s) ^ (kp & 15)) << 4)) = w0; *(LAS u32x4*)(lds + SM_WST + kp * 512 + (((2 * s + 1) ^ (kp & 15)) << 4)) = w1; }
    }
    {
        const int R = tid & 255, t = R >> 4, c = R & 15, half = tid >> 8;
#pragma unroll 4
        for (int i = 0; i < 8; ++i) { float v[8]; const f32x4 cr0 = *(const f32x4*)(a.in[I_CRE] + ((size_t)g * 16 + c) * 64 + 8 * i), cr1 = *(const f32x4*)(a.in[I_CRE] + ((size_t)g * 16 + c) * 64 + 8 * i + 4),
                                                         ci0 = *(const f32x4*)(a.in[I_CIM] + ((size_t)g * 16 + c) * 64 + 8 * i), ci1 = *(const f32x4*)(a.in[I_CIM] + ((size_t)g * 16 + c) * 64 + 8 * i + 4);
#pragma unroll
            for (int j = 0; j < 8; ++j) { const float cr = j < 4 ? cr0[j] : cr1[j - 4], ci = j < 4 ? ci0[j] : ci1[j - 4]; const f32x2_t pw = POW[(8 * i + j) * 17 + t + 1];
                v[j] = half ? -(cr * pw.y + ci * pw.x) : (cr * pw.x - ci * pw.y); }
            u32x4 w; w.x = pk2(v[0], v[1]); w.y = pk2(v[2], v[3]); w.z = pk2(v[4], v[5]); w.w = pk2(v[6], v[7]);
            *(LAS u32x4*)(lds + SM_WC + addr256(R, 8 * half + i)) = w; }
    }
    __syncthreads();
    {
        bf16x8 Bs[4];
        {   float re8[2][8], im8[2][8];
#pragma unroll
            for (int ks = 0; ks < 2; ++ks)
#pragma unroll
                for (int j = 0; j < 8; ++j) { const int p = 32 * ks + 8 * q + j; const float br = a.in[I_BRE][((size_t)g * 64 + p) * 16 + r], bi = a.in[I_BIM][((size_t)g * 64 + p) * 16 + r]; const f32x2_t cf = CF[p];
                    re8[ks][j] = cf.x * br - cf.y * bi; im8[ks][j] = cf.x * bi + cf.y * br; }
            Bs[0] = pack8(re8[0]); Bs[1] = pack8(re8[1]); Bs[2] = pack8(im8[0]); Bs[3] = pack8(im8[1]); }
#pragma unroll
        for (int di = 0; di < 2; ++di) { const int d = 2 * wave + di; f32x4 acc = {0.f, 0.f, 0.f, 0.f};
            if (d == 0) {
#pragma unroll
                for (int ks = 0; ks < 4; ++ks) { float cv[8]; ld_f8((ks < 2 ? a.in[I_CRE] : a.in[I_CIM]) + ((size_t)g * 16 + r) * 64 + 32 * (ks & 1) + 8 * q, cv);
                    if (ks >= 2) {
#pragma unroll
                        for (int j = 0; j < 8; ++j) cv[j] = -cv[j]; }
                    acc = MFMA16(pack8(cv), Bs[ks], acc); }
#pragma unroll
                for (int reg = 0; reg < 4; ++reg) if (4 * q + reg == r) acc[reg] += a.in[I_S5D][g * 16 + r];
            } else {
#pragma unroll
                for (int ks = 0; ks < 4; ++ks) acc = MFMA16(*(const LAS bf16x8*)(lds + SM_WC + addr256(16 * (d - 1) + r, 4 * ks + q)), Bs[ks], acc); }
#pragma unroll
            for (int reg = 0; reg < 4; ++reg) *(LAS bf16*)(lds + SM_KT + ((d * 16 + 4 * q + reg) * 16 + r) * 2) = (bf16)f2bf(acc[reg]); }
    }
    __syncthreads();
    }
    for (int rep_1 = 0; rep_1 < (S5MM_REP == 2 ? 2 : 1); ++rep_1) {
    for (int cb = wave; cb < 20; cb += NWAVES) {
        bf16x8 Uf[8]; s5_load_u(a, g, hb, cb, lane, Uf);
        bf16x8 Fa[8], Fb[8];
#define LDW(F, mt_) do { _Pragma("unroll") for (int ks = 0; ks < 8; ++ks) { const int row = 16 * (mt_) + r; F[ks] = *(const LAS bf16x8*)(lds + SM_WST + row * 512 + (((4 * ks + q) ^ (row & 15)) << 4)); } } while (0)
#define MMW(F, mt_) do { f32x4 acc = {0.f, 0.f, 0.f, 0.f}; _Pragma("unroll") for (int ks = 0; ks < 8; ++ks) acc = MFMA16(F[ks], Uf[ks], acc); *(f32x4*)(LB + (size_t)(16 * cb + r) * 128 + 16 * (mt_) + 4 * q) = acc; } while (0)
        LDW(Fa, 0);
#pragma unroll
        for (int m2 = 0; m2 < 4; ++m2) { LDW(Fb, 2 * m2 + 1); __builtin_amdgcn_sched_barrier(0); MMW(Fa, 2 * m2); __builtin_amdgcn_sched_barrier(0);
            if (m2 < 3) LDW(Fa, 2 * m2 + 2); __builtin_amdgcn_sched_barrier(0); MMW(Fb, 2 * m2 + 1); __builtin_amdgcn_sched_barrier(0); }
#undef LDW
#undef MMW
    }
    __syncthreads();
    }
    for (int rep_2 = 0; rep_2 < (S5MM_REP == 3 ? 2 : 1); ++rep_2) {
    if (wave < 2) {
        const int b = 2 * hb + wave; const f32x2_t a16 = POW[lane * 17 + 16]; float xr = 0.f, xi = 0.f;
        const float* lp = LB + (size_t)(wave * 128) * 128; float* xp = XB + (size_t)(wave * 128) * 128;
        float lr_[8], li_[8], nr_[8], ni_[8];
#pragma unroll
        for (int k = 0; k < 8; ++k) { lr_[k] = lp[(size_t)k * 128 + lane]; li_[k] = lp[(size_t)k * 128 + 64 + lane]; }
#pragma unroll 1
        for (int n0 = 0; n0 < 128; n0 += 8) {
            const int nn = n0 + 8 < 128 ? n0 + 8 : n0;
#pragma unroll
            for (int k = 0; k < 8; ++k) { nr_[k] = lp[(size_t)(nn + k) * 128 + lane]; ni_[k] = lp[(size_t)(nn + k) * 128 + 64 + lane]; }
#pragma unroll
            for (int k = 0; k < 8; ++k) { xp[(size_t)(n0 + k) * 128 + lane] = xr; xp[(size_t)(n0 + k) * 128 + 64 + lane] = xi;
                const float nr = a16.x * xr - a16.y * xi + lr_[k], ni = a16.x * xi + a16.y * xr + li_[k]; xr = nr; xi = ni; }
#pragma unroll
            for (int k = 0; k < 8; ++k) { lr_[k] = nr_[k]; li_[k] = ni_[k]; } }
        const size_t so = ((size_t)b * 128 + g) * 64 + lane; a.out[O_S5R_P + so] = xr; a.out[O_S5I_P + so] = xi;
    } else if (wave < 6) {
        const f32x2_t a16 = POW[lane * 17 + 16], a8 = POW[lane * 17 + 8]; const float inv = 1.0f / (a8.x * a8.x + a8.y * a8.y), i8r = a8.x * inv, i8i = -a8.y * inv;
#pragma unroll 1
        for (int j = 0; j < 16; ++j) { const int sc = 16 * (wave - 2) + j, col = 256 + sc, bs = 64 * hb + sc; const size_t so = ((size_t)bs * 128 + g) * 64 + lane;
            const float xr = a.in[I_S5RE][so], xi = a.in[I_S5IM][so]; XB[(size_t)col * 128 + lane] = xr; XB[(size_t)col * 128 + 64 + lane] = xi;
            const float zr = a16.x * xr - a16.y * xi + LB[(size_t)col * 128 + lane], zi = a16.x * xi + a16.y * xr + LB[(size_t)col * 128 + 64 + lane];
            a.out[O_S5R_S + so] = zr * i8r - zi * i8i; a.out[O_S5I_S + so] = zr * i8i + zi * i8r; }
    }
    __syncthreads();
    }
    for (int rep_3 = 0; rep_3 < (S5MM_REP == 4 ? 2 : 1); ++rep_3) {
    for (int cb = wave; cb < 20; cb += NWAVES) {
        bf16x8 Uf[8], Xf[4]; s5_load_u(a, g, hb, cb, lane, Uf);
        const int col = 16 * cb + r; const bool samp = col >= 256;
#pragma unroll
        for (int ks = 0; ks < 4; ++ks) { float x[8]; ld_f8(XB + (size_t)col * 128 + 32 * ks + 8 * q, x); Xf[ks] = pack8(x); }
#pragma unroll
        for (int t = 0; t < 16; ++t) { f32x4 acc = {0.f, 0.f, 0.f, 0.f};
            bf16x8 Fk[8], Fw[4];
#pragma unroll
            for (int ks = 0; ks <= t / 2; ++ks) { const int d = t - 2 * ks - (q >> 1);
                Fk[ks] = *(const LAS bf16x8*)(lds + SM_KT + (((d < 0 ? 0 : d) * 16 + r) * 16 + 8 * (q & 1)) * 2); if (d < 0) Fk[ks] = (bf16x8){0, 0, 0, 0, 0, 0, 0, 0}; }
#pragma unroll
            for (int ks = 0; ks < 4; ++ks) Fw[ks] = *(const LAS bf16x8*)(lds + SM_WC + addr256(16 * t + r, 4 * ks + q));
            __builtin_amdgcn_sched_barrier(0);
#pragma unroll
            for (int ks = 0; ks <= t / 2; ++ks) acc = MFMA16(Fk[ks], Uf[ks], acc);
#pragma unroll
            for (int ks = 0; ks < 4; ++ks) acc = MFMA16(Fw[ks], Xf[ks], acc);
            if (!samp || t < 8) { u32x2 o; o.x = cvtpk(gelu_tanh_fast(acc[0]), gelu_tanh_fast(acc[1])); o.y = cvtpk(gelu_tanh_fast(acc[2]), gelu_tanh_fast(acc[3]));
                *(u32x2*)(G2 + (size_t)s5_row(hb, col, t) * DM + g * 16 + 4 * q) = o; }
            asm volatile("" ::: "memory"); }
    }
    }
}

constexpr int N_PHASES = 21;
constexpr unsigned DUPMASK = 0u;
constexpr int P3PROBE = 0;
__global__ void __launch_bounds__(NTHR, 2) fwd_kernel(Args a) {
    extern __shared__ __attribute__((aligned(16))) unsigned char lds_raw[];
    LAS unsigned char* lds = (LAS unsigned char*)lds_raw;
    const int tid = threadIdx.x, lane = tid & 63, wave = __builtin_amdgcn_readfirstlane(tid >> 6);
    constexpr int G = 256;
    const int gw = blockIdx.x * NWAVES + wave, NGW = G * NWAVES;
    unsigned char* ws = a.ws;
    const int lo = a.ph_lo, hi = a.ph_hi;
    volatile LAS unsigned* MISC = (volatile LAS unsigned*)(lds + MISC_OFF);
    if (tid < 64) MISC[tid] = 0u;
    __syncthreads();
    XcdBarrier bar = xcd_barrier_post((unsigned*)(ws + WS_CTL) + CW_BAR, MISC + 8);
#define IN(k) (lo <= (k) && (k) < hi)
#define SEAM(k) do { if (IN(k) && IN((k) + 1)) xcd_barrier(bar); } while (0)
#define PHASE(k, ...) if (IN(k)) { __VA_ARGS__ if ((DUPMASK >> (k)) & 1u) { xcd_barrier(bar); __VA_ARGS__ } } SEAM(k);
#define GEMM_PHASE(EPI, Aop, Bop, N_, K_, E_) do { pg8::Gemm g{(const pg8::bf16_t*)(Aop), (const pg8::bf16_t*)(Bop), MTOT, (N_), (K_), (K_)}; pg8::StaticOrder S; S.init(MTOT, (N_), G, (int)blockIdx.x); \
        pg8::gemm_phase<EPI, pg8::StaticOrder, true, true>(lds, g, S, E_); } while (0)
#define SS ((float*)(ws + WS_SS))
#define X ((float*)(ws + WS_X))
#define H ((bf16*)(ws + WS_H))
#define G2 ((bf16*)(ws + WS_G2))
#define BIG ((bf16*)(ws + WS_BIG))
#define ACT ((bf16*)(ws + WS_ACT))

    PHASE(0, ph_prologue(a, lds, tid, lane, wave, gw, NGW, G);)
    PHASE(1, pg8::EpiBf16Plain E{BIG, NPROJ}; GEMM_PHASE(pg8::EpiBf16Plain, H, ws + WS_WIN, NPROJ, 2048, E);)
    PHASE(2, ph_mix_prep(a, lds, tid, lane, wave, gw, NGW, G);)
    if (IN(3)) { ph_scans(a, lds, tid, lane, wave, G); if (P3PROBE) { xcd_barrier(bar); ph_scans(a, lds, tid, lane, wave, G, P3PROBE); } } SEAM(3);
    PHASE(4, ph_mix_norm(a, lane, gw, NGW);)
    PHASE(5, pg8::EpiResNorm E{X, H, SS, DM, a.in[I_XP], a.in[I_XS]}; GEMM_PHASE(pg8::EpiResNorm, G2, ws + WS_WOUT, 2048, 2048, E);
             if (G == 256 && blockIdx.x >= 32) convert_group(a, 3, (LAS float*)(lds + wave * 8704), lane, ((int)blockIdx.x - 32) * NWAVES + wave, 224 * NWAVES);)
    PHASE(7, if (G == 256) { pg8::EpiBf16Rstd E{BIG, NUP, SS};
                    if (((int)blockIdx.x & 7) < 4) { convert_group(a, 2, (LAS float*)(lds + wave * 8704), lane, (int)blockIdx.x * NWAVES + wave, 256 * NWAVES); __syncthreads(); }
                    { const int L = (int)blockIdx.x - 128; pg8::Gemm g{(const pg8::bf16_t*)H, (const pg8::bf16_t*)(ws + WS_WUP), MTOT, NUP, 2048, 2048}; pg8::PlusOne S; S.init(MP, NUP, G, (int)blockIdx.x); S.extra = pg8::Unit{32 + (L & 3), L >> 2}; S.has_extra = L >= 0;
                      pg8::gemm_phase<pg8::EpiBf16Rstd, pg8::PlusOne, true, true>(lds, g, S, E); }
                    if (((int)blockIdx.x & 7) >= 4) convert_group(a, 2, (LAS float*)(lds + wave * 8704), lane, (int)blockIdx.x * NWAVES + wave, 256 * NWAVES); }
                  else { pg8::EpiBf16Rstd E{BIG, NUP, SS}; GEMM_PHASE(pg8::EpiBf16Rstd, H, ws + WS_WUP, NUP, 2048, E); })
    PHASE(18, if (G == 256) { if (blockIdx.x < 48) { pg8::EpiBf16Rstd E{BIG, NUP, SS};
                        const int L = 128 + (int)blockIdx.x; pg8::Gemm g{(const pg8::bf16_t*)H, (const pg8::bf16_t*)(ws + WS_WUP), MTOT, NUP, 2048, 2048}; pg8::OneUnit S{{32 + (L & 3), L >> 2}, true}; pg8::gemm_phase<pg8::EpiBf16Rstd, pg8::OneUnit, true, true>(lds, g, S, E); }
                      else ffn_conv_prompt(a, 0, lane, ((int)blockIdx.x - 48) * NWAVES + wave, 208 * NWAVES); }
                  else ffn_conv_prompt(a, 0, lane, gw, NGW);)
    PHASE(8, ffn_conv_sample(a, 0, lane, gw, NGW);)
    PHASE(9, { pg8::EpiResNorm E{X, H, SS + MTOT, DM, X, X + (size_t)8192 * DM};
                 pg8::Gemm g{(const pg8::bf16_t*)ACT, (const pg8::bf16_t*)(ws + WS_WDN), MP, 2048, DFF, DFF}; pg8::StaticOrder S; S.init(MP, 2048, G, (int)blockIdx.x);
                 pg8::gemm_phase<pg8::EpiResNorm, pg8::StaticOrder, true, true>(lds, g, S, E); }
               { const int p = (int)blockIdx.x, kq = p & 3, un = p >> 2;
                 pg8::EpiSlab E{(float*)BIG + (size_t)kq * MS * DM, DM};
                 pg8::Gemm g{(const pg8::bf16_t*)ACT + kq * 1408, (const pg8::bf16_t*)(ws + WS_WDN) + kq * 1408, MTOT, 2048, 1408, DFF};
                 pg8::OneUnit S{{32 + (un & 3), un >> 2}, p < 128};
                 pg8::gemm_phase<pg8::EpiSlab, pg8::OneUnit, true, true>(lds, g, S, E); }
               )
    PHASE(10, ph_combine<false>(X, H, SS + MTOT, (const float*)BIG, lane, gw, NGW, (bf16*)(ws + WS_UG0), a.in[I_NMIX] + DM);
              ph_ug_prompt(H, SS + MTOT, a.in[I_NMIX] + DM, (bf16*)(ws + WS_UG0), lane, gw, NGW);)
    PHASE(11, if (G == 256) ph_s5_mm(a, lds, (int)blockIdx.x, tid, lane, wave); else { for (int task = (int)blockIdx.x; task < 256; task += G) ph_s5_mm(a, lds, task, tid, lane, wave); })
    PHASE(12, { pg8::EpiGluRes E{X, H, SS + 2 * MTOT, DM};
                  pg8::Gemm g{(const pg8::bf16_t*)G2, (const pg8::bf16_t*)(ws + WS_WGLU), MP, NGLU, 2048, 2048}; pg8::StaticOrder S; S.init(MP, NGLU, G, (int)blockIdx.x);
                  pg8::gemm_phase<pg8::EpiGluRes, pg8::StaticOrder, true, true>(lds, g, S, E); }
                { const int p = (int)blockIdx.x, kq = p & 3, un = p >> 2;
                  pg8::EpiSlab E{(float*)BIG + (size_t)kq * MS * NGLU, NGLU};
                  pg8::Gemm g{(const pg8::bf16_t*)G2 + kq * 512, (const pg8::bf16_t*)(ws + WS_WGLU) + kq * 512, MTOT, NGLU, 512, 2048};
                  pg8::OneUnit S{{32 + (un & 3), un >> 2}, true};
                  pg8::gemm_phase<pg8::EpiSlab, pg8::OneUnit, true, true>(lds, g, S, E); })
    PHASE(13, ph_combine<true>(X, H, SS + 2 * MTOT, (const float*)BIG, lane, gw, NGW);)
    PHASE(14, if (G == 256) { pg8::EpiBf16Rstd E{BIG, NUP, SS + 2 * MTOT};
                    { const int L = (int)blockIdx.x - 128; pg8::Gemm g{(const pg8::bf16_t*)H, (const pg8::bf16_t*)(ws + WS_WUP + (size_t)NUP * 2048 * 2), MTOT, NUP, 2048, 2048}; pg8::PlusOne S; S.init(MP, NUP, G, (int)blockIdx.x); S.extra = pg8::Unit{32 + (L & 3), L >> 2}; S.has_extra = L >= 0;
                      pg8::gemm_phase<pg8::EpiBf16Rstd, pg8::PlusOne, true, true>(lds, g, S, E); } }
                  else { pg8::EpiBf16Rstd E{BIG, NUP, SS + 2 * MTOT}; GEMM_PHASE(pg8::EpiBf16Rstd, H, ws + WS_WUP + (size_t)NUP * 2048 * 2, NUP, 2048, E); })
    PHASE(19, if (G == 256) { if (blockIdx.x < 48) { pg8::EpiBf16Rstd E{BIG, NUP, SS + 2 * MTOT};
                        const int L = 128 + (int)blockIdx.x; pg8::Gemm g{(const pg8::bf16_t*)H, (const pg8::bf16_t*)(ws + WS_WUP + (size_t)NUP * 2048 * 2), MTOT, NUP, 2048, 2048}; pg8::OneUnit S{{32 + (L & 3), L >> 2}, true}; pg8::gemm_phase<pg8::EpiBf16Rstd, pg8::OneUnit, true, true>(lds, g, S, E); }
                      else ffn_conv_prompt(a, 1, lane, ((int)blockIdx.x - 48) * NWAVES + wave, 208 * NWAVES); }
                  else ffn_conv_prompt(a, 1, lane, gw, NGW);)
    PHASE(15, ffn_conv_sample(a, 1, lane, gw, NGW);)
    PHASE(16, { pg8::EpiResNorm E{X, H, SS + 3 * MTOT, DM, X, X + (size_t)8192 * DM};
                  pg8::Gemm g{(const pg8::bf16_t*)ACT, (const pg8::bf16_t*)(ws + WS_WDN + (size_t)2048 * DFF * 2), MP, 2048, DFF, DFF}; pg8::StaticOrder S; S.init(MP, 2048, G, (int)blockIdx.x);
                  pg8::gemm_phase<pg8::EpiResNorm, pg8::StaticOrder, true, true>(lds, g, S, E); }
                { const int p = (int)blockIdx.x, kq = p & 3, un = p >> 2;
                  pg8::EpiSlab E{(float*)BIG + (size_t)kq * MS * DM, DM};
                  pg8::Gemm g{(const pg8::bf16_t*)ACT + kq * 1408, (const pg8::bf16_t*)(ws + WS_WDN + (size_t)2048 * DFF * 2) + kq * 1408, MTOT, 2048, 1408, DFF};
                  pg8::OneUnit S{{32 + (un & 3), un >> 2}, p < 128};
                  pg8::gemm_phase<pg8::EpiSlab, pg8::OneUnit, true, true>(lds, g, S, E); })
    if (IN(17)) { int t17 = threadIdx.x; asm volatile("" : "+v"(t17));
                  ph_rms_out(X, SS + 3 * MTOT, (const float*)BIG, a.in[I_NFIN], a.out + O_Y, t17 & 63, (int)blockIdx.x * NWAVES + __builtin_amdgcn_readfirstlane(t17 >> 6), NGW); }
#undef IN
#undef SEAM
#undef GEMM_PHASE
#undef SS
#undef X
#undef H
#undef G2
#undef BIG
#undef ACT
}

#ifndef MK_PER_PHASE
#define MK_PER_PHASE 0
#endif
extern "C" void kernel_launch(void* const* d_in, const int* in_sizes, int n_in, void* d_out, int out_size, void* d_ws, size_t ws_size, hipStream_t stream) {
    static int grid = 0;
    if (grid == 0) {
        if (n_in != 32 || out_size != (int)O_END || ws_size < WS_END) { fprintf(stderr, "kernel_launch: unexpected shapes: n_in %d out %d (want %zu) ws %zu (want %zu); nothing launched\n", n_in, out_size, (size_t)O_END, ws_size, (size_t)WS_END); grid = -1; return; }
        int dev = 0, cus = 0, per_cu = 0;
        if (hipGetDevice(&dev) != hipSuccess || hipDeviceGetAttribute(&cus, hipDeviceAttributeMultiprocessorCount, dev) != hipSuccess) { fprintf(stderr, "kernel_launch: device query failed\n"); grid = -1; return; }
        if (hipFuncSetAttribute((const void*)fwd_kernel, hipFuncAttributeMaxDynamicSharedMemorySize, LDS_BYTES) != hipSuccess) { fprintf(stderr, "kernel_launch: hipFuncSetAttribute failed\n"); grid = -1; return; }
        if (hipOccupancyMaxActiveBlocksPerMultiprocessor(&per_cu, (const void*)fwd_kernel, NTHR, LDS_BYTES) != hipSuccess || per_cu < 1) { fprintf(stderr, "kernel_launch: occupancy query says %d blocks per CU\n", per_cu); per_cu = 1; }
        (void)hipGetLastError();
        if (cus < 256) { fprintf(stderr, "kernel_launch: this kernel needs 256 CUs (one resident workgroup each), the device has %d; nothing launched\n", cus); grid = -1; return; }
        grid = 256;
        fprintf(stderr, "kernel_launch: grid %d (occupancy query %d per CU)\n", grid, per_cu);
    }
    if (grid < 0) return;
    if (hipMemsetAsync((char*)d_ws + WS_CTL, 0, CTL_ZERO_BYTES, stream) != hipSuccess) { fprintf(stderr, "kernel_launch: hipMemsetAsync failed\n"); return; }
    Args a{};
    for (int i = 0; i < 32; ++i) a.in[i] = (const float*)d_in[i];
    a.out = (float*)d_out; a.ws = (unsigned char*)d_ws;
#if MK_PER_PHASE
    for (int ph = 0; ph < N_PHASES; ++ph) { a.ph_lo = ph; a.ph_hi = ph + 1; hipLaunchKernelGGL(fwd_kernel, dim3(grid), dim3(NTHR), LDS_BYTES, stream, a); }
#else
    a.ph_lo = 0; a.ph_hi = N_PHASES;
    void* args[] = {&a};
    hipError_t e = hipLaunchCooperativeKernel((const void*)fwd_kernel, dim3(grid), dim3(NTHR), args, LDS_BYTES, stream);
    if (e != hipSuccess) fprintf(stderr, "kernel_launch: cooperative launch failed: %s (grid %d)\n", hipGetErrorString(e), grid);
#endif
}
```

```cpp
#include <hip/hip_runtime.h>
#include <hip/hip_cooperative_groups.h>
#include <cstdio>
#include <cstdint>
#include <cmath>
namespace cg = cooperative_groups;
namespace pg8 {
#define PG8_LAS __attribute__((address_space(3)))
typedef unsigned short bf16_t;
typedef short bf16x8 __attribute__((ext_vector_type(8)));
typedef float f32x4 __attribute__((ext_vector_type(4)));
typedef unsigned u32x4 __attribute__((ext_vector_type(4)));
constexpr int BM = 256, BK = 64, HALF = 128, HTB = HALF * BK * 2  , STAGE_BYTES = 8 * HTB, NXCD = 8, WGM = 4;

__host__ __device__ __forceinline__ int lds_byte(int r, int c) { const int st = (r >> 4) * 2 + (c >> 5), rr = r & 15, cc = c & 31, ob = rr * 64 + cc * 2; return st * 1024 + (ob ^ (((ob >> 9) & 1) << 5)); }
__host__ __device__ __forceinline__ void stage_rc(int b, int& R, int& C) { const int st = b / 1024, sb = b % 1024, swz = sb ^ (((sb >> 9) & 1) << 5); R = (st >> 1) * 16 + swz / 64; C = (st & 1) * 32 + (swz % 64) / 2; }
__host__ __device__ __forceinline__ int perm32(int rho) { const int n = rho >> 4, i = rho & 15; return 8 * (i >> 2) + 4 * n + (i & 3); }

struct Unit { int pm, pn; };
struct Gemm { const bf16_t* A; const bf16_t* Bt; int M, N, K, ldk; };

struct StaticOrder {
    int nM, nN, nwg, G, c;
    __host__ __device__ void init(int M, int N, int G_, int c_) { nM = M / BM; nN = N / BM; nwg = nM * nN; G = G_; c = c_; }
    __host__ __device__ bool next(int i, Unit& u) const {
        const long L = (long)i * G + c; if (L >= nwg) return false;
        int wgid = (int)L; { const int q = nwg / NXCD, r = nwg % NXCD, xcd = wgid % NXCD, off = wgid / NXCD; wgid = (xcd < r ? xcd * (q + 1) : r * (q + 1) + (xcd - r) * q) + off; }
        const int nig = WGM * nN, gid = wgid / nig, fm = gid * WGM, gsz = (nM - fm) < WGM ? (nM - fm) : WGM;
        u.pm = fm + ((wgid % nig) % gsz); u.pn = (wgid % nig) / gsz; return true;
    }
    __device__ __forceinline__ void a_ready(const Unit&) const {}
    __device__ __forceinline__ void done(const Unit&) const {}
};

__device__ __forceinline__ unsigned cvt_pk_bf16(float lo, float hi) { unsigned r; asm volatile("v_cvt_pk_bf16_f32 %0, %1, %2" : "=v"(r) : "v"(lo), "v"(hi)); return r; }

struct EpiBf16Plain {
    static constexpr bool PERM = true, AFTER_DRAIN = false;
    bf16_t* O; int ldc;
    __device__ __forceinline__ void operator()(const f32x4 (&acc)[2][2][4][2], const Unit& u, int wr, int wc, int fr, int fq) const {
        const int row0 = u.pm * BM + wr * 64 + fr, col0 = u.pn * BM + wc * 32 + 8 * fq;
#pragma unroll
        for (int ai = 0; ai < 2; ++ai)
#pragma unroll
            for (int m = 0; m < 4; ++m) { bf16_t* rowp = O + (size_t)(row0 + ai * HALF + m * 16) * ldc + col0;
#pragma unroll
                for (int bj = 0; bj < 2; ++bj) { const f32x4 v0 = acc[ai][bj][m][0], v1 = acc[ai][bj][m][1];
                    u32x4 w; w.x = cvt_pk_bf16(v0[0], v0[1]); w.y = cvt_pk_bf16(v0[2], v0[3]); w.z = cvt_pk_bf16(v1[0], v1[1]); w.w = cvt_pk_bf16(v1[2], v1[3]);
                    *(u32x4*)(rowp + bj * HALF) = w; } }
    }
};
struct EpiResF32 {
    static constexpr bool PERM = false, AFTER_DRAIN = false;
    float* X; int ldc;
    __device__ __forceinline__ void operator()(const f32x4 (&acc)[2][2][4][2], const Unit& u, int wr, int wc, int fr, int fq) const {
        const int row0 = u.pm * BM + wr * 64 + fr, col0 = u.pn * BM + wc * 32 + 4 * fq;
#pragma unroll
        for (int ai = 0; ai < 2; ++ai)
#pragma unroll
            for (int m = 0; m < 4; ++m) { float* rowp = X + (size_t)(row0 + ai * HALF + m * 16) * ldc + col0;
#pragma unroll
                for (int bj = 0; bj < 2; ++bj)
#pragma unroll
                    for (int n = 0; n < 2; ++n) { f32x4* p = (f32x4*)(rowp + bj * HALF + n * 16); *p = *p + acc[ai][bj][m][n]; }
                asm volatile("" ::: "memory"); }
    }
};
struct PlusOne : StaticOrder {
    Unit extra; bool has_extra;
    __device__ bool next(int i, Unit& u) const {
        if (StaticOrder::next(i, u)) return true;
        const int np = (nwg - c + G - 1) / G;
        if (has_extra && i == np) { u = extra; return true; }
        return false;
    }
};
struct OneUnit {
    Unit u; bool valid;
    __device__ bool next(int i, Unit& o) const { if (i != 0 || !valid) return false; o = u; return true; }
    __device__ __forceinline__ void a_ready(const Unit&) const {}
    __device__ __forceinline__ void done(const Unit&) const {}
};
struct EpiSlab {
    static constexpr bool PERM = false, AFTER_DRAIN = false;
    float* S; int ldc;
    __device__ __forceinline__ void operator()(const f32x4 (&acc)[2][2][4][2], const Unit& u, int wr, int wc, int fr, int fq) const {
        const int row0 = (u.pm - 32) * BM + wr * 64 + fr, col0 = u.pn * BM + wc * 32 + 4 * fq;
#pragma unroll
        for (int ai = 0; ai < 2; ++ai)
#pragma unroll
            for (int m = 0; m < 4; ++m) { float* rowp = S + (size_t)(row0 + ai * HALF + m * 16) * ldc + col0;
#pragma unroll
                for (int bj = 0; bj < 2; ++bj)
#pragma unroll
                    for (int n = 0; n < 2; ++n) *(f32x4*)(rowp + bj * HALF + n * 16) = acc[ai][bj][m][n]; }
    }
};
struct EpiResNorm {
    static constexpr bool PERM = false, AFTER_DRAIN = false;
    float* X; bf16_t* XB; float* SS; int ldc; const float* R0; const float* R1;
    __device__ __forceinline__ void operator()(const f32x4 (&acc)[2][2][4][2], const Unit& u, int wr, int wc, int fr, int fq) const {
        const int row0 = u.pm * BM + wr * 64 + fr, col0 = u.pn * BM + wc * 32 + 4 * fq;
        const float* Rb = (u.pm < 32) ? R0 : R1 - (size_t)8192 * ldc;
#pragma unroll
        for (int ap = 0; ap < 4; ++ap) {
            const int ai = ap >> 1, m0 = (ap & 1) * 2;
            f32x4 res[2][4];
#pragma unroll
            for (int mm = 0; mm < 2; ++mm) { const float* rp = Rb + (size_t)(row0 + ai * HALF + (m0 + mm) * 16) * ldc + col0;
#pragma unroll
                for (int i = 0; i < 4; ++i) res[mm][i] = *(const f32x4*)(rp + (i >> 1) * HALF + (i & 1) * 16); }
#pragma unroll
            for (int mm = 0; mm < 2; ++mm) { const int m = m0 + mm, row = row0 + ai * HALF + m * 16; float* rowp = X + (size_t)row * ldc + col0; bf16_t* rowb = XB + (size_t)row * ldc + col0; float ss = 0.f;
#pragma unroll
                for (int i = 0; i < 4; ++i) { const int bj = i >> 1, n = i & 1; const f32x4 v = res[mm][i] + acc[ai][bj][m][n]; *(f32x4*)(rowp + bj * HALF + n * 16) = v;
                    ss += (v[0] * v[0] + v[1] * v[1]) + (v[2] * v[2] + v[3] * v[3]);
                    unsigned lo = cvt_pk_bf16(v[0], v[1]), hi = cvt_pk_bf16(v[2], v[3]); *(unsigned long long*)(rowb + bj * HALF + n * 16) = ((unsigned long long)hi << 32) | lo; }
                ss += __shfl_xor(ss, 16); ss += __shfl_xor(ss, 32);
                if (fq == 0) atomicAdd(SS + row, ss); }
            asm volatile("" ::: "memory"); }
    }
};
struct EpiBf16Rstd {
    static constexpr bool PERM = true, AFTER_DRAIN = false;
    bf16_t* O; int ldc; const float* SS;
    __device__ __forceinline__ void operator()(const f32x4 (&acc)[2][2][4][2], const Unit& u, int wr, int wc, int fr, int fq) const {
        const int row0 = u.pm * BM + wr * 64 + fr, col0 = u.pn * BM + wc * 32 + 8 * fq;
        float ssv[8];
#pragma unroll
        for (int g = 0; g < 8; ++g) ssv[g] = SS[row0 + (g >> 2) * HALF + (g & 3) * 16];
#pragma unroll
        for (int ai = 0; ai < 2; ++ai)
#pragma unroll
            for (int m = 0; m < 4; ++m) { const int row = row0 + ai * HALF + m * 16; bf16_t* rowp = O + (size_t)row * ldc + col0; const float rs = 1.0f / sqrtf(ssv[ai * 4 + m] * (1.0f / 2048.0f) + 1e-6f);
#pragma unroll
                for (int bj = 0; bj < 2; ++bj) { const f32x4 v0 = acc[ai][bj][m][0] * rs, v1 = acc[ai][bj][m][1] * rs;
                    u32x4 w; w.x = cvt_pk_bf16(v0[0], v0[1]); w.y = cvt_pk_bf16(v0[2], v0[3]); w.z = cvt_pk_bf16(v1[0], v1[1]); w.w = cvt_pk_bf16(v1[2], v1[3]);
                    *(u32x4*)(rowp + bj * HALF) = w; } }
    }
};
struct EpiGluRes {
    static constexpr bool PERM = false, AFTER_DRAIN = false;
    float* X; bf16_t* XB; float* SS; int ldc;
    __device__ __forceinline__ void operator()(const f32x4 (&acc)[2][2][4][2], const Unit& u, int wr, int wc, int fr, int fq) const {
        const int row0 = u.pm * BM + wr * 64 + fr, col0 = u.pn * HALF + wc * 32 + 4 * fq;
        f32x4 res[8][2];
#pragma unroll
        for (int g = 0; g < 8; ++g)
#pragma unroll
            for (int n = 0; n < 2; ++n) res[g][n] = *(const f32x4*)(X + (size_t)(row0 + (g >> 2) * HALF + (g & 3) * 16) * ldc + col0 + n * 16);
#pragma unroll
        for (int g = 0; g < 8; ++g) { const int ai = g >> 2, m = g & 3, row = row0 + ai * HALF + m * 16; float* rowp = X + (size_t)row * ldc + col0; bf16_t* rowb = XB + (size_t)row * ldc + col0; float ss = 0.f;
#pragma unroll
            for (int n = 0; n < 2; ++n) { const f32x4 v = acc[ai][0][m][n], gt = acc[ai][1][m][n]; f32x4 o = res[g][n];
#pragma unroll
                for (int j = 0; j < 4; ++j) o[j] += v[j] / (1.0f + __expf(-gt[j]));
                *(f32x4*)(rowp + n * 16) = o; ss += (o[0] * o[0] + o[1] * o[1]) + (o[2] * o[2] + o[3] * o[3]);
                unsigned lo = cvt_pk_bf16(o[0], o[1]), hi = cvt_pk_bf16(o[2], o[3]); *(unsigned long long*)(rowb + n * 16) = ((unsigned long long)hi << 32) | lo; }
            ss += __shfl_xor(ss, 16); ss += __shfl_xor(ss, 32);
            if (fq == 0) atomicAdd(SS + row, ss); }
    }
};

template <class Epi, class Sched, bool ALIGN_EPI = false, bool SP2 = false>
__device__ __forceinline__ void gemm_phase(PG8_LAS unsigned char* lds, const Gemm g, const Sched& S, const Epi& E) {
    const int tid = threadIdx.x, wid = __builtin_amdgcn_readfirstlane(tid >> 6), lane = tid & 63, wr = wid >> 2, wc = wid & 3, fr = lane & 15, fq = lane >> 4;
    const int K = g.ldk, nt = g.K / BK;
    unsigned voffA[2], voffB[2];
#pragma unroll
    for (int i = 0; i < 2; ++i) { int R, C; stage_rc(tid * 16 + i * 8192, R, C); const int Rb = Epi::PERM ? ((R & ~31) + perm32(R & 31)) : R;
        voffA[i] = (unsigned)(R * K + C) * 2u; voffB[i] = (unsigned)(Rb * K + C) * 2u; }
    const size_t kstep = (size_t)(BK * 2);
    const size_t hstep = (size_t)HALF * K * 2;
    const size_t tstep = 2 * hstep;
    const unsigned ldsw = (unsigned)wid * 1024u;
    const int aoff = lds_byte(wr * 64 + fr, fq * 8), boff = lds_byte(wc * 32 + fr, fq * 8);
#define PG8_SA(b, h) (((b) * 2 + (h)) * HTB)
#define PG8_SB(b, h) ((4 + (b) * 2 + (h)) * HTB)
#define PG8_STAGE(bufoff, gbase, voff) do { _Pragma("unroll") for (int _i = 0; _i < 2; ++_i) \
        __builtin_amdgcn_global_load_lds((const unsigned*)((const char*)(gbase) + (voff)[_i]), (PG8_LAS unsigned*)(lds + (bufoff) + ldsw + _i * 8192), 16, 0, 0); } while (0)
#define PG8_LDA(dst, b, h) do { _Pragma("unroll") for (int m = 0; m < 4; ++m) _Pragma("unroll") for (int k = 0; k < 2; ++k) dst[m][k] = *(const PG8_LAS bf16x8*)(lds + PG8_SA(b, h) + aoff + m * 2048 + k * 1024); } while (0)
#define PG8_LDB(dst, b, h) do { _Pragma("unroll") for (int n = 0; n < 2; ++n) _Pragma("unroll") for (int k = 0; k < 2; ++k) dst[n][k] = *(const PG8_LAS bf16x8*)(lds + PG8_SB(b, h) + boff + n * 2048 + k * 1024); } while (0)
#define PG8_MMA(ai, bj, At, Bt) do { __builtin_amdgcn_s_setprio(1); _Pragma("unroll") for (int m = 0; m < 4; ++m) _Pragma("unroll") for (int n = 0; n < 2; ++n) _Pragma("unroll") for (int k = 0; k < 2; ++k) \
        acc[ai][bj][m][n] = __builtin_amdgcn_mfma_f32_16x16x32_bf16(Bt[n][k], At[m][k], acc[ai][bj][m][n], 0, 0, 0); __builtin_amdgcn_s_setprio(0); } while (0)
#define PG8_WAIT_V(n) asm volatile("s_waitcnt vmcnt(" #n ")" ::: "memory")
#define PG8_WAIT_L(n) asm volatile("s_waitcnt lgkmcnt(" #n ")" ::: "memory")
#define PG8_BAR __builtin_amdgcn_s_barrier()
#define PG8_SCHED __builtin_amdgcn_sched_barrier(0)
    Unit cur, nxt; int ui = 0;
    if (!S.next(0, cur)) return;
    f32x4 acc[2][2][4][2];
#pragma unroll
    for (int a = 0; a < 2; ++a)
#pragma unroll
        for (int b = 0; b < 2; ++b)
#pragma unroll
            for (int m = 0; m < 4; ++m)
#pragma unroll
                for (int n = 0; n < 2; ++n) acc[a][b][m][n] = (f32x4){0.f, 0.f, 0.f, 0.f};
    bf16x8 At[4][2], B0[2][2], B1[2][2];
    const char* cA = (const char*)g.A + (size_t)cur.pm * tstep; const char* cB = (const char*)g.Bt + (size_t)cur.pn * tstep;
    S.a_ready(cur);
    if constexpr (SP2) {
        PG8_STAGE(PG8_SB(0, 0), cB, voffB); PG8_STAGE(PG8_SB(0, 1), cB + hstep, voffB); PG8_STAGE(PG8_SA(0, 0), cA, voffA); PG8_STAGE(PG8_SA(0, 1), cA + hstep, voffA);
        if (wr == 1) PG8_BAR;
        PG8_WAIT_V(2); PG8_BAR;
        PG8_STAGE(PG8_SB(1, 0), cB + kstep, voffB); PG8_STAGE(PG8_SA(1, 0), cA + kstep, voffA); PG8_STAGE(PG8_SB(1, 1), cB + hstep + kstep, voffB);
        PG8_WAIT_V(6); PG8_BAR;
    } else {
        PG8_STAGE(PG8_SB(0, 0), cB, voffB); PG8_STAGE(PG8_SA(0, 0), cA, voffA); PG8_STAGE(PG8_SB(0, 1), cB + hstep, voffB); PG8_STAGE(PG8_SA(0, 1), cA + hstep, voffA);
        if (wr == 1) PG8_BAR;
        PG8_WAIT_V(4); PG8_BAR;
        PG8_STAGE(PG8_SB(1, 0), cB + kstep, voffB); PG8_STAGE(PG8_SA(1, 0), cA + kstep, voffA); PG8_STAGE(PG8_SB(1, 1), cB + hstep + kstep, voffB);
        PG8_WAIT_V(6); PG8_BAR;
    }
    for (;;) {
        const bool has_next = S.next(ui + 1, nxt);
        const char* nA = has_next ? (const char*)g.A + (size_t)nxt.pm * tstep : cA; const char* nB = has_next ? (const char*)g.Bt + (size_t)nxt.pn * tstep : cB;
        for (int t = 0; t < nt; t += 2) {
            const bool last = (t == nt - 2);
            const char* a1 = cA + (size_t)(t + 1) * kstep;
            const char* a2 = last ? nA : cA + (size_t)(t + 2) * kstep; const char* b2 = last ? nB : cB + (size_t)(t + 2) * kstep;
            const char* a3 = a2 + kstep; const char* b3 = b2 + kstep;
            if (last && has_next) S.a_ready(nxt);
            if constexpr (SP2) {
            PG8_LDB(B0, 0, 0); PG8_LDB(B1, 0, 1); PG8_SCHED; PG8_LDA(At, 0, 0); PG8_STAGE(PG8_SA(1, 1), a1 + hstep, voffA);
            PG8_WAIT_V(8); PG8_WAIT_L(0); PG8_BAR; PG8_MMA(0, 0, At, B0); PG8_MMA(0, 1, At, B1); PG8_BAR; PG8_SCHED;
            PG8_LDA(At, 0, 1); PG8_STAGE(PG8_SB(0, 0), b2, voffB); PG8_STAGE(PG8_SB(0, 1), b2 + hstep, voffB); PG8_STAGE(PG8_SA(0, 0), a2, voffA);
            PG8_WAIT_V(8); PG8_WAIT_L(0); PG8_BAR; PG8_MMA(1, 0, At, B0); PG8_MMA(1, 1, At, B1); PG8_BAR; PG8_SCHED;
            PG8_LDB(B0, 1, 0); PG8_LDB(B1, 1, 1); PG8_SCHED; PG8_LDA(At, 1, 0); PG8_STAGE(PG8_SA(0, 1), a2 + hstep, voffA);
            PG8_WAIT_V(8); PG8_WAIT_L(0); PG8_BAR; PG8_MMA(0, 0, At, B0); PG8_MMA(0, 1, At, B1); PG8_BAR; PG8_SCHED;
            PG8_LDA(At, 1, 1); PG8_STAGE(PG8_SB(1, 0), b3, voffB); PG8_STAGE(PG8_SB(1, 1), b3 + hstep, voffB); PG8_STAGE(PG8_SA(1, 0), a3, voffA);
            PG8_WAIT_V(8); PG8_WAIT_L(0); PG8_BAR; PG8_MMA(1, 0, At, B0); PG8_MMA(1, 1, At, B1); PG8_BAR; PG8_SCHED;
            } else {
            PG8_LDB(B0, 0, 0); PG8_SCHED; PG8_LDA(At, 0, 0); PG8_STAGE(PG8_SA(1, 1), a1 + hstep, voffA);
            PG8_WAIT_L(8); PG8_BAR; PG8_WAIT_L(0); PG8_MMA(0, 0, At, B0); PG8_BAR; PG8_SCHED;
            PG8_LDB(B1, 0, 1); PG8_STAGE(PG8_SB(0, 0), b2, voffB);
            PG8_BAR; PG8_WAIT_L(0); PG8_MMA(0, 1, At, B1); PG8_BAR;
            PG8_LDA(At, 0, 1); PG8_STAGE(PG8_SA(0, 0), a2, voffA);
            PG8_BAR; PG8_WAIT_L(0); PG8_MMA(1, 0, At, B0); PG8_BAR; PG8_SCHED;
            PG8_STAGE(PG8_SB(0, 1), b2 + hstep, voffB);
            PG8_WAIT_V(6); PG8_BAR; PG8_MMA(1, 1, At, B1); PG8_BAR;
            PG8_LDB(B0, 1, 0); PG8_SCHED; PG8_LDA(At, 1, 0); PG8_STAGE(PG8_SA(0, 1), a2 + hstep, voffA);
            PG8_WAIT_L(8); PG8_BAR; PG8_WAIT_L(0); PG8_MMA(0, 0, At, B0); PG8_BAR; PG8_SCHED;
            PG8_LDB(B1, 1, 1); PG8_STAGE(PG8_SB(1, 0), b3, voffB);
            PG8_BAR; PG8_WAIT_L(0); PG8_MMA(0, 1, At, B1); PG8_BAR;
            PG8_LDA(At, 1, 1); PG8_STAGE(PG8_SA(1, 0), a3, voffA);
            PG8_BAR; PG8_WAIT_L(0); PG8_MMA(1, 0, At, B0); PG8_BAR; PG8_SCHED;
            PG8_STAGE(PG8_SB(1, 1), b3 + hstep, voffB);
            PG8_WAIT_V(6); PG8_BAR; PG8_MMA(1, 1, At, B1); PG8_BAR;
            }
        }
        if constexpr (ALIGN_EPI) { if (wr == 0) PG8_BAR; }
        if constexpr (!Epi::AFTER_DRAIN) { E(acc, cur, wr, wc, fr, fq); S.done(cur); }
        if (!has_next) break;
#pragma unroll
        for (int a = 0; a < 2; ++a)
#pragma unroll
            for (int b = 0; b < 2; ++b)
#pragma unroll
                for (int m = 0; m < 4; ++m)
#pragma unroll
                    for (int n = 0; n < 2; ++n) acc[a][b][m][n] = (f32x4){0.f, 0.f, 0.f, 0.f};
        cur = nxt; cA = nA; cB = nB; ++ui;
        if constexpr (ALIGN_EPI) { if (wr == 1) PG8_BAR; }
    }
    PG8_WAIT_V(0);
    if constexpr (!ALIGN_EPI) { if (wr == 0) PG8_BAR; }
    PG8_BAR;
    if constexpr (Epi::AFTER_DRAIN) { E.fused(acc, cur, wr, wc, fr, fq, lds, wid, lane); S.done(cur); }
#undef PG8_SA
#undef PG8_SB
#undef PG8_STAGE
#undef PG8_LDA
#undef PG8_LDB
#undef PG8_MMA
#undef PG8_WAIT_V
#undef PG8_WAIT_L
#undef PG8_BAR
#undef PG8_SCHED
}
}

constexpr int NWAVES = 8, NTHR = 512;
constexpr int MP = 8192, MS = 1024, MTOT = 9216, DM = 2048;
constexpr int SEQ = 2048, DECS = 8, DECB = 128;
constexpr int NPROJ = 7168, DIN = 7184, DFF = 5632, NUP = 11264, NGLU = 4096;
constexpr int C_QA = 0, C_KA = 1024, C_VA = 2048, C_ZA = 3072, C_QB = 4096, C_KB = 4608, C_VB = 5120, C_GB = 6144;
constexpr float EPS = 1e-6f;
constexpr size_t MiB = 1u << 20;
constexpr size_t WS_CTL = 0;
constexpr size_t WS_WIN = 1 * MiB;
constexpr size_t WS_WOUT = WS_WIN + 28 * MiB;
constexpr size_t WS_WUP = WS_WOUT + 8 * MiB;
constexpr size_t WS_WDN = WS_WUP + 88 * MiB;
constexpr size_t WS_WGLU = WS_WDN + 44 * MiB;
constexpr size_t WS_X = WS_WGLU + 16 * MiB;
constexpr size_t WS_H = WS_X + 72 * MiB;
constexpr size_t WS_G2 = WS_H + 36 * MiB;
constexpr size_t WS_GATE = WS_G2 + 36 * MiB;
constexpr size_t WS_TAB = WS_GATE + 1 * MiB;
constexpr size_t WS_BIG = WS_TAB + 2 * MiB;
constexpr size_t WS_OA = WS_BIG + 126 * MiB, WS_OB = WS_OA + 36 * MiB;
constexpr size_t WS_ACT = WS_BIG + 198 * MiB;
constexpr size_t WS_END = WS_ACT + 99 * MiB;
constexpr size_t WS_UG0 = WS_BIG + 64 * MiB;
constexpr size_t O_Y = 0, O_GDN_P = 18874368, O_GDN_S = O_GDN_P + 524288, O_GCB_P = O_GDN_S + 16777216, O_GCB_S = O_GCB_P + 36864,
                 O_RET_P = O_GCB_S + 1179648, O_RET_S = O_RET_P + 524288, O_S5R_P = O_RET_S + 16777216, O_S5R_S = O_S5R_P + 32768,
                 O_S5I_P = O_S5R_S + 1048576, O_S5I_S = O_S5I_P + 32768, O_FCB_P = O_S5I_S + 1048576, O_FCB_S = O_FCB_P + 180224, O_END = O_FCB_S + 5767168;

constexpr int LDS_BYTES = 148480 + 512;
constexpr int MISC_OFF = 148480;
#define LAS __attribute__((address_space(3)))
typedef unsigned short bf16;
typedef float f32x4 __attribute__((ext_vector_type(4)));
typedef unsigned u32x4 __attribute__((ext_vector_type(4)));
typedef unsigned u32x2 __attribute__((ext_vector_type(2)));
#define LDS_WAIT() asm volatile("s_waitcnt lgkmcnt(0)" ::: "memory")

struct Args { const float* in[32]; float* out; unsigned char* ws; int ph_lo, ph_hi; };
enum { I_XP = 0, I_XS, I_SGDN, I_SGCB, I_SRET, I_S5RE, I_S5IM, I_SFCB, I_NMIX, I_NFFN, I_NFIN, I_WIN, I_GCW, I_GALOG, I_GDTB, I_GNW, I_RGW, I_RGB, I_WOUT,
       I_LRE, I_LIM, I_LDT, I_BRE, I_BIM, I_CRE, I_CIM, I_S5D, I_WGLU, I_WUP, I_FCW, I_FCBIAS, I_WDN };

__device__ __forceinline__ float wave_sum(float v) {
#pragma unroll
    for (int o = 1; o < 64; o <<= 1) v += __shfl_xor(v, o);
    return v;
}
__device__ __forceinline__ unsigned f2bf(float f) { unsigned u = __builtin_bit_cast(unsigned, f); return (u + 0x7fffu + ((u >> 16) & 1u)) >> 16; }
__device__ __forceinline__ unsigned pk2(float lo, float hi) { return f2bf(lo) | (f2bf(hi) << 16); }
__device__ __forceinline__ float bf2f(unsigned short b) { return __builtin_bit_cast(float, (unsigned)b << 16); }
__device__ __forceinline__ void unpack8(const u32x4 w, float (&f)[8]) {
    f[0] = __builtin_bit_cast(float, w.x << 16); f[1] = __builtin_bit_cast(float, w.x & 0xffff0000u);
    f[2] = __builtin_bit_cast(float, w.y << 16); f[3] = __builtin_bit_cast(float, w.y & 0xffff0000u);
    f[4] = __builtin_bit_cast(float, w.z << 16); f[5] = __builtin_bit_cast(float, w.z & 0xffff0000u);
    f[6] = __builtin_bit_cast(float, w.w << 16); f[7] = __builtin_bit_cast(float, w.w & 0xffff0000u);
}
__device__ __forceinline__ void ld_bf8(const bf16* p, float (&f)[8]) { unpack8(*(const u32x4*)p, f); }
__device__ __forceinline__ void ld_f8(const float* p, float (&f)[8]) { const f32x4 a = *(const f32x4*)p, b = *(const f32x4*)(p + 4); f[0] = a[0]; f[1] = a[1]; f[2] = a[2]; f[3] = a[3]; f[4] = b[0]; f[5] = b[1]; f[6] = b[2]; f[7] = b[3]; }
__device__ __forceinline__ void st_bf8(bf16* p, const float (&f)[8]) { u32x4 w; w.x = pk2(f[0], f[1]); w.y = pk2(f[2], f[3]); w.z = pk2(f[4], f[5]); w.w = pk2(f[6], f[7]); *(u32x4*)p = w; }
__device__ __forceinline__ float silu_f(float x) { return x / (1.0f + expf(-x)); }
__device__ __forceinline__ float sigmoid_f(float x) { return 1.0f / (1.0f + expf(-x)); }
__device__ __forceinline__ float softplus_f(float x) { return x > 20.f ? x : log1pf(expf(x)); }
__device__ __forceinline__ float gelu_tanh_fast(float y) { const float z = 0.7978845608028654f * (y + 0.044715f * y * y * y); const float e = __builtin_amdgcn_exp2f(z * 2.8853900817779268f); return y * (1.0f - __builtin_amdgcn_rcpf(e + 1.0f)); }
__device__ __forceinline__ float gelu_tanh(float y) { const float z = 0.7978845608028654f * (y + 0.044715f * y * y * y); const float th = 1.0f - 2.0f / (expf(2.0f * z) + 1.0f); return 0.5f * y * (1.0f + th); }
__device__ __forceinline__ void sincos_d(double a, double& s, double& c) {
    const double n = rint(a * 0.63661977236758134308);
    double r = fma(-n, 1.57079632679489655800e+00, a); r = fma(-n, 6.12323399573676603587e-17, r);
    const double r2 = r * r;
    double ps = 1.0 / 6227020800.0; ps = fma(ps, r2, -1.0 / 39916800.0); ps = fma(ps, r2, 1.0 / 362880.0); ps = fma(ps, r2, -1.0 / 5040.0); ps = fma(ps, r2, 1.0 / 120.0); ps = fma(ps, r2, -1.0 / 6.0); ps = fma(ps * r2, r, r);
    double pc = 1.0 / 479001600.0; pc = fma(pc, r2, -1.0 / 3628800.0); pc = fma(pc, r2, 1.0 / 40320.0); pc = fma(pc, r2, -1.0 / 720.0); pc = fma(pc, r2, 1.0 / 24.0); pc = fma(pc, r2, -0.5); pc = fma(pc, r2, 1.0);
    const int q = (int)(long long)n & 3;
    s = (q == 0) ? ps : (q == 1) ? pc : (q == 2) ? -ps : -pc;
    c = (q == 0) ? pc : (q == 1) ? -ps : (q == 2) ? -pc : ps;
}

#define GAS __attribute__((address_space(1)))
constexpr int CW_BAR = 4096;
constexpr size_t CTL_ZERO_BYTES = 524288;
constexpr size_t WS_SS = WS_CTL + 262144;
#define XB_TMO      128
#define XB_XCNT(j)  (256  + 64 * (j))
#define XB_XSUB(j)  (1280 + 64 * (j))
#define XB_XGEN(j)  (2304 + 64 * (j))
#define XB_TOP      3328
#define XB_TOPGEN   3392
#define XCD_BAR_WORDS 3456
#define XB_SPIN_CAP (1u << 18)

__device__ __forceinline__ unsigned xb_ld(unsigned* p)              { return __hip_atomic_load(p, __ATOMIC_RELAXED, __HIP_MEMORY_SCOPE_AGENT); }
__device__ __forceinline__ unsigned xb_add(unsigned* p, unsigned v) { return __hip_atomic_fetch_add(p, v, __ATOMIC_RELAXED, __HIP_MEMORY_SCOPE_AGENT); }
__device__ __forceinline__ unsigned xb_xcc_id() { return (unsigned)__builtin_amdgcn_s_getreg((3 << 11) | 20) & 0xFu; }
#define XB_SPIN(cond, bar) do { unsigned _sp = 0; while (cond) { __builtin_amdgcn_s_sleep(1); \
    if ((++_sp & 255u) == 0u) { if (xb_ld(&(bar)[XB_TMO])) break; if (_sp > XB_SPIN_CAP) { atomicAdd(&(bar)[XB_TMO], 1u); break; } } } } while (0)

struct XcdBarrier {
    unsigned* bar; unsigned x;
    volatile LAS unsigned* st;
};

__device__ __forceinline__ XcdBarrier xcd_barrier_post(unsigned* bar, volatile LAS unsigned* st) {
    XcdBarrier b; b.bar = bar; b.x = xb_xcc_id(); b.st = st;
    if (threadIdx.x == 0) (void)xb_add(&bar[XB_XCNT(b.x)], 1u);
    return b;
}
__device__ __forceinline__ void xcd_barrier_complete(unsigned* bar, unsigned x, unsigned& nloc, unsigned& nx) {
    const unsigned G = gridDim.x * gridDim.y * gridDim.z;
    unsigned sum, cnt, mine, sp = 0u;
    for (;;) {
        sum = 0u; cnt = 0u; mine = 0u;
#pragma unroll
        for (unsigned j = 0; j < 16; ++j) { const unsigned c = xb_ld(&bar[XB_XCNT(j)]); sum += c; cnt += (c > 0u) ? 1u : 0u; mine = (j == x) ? c : mine; }
        if (sum == G) break;
        __builtin_amdgcn_s_sleep(1);
        if ((++sp & 255u) == 0u) { if (xb_ld(&bar[XB_TMO])) break; if (sp > XB_SPIN_CAP) { atomicAdd(&bar[XB_TMO], 1u); break; } }
    }
    nloc = mine > 0u ? mine : 1u; nx = cnt > 0u ? cnt : 1u;
}

__device__ __forceinline__ void xcd_barrier(const XcdBarrier& b) {
    asm volatile("s_waitcnt vmcnt(0)" ::: "memory");
    __syncthreads();
    if (threadIdx.x == 0) {
        unsigned* bar = b.bar;
        __builtin_amdgcn_s_waitcnt(0);
        unsigned nloc = b.st[0], nx = b.st[1];
        if (nloc == 0u) { xcd_barrier_complete(bar, b.x, nloc, nx); b.st[0] = nloc; b.st[1] = nx; }
        const unsigned old = xb_add(&bar[XB_XSUB(b.x)], 1u);
        const unsigned gen = old / nloc;
        if (old + 1u == (gen + 1u) * nloc) {
            __builtin_amdgcn_fence(__ATOMIC_RELEASE, "agent");
            asm volatile("s_waitcnt vmcnt(0)" ::: "memory");
            const unsigned og = xb_add(&bar[XB_TOP], 1u);
            const unsigned tg = og / nx;
            if (og + 1u == (tg + 1u) * nx) xb_add(&bar[XB_TOPGEN], 1u);
            else XB_SPIN(xb_ld(&bar[XB_TOPGEN]) == tg, bar);
            __builtin_amdgcn_fence(__ATOMIC_ACQUIRE, "agent");
            xb_add(&bar[XB_XGEN(b.x)], 1u);
            asm volatile("s_waitcnt vmcnt(0)" ::: "memory");
        } else {
            XB_SPIN(xb_ld(&bar[XB_XGEN(b.x)]) == gen, bar);
            __builtin_amdgcn_fence(__ATOMIC_ACQUIRE, "agent");
            asm volatile("s_waitcnt vmcnt(0)" ::: "memory");
        }
    }
    __syncthreads();
}


__device__ __forceinline__ void transpose_item(const float* W, int ldw, int src_col0, int k0, bf16* WT, int K, int dst_row0, LAS float* scr, int lane, const float* ksc = nullptr) {
    float wv[32];
    { const float* wp = W + (size_t)(k0 + (lane >> 5)) * ldw + src_col0 + (lane & 31);
#pragma unroll
      for (int i = 0; i < 32; ++i) wv[i] = __builtin_nontemporal_load(wp + (size_t)(2 * i) * ldw); }
#pragma unroll
    for (int i = 0; i < 32; ++i) scr[(2 * i + (lane >> 5)) * 33 + (lane & 31)] = wv[i];
    const int c = lane & 7;
    f32x4 s0 = {1.f, 1.f, 1.f, 1.f}, s1 = {1.f, 1.f, 1.f, 1.f};
    if (ksc) { s0 = *(const f32x4*)(ksc + k0 + 8 * c); s1 = *(const f32x4*)(ksc + k0 + 8 * c + 4); }
    LDS_WAIT(); asm volatile("" ::: "memory");
#pragma unroll
    for (int j = 0; j < 4; ++j) { const int n = (lane >> 3) + 8 * j; const LAS float* s = scr + (8 * c) * 33 + n;
        u32x4 o; o.x = pk2(s[0 * 33] * s0[0], s[1 * 33] * s0[1]); o.y = pk2(s[2 * 33] * s0[2], s[3 * 33] * s0[3]); o.z = pk2(s[4 * 33] * s1[0], s[5 * 33] * s1[1]); o.w = pk2(s[6 * 33] * s1[2], s[7 * 33] * s1[3]);
        *(u32x4*)(WT + (size_t)(dst_row0 + n) * K + k0 + 8 * c) = o; }
    LDS_WAIT(); asm volatile("" ::: "memory");
}
__device__ __forceinline__ int ileave_src(int n0, int half) { const int t = n0 >> 8, w = n0 & 255; return (w < 128) ? t * 128 + w : half + t * 128 + (w - 128); }

__device__ __forceinline__ void convert_group(const Args& a, int group, LAS float* scr, int lane, int w, int nw) {
    unsigned char* ws = a.ws;
    constexpr int I_IN = 32 * 224, I_OUT = 32 * 64, I_UP = 32 * 352, I_DN = 88 * 64, I_GLU = 32 * 128;
    if (group == 0) {
        for (int r = w; r < I_IN; r += nw) { const int kb = r / 224, n0 = 32 * (r % 224); transpose_item(a.in[I_WIN], DIN, n0 < 4096 ? n0 : n0 + 16, 64 * kb, (bf16*)(ws + WS_WIN), 2048, n0, scr, lane); }
    } else {
        const int l = (group == 2) ? 1 : 0, I_A = (l == 0) ? I_OUT : I_GLU;
        const int lo_ = (group == 3) ? I_A : 0, hi_ = (group == 1) ? I_A : I_A + I_UP + I_DN;
        for (int it = lo_ + w; it < hi_; it += nw) {
            int r = it;
            if (r < I_A) { if (l == 0) { const int kb = r / 64, n0 = 32 * (r % 64); transpose_item(a.in[I_WOUT], 2048, n0, 64 * kb, (bf16*)(ws + WS_WOUT), 2048, n0, scr, lane); }
                           else { const int kb = r / 128, n0 = 32 * (r % 128); transpose_item(a.in[I_WGLU], NGLU, ileave_src(n0, 2048), 64 * kb, (bf16*)(ws + WS_WGLU), 2048, n0, scr, lane); }
                           continue; } r -= I_A;
            if (r < I_UP) { const int kb = r / 352, n0 = 32 * (r % 352);
                transpose_item(a.in[I_WUP] + (size_t)l * 2048 * NUP, NUP, ileave_src(n0, DFF), 64 * kb, (bf16*)(ws + WS_WUP) + (size_t)l * NUP * 2048, 2048, n0, scr, lane, a.in[I_NFFN] + l * DM); continue; } r -= I_UP;
            { const int kb = r / 64, n0 = 32 * (r % 64); transpose_item(a.in[I_WDN] + (size_t)l * DFF * 2048, 2048, n0, 64 * kb, (bf16*)(ws + WS_WDN) + (size_t)l * 2048 * DFF, DFF, n0, scr, lane); }
        }
    }
}
constexpr int PRO_REP = 0;
__device__ __forceinline__ void ph_prologue(const Args& a, LAS unsigned char* lds, int tid, int lane, int wave, int gw, int NGW, int G) {
    unsigned char* ws = a.ws;
    for (int rp = 0; rp < (PRO_REP == 1 ? 2 : 1); ++rp)
    {   LAS float* scr = (LAS float*)(lds + wave * 8704);
        convert_group(a, 0, scr, lane, gw, NGW);
        if (G != 256) { convert_group(a, 1, scr, lane, gw, NGW); convert_group(a, 3, scr, lane, gw, NGW); convert_group(a, 2, scr, lane, gw, NGW); }
    }
    for (int rp = 0; rp < (PRO_REP == 2 ? 2 : 1); ++rp)
    {
        float* tab = (float*)(ws + WS_TAB);
        for (int idx = gw * 64 + lane; idx < 2056 * 64; idx += NGW * 64) { const int i = idx & 63, slot = idx >> 6; const int pos = slot < 2048 ? slot : 16384 + (slot - 2048);
            double s, c; sincos_d((double)pos * exp(-(double)i * (9.210340371976184 / 64.0)), s, c); tab[slot * 128 + i] = (float)c; tab[slot * 128 + 64 + i] = (float)s; }
    }
    __syncthreads();
    LAS float* WgT = (LAS float*)lds;
    {   f32x4 wg[4][4];
#pragma unroll
        for (int i = 0; i < 4; ++i)
#pragma unroll
            for (int j = 0; j < 4; ++j) wg[i][j] = *(const f32x4*)(a.in[I_WIN] + (size_t)(tid + 512 * i) * DIN + 4096 + 4 * j);
#pragma unroll
        for (int i = 0; i < 4; ++i)
#pragma unroll
            for (int j = 0; j < 4; ++j)
#pragma unroll
                for (int e = 0; e < 4; ++e) WgT[(4 * j + e) * 2048 + tid + 512 * i] = wg[i][j][e]; }
    __syncthreads();
    bf16* H = (bf16*)(ws + WS_H); float* GATE = (float*)(ws + WS_GATE);
    const float* nw = a.in[I_NMIX];
    const bool b5 = lane & 32, b4 = lane & 16, b3 = lane & 8, b2 = lane & 4;
    const int hme = (b5 ? 8 : 0) + (b4 ? 4 : 0) + (b3 ? 2 : 0) + (b2 ? 1 : 0);
    const float galog = a.in[I_GALOG][hme & 7], gdtb = a.in[I_GDTB][hme & 7];
    f32x4 nwr[8];
#pragma unroll
    for (int j = 0; j < 8; ++j) nwr[j] = ((const f32x4*)nw)[lane + 64 * j];
    for (int rp = 0; rp < (PRO_REP == 3 ? 2 : 1); ++rp) {
    f32x4 vn[8];
    { const int m = gw; const float* xr = (m < MP) ? a.in[I_XP] + (size_t)m * DM : a.in[I_XS] + (size_t)(m - MP) * DM;
#pragma unroll
      for (int j = 0; j < 8; ++j) vn[j] = ((const f32x4*)xr)[lane + 64 * j]; }
    for (int m = gw; m < MTOT; m += NGW) {
        f32x4 v[8]; float ss = 0.f;
#pragma unroll
        for (int j = 0; j < 8; ++j) { v[j] = vn[j]; ss += (v[j][0] * v[j][0] + v[j][1] * v[j][1]) + (v[j][2] * v[j][2] + v[j][3] * v[j][3]); }
        { const int mn = (m + NGW < MTOT) ? m + NGW : m;
          const float* xr = (mn < MP) ? a.in[I_XP] + (size_t)mn * DM : a.in[I_XS] + (size_t)(mn - MP) * DM;
#pragma unroll
          for (int j = 0; j < 8; ++j) vn[j] = ((const f32x4*)xr)[lane + 64 * j]; }
        const float rstd = 1.0f / sqrtf(wave_sum(ss) * (1.0f / DM) + EPS);
#pragma unroll
        for (int j = 0; j < 8; ++j) { v[j] = v[j] * rstd * nwr[j];
            u32x2 o; o.x = pk2(v[j][0], v[j][1]); o.y = pk2(v[j][2], v[j][3]); ((u32x2*)(H + (size_t)m * DM))[lane + 64 * j] = o; }
        float gs_[16];
#pragma unroll
        for (int h = 0; h < 16; ++h) { float s = 0.f;
#pragma unroll
            for (int j = 0; j < 8; ++j) { const f32x4 w4 = *(const LAS f32x4*)(WgT + h * 2048 + 4 * lane + 256 * j); s += (v[j][0] * w4[0] + v[j][1] * w4[1]) + (v[j][2] * w4[2] + v[j][3] * w4[3]); }
            gs_[h] = s; if (h & 1) asm volatile("" ::: "memory"); }
        {   float k8[8], k4[4], k2[2], y;
#pragma unroll
            for (int i = 0; i < 8; ++i) { const float send = b5 ? gs_[i] : gs_[8 + i], keep = b5 ? gs_[8 + i] : gs_[i]; k8[i] = keep + __shfl_xor(send, 32); }
#pragma unroll
            for (int i = 0; i < 4; ++i) { const float send = b4 ? k8[i] : k8[4 + i], keep = b4 ? k8[4 + i] : k8[i]; k4[i] = keep + __shfl_xor(send, 16); }
#pragma unroll
            for (int i = 0; i < 2; ++i) { const float send = b3 ? k4[i] : k4[2 + i], keep = b3 ? k4[2 + i] : k4[i]; k2[i] = keep + __shfl_xor(send, 8); }
            { const float send = b2 ? k2[0] : k2[1], keep = b2 ? k2[1] : k2[0]; y = keep + __shfl_xor(send, 4); }
            y += __shfl_xor(y, 2); y += __shfl_xor(y, 1);
            if ((lane & 3) == 0) { float o; if (hme < 8) o = -expf(galog) * softplus_f(y + gdtb); else o = sigmoid_f(y); GATE[m * 16 + hme] = o; } }
    }
    }
    __syncthreads();
}

__device__ __forceinline__ void ph_rms_rows(const float* X, const float* nw, bf16* H, int lane, int gw, int NGW) {
    for (int m = gw; m < MTOT; m += NGW) {
        f32x4 v[8]; float ss = 0.f;
#pragma unroll
        for (int j = 0; j < 8; ++j) { v[j] = ((const f32x4*)(X + (size_t)m * DM))[lane + 64 * j]; ss += (v[j][0] * v[j][0] + v[j][1] * v[j][1]) + (v[j][2] * v[j][2] + v[j][3] * v[j][3]); }
        const float rstd = 1.0f / sqrtf(wave_sum(ss) * (1.0f / DM) + EPS);
#pragma unroll
        for (int j = 0; j < 8; ++j) { const f32x4 w4 = ((const f32x4*)nw)[lane + 64 * j]; v[j] = v[j] * rstd * w4;
            u32x2 o; o.x = pk2(v[j][0], v[j][1]); o.y = pk2(v[j][2], v[j][3]); ((u32x2*)(H + (size_t)m * DM))[lane + 64 * j] = o; }
    }
}
__device__ __forceinline__ void ph_rms_out(const float* X, const float* SS, const float* SLAB, const float* nw, float* Y, int lane, int gw, int NGW) {
    f32x4 w[8];
#pragma unroll
    for (int j = 0; j < 8; ++j) w[j] = ((const f32x4*)nw)[lane + 64 * j];
    for (int m = gw; m < MTOT; m += NGW) {
        f32x4 v[8];
#pragma unroll
        for (int j = 0; j < 8; ++j) v[j] = ((const f32x4*)(X + (size_t)m * DM))[lane + 64 * j];
        float rstd;
        if (m < MP) rstd = 1.0f / sqrtf(SS[m] * (1.0f / DM) + EPS);
        else {
            f32x4 sl[8][4];
#pragma unroll
            for (int j = 0; j < 8; ++j)
#pragma unroll
                for (int k = 0; k < 4; ++k) sl[j][k] = ((const f32x4*)(SLAB + ((size_t)k * MS + (m - MP)) * DM))[lane + 64 * j];
            float ss = 0.f;
#pragma unroll
            for (int j = 0; j < 8; ++j) { v[j] = v[j] + ((sl[j][0] + sl[j][1]) + (sl[j][2] + sl[j][3]));
                ss += (v[j][0] * v[j][0] + v[j][1] * v[j][1]) + (v[j][2] * v[j][2] + v[j][3] * v[j][3]); }
            rstd = 1.0f / sqrtf(wave_sum(ss) * (1.0f / DM) + EPS);
        }
#pragma unroll
        for (int j = 0; j < 8; ++j) ((f32x4*)(Y + (size_t)m * DM))[lane + 64 * j] = v[j] * rstd * w[j];
    }
}

template <bool GLU>
__device__ __forceinline__ void ph_combine(float* X, bf16* XB, float* SS, const float* SLAB, int lane, int gw, int NGW, bf16* UGW = nullptr, const float* NW = nullptr) {
    constexpr int LDS_ = GLU ? NGLU : DM;
    for (int mr = gw; mr < MS; mr += NGW) {
        const size_t m = (size_t)MP + mr; float ss = 0.f;
        f32x4 xk[8];
#pragma unroll
        for (int jh = 0; jh < 2; ++jh) {
            f32x4 sv[4][4], sg[4][4];
#pragma unroll
            for (int jj = 0; jj < 4; ++jj) { const int j = 4 * jh + jj, c = 4 * (lane + 64 * j);
                xk[j] = *(const f32x4*)(X + m * DM + c);
                const int sc = GLU ? ((c >> 7) << 8) + (c & 127) : c;
#pragma unroll
                for (int k = 0; k < 4; ++k) { const float* sp = SLAB + ((size_t)k * MS + mr) * LDS_ + sc; sv[jj][k] = *(const f32x4*)sp; if (GLU) sg[jj][k] = *(const f32x4*)(sp + 128); } }
#pragma unroll
            for (int jj = 0; jj < 4; ++jj) { const int j = 4 * jh + jj, c = 4 * (lane + 64 * j);
                f32x4 x = xk[j];
                if (GLU) { const f32x4 v = (sv[jj][0] + sv[jj][1]) + (sv[jj][2] + sv[jj][3]), g = (sg[jj][0] + sg[jj][1]) + (sg[jj][2] + sg[jj][3]);
#pragma unroll
                    for (int e = 0; e < 4; ++e) x[e] += v[e] / (1.0f + __expf(-g[e]));
                } else x = x + ((sv[jj][0] + sv[jj][1]) + (sv[jj][2] + sv[jj][3]));
                xk[j] = x; ss += (x[0] * x[0] + x[1] * x[1]) + (x[2] * x[2] + x[3] * x[3]);
                *(f32x4*)(X + m * DM + c) = x;
                u32x2 o; o.x = pk2(x[0], x[1]); o.y = pk2(x[2], x[3]); *(u32x2*)(XB + m * DM + c) = o; }
        }
        ss = wave_sum(ss);
        if (lane == 0) SS[m] = ss;
        if (UGW) {
            const float rs = __builtin_amdgcn_rsqf(ss * (1.0f / DM) + EPS);
            f32x4 w4[8];
#pragma unroll
            for (int j = 0; j < 8; ++j) w4[j] = *(const f32x4*)(NW + 4 * (lane + 64 * j));
#pragma unroll
            for (int j = 0; j < 8; ++j) { const int c = 4 * (lane + 64 * j); const f32x4 x = xk[j];
                u32x2 o; o.x = pk2(x[0] * rs * w4[j][0], x[1] * rs * w4[j][1]); o.y = pk2(x[2] * rs * w4[j][2], x[3] * rs * w4[j][3]);
                *(u32x2*)(UGW + ((size_t)(c >> 4) * MTOT + m) * 16 + (c & 15)) = o; }
        }
    }
}
__device__ __forceinline__ void ph_ug_prompt(const bf16* XB, const float* SS, const float* NW, bf16* UG, int lane, int gw, int NGW) {
    float wv[32];
#pragma unroll
    for (int i = 0; i < 8; ++i) { const f32x4 w4 = *(const f32x4*)(NW + 32 * lane + 4 * i); wv[4 * i] = w4[0]; wv[4 * i + 1] = w4[1]; wv[4 * i + 2] = w4[2]; wv[4 * i + 3] = w4[3]; }
    for (int m = gw; m < MP; m += NGW) {
        u32x4 raw[4];
#pragma unroll
        for (int i = 0; i < 4; ++i) raw[i] = *(const u32x4*)(XB + (size_t)m * DM + 32 * lane + 8 * i);
        const float rs = __builtin_amdgcn_rsqf(SS[m] * (1.0f / DM) + EPS);
#pragma unroll
        for (int i = 0; i < 4; ++i) { float x[8]; unpack8(raw[i], x);
#pragma unroll
            for (int j = 0; j < 8; ++j) x[j] = x[j] * rs * wv[8 * i + j];
            st_bf8(UG + ((size_t)(2 * lane + (i >> 1)) * MTOT + m) * 16 + 8 * (i & 1), x); }
    }
}

typedef short bf16x8 __attribute__((ext_vector_type(8)));
constexpr int GREC_WN = 0, GREC_QD = 16384, GREC_QK = 32768, GREC_KD = 40960, GREC_IMG = 57344, GREC_UT = 57344, GREC_BYTES = 90112;
constexpr int RREC_QD = 0, RREC_QK = 16384, RREC_KD = 24576, RREC_IMG = 40960, RREC_VT = 40960, RREC_BYTES = 73728;
constexpr size_t WS_GREC = WS_ACT, WS_RREC = WS_G2, WS_GL = WS_CTL + 131072;
constexpr size_t WS_QKS = WS_H, WS_VAS = WS_H + 8 * MiB;
__device__ __forceinline__ int kpos(int k) { return (k & ~31) | (((k >> 2) & 3) << 3) | (((k >> 4) & 1) << 2) | (k & 3); }
__device__ __forceinline__ int addr256(int row, int chunk) { return row * 256 + ((chunk ^ (row & 15)) << 4); }
__device__ __forceinline__ int addr128(int row, int chunk) { return row * 128 + ((chunk ^ ((row >> 1) & 7)) << 4); }
__device__ __forceinline__ unsigned cvtpk(float lo, float hi) { unsigned r; asm volatile("v_cvt_pk_bf16_f32 %0, %1, %2" : "=v"(r) : "v"(lo), "v"(hi)); return r; }
__device__ __forceinline__ bf16x8 pack_tiles(const f32x4 lo, const f32x4 hi) { u32x4 w; w.x = cvtpk(lo[0], lo[1]); w.y = cvtpk(lo[2], lo[3]); w.z = cvtpk(hi[0], hi[1]); w.w = cvtpk(hi[2], hi[3]); return __builtin_bit_cast(bf16x8, w); }
#define MFMA16(a, b, c) __builtin_amdgcn_mfma_f32_16x16x32_bf16((a), (b), (c), 0, 0, 0)

__device__ __forceinline__ void img256_put8(unsigned char* img, int row, int grp, const float (&v)[8]) {
    const int s = grp >> 2, t = (grp >> 1) & 1, qq0 = (grp & 1) * 2;
    u32x2 p0, p1; p0.x = pk2(v[0], v[1]); p0.y = pk2(v[2], v[3]); p1.x = pk2(v[4], v[5]); p1.y = pk2(v[6], v[7]);
    *(u32x2*)(img + addr256(row, 4 * s + qq0) + 8 * t) = p0; *(u32x2*)(img + addr256(row, 4 * s + qq0 + 1) + 8 * t) = p1;
}

constexpr int GP_K32 = 0, GP_V32 = 33024, GP_QS = 66048, GP_KS = 82432, GP_LM = 98816, GP_G = 115200;
__device__ __forceinline__ void gdn_prep_chunk(const Args& a, LAS unsigned char* lds, int b, int h, int n, int tid, int lane, int wave) {
    unsigned char* ws = a.ws;
    const bf16* PROJ = (const bf16*)(ws + WS_BIG); const float* GATE = (const float*)(ws + WS_GATE);
    const int cid = (b * 8 + h) * 32 + n, row0 = b * SEQ + 64 * n;
    unsigned char* rec = ws + WS_GREC + (size_t)cid * GREC_BYTES;
    LAS float* K32 = (LAS float*)(lds + GP_K32); LAS float* V32 = (LAS float*)(lds + GP_V32); LAS float* Lm = (LAS float*)(lds + GP_LM);
    LAS float* gs = (LAS float*)(lds + GP_G);
    __syncthreads();
    if (wave == 0) {
        float v = GATE[(size_t)(row0 + lane) * 16 + h];
#pragma unroll
        for (int o = 1; o < 64; o <<= 1) { const float t = __shfl_up(v, o); if (lane >= o) v += t; }
        const float gl = __shfl(v, 63);
        const float be = GATE[(size_t)(row0 + lane) * 16 + 8 + h], ev = expf(v);
        gs[lane] = v; gs[64 + lane] = be; gs[128 + lane] = ev; gs[192 + lane] = expf(gl - v); gs[256 + lane] = be * ev; gs[320 + lane] = 1.0f;
        if (lane == 63) ((float*)(ws + WS_GL))[cid] = expf(gl);
    }
    __syncthreads();
    {
        const int c = tid >> 3, sub = tid & 7, t = 64 * n + c; const size_t m = (size_t)row0 + c;
        const float egc = gs[128 + c], bec = gs[64 + c];
        float qv[2][8], kv[2][8];
#pragma unroll
        for (int i = 0; i < 6; ++i) {
            const int grp = sub + 8 * (i & 1), typ = i >> 1, col = typ * 1024 + h * 128 + grp * 8;
            float acc[8];
#pragma unroll
            for (int e = 0; e < 8; ++e) acc[e] = 0.f;
            if (n > 0) {
                float x[4][8], w[4][8];
#pragma unroll
                for (int j = 0; j < 4; ++j) { ld_bf8(PROJ + (m - 3 + j) * NPROJ + col, x[j]); ld_f8(a.in[I_GCW] + (size_t)j * 3072 + col, w[j]); }
#pragma unroll
                for (int j = 0; j < 4; ++j)
#pragma unroll
                    for (int e = 0; e < 8; ++e) acc[e] += w[j][e] * x[j][e];
            } else {
#pragma unroll
                for (int j = 0; j < 4; ++j) if (t - 3 + j >= 0) { float x[8], w[8]; ld_bf8(PROJ + (m - 3 + j) * NPROJ + col, x); ld_f8(a.in[I_GCW] + (size_t)j * 3072 + col, w);
#pragma unroll
                    for (int e = 0; e < 8; ++e) acc[e] += w[e] * x[e]; }
            }
#pragma unroll
            for (int e = 0; e < 8; ++e) acc[e] = silu_f(acc[e]);
            if (typ == 0) {
#pragma unroll
                for (int e = 0; e < 8; ++e) qv[i & 1][e] = acc[e];
            } else if (typ == 1) {
#pragma unroll
                for (int e = 0; e < 8; ++e) kv[i & 1][e] = acc[e];
            } else {
#pragma unroll
                for (int e = 0; e < 8; ++e) V32[c * 129 + grp * 8 + e] = acc[e] * bec; }
            if (i & 1) asm volatile("" ::: "memory");
        }
        float sq = 0.f, sk = 0.f;
#pragma unroll
        for (int e = 0; e < 8; ++e) { sq += qv[0][e] * qv[0][e] + qv[1][e] * qv[1][e]; sk += kv[0][e] * kv[0][e] + kv[1][e] * kv[1][e]; }
        sq += __shfl_xor(sq, 1); sq += __shfl_xor(sq, 2); sq += __shfl_xor(sq, 4); sk += __shfl_xor(sk, 1); sk += __shfl_xor(sk, 2); sk += __shfl_xor(sk, 4);
        const float rq = (1.0f / sqrtf(sq + EPS)) * 0.08838834764831845f, rk = 1.0f / sqrtf(sk + EPS);
#pragma unroll
        for (int i = 0; i < 2; ++i) { const int grp = sub + 8 * i; float qd[8];
#pragma unroll
            for (int e = 0; e < 8; ++e) { qv[i][e] *= rq; kv[i][e] *= rk; qd[e] = qv[i][e] * egc; K32[c * 129 + grp * 8 + e] = kv[i][e]; }
            u32x4 wq, wk; wq.x = pk2(qv[i][0], qv[i][1]); wq.y = pk2(qv[i][2], qv[i][3]); wq.z = pk2(qv[i][4], qv[i][5]); wq.w = pk2(qv[i][6], qv[i][7]);
            wk.x = pk2(kv[i][0], kv[i][1]); wk.y = pk2(kv[i][2], kv[i][3]); wk.z = pk2(kv[i][4], kv[i][5]); wk.w = pk2(kv[i][6], kv[i][7]);
            *(LAS u32x4*)(lds + GP_QS + addr256(c, grp)) = wq; *(LAS u32x4*)(lds + GP_KS + addr256(c, grp)) = wk;
            img256_put8(rec + GREC_QD, c, grp, qd); }
    }
    __syncthreads();
    {
        const int r = lane & 15, q = lane >> 4;
#pragma unroll
        for (int ti = 0; ti < 2; ++ti) {
            const int tt = 2 * wave + ti, ct = tt >> 2, cu = tt & 3;
            f32x4 akk = {0.f, 0.f, 0.f, 0.f}, aqk = {0.f, 0.f, 0.f, 0.f};
#pragma unroll
            for (int ks = 0; ks < 4; ++ks) {
                const bf16x8 bk = *(const LAS bf16x8*)(lds + GP_KS + addr256(16 * cu + r, 4 * ks + q));
                const bf16x8 ak = *(const LAS bf16x8*)(lds + GP_KS + addr256(16 * ct + r, 4 * ks + q));
                const bf16x8 aq = *(const LAS bf16x8*)(lds + GP_QS + addr256(16 * ct + r, 4 * ks + q));
                akk = MFMA16(ak, bk, akk); aqk = MFMA16(aq, bk, aqk);
            }
            const int c2 = 16 * cu + r; const float g2 = gs[c2]; const int p2 = kpos(c2);
#pragma unroll
            for (int reg = 0; reg < 4; ++reg) { const int c = 16 * ct + 4 * q + reg; const float dec = (c2 <= c) ? expf(gs[c] - g2) : 0.f;
                Lm[c * 64 + c2] = (c2 < c) ? gs[64 + c] * akk[reg] * dec : 0.f;
                *(bf16*)(rec + GREC_QK + addr128(c, p2 >> 3) + (p2 & 7) * 2) = (bf16)f2bf(aqk[reg] * dec); }
        }
    }
    __syncthreads();
    if (tid < 256) {
        const bool isu = tid < 128; const int col = isu ? tid : tid - 128;
        const LAS float* rb = (const LAS float*)(lds + (isu ? GP_V32 : GP_K32)) + col; const LAS float* scp = gs + (isu ? 320 : 256);
        int zlane; asm volatile("v_mov_b32 %0, 0" : "=v"(zlane));
        const LAS float* Lz = Lm + zlane;
        float sol[64];
#pragma unroll
        for (int c = 0; c < 64; ++c) {
            float pa[4] = {rb[c * 129] * scp[c], 0.f, 0.f, 0.f};
#pragma unroll
            for (int c4 = 0; c4 < (c + 3) / 4; ++c4) { const f32x4 l4 = *(const LAS f32x4*)(Lz + c * 64 + 4 * c4);
#pragma unroll
                for (int j = 0; j < 4; ++j) if (4 * c4 + j < c) pa[j] -= l4[j] * sol[4 * c4 + j]; }
            sol[c] = (pa[0] + pa[1]) + (pa[2] + pa[3]);
            asm volatile("" ::: "memory");
        }
        if (isu) { float* ut = (float*)(rec + GREC_UT) + col * 64;
#pragma unroll
            for (int c4 = 0; c4 < 16; ++c4) *(f32x4*)(ut + 4 * c4) = (f32x4){sol[4 * c4], sol[4 * c4 + 1], sol[4 * c4 + 2], sol[4 * c4 + 3]}; }
        else { const int p = kpos(col), ch = p >> 3, wi = (p & 7) * 2;
            int xo[16];
#pragma unroll
            for (int k = 0; k < 16; ++k) xo[k] = ((ch ^ k) << 4) + wi;
#pragma unroll
            for (int c = 0; c < 64; ++c) *(LAS bf16*)(lds + GP_QS + c * 256 + xo[c & 15]) = (bf16)f2bf(-sol[c]); }
    } else {
        const int c = lane, p = kpos(c), ch = p >> 3, wi = (p & 7) * 2; const float sc = gs[192 + c];
#pragma unroll 2
        for (int i = 0; i < 32; ++i) { const int d = (wave - 4) * 32 + i; *(bf16*)(rec + GREC_KD + addr128(d, ch) + wi) = (bf16)f2bf(K32[c * 129 + d] * sc); }
    }
    __syncthreads();
#pragma unroll
    for (int i = 0; i < 2; ++i) *(u32x4*)(rec + GREC_WN + (i * NTHR + tid) * 16) = *(const LAS u32x4*)(lds + GP_QS + (i * NTHR + tid) * 16);
}

constexpr int RP_K32 = 0, RP_V16 = 33024, RP_QS = 66048, RP_KS = 82432;
__device__ __forceinline__ void ret_prep_chunk(const Args& a, LAS unsigned char* lds, int b, int h, int n, int tid, int lane, int wave) {
    unsigned char* ws = a.ws;
    const bf16* PROJ = (const bf16*)(ws + WS_BIG); const float* tab = (const float*)(ws + WS_TAB);
    const int cid = (b * 4 + h) * 32 + n, row0 = b * SEQ + 64 * n;
    unsigned char* rec = ws + WS_RREC + (size_t)cid * RREC_BYTES;
    LAS float* K32 = (LAS float*)(lds + RP_K32); LAS bf16* V16 = (LAS bf16*)(lds + RP_V16);
    const float l2g = log2f(1.0f - exp2f(-5.0f - (float)h));
    __syncthreads();
    {
        const int c = tid >> 3, sub = tid & 7; const size_t m = (size_t)row0 + c; const bf16* pr = PROJ + m * NPROJ;
        float ql[8], qh[8], kl[8], kh[8], cs[8], sn[8];
        ld_bf8(pr + C_QB + h * 128 + sub * 8, ql); ld_bf8(pr + C_QB + h * 128 + 64 + sub * 8, qh); ld_bf8(pr + C_KB + h * 128 + sub * 8, kl); ld_bf8(pr + C_KB + h * 128 + 64 + sub * 8, kh);
        ld_f8(tab + (size_t)(64 * n + c) * 128 + sub * 8, cs); ld_f8(tab + (size_t)(64 * n + c) * 128 + 64 + sub * 8, sn);
        float q0[8], q1[8], k0[8], k1[8], d0[8], d1[8]; const float qdec = exp2f(l2g * (float)(c + 1));
#pragma unroll
        for (int e = 0; e < 8; ++e) { q0[e] = ql[e] * cs[e] - qh[e] * sn[e]; q1[e] = ql[e] * sn[e] + qh[e] * cs[e];
            k0[e] = (kl[e] * cs[e] - kh[e] * sn[e]) * 0.08838834764831845f; k1[e] = (kl[e] * sn[e] + kh[e] * cs[e]) * 0.08838834764831845f;
            d0[e] = q0[e] * qdec; d1[e] = q1[e] * qdec; K32[c * 129 + sub * 8 + e] = k0[e]; K32[c * 129 + 64 + sub * 8 + e] = k1[e]; }
        u32x4 w; w.x = pk2(q0[0], q0[1]); w.y = pk2(q0[2], q0[3]); w.z = pk2(q0[4], q0[5]); w.w = pk2(q0[6], q0[7]); *(LAS u32x4*)(lds + RP_QS + addr256(c, sub)) = w;
        w.x = pk2(q1[0], q1[1]); w.y = pk2(q1[2], q1[3]); w.z = pk2(q1[4], q1[5]); w.w = pk2(q1[6], q1[7]); *(LAS u32x4*)(lds + RP_QS + addr256(c, 8 + sub)) = w;
        w.x = pk2(k0[0], k0[1]); w.y = pk2(k0[2], k0[3]); w.z = pk2(k0[4], k0[5]); w.w = pk2(k0[6], k0[7]); *(LAS u32x4*)(lds + RP_KS + addr256(c, sub)) = w;
        w.x = pk2(k1[0], k1[1]); w.y = pk2(k1[2], k1[3]); w.z = pk2(k1[4], k1[5]); w.w = pk2(k1[6], k1[7]); *(LAS u32x4*)(lds + RP_KS + addr256(c, 8 + sub)) = w;
        img256_put8(rec + RREC_QD, c, sub, d0); img256_put8(rec + RREC_QD, c, 8 + sub, d1);
#pragma unroll
        for (int i = 0; i < 4; ++i) { const u32x4 v = *(const u32x4*)(pr + C_VB + h * 256 + (sub + 8 * i) * 8); LAS unsigned* dst = (LAS unsigned*)(V16 + c * 258 + (sub + 8 * i) * 8); dst[0] = v.x; dst[1] = v.y; dst[2] = v.z; dst[3] = v.w; }
    }
    __syncthreads();
    {
        const int r = lane & 15, q = lane >> 4;
#pragma unroll
        for (int ti = 0; ti < 2; ++ti) {
            const int tt = 2 * wave + ti, ct = tt >> 2, cu = tt & 3;
            f32x4 aqk = {0.f, 0.f, 0.f, 0.f};
#pragma unroll
            for (int ks = 0; ks < 4; ++ks) {
                const bf16x8 bk = *(const LAS bf16x8*)(lds + RP_KS + addr256(16 * cu + r, 4 * ks + q));
                const bf16x8 aq = *(const LAS bf16x8*)(lds + RP_QS + addr256(16 * ct + r, 4 * ks + q));
                aqk = MFMA16(aq, bk, aqk);
            }
            const int c2 = 16 * cu + r, p2 = kpos(c2);
#pragma unroll
            for (int reg = 0; reg < 4; ++reg) { const int c = 16 * ct + 4 * q + reg; const float dec = (c2 <= c) ? exp2f(l2g * (float)(c - c2)) : 0.f;
                *(bf16*)(rec + RREC_QK + addr128(c, p2 >> 3) + (p2 & 7) * 2) = (bf16)f2bf(aqk[reg] * dec); }
        }
        const int c = lane, p = kpos(c), ch = p >> 3, wi = (p & 7) * 2; const float sc = exp2f(l2g * (float)(63 - c));
#pragma unroll 2
        for (int i = 0; i < 16; ++i) { const int d = wave * 16 + i; *(bf16*)(rec + RREC_KD + addr128(d, ch) + wi) = (bf16)f2bf(K32[c * 129 + d] * sc); }
#pragma unroll 2
        for (int i = 0; i < 32; ++i) { const int e = wave * 32 + i; *(bf16*)(rec + RREC_VT + e * 128 + p * 2) = V16[c * 258 + e]; }
    }
}

template <bool GDN>
__device__ __forceinline__ void chunk_scan(const Args& a, LAS unsigned char* lds, int task, int tid, int lane, int wave) {
    unsigned char* ws = a.ws;
    constexpr int IMG = GDN ? GREC_IMG : RREC_IMG, REC = GDN ? GREC_BYTES : RREC_BYTES, NP = IMG / 16 / NTHR;
    constexpr int O_WN = GREC_WN, O_QD = GDN ? GREC_QD : RREC_QD, O_QK = GDN ? GREC_QK : RREC_QK, O_KD = GDN ? GREC_KD : RREC_KD;
    const int r = lane & 15, q = lane >> 4;
    int b, h, e0, cid0;
    if (GDN) { b = task >> 3; h = task & 7; e0 = 16 * wave; cid0 = (b * 8 + h) * 32; }
    else { b = task >> 3; h = (task >> 1) & 3; e0 = 128 * (task & 1) + 16 * wave; cid0 = (b * 4 + h) * 32; }
    const unsigned char* rec = ws + (GDN ? WS_GREC : WS_RREC) + (size_t)cid0 * REC;
    const float* GL = (const float*)(ws + WS_GL) + cid0;
    float* O = (float*)(ws + (GDN ? WS_OA : WS_OB)) + (size_t)b * SEQ * 1024 + h * (GDN ? 128 : 256) + e0 + r;
    const float gch = GDN ? 0.f : exp2f(64.0f * log2f(1.0f - exp2f(-5.0f - (float)h)));
    f32x4 S[8];
#pragma unroll
    for (int dt = 0; dt < 8; ++dt) S[dt] = (f32x4){0.f, 0.f, 0.f, 0.f};
    __syncthreads();
    constexpr int SLICE = GDN ? 4096 : 2048, SL_OFF = 2 * GREC_IMG;
    LAS unsigned char* slot = lds + SL_OFF + wave * SLICE;
#define STAGE_IMG(recp, bufp) do { _Pragma("unroll") for (int i_ = 0; i_ < NP; ++i_) \
        __builtin_amdgcn_global_load_lds((const unsigned*)((recp) + (size_t)(i_ * NTHR + tid) * 16), (LAS unsigned*)((bufp) + (i_ * NTHR + wave * 64) * 16), 16, 0, 0); } while (0)
#define STAGE_SLICE(recp) do { _Pragma("unroll") for (int i_ = 0; i_ < SLICE / 1024; ++i_) \
        __builtin_amdgcn_global_load_lds((const unsigned*)((recp) + (GDN ? GREC_UT + e0 * 256 : RREC_VT + e0 * 128) + i_ * 1024 + lane * 16), (LAS unsigned*)(slot + i_ * 1024), 16, 0, 0); } while (0)
    STAGE_IMG(rec, lds); STAGE_SLICE(rec);
    for (int n = 0; n < 32; ++n) {
        const unsigned char* nrec = rec + (size_t)(n + 1 < 32 ? n + 1 : n) * REC;
        f32x4 uc[4]; bf16x8 bv[2];
        const float gl = GDN ? GL[n] : gch;
        if (n == 0) asm volatile("s_waitcnt vmcnt(0) lgkmcnt(0)" ::: "memory"); else asm volatile("s_waitcnt vmcnt(16) lgkmcnt(0)" ::: "memory");
        __builtin_amdgcn_s_barrier();
        asm volatile("" ::: "memory");
        if (GDN) {
#pragma unroll
            for (int ct = 0; ct < 4; ++ct) uc[ct] = *(const LAS f32x4*)(slot + r * 256 + (16 * ct + 4 * q) * 4);
        } else {
#pragma unroll
            for (int s = 0; s < 2; ++s) bv[s] = *(const LAS bf16x8*)(slot + r * 128 + (4 * s + q) * 16);
        }
        asm volatile("s_waitcnt lgkmcnt(0)" ::: "memory");
        if (n + 1 < 32) { STAGE_IMG(nrec, lds + ((n + 1) & 1) * IMG); STAGE_SLICE(nrec); }
        asm volatile("" ::: "memory"); __builtin_amdgcn_sched_barrier(0);
        LAS unsigned char* B = lds + (n & 1) * IMG;
        bf16x8 bs[4];
#pragma unroll
        for (int s = 0; s < 4; ++s) bs[s] = pack_tiles(S[2 * s], S[2 * s + 1]);
        f32x4 ao[4];
#pragma unroll
        for (int ct = 0; ct < 4; ++ct) ao[ct] = (f32x4){0.f, 0.f, 0.f, 0.f};
        bf16x8 FA[8], FB[8];
#define LD256(F, off, s0) do { _Pragma("unroll") for (int i_ = 0; i_ < 8; ++i_) F[i_] = *(const LAS bf16x8*)(B + (off) + addr256(16 * (i_ & 3) + r, 4 * ((s0) + (i_ >> 2)) + q)); } while (0)
#define LD128(F, off, t0) do { _Pragma("unroll") for (int i_ = 0; i_ < 8; ++i_) F[i_] = *(const LAS bf16x8*)(B + (off) + addr128(16 * ((t0) + (i_ & 3)) + r, 4 * (i_ >> 2) + q)); } while (0)
#define MM(F, ACC, BOP, s0) do { _Pragma("unroll") for (int i_ = 0; i_ < 8; ++i_) ACC[i_ & 3] = MFMA16(F[i_], BOP[(s0) + (i_ >> 2)], ACC[i_ & 3]); } while (0)
#define SB() __builtin_amdgcn_sched_barrier(0)
        if (GDN) {
            LD256(FA, O_WN, 0); SB();
            LD256(FB, O_WN, 2); SB(); MM(FA, uc, bs, 0); SB();
            LD256(FA, O_QD, 0); SB(); MM(FB, uc, bs, 2); SB();
            bv[0] = pack_tiles(uc[0], uc[1]); bv[1] = pack_tiles(uc[2], uc[3]);
        } else { LD256(FA, O_QD, 0); SB(); }
        LD256(FB, O_QD, 2); SB(); MM(FA, ao, bs, 0); SB();
        LD128(FA, O_QK, 0); SB(); MM(FB, ao, bs, 2); SB();
        LD128(FB, O_KD, 0); SB(); MM(FA, ao, bv, 0); SB();
#pragma unroll
        for (int dt = 0; dt < 8; ++dt) S[dt] = S[dt] * gl;
        LD128(FA, O_KD, 4); SB();
        { f32x4 (&S0)[8] = S; _Pragma("unroll") for (int i_ = 0; i_ < 8; ++i_) S0[i_ & 3] = MFMA16(FB[i_], bv[i_ >> 2], S0[i_ & 3]); } SB();
        { _Pragma("unroll") for (int i_ = 0; i_ < 8; ++i_) S[4 + (i_ & 3)] = MFMA16(FA[i_], bv[i_ >> 2], S[4 + (i_ & 3)]); } SB();
#undef LD256
#undef LD128
#undef MM
#undef SB
#pragma unroll
        for (int ct = 0; ct < 4; ++ct)
#pragma unroll
            for (int reg = 0; reg < 4; ++reg) O[(size_t)(64 * n + 16 * ct + 4 * q + reg) * 1024] = ao[ct][reg];
    }
#undef STAGE_IMG
#undef STAGE_SLICE
    float* so = a.out + (GDN ? O_GDN_P + (size_t)(b * 8 + h) * 128 * 128 : O_RET_P + (size_t)(b * 4 + h) * 128 * 256) + e0 + r;
#pragma unroll
    for (int dt = 0; dt < 8; ++dt)
#pragma unroll
        for (int reg = 0; reg < 4; ++reg) so[(size_t)(16 * dt + 4 * q + reg) * (GDN ? 128 : 256)] = S[dt][reg];
}

__device__ __forceinline__ void ph_gdn_prep(const Args& a, int lane, int gw, int NGW) {
    unsigned char* ws = a.ws;
    const bf16* PROJ = (const bf16*)(ws + WS_BIG);
    for (int idx = gw * 64 + lane; idx < (4 + DECB) * 3 * 3072; idx += NGW * 64) {
        const int c = idx % 3072, j = (idx / 3072) % 3, sb = idx / (3 * 3072);
        if (sb < 4) a.out[O_GCB_P + idx] = bf2f(PROJ[(size_t)(sb * SEQ + SEQ - 3 + j) * NPROJ + c]);
        else { const int b = sb - 4; a.out[O_GCB_S + ((size_t)b * 3 + j) * 3072 + c] = bf2f(PROJ[(size_t)(MP + b * DECS + DECS - 3 + j) * NPROJ + c]); }
    }
}

__device__ __forceinline__ void ph_mix_prep(const Args& a, LAS unsigned char* lds, int tid, int lane, int wave, int gw, int NGW, int G) {
    for (int t = blockIdx.x; t < 1024; t += G) gdn_prep_chunk(a, lds, t >> 8, (t >> 5) & 7, t & 31, tid, lane, wave);
    for (int r = blockIdx.x; r < 512; r += G) ret_prep_chunk(a, lds, r >> 7, (r >> 5) & 3, r & 31, tid, lane, wave);
    ph_gdn_prep(a, lane, gw, NGW);
}
constexpr int SB_Q = 0, SB_K = 4096, SB_V = 8192, SB_G = 12288;
#define LDS_BARRIER() asm volatile("s_waitcnt lgkmcnt(0)\n\ts_barrier" ::: "memory")
__device__ __forceinline__ float oct_sum(float v) {
    v += __builtin_bit_cast(float, __builtin_amdgcn_mov_dpp(__builtin_bit_cast(int, v), 0xB1, 0xF, 0xF, true));
    v += __builtin_bit_cast(float, __builtin_amdgcn_mov_dpp(__builtin_bit_cast(int, v), 0x4E, 0xF, 0xF, true));
    v += __builtin_bit_cast(float, __builtin_amdgcn_mov_dpp(__builtin_bit_cast(int, v), 0x141, 0xF, 0xF, true));
    return v;
}
__device__ __forceinline__ void gdn_sample_pair(const Args& a, LAS unsigned char* lds, int st, int lane, int wave) {
    unsigned char* ws = a.ws;
    const bf16* PROJ = (const bf16*)(ws + WS_BIG); const float* GATE = (const float*)(ws + WS_GATE); float* OA = (float*)(ws + WS_OA);
    const int hb = wave >> 2, w4 = wave & 3, b = st >> 3, h = st & 7;
    LAS unsigned char* L = lds + hb * 16384;
    LAS float* qs = (LAS float*)(L + SB_Q); LAS float* ks = (LAS float*)(L + SB_K); LAS float* vs = (LAS float*)(L + SB_V); LAS float* gt = (LAS float*)(L + SB_G);
    const int dg = lane & 7, ec = lane >> 3, wcol = 32 * w4 + 4 * ec;
    float2 wj[3][4], xs[3][5]; unsigned xp[3][5]; float g0[2], g1[2];
#pragma unroll
    for (int typ = 0; typ < 3; ++typ) { const int col = typ * 1024 + h * 128 + 2 * lane;
#pragma unroll
        for (int j = 0; j < 4; ++j) wj[typ][j] = *(const float2*)(a.in[I_GCW] + (size_t)j * 3072 + col);
#pragma unroll
        for (int jj = 0; jj < 5; ++jj) { const int tq = 2 * w4 + jj; xs[typ][jj] = *(const float2*)(a.in[I_SGCB] + ((size_t)b * 3 + (tq < 3 ? tq : 2)) * 3072 + col);
            xp[typ][jj] = *(const unsigned*)(PROJ + (size_t)(MP + b * DECS + (tq >= 3 ? tq - 3 : 0)) * NPROJ + col); } }
#pragma unroll
    for (int tt = 0; tt < 2; ++tt) { const size_t m = (size_t)MP + b * DECS + 2 * w4 + tt; g0[tt] = GATE[m * 16 + h]; g1[tt] = GATE[m * 16 + 8 + h]; }
    asm volatile("" ::: "memory");
    f32x4 S[16];
    { const float* sp = a.in[I_SGDN] + (((size_t)b * 8 + h) * 128 + dg * 16) * 128 + wcol;
#pragma unroll
      for (int i = 0; i < 16; ++i) S[i] = *(const f32x4*)(sp + (size_t)i * 128); }
    LDS_BARRIER();
#pragma unroll
    for (int typ = 0; typ < 3; ++typ) {
        asm volatile("" : "+v"(wj[typ][0].x), "+v"(wj[typ][0].y), "+v"(wj[typ][1].x), "+v"(wj[typ][1].y), "+v"(wj[typ][2].x), "+v"(wj[typ][2].y), "+v"(wj[typ][3].x), "+v"(wj[typ][3].y));
        asm volatile("" : "+v"(xs[typ][0].x), "+v"(xs[typ][0].y), "+v"(xs[typ][1].x), "+v"(xs[typ][1].y), "+v"(xs[typ][2].x), "+v"(xs[typ][2].y), "+v"(xs[typ][3].x), "+v"(xs[typ][3].y), "+v"(xs[typ][4].x), "+v"(xs[typ][4].y));
        asm volatile("" : "+v"(xp[typ][0]), "+v"(xp[typ][1]), "+v"(xp[typ][2]), "+v"(xp[typ][3]), "+v"(xp[typ][4])); }
    asm volatile("" : "+v"(g0[0]), "+v"(g0[1]), "+v"(g1[0]), "+v"(g1[1]));
#pragma unroll
    for (int tt = 0; tt < 2; ++tt) { const int c = 2 * w4 + tt;
#pragma unroll
        for (int typ = 0; typ < 3; ++typ) { float a0 = 0.f, a1 = 0.f;
#pragma unroll
            for (int j = 0; j < 4; ++j) { const bool st_ = (c + j) < 3; const unsigned w = xp[typ][tt + j]; const float x0 = st_ ? xs[typ][tt + j].x : __builtin_bit_cast(float, w << 16), x1 = st_ ? xs[typ][tt + j].y : __builtin_bit_cast(float, w & 0xffff0000u);
                a0 += wj[typ][j].x * x0; a1 += wj[typ][j].y * x1; }
            a0 = silu_f(a0); a1 = silu_f(a1);
            if (typ < 2) { const float rs = (1.0f / sqrtf(wave_sum(a0 * a0 + a1 * a1) + EPS)) * (typ == 0 ? 0.08838834764831845f : 1.0f); a0 *= rs; a1 *= rs; }
            LAS float* dst = (typ == 0 ? qs : typ == 1 ? ks : vs) + c * 128 + 2 * lane; dst[0] = a0; dst[1] = a1; }
        if (lane == 0) { gt[c] = g0[tt]; gt[8 + c] = g1[tt]; } }
    LDS_BARRIER();
#pragma unroll 1
    for (int c = 0; c < 8; ++c) {
        const float al = expf(gt[c]), be = gt[8 + c];
        float kk[16], qq[16];
#pragma unroll
        for (int i4 = 0; i4 < 4; ++i4) { const f32x4 k4 = *(const LAS f32x4*)(ks + c * 128 + dg * 16 + 4 * i4), q4 = *(const LAS f32x4*)(qs + c * 128 + dg * 16 + 4 * i4);
            kk[4 * i4] = k4[0]; kk[4 * i4 + 1] = k4[1]; kk[4 * i4 + 2] = k4[2]; kk[4 * i4 + 3] = k4[3]; qq[4 * i4] = q4[0]; qq[4 * i4 + 1] = q4[1]; qq[4 * i4 + 2] = q4[2]; qq[4 * i4 + 3] = q4[3]; }
        const f32x4 v4 = *(const LAS f32x4*)(vs + c * 128 + wcol);
        f32x4 r0 = {0.f, 0.f, 0.f, 0.f}, r1 = {0.f, 0.f, 0.f, 0.f};
#pragma unroll
        for (int i = 0; i < 16; i += 2) { r0 = r0 + S[i] * kk[i]; r1 = r1 + S[i + 1] * kk[i + 1]; }
        f32x4 rr = r0 + r1;
#pragma unroll
        for (int j = 0; j < 4; ++j) rr[j] = oct_sum(rr[j]);
        const f32x4 dl = (v4 - rr * al) * be;
        f32x4 o0 = {0.f, 0.f, 0.f, 0.f}, o1 = {0.f, 0.f, 0.f, 0.f};
#pragma unroll
        for (int i = 0; i < 16; i += 2) { S[i] = S[i] * al + dl * kk[i]; S[i + 1] = S[i + 1] * al + dl * kk[i + 1]; o0 = o0 + S[i] * qq[i]; o1 = o1 + S[i + 1] * qq[i + 1]; }
        f32x4 oo = o0 + o1;
#pragma unroll
        for (int j = 0; j < 4; ++j) oo[j] = oct_sum(oo[j]);
        if (dg == 0) *(f32x4*)(OA + (size_t)(MP + b * DECS + c) * 1024 + h * 128 + wcol) = oo;
    }
    { float* so = a.out + O_GDN_S + (((size_t)b * 8 + h) * 128 + dg * 16) * 128 + wcol;
#pragma unroll
      for (int i = 0; i < 16; ++i) *(f32x4*)(so + (size_t)i * 128) = S[i]; }
}
__device__ __forceinline__ void ret_sample_pair(const Args& a, LAS unsigned char* lds, int st, int lane, int wave) {
    unsigned char* ws = a.ws;
    const bf16* PROJ = (const bf16*)(ws + WS_BIG); const float* tab = (const float*)(ws + WS_TAB); float* OB = (float*)(ws + WS_OB);
    const int hb = wave >> 2, w4 = wave & 3, r_ = st - 1024, b = r_ >> 3, h = (r_ >> 1) & 3, half = r_ & 1;
    LAS unsigned char* L = lds + hb * 16384;
    LAS float* qs = (LAS float*)(L + SB_Q); LAS float* ks = (LAS float*)(L + SB_K); LAS float* vs = (LAS float*)(L + SB_V);
    const int dg = lane & 7, ec = lane >> 3, wcol = 32 * w4 + 4 * ec;
    const float gamma = 1.0f - exp2f(-5.0f - (float)h);
    float cs[2], sn[2]; unsigned rq[2][2], rk[2][2], vw[2];
#pragma unroll
    for (int tt = 0; tt < 2; ++tt) { const int c = 2 * w4 + tt; const unsigned short* pr = (const unsigned short*)(PROJ + (size_t)(MP + b * DECS + c) * NPROJ); const float* tp = tab + (size_t)(2048 + c) * 128;
        cs[tt] = tp[lane]; sn[tt] = tp[64 + lane];
        rq[tt][0] = pr[C_QB + h * 128 + lane]; rq[tt][1] = pr[C_QB + h * 128 + 64 + lane]; rk[tt][0] = pr[C_KB + h * 128 + lane]; rk[tt][1] = pr[C_KB + h * 128 + 64 + lane];
        vw[tt] = *(const unsigned*)(pr + C_VB + h * 256 + half * 128 + 2 * lane); }
    asm volatile("" ::: "memory");
    f32x4 S[16];
    { const float* sp = a.in[I_SRET] + (((size_t)b * 4 + h) * 128 + dg * 16) * 256 + half * 128 + wcol;
#pragma unroll
      for (int i = 0; i < 16; ++i) S[i] = *(const f32x4*)(sp + (size_t)i * 256); }
    LDS_BARRIER();
    asm volatile("" : "+v"(cs[0]), "+v"(sn[0]), "+v"(rq[0][0]), "+v"(rq[0][1]), "+v"(rk[0][0]), "+v"(rk[0][1]), "+v"(vw[0]), "+v"(cs[1]), "+v"(sn[1]), "+v"(rq[1][0]), "+v"(rq[1][1]), "+v"(rk[1][0]), "+v"(rk[1][1]), "+v"(vw[1]));
#pragma unroll
    for (int tt = 0; tt < 2; ++tt) { const int c = 2 * w4 + tt;
        const float ql = __builtin_bit_cast(float, rq[tt][0] << 16), qh = __builtin_bit_cast(float, rq[tt][1] << 16), kl = __builtin_bit_cast(float, rk[tt][0] << 16), kh = __builtin_bit_cast(float, rk[tt][1] << 16);
        qs[c * 128 + lane] = ql * cs[tt] - qh * sn[tt]; qs[c * 128 + 64 + lane] = ql * sn[tt] + qh * cs[tt];
        ks[c * 128 + lane] = (kl * cs[tt] - kh * sn[tt]) * 0.08838834764831845f; ks[c * 128 + 64 + lane] = (kl * sn[tt] + kh * cs[tt]) * 0.08838834764831845f;
        vs[c * 128 + 2 * lane] = __builtin_bit_cast(float, vw[tt] << 16); vs[c * 128 + 2 * lane + 1] = __builtin_bit_cast(float, vw[tt] & 0xffff0000u); }
    LDS_BARRIER();
#pragma unroll 1
    for (int c = 0; c < 8; ++c) {
        float kk[16], qq[16];
#pragma unroll
        for (int i4 = 0; i4 < 4; ++i4) { const f32x4 k4 = *(const LAS f32x4*)(ks + c * 128 + dg * 16 + 4 * i4), q4 = *(const LAS f32x4*)(qs + c * 128 + dg * 16 + 4 * i4);
            kk[4 * i4] = k4[0]; kk[4 * i4 + 1] = k4[1]; kk[4 * i4 + 2] = k4[2]; kk[4 * i4 + 3] = k4[3]; qq[4 * i4] = q4[0]; qq[4 * i4 + 1] = q4[1]; qq[4 * i4 + 2] = q4[2]; qq[4 * i4 + 3] = q4[3]; }
        const f32x4 v4 = *(const LAS f32x4*)(vs + c * 128 + wcol);
        f32x4 o0 = {0.f, 0.f, 0.f, 0.f}, o1 = {0.f, 0.f, 0.f, 0.f};
#pragma unroll
        for (int i = 0; i < 16; i += 2) { S[i] = S[i] * gamma + v4 * kk[i]; S[i + 1] = S[i + 1] * gamma + v4 * kk[i + 1]; o0 = o0 + S[i] * qq[i]; o1 = o1 + S[i + 1] * qq[i + 1]; }
        f32x4 oo = o0 + o1;
#pragma unroll
        for (int j = 0; j < 4; ++j) oo[j] = oct_sum(oo[j]);
        if (dg == 0) *(f32x4*)(OB + (size_t)(MP + b * DECS + c) * 1024 + h * 256 + half * 128 + wcol) = oo;
    }
    { float* so = a.out + O_RET_S + (((size_t)b * 4 + h) * 128 + dg * 16) * 256 + half * 128 + wcol;
#pragma unroll
      for (int i = 0; i < 16; ++i) *(f32x4*)(so + (size_t)i * 256) = S[i]; }
}
__device__ __forceinline__ void sample_pairs(const Args& a, LAS unsigned char* lds, int p0, int stride, int cnt, int lane, int wave) {
    const int hb = wave >> 2;
    __builtin_amdgcn_s_waitcnt(0);
#pragma unroll 1
    for (int k = 0; k < cnt; ++k) { const int pr = p0 + k * stride, st = 2 * pr + hb;
        if (pr < 512) gdn_sample_pair(a, lds, st, lane, wave); else ret_sample_pair(a, lds, st, lane, wave); }
}
__device__ __forceinline__ void ph_scans(const Args& a, LAS unsigned char* lds, int tid, int lane, int wave, int G, int mode = 3) {
    const int blk = blockIdx.x;
    if (mode & 1) { if (blk < 32) chunk_scan<true>(a, lds, blk, tid, lane, wave); else if (blk < 64) chunk_scan<false>(a, lds, blk - 32, tid, lane, wave); }
    if ((mode & 2) && blk >= 64) sample_pairs(a, lds, blk - 64, 192, (blk - 64) < 64 ? 6 : 5, lane, wave);
    if (mode == 3 && blk >= 64) convert_group(a, 1, (LAS float*)(lds + 32768 + wave * 8704), lane, (blk - 64) * NWAVES + wave, 192 * NWAVES);
}

__device__ __forceinline__ void ph_mix_norm(const Args& a, int lane, int gw, int NGW) {
    unsigned char* ws = a.ws;
    const bf16* PROJ = (const bf16*)(ws + WS_BIG); const float* OA = (const float*)(ws + WS_OA); const float* OB = (const float*)(ws + WS_OB); bf16* MIX = (bf16*)(ws + WS_G2);
    float wa[2][8], wb[2][8], bb[2][8];
#pragma unroll
    for (int i = 0; i < 2; ++i) { const int col = 8 * (lane + 64 * i); ld_f8(a.in[I_GNW] + (col & 127), wa[i]); ld_f8(a.in[I_RGW] + col, wb[i]); ld_f8(a.in[I_RGB] + col, bb[i]); }
    for (int m = gw; m < MTOT; m += NGW) {
        f32x4 oa[2][2], ob[2][2]; u32x4 zz[2], gg[2];
#pragma unroll
        for (int i = 0; i < 2; ++i) { const int col = 8 * (lane + 64 * i);
            oa[i][0] = *(const f32x4*)(OA + (size_t)m * 1024 + col); oa[i][1] = *(const f32x4*)(OA + (size_t)m * 1024 + col + 4);
            ob[i][0] = *(const f32x4*)(OB + (size_t)m * 1024 + col); ob[i][1] = *(const f32x4*)(OB + (size_t)m * 1024 + col + 4);
            zz[i] = *(const u32x4*)(PROJ + (size_t)m * NPROJ + C_ZA + col); gg[i] = *(const u32x4*)(PROJ + (size_t)m * NPROJ + C_GB + col); }
#pragma unroll
        for (int i = 0; i < 2; ++i) {
            const int col = 8 * (lane + 64 * i);
            float o[8] = {oa[i][0][0], oa[i][0][1], oa[i][0][2], oa[i][0][3], oa[i][1][0], oa[i][1][1], oa[i][1][2], oa[i][1][3]}, z[8]; unpack8(zz[i], z);
            float ss = 0.f;
#pragma unroll
            for (int e = 0; e < 8; ++e) ss += o[e] * o[e];
            ss += __shfl_xor(ss, 1); ss += __shfl_xor(ss, 2); ss += __shfl_xor(ss, 4); ss += __shfl_xor(ss, 8);
            const float rs = 1.0f / sqrtf(ss * (1.0f / 128.0f) + EPS);
#pragma unroll
            for (int e = 0; e < 8; ++e) o[e] = o[e] * rs * wa[i][e] * silu_f(z[e]);
            st_bf8(MIX + (size_t)m * 2048 + col, o);
        }
#pragma unroll
        for (int i = 0; i < 2; ++i) {
            const int col = 8 * (lane + 64 * i);
            float o[8] = {ob[i][0][0], ob[i][0][1], ob[i][0][2], ob[i][0][3], ob[i][1][0], ob[i][1][1], ob[i][1][2], ob[i][1][3]}, g[8]; unpack8(gg[i], g);
            float s_ = 0.f;
#pragma unroll
            for (int e = 0; e < 8; ++e) s_ += o[e];
            s_ += __shfl_xor(s_, 1); s_ += __shfl_xor(s_, 2); s_ += __shfl_xor(s_, 4); s_ += __shfl_xor(s_, 8); s_ += __shfl_xor(s_, 16);
            const float mu = s_ * (1.0f / 256.0f); float q = 0.f;
#pragma unroll
            for (int e = 0; e < 8; ++e) { o[e] -= mu; q += o[e] * o[e]; }
            q += __shfl_xor(q, 1); q += __shfl_xor(q, 2); q += __shfl_xor(q, 4); q += __shfl_xor(q, 8); q += __shfl_xor(q, 16);
            const float rs = 1.0f / sqrtf(q * (1.0f / 256.0f) + EPS);
#pragma unroll
            for (int e = 0; e < 8; ++e) o[e] = (o[e] * rs * wb[i][e] + bb[i][e]) * silu_f(g[e]);
            st_bf8(MIX + (size_t)m * 2048 + 1024 + col, o);
        }
    }
}

__device__ __forceinline__ void ffn_conv_prompt(const Args& a, int layer, int lane, int gw, int NGW) {
    unsigned char* ws = a.ws;
    const bf16* UP = (const bf16*)(ws + WS_BIG); bf16* ACT = (bf16*)(ws + WS_ACT);
    const float* cw = a.in[I_FCW] + (size_t)layer * 3 * NUP; const float* cb = a.in[I_FCBIAS] + (size_t)layer * NUP;
    for (int task = gw; task < 128 * 11; task += NGW) {
        const int run = task / 11, cblk = task % 11, m0 = run * 64, t0 = m0 % SEQ;
        const int j0 = 8 * (lane + 64 * cblk), ucol = ((j0 >> 7) << 8) + (j0 & 127);
        float wv[3][8], wg[3][8], bv_[8], bg_[8]; ld_f8(cb + j0, bv_); ld_f8(cb + DFF + j0, bg_);
#pragma unroll
        for (int jj = 0; jj < 3; ++jj) { ld_f8(cw + (size_t)jj * NUP + j0, wv[jj]); ld_f8(cw + (size_t)jj * NUP + DFF + j0, wg[jj]); }
        float p2v[8], p2g[8], p1v[8], p1g[8];
        if (t0 == 0) {
#pragma unroll
            for (int e = 0; e < 8; ++e) { p2v[e] = 0.f; p2g[e] = 0.f; p1v[e] = 0.f; p1g[e] = 0.f; }
        } else { const bf16* r2 = UP + (size_t)(m0 - 2) * NUP + ucol; ld_bf8(r2, p2v); ld_bf8(r2 + 128, p2g); ld_bf8(r2 + NUP, p1v); ld_bf8(r2 + NUP + 128, p1g); }
        const bf16* rp = UP + (size_t)m0 * NUP + ucol; bf16* op = ACT + (size_t)m0 * DFF + j0;
#pragma unroll 1
        for (int i8 = 0; i8 < 8; ++i8) {
            u32x4 lv[8], lg[8];
#pragma unroll
            for (int k = 0; k < 8; ++k) { lv[k] = *(const u32x4*)(rp + (size_t)k * NUP); lg[k] = *(const u32x4*)(rp + (size_t)k * NUP + 128); }
#pragma unroll
            for (int k = 0; k < 8; ++k) { float xv[8], xg[8], o[8]; unpack8(lv[k], xv); unpack8(lg[k], xg);
#pragma unroll
                for (int e = 0; e < 8; ++e) { const float va = bv_[e] + wv[0][e] * p2v[e] + wv[1][e] * p1v[e] + wv[2][e] * xv[e], ga = bg_[e] + wg[0][e] * p2g[e] + wg[1][e] * p1g[e] + wg[2][e] * xg[e];
                    o[e] = silu_f(ga) * va; p2v[e] = p1v[e]; p2g[e] = p1g[e]; p1v[e] = xv[e]; p1g[e] = xg[e]; }
                st_bf8(op + (size_t)k * DFF, o); }
            rp += (size_t)8 * NUP; op += (size_t)8 * DFF;
        }
    }
}
__device__ __forceinline__ void ffn_conv_sample(const Args& a, int layer, int lane, int gw, int NGW) {
    unsigned char* ws = a.ws;
    const bf16* UP = (const bf16*)(ws + WS_BIG); bf16* ACT = (bf16*)(ws + WS_ACT);
    const float* cw = a.in[I_FCW] + (size_t)layer * 3 * NUP; const float* cb = a.in[I_FCBIAS] + (size_t)layer * NUP; const float* cst = a.in[I_SFCB] + (size_t)layer * DECB * 2 * NUP;
    for (int task = gw; task < MS * 11; task += NGW) {
        const int m = MP + task / 11, i = task % 11;
        const int b = (m - MP) / DECS, t = (m - MP) % DECS;
        {
            const int j0 = 8 * (lane + 64 * i), ucol = ((j0 >> 7) << 8) + (j0 & 127);
            float va[8], ga[8]; ld_f8(cb + j0, va); ld_f8(cb + DFF + j0, ga);
#pragma unroll
            for (int jj = 0; jj < 3; ++jj) { float xv[8], xg[8], sv[8], sg[8], wv[8], wg[8]; const int tt = t + jj; const bool from_state = tt < 2;
                const bf16* r = UP + (size_t)(MP + b * DECS + (tt >= 2 ? tt - 2 : 0)) * NUP + ucol; ld_bf8(r, xv); ld_bf8(r + 128, xg);
                const float* rs_ = cst + ((size_t)b * 2 + (tt < 2 ? tt : 1)) * NUP + j0; ld_f8(rs_, sv); ld_f8(rs_ + DFF, sg);
                ld_f8(cw + (size_t)jj * NUP + j0, wv); ld_f8(cw + (size_t)jj * NUP + DFF + j0, wg);
#pragma unroll
                for (int e = 0; e < 8; ++e) { va[e] += wv[e] * (from_state ? sv[e] : xv[e]); ga[e] += wg[e] * (from_state ? sg[e] : xg[e]); } }
            float o[8];
#pragma unroll
            for (int e = 0; e < 8; ++e) o[e] = silu_f(ga[e]) * va[e];
            st_bf8(ACT + (size_t)m * DFF + j0, o);
        }
    }
    constexpr int NCH = (4 + DECB) * 2 * (NUP / 8);
    float xx[3][8]; int chs[3];
#pragma unroll
    for (int u = 0; u < 3; ++u) { const int ch = gw * 64 + lane + u * NGW * 64; chs[u] = ch; const int cc = ch < NCH ? ch : 0;
        const int c = 8 * (cc % (NUP / 8)), rr = cc / (NUP / 8), r = rr & 1, sb = rr >> 1;
        const int j = c < DFF ? c : c - DFF, ucol = ((j >> 7) << 8) + (j & 127) + (c < DFF ? 0 : 128);
        const size_t row = sb < 4 ? (size_t)(sb * SEQ + SEQ - 2 + r) : (size_t)(MP + (sb - 4) * DECS + DECS - 2 + r);
        ld_bf8(UP + row * NUP + ucol, xx[u]); }
#pragma unroll
    for (int u = 0; u < 3; ++u) { const int ch = chs[u]; if (ch < NCH) {
        const int c = 8 * (ch % (NUP / 8)), rr = ch / (NUP / 8), r = rr & 1, sb = rr >> 1;
        float* dst = sb < 4 ? a.out + O_FCB_P + ((size_t)(layer * 4 + sb) * 2 + r) * NUP + c : a.out + O_FCB_S + ((size_t)(layer * DECB + (sb - 4)) * 2 + r) * NUP + c;
        *(f32x4*)dst = (f32x4){xx[u][0], xx[u][1], xx[u][2], xx[u][3]}; *(f32x4*)(dst + 4) = (f32x4){xx[u][4], xx[u][5], xx[u][6], xx[u][7]}; } }
    static_assert(NCH <= 3 * 256 * NWAVES * 64, "three chunks per lane cover the conv states");
}

__device__ __forceinline__ void s5_task(const Args& a, bool prompt, int b, int g, int lane) {
    unsigned char* ws = a.ws;
    const bf16* H = (const bf16*)(ws + WS_H); bf16* G2 = (bf16*)(ws + WS_G2);
    const int p = lane, gp = g * 64 + p;
    const double lr = (double)a.in[I_LRE][gp], li = (double)a.in[I_LIM][gp], dt = exp((double)a.in[I_LDT][g]);
    const double mag = exp(lr * dt); double sn, cs; sincos_d(li * dt, sn, cs);
    const double abr = mag * cs, abi = mag * sn, den = lr * lr + li * li;
    const double cfr = ((abr - 1.0) * lr + abi * li) / den, cfi = (abi * lr - (abr - 1.0) * li) / den;
    float bbr[16], bbi[16], cr[16], ci[16];
#pragma unroll
    for (int c = 0; c < 16; ++c) { const double br = (double)a.in[I_BRE][(size_t)gp * 16 + c], bi = (double)a.in[I_BIM][(size_t)gp * 16 + c]; bbr[c] = (float)(cfr * br - cfi * bi); bbi[c] = (float)(cfr * bi + cfi * br);
        cr[c] = a.in[I_CRE][((size_t)g * 16 + c) * 64 + p]; ci[c] = a.in[I_CIM][((size_t)g * 16 + c) * 64 + p]; }
    const float ar = (float)abr, ai = (float)abi;
    float xr = 0.f, xi = 0.f;
    if (!prompt) { xr = a.in[I_S5RE][((size_t)b * 128 + g) * 64 + p]; xi = a.in[I_S5IM][((size_t)b * 128 + g) * 64 + p]; }
    const bool b5 = lane & 32, b4 = lane & 16, b3 = lane & 8, b2 = lane & 4;
    const int cme = (b5 ? 8 : 0) + (b4 ? 4 : 0) + (b3 ? 2 : 0) + (b2 ? 1 : 0);
    const float dme = a.in[I_S5D][g * 16 + cme];
    const int L = prompt ? SEQ : DECS, row0 = prompt ? b * SEQ : MP + b * DECS;
    const bf16* hp = H + (size_t)row0 * DM + g * 16;
    u32x4 nu0 = *(const u32x4*)hp, nu1 = *(const u32x4*)(hp + 8); unsigned short nume = hp[cme];
    for (int t = 0; t < L; ++t) {
        float u[16]; { float ua[8], ub[8]; unpack8(nu0, ua); unpack8(nu1, ub);
#pragma unroll
            for (int c = 0; c < 8; ++c) { u[c] = ua[c]; u[8 + c] = ub[c]; } }
        const float ume = bf2f(nume);
        if (t + 1 < L) { hp += DM; nu0 = *(const u32x4*)hp; nu1 = *(const u32x4*)(hp + 8); nume = hp[cme]; }
        float bur = 0.f, bui = 0.f;
#pragma unroll
        for (int c = 0; c < 16; ++c) { bur += bbr[c] * u[c]; bui += bbi[c] * u[c]; }
        const float nxr = ar * xr - ai * xi + bur, nxi = ar * xi + ai * xr + bui; xr = nxr; xi = nxi;
        float vals[16];
#pragma unroll
        for (int c = 0; c < 16; ++c) vals[c] = cr[c] * xr - ci[c] * xi;
        float k8[8], k4[4], k2[2], y;
#pragma unroll
        for (int i = 0; i < 8; ++i) { const float send = b5 ? vals[i] : vals[8 + i], keep = b5 ? vals[8 + i] : vals[i]; k8[i] = keep + __shfl_xor(send, 32); }
#pragma unroll
        for (int i = 0; i < 4; ++i) { const float send = b4 ? k8[i] : k8[4 + i], keep = b4 ? k8[4 + i] : k8[i]; k4[i] = keep + __shfl_xor(send, 16); }
#pragma unroll
        for (int i = 0; i < 2; ++i) { const float send = b3 ? k4[i] : k4[2 + i], keep = b3 ? k4[2 + i] : k4[i]; k2[i] = keep + __shfl_xor(send, 8); }
        { const float send = b2 ? k2[0] : k2[1], keep = b2 ? k2[1] : k2[0]; y = keep + __shfl_xor(send, 4); }
        y += __shfl_xor(y, 2); y += __shfl_xor(y, 1);
        y = gelu_tanh(y + dme * ume);
        if ((lane & 3) == 0) G2[(size_t)(row0 + t) * DM + g * 16 + cme] = (bf16)f2bf(y);
    }
    const size_t so = ((size_t)b * 128 + g) * 64 + p;
    a.out[(prompt ? O_S5R_P : O_S5R_S) + so] = xr; a.out[(prompt ? O_S5I_P : O_S5I_S) + so] = xi;
}
__device__ __forceinline__ bf16x8 pack8(const float (&v)[8]) { u32x4 w; w.x = cvtpk(v[0], v[1]); w.y = cvtpk(v[2], v[3]); w.z = cvtpk(v[4], v[5]); w.w = cvtpk(v[6], v[7]); return __builtin_bit_cast(bf16x8, w); }
__device__ __forceinline__ float bfround(float x) { return __builtin_bit_cast(float, f2bf(x) << 16); }
constexpr int S5_PITCH = 132, S5_WAVE_LDS = 16 * S5_PITCH * 4;
constexpr int S5_SEG = 128, S5_NSEG = SEQ / S5_SEG;
constexpr size_t WS_S5E = WS_ACT;
struct S5C {
    bf16x8 Bf[8];
    bf16x8 Ch[4], Cl[4], Df;
    float nwa[8];
    float ar, ai;
};
__device__ __forceinline__ void s5_first(const bf16* H, const float* SS, int g, int row0, int lane, u32x4& An, float& sn_) {
    const int r = lane & 15, q = lane >> 4, rlast = MTOT - 1 - row0, rr = r < rlast ? r : rlast;
    An = *(const u32x4*)(H + (size_t)(row0 + rr) * DM + g * 16 + 8 * (q & 1)); sn_ = SS[row0 + rr];
}
template <bool FULL>
__device__ __forceinline__ void s5_run(const S5C& C, const bf16* H, const float* SS, bf16* G2, LAS float* T, int g, int row0, int L, float& xr, float& xi, int lane, u32x4 An, float sn_) {
    const int r = lane & 15, q = lane >> 4;
    const bf16* hp = H + (size_t)row0 * DM + g * 16 + 8 * (q & 1);
    for (int t0 = 0; t0 < L; t0 += 16) {
        bf16x8 A; { float xa[8]; unpack8(An, xa); const float rs = 1.0f / sqrtf(sn_ * (1.0f / DM) + EPS);
#pragma unroll
            for (int j = 0; j < 8; ++j) xa[j] = xa[j] * rs * C.nwa[j];
            A = pack8(xa); }
        if (t0 + 16 < L) { An = *(const u32x4*)(hp + (size_t)(t0 + 16 + r) * DM); sn_ = SS[row0 + t0 + 16 + r]; }
#pragma unroll
        for (int nt = 0; nt < 8; ++nt) { const f32x4 d = MFMA16(A, C.Bf[nt], ((f32x4){0.f, 0.f, 0.f, 0.f}));
#pragma unroll
            for (int reg = 0; reg < 4; ++reg) T[(4 * q + reg) * S5_PITCH + 16 * nt + r] = d[reg]; }
        float bur[16], bui[16];
#pragma unroll
        for (int t = 0; t < 16; ++t) { bur[t] = T[t * S5_PITCH + lane]; bui[t] = T[t * S5_PITCH + 64 + lane]; }
#pragma unroll
        for (int t = 0; t < 16; ++t) { if (t0 + t < L) { const float nr = C.ar * xr - C.ai * xi + bur[t], ni = C.ar * xi + C.ai * xr + bui[t]; xr = nr; xi = ni; } bur[t] = xr; bui[t] = xi; }
        if (FULL) {
#pragma unroll
            for (int t = 0; t < 16; ++t) { T[t * S5_PITCH + lane] = bur[t]; T[t * S5_PITCH + 64 + lane] = bui[t]; }
            f32x4 y = MFMA16(A, C.Df, ((f32x4){0.f, 0.f, 0.f, 0.f}));
#pragma unroll
            for (int s = 0; s < 4; ++s) { const f32x4 x0 = *(const LAS f32x4*)(T + r * S5_PITCH + 32 * s + 8 * q), x1 = *(const LAS f32x4*)(T + r * S5_PITCH + 32 * s + 8 * q + 4);
                u32x4 wh; wh[0] = cvtpk(x0[0], x0[1]); wh[1] = cvtpk(x0[2], x0[3]); wh[2] = cvtpk(x1[0], x1[1]); wh[3] = cvtpk(x1[2], x1[3]);
                const bf16x8 xh = __builtin_bit_cast(bf16x8, wh);
                y = MFMA16(xh, C.Ch[s], y); y = MFMA16(xh, C.Cl[s], y); }
#pragma unroll
            for (int reg = 0; reg < 4; ++reg) { const int t = t0 + 4 * q + reg; if (t < L) G2[(size_t)(row0 + t) * DM + g * 16 + r] = (bf16)f2bf(gelu_tanh(y[reg])); }
        }
    }
}
__device__ __forceinline__ void s5_wave(const Args& a, LAS float* T, bool second, int g, int sub, int lane) {
    unsigned char* ws = a.ws;
    const bf16* H = (const bf16*)(ws + WS_H); bf16* G2 = (bf16*)(ws + WS_G2); const float* SS = (const float*)(ws + WS_SS) + MTOT;
    float* E = (float*)(ws + WS_S5E);
    const int r = lane & 15, q = lane >> 4;
    S5C C;
    float cfrf, cfif, a128r, a128i;
    {   const int gp = g * 64 + lane;
        const double lr = (double)a.in[I_LRE][gp], li = (double)a.in[I_LIM][gp], dt = exp((double)a.in[I_LDT][g]);
        const double mag = exp(lr * dt); double sn, cs; sincos_d(li * dt, sn, cs);
        const double abr = mag * cs, abi = mag * sn, den = lr * lr + li * li;
        C.ar = (float)abr; C.ai = (float)abi; cfrf = (float)(((abr - 1.0) * lr + abi * li) / den); cfif = (float)((abi * lr - (abr - 1.0) * li) / den);
        const double m128 = exp(lr * dt * (double)S5_SEG); sincos_d(li * dt * (double)S5_SEG, sn, cs); a128r = (float)(m128 * cs); a128i = (float)(m128 * sn); }
    ld_f8(a.in[I_NMIX] + DM + g * 16 + 8 * (q & 1), C.nwa);
#pragma unroll
    for (int nt = 0; nt < 8; ++nt) { const int p = (16 * nt + r) & 63; const float cr_ = __shfl(cfrf, p), ci_ = __shfl(cfif, p);
        float br[8], bi[8], v[8]; ld_f8(a.in[I_BRE] + ((size_t)g * 64 + p) * 16 + 8 * (q & 1), br); ld_f8(a.in[I_BIM] + ((size_t)g * 64 + p) * 16 + 8 * (q & 1), bi);
#pragma unroll
        for (int j = 0; j < 8; ++j) { const float val = (nt < 4) ? (cr_ * br[j] - ci_ * bi[j]) : (cr_ * bi[j] + ci_ * br[j]); const float hi = bfround(val); v[j] = (q < 2) ? hi : (val - hi); }
        C.Bf[nt] = pack8(v); }
#pragma unroll
    for (int s = 0; s < 4; ++s) { float cv[8], hi[8], lo[8]; ld_f8((s < 2 ? a.in[I_CRE] : a.in[I_CIM]) + ((size_t)g * 16 + r) * 64 + 32 * (s & 1) + 8 * q, cv);
#pragma unroll
        for (int j = 0; j < 8; ++j) { const float val = (s < 2) ? cv[j] : -cv[j]; hi[j] = bfround(val); lo[j] = val - hi[j]; }
        C.Ch[s] = pack8(hi); C.Cl[s] = pack8(lo); }
    {   const float dv = a.in[I_S5D][g * 16 + r], dh = bfround(dv), dl = dv - dh; float v[8];
#pragma unroll
        for (int j = 0; j < 8; ++j) v[j] = ((r & 7) == j && (r >> 3) == (q & 1)) ? (q < 2 ? dh : dl) : 0.f;
        C.Df = pack8(v); }
    const int NT = second ? 4 : 12;
    u32x4 Ap; float sp_, xpr = 0.f, xpi = 0.f;
    s5_first(H, SS, g, sub * S5_SEG, lane, Ap, sp_);
#pragma unroll 1
    for (int ti = 0; ti < NT; ++ti) {
        const u32x4 Ac = Ap; const float sc_ = sp_, xcr = xpr, xci = xpi;
        if (ti + 1 < NT) { const int tn = ti + 1;
            if (tn < 4) s5_first(H, SS, g, tn * SEQ + sub * S5_SEG, lane, Ap, sp_);
            else { const int bn = sub * 8 + (tn - 4); s5_first(H, SS, g, MP + bn * DECS, lane, Ap, sp_); const size_t so = ((size_t)bn * 128 + g) * 64 + lane; xpr = a.in[I_S5RE][so]; xpi = a.in[I_S5IM][so]; } }
        if (ti < 4) { const int b = ti, row0 = b * SEQ + sub * S5_SEG; float* Eb = E + (((size_t)b * 128 + g) * S5_NSEG) * 128;
            if (!second) { float xr = 0.f, xi = 0.f; s5_run<false>(C, H, SS, G2, T, g, row0, S5_SEG, xr, xi, lane, Ac, sc_); Eb[sub * 128 + lane] = xr; Eb[sub * 128 + 64 + lane] = xi; }
            else { float er[15], ei[15];
#pragma unroll
                for (int m = 0; m < 15; ++m) { const int mm = m < sub ? m : 0; er[m] = Eb[mm * 128 + lane]; ei[m] = Eb[mm * 128 + 64 + lane]; }
                float xr = 0.f, xi = 0.f;
#pragma unroll
                for (int m = 0; m < 15; ++m) if (m < sub) { const float nr = a128r * xr - a128i * xi + er[m], ni = a128r * xi + a128i * xr + ei[m]; xr = nr; xi = ni; }
                s5_run<true>(C, H, SS, G2, T, g, row0, S5_SEG, xr, xi, lane, Ac, sc_);
                if (sub == S5_NSEG - 1) { const size_t so = ((size_t)b * 128 + g) * 64 + lane; a.out[O_S5R_P + so] = xr; a.out[O_S5I_P + so] = xi; } }
        } else { const int b = sub * 8 + (ti - 4); const size_t so = ((size_t)b * 128 + g) * 64 + lane;
            float xr = xcr, xi = xci;
            s5_run<true>(C, H, SS, G2, T, g, MP + b * DECS, DECS, xr, xi, lane, Ac, sc_);
            a.out[O_S5R_S + so] = xr; a.out[O_S5I_S + so] = xi; }
    }
}
__device__ __forceinline__ void ph_s5(const Args& a, LAS unsigned char* lds, bool second, int lane, int wave, int gw, int NGW) {
    LAS float* T = (LAS float*)(lds + wave * S5_WAVE_LDS);
    for (int w = gw; w < 2048; w += NGW) s5_wave(a, T, second, w >> 4, w & 15, lane);
}

constexpr int S5MM_REP = 0;
constexpr int SM_WC = 0, SM_WST = 65536, SM_KT = 131072, SM_POW = 139264, SM_CF = 147968;
constexpr size_t WS_S5L = WS_ACT, WS_S5X = WS_ACT + 48 * MiB, WS_UG = WS_BIG + 64 * MiB;
typedef float f32x2_t __attribute__((ext_vector_type(2)));
__device__ __forceinline__ int s5_row(int hb, int col, int t) {
    return col < 256 ? (2 * hb + (col >> 7)) * SEQ + 16 * (col & 127) + t : MP + (64 * hb + (col - 256)) * DECS + t;
}
__device__ __forceinline__ void s5_load_u(const Args& a, int g, int hb, int cb, int lane, bf16x8 (&Uf)[8]) {
    const bf16* UG = (const bf16*)(a.ws + WS_UG0);
    const int r = lane & 15, q = lane >> 4, col = 16 * cb + r; const bool samp = col >= 256;
    const bf16* up = UG + ((size_t)g * MTOT + s5_row(hb, col, 0)) * 16 + 16 * (q >> 1) + 8 * (q & 1);
#pragma unroll
    for (int ks = 0; ks < 8; ++ks) { Uf[ks] = *(const bf16x8*)(up + ((samp && ks >= 4) ? 0 : 32 * ks)); if (samp && ks >= 4) Uf[ks] = (bf16x8){0, 0, 0, 0, 0, 0, 0, 0}; }
}
__device__ __forceinline__ void ph_s5_mm(const Args& a, LAS unsigned char* lds, int task, int tid, int lane, int wave) {
    unsigned char* ws = a.ws;
    const int g = task >> 1, hb = task & 1, r = lane & 15, q = lane >> 4;
    LAS f32x2_t* POW = (LAS f32x2_t*)(lds + SM_POW); LAS f32x2_t* CF = (LAS f32x2_t*)(lds + SM_CF);
    float* LB = (float*)(ws + WS_S5L) + (size_t)task * 320 * 128; float* XB = (float*)(ws + WS_S5X) + (size_t)task * 320 * 128;
    bf16* G2 = (bf16*)(ws + WS_G2);
    for (int rep_t = 0; rep_t < (S5MM_REP == 1 ? 2 : 1); ++rep_t) {
    __syncthreads();
    if (tid < 64) { const int gp = g * 64 + tid;
        const double lr = (double)a.in[I_LRE][gp], li = (double)a.in[I_LIM][gp], dt = exp((double)a.in[I_LDT][g]);
        const double mag = exp(lr * dt); double sn, cs; sincos_d(li * dt, sn, cs);
        const double abr = mag * cs, abi = mag * sn, den = lr * lr + li * li;
        CF[tid] = (f32x2_t){(float)(((abr - 1.0) * lr + abi * li) / den), (float)((abi * lr - (abr - 1.0) * li) / den)};
        double pr = 1.0, pi = 0.0;
#pragma unroll 1
        for (int e = 0; e <= 16; ++e) { POW[tid * 17 + e] = (f32x2_t){(float)pr, (float)pi}; const double nr = pr * abr - pi * abi, ni = pr * abi + pi * abr; pr = nr; pi = ni; } }
    __syncthreads();
    {
        const int kp = tid & 127, p = kp & 63, part = kp >> 6, s0 = 4 * (tid >> 7);
        const f32x2_t cf = CF[p]; float bbr[16], bbi[16];
#pragma unroll
        for (int c4 = 0; c4 < 4; ++c4) { const f32x4 br = *(const f32x4*)(a.in[I_BRE] + ((size_t)g * 64 + p) * 16 + 4 * c4), bi = *(const f32x4*)(a.in[I_BIM] + ((size_t)g * 64 + p) * 16 + 4 * c4);
#pragma unroll
            for (int j = 0; j < 4; ++j) { bbr[4 * c4 + j] = cf.x * br[j] - cf.y * bi[j]; bbi[4 * c4 + j] = cf.x * bi[j] + cf.y * br[j]; } }
#pragma unroll
        for (int si = 0; si < 4; ++si) { const int s = s0 + si; const f32x2_t pw = POW[p * 17 + 15 - s]; float v[16];
#pragma unroll
            for (int c = 0; c < 16; ++c) v[c] = part ? (pw.x * bbi[c] + pw.y * bbr[c]) : (pw.x * bbr[c] - pw.y * bbi[c]);
            u32x4 w0, w1; w0.x = pk2(v[0], v[1]); w0.y = pk2(v[2], v[3]); w0.z = pk2(v[4], v[5]); w0.w = pk2(v[6], v[7]); w1.x = pk2(v[8], v[9]); w1.y = pk2(v[10], v[11]); w1.z = pk2(v[12], v[13]); w1.w = pk2(v[14], v[15]);
            *(LAS u32x4*)(lds + SM_WST + kp * 512 + (((2 * s) ^ (kp & 15)) << 4)) = w0; *(LAS u32x4*)(lds + SM_WST + kp * 512 + (((2 * s + 1) ^ (kp & 15)) << 4)) = w1; }
    }
    {
        const int R = tid & 255, t = R >> 4, c = R & 15, half = tid >> 8;
#pragma unroll 4
        for (int i = 0; i < 8; ++i) { float v[8]; const f32x4 cr0 = *(const f32x4*)(a.in[I_CRE] + ((size_t)g * 16 + c) * 64 + 8 * i), cr1 = *(const f32x4*)(a.in[I_CRE] + ((size_t)g * 16 + c) * 64 + 8 * i + 4),
                                                         ci0 = *(const f32x4*)(a.in[I_CIM] + ((size_t)g * 16 + c) * 64 + 8 * i), ci1 = *(const f32x4*)(a.in[I_CIM] + ((size_t)g * 16 + c) * 64 + 8 * i + 4);
#pragma unroll
            for (int j = 0; j < 8; ++j) { const float cr = j < 4 ? cr0[j] : cr1[j - 4], ci = j < 4 ? ci0[j] : ci1[j - 4]; const f32x2_t pw = POW[(8 * i + j) * 17 + t + 1];
                v[j] = half ? -(cr * pw.y + ci * pw.x) : (cr * pw.x - ci * pw.y); }
            u32x4 w; w.x = pk2(v[0], v[1]); w.y = pk2(v[2], v[3]); w.z = pk2(v[4], v[5]); w.w = pk2(v[6], v[7]);
            *(LAS u32x4*)(lds + SM_WC + addr256(R, 8 * half + i)) = w; }
    }
    __syncthreads();
    {
        bf16x8 Bs[4];
        {   float re8[2][8], im8[2][8];
#pragma unroll
            for (int ks = 0; ks < 2; ++ks)
#pragma unroll
                for (int j = 0; j < 8; ++j) { const int p = 32 * ks + 8 * q + j; const float br = a.in[I_BRE][((size_t)g * 64 + p) * 16 + r], bi = a.in[I_BIM][((size_t)g * 64 + p) * 16 + r]; const f32x2_t cf = CF[p];
                    re8[ks][j] = cf.x * br - cf.y * bi; im8[ks][j] = cf.x * bi + cf.y * br; }
            Bs[0] = pack8(re8[0]); Bs[1] = pack8(re8[1]); Bs[2] = pack8(im8[0]); Bs[3] = pack8(im8[1]); }
#pragma unroll
        for (int di = 0; di < 2; ++di) { const int d = 2 * wave + di; f32x4 acc = {0.f, 0.f, 0.f, 0.f};
            if (d == 0) {
#pragma unroll
                for (int ks = 0; ks < 4; ++ks) { float cv[8]; ld_f8((ks < 2 ? a.in[I_CRE] : a.in[I_CIM]) + ((size_t)g * 16 + r) * 64 + 32 * (ks & 1) + 8 * q, cv);
                    if (ks >= 2) {
#pragma unroll
                        for (int j = 0; j < 8; ++j) cv[j] = -cv[j]; }
                    acc = MFMA16(pack8(cv), Bs[ks], acc); }
#pragma unroll
                for (int reg = 0; reg < 4; ++reg) if (4 * q + reg == r) acc[reg] += a.in[I_S5D][g * 16 + r];
            } else {
#pragma unroll
                for (int ks = 0; ks < 4; ++ks) acc = MFMA16(*(const LAS bf16x8*)(lds + SM_WC + addr256(16 * (d - 1) + r, 4 * ks + q)), Bs[ks], acc); }
#pragma unroll
            for (int reg = 0; reg < 4; ++reg) *(LAS bf16*)(lds + SM_KT + ((d * 16 + 4 * q + reg) * 16 + r) * 2) = (bf16)f2bf(acc[reg]); }
    }
    __syncthreads();
    }
    for (int rep_1 = 0; rep_1 < (S5MM_REP == 2 ? 2 : 1); ++rep_1) {
    for (int cb = wave; cb < 20; cb += NWAVES) {
        bf16x8 Uf[8]; s5_load_u(a, g, hb, cb, lane, Uf);
        bf16x8 Fa[8], Fb[8];
#define LDW(F, mt_) do { _Pragma("unroll") for (int ks = 0; ks < 8; ++ks) { const int row = 16 * (mt_) + r; F[ks] = *(const LAS bf16x8*)(lds + SM_WST + row * 512 + (((4 * ks + q) ^ (row & 15)) << 4)); } } while (0)
#define MMW(F, mt_) do { f32x4 acc = {0.f, 0.f, 0.f, 0.f}; _Pragma("unroll") for (int ks = 0; ks < 8; ++ks) acc = MFMA16(F[ks], Uf[ks], acc); *(f32x4*)(LB + (size_t)(16 * cb + r) * 128 + 16 * (mt_) + 4 * q) = acc; } while (0)
        LDW(Fa, 0);
#pragma unroll
        for (int m2 = 0; m2 < 4; ++m2) { LDW(Fb, 2 * m2 + 1); __builtin_amdgcn_sched_barrier(0); MMW(Fa, 2 * m2); __builtin_amdgcn_sched_barrier(0);
            if (m2 < 3) LDW(Fa, 2 * m2 + 2); __builtin_amdgcn_sched_barrier(0); MMW(Fb, 2 * m2 + 1); __builtin_amdgcn_sched_barrier(0); }
#undef LDW
#undef MMW
    }
    __syncthreads();
    }
    for (int rep_2 = 0; rep_2 < (S5MM_REP == 3 ? 2 : 1); ++rep_2) {
    if (wave < 2) {
        const int b = 2 * hb + wave; const f32x2_t a16 = POW[lane * 17 + 16]; float xr = 0.f, xi = 0.f;
        const float* lp = LB + (size_t)(wave * 128) * 128; float* xp = XB + (size_t)(wave * 128) * 128;
        float lr_[8], li_[8], nr_[8], ni_[8];
#pragma unroll
        for (int k = 0; k < 8; ++k) { lr_[k] = lp[(size_t)k * 128 + lane]; li_[k] = lp[(size_t)k * 128 + 64 + lane]; }
#pragma unroll 1
        for (int n0 = 0; n0 < 128; n0 += 8) {
            const int nn = n0 + 8 < 128 ? n0 + 8 : n0;
#pragma unroll
            for (int k = 0; k < 8; ++k) { nr_[k] = lp[(size_t)(nn + k) * 128 + lane]; ni_[k] = lp[(size_t)(nn + k) * 128 + 64 + lane]; }
#pragma unroll
            for (int k = 0; k < 8; ++k) { xp[(size_t)(n0 + k) * 128 + lane] = xr; xp[(size_t)(n0 + k) * 128 + 64 + lane] = xi;
                const float nr = a16.x * xr - a16.y * xi + lr_[k], ni = a16.x * xi + a16.y * xr + li_[k]; xr = nr; xi = ni; }
#pragma unroll
            for (int k = 0; k < 8; ++k) { lr_[k] = nr_[k]; li_[k] = ni_[k]; } }
        const size_t so = ((size_t)b * 128 + g) * 64 + lane; a.out[O_S5R_P + so] = xr; a.out[O_S5I_P + so] = xi;
    } else if (wave < 6) {
        const f32x2_t a16 = POW[lane * 17 + 16], a8 = POW[lane * 17 + 8]; const float inv = 1.0f / (a8.x * a8.x + a8.y * a8.y), i8r = a8.x * inv, i8i = -a8.y * inv;
#pragma unroll 1
        for (int j = 0; j < 16; ++j) { const int sc = 16 * (wave - 2) + j, col = 256 + sc, bs = 64 * hb + sc; const size_t so = ((size_t)bs * 128 + g) * 64 + lane;
            const float xr = a.in[I_S5RE][so], xi = a.in[I_S5IM][so]; XB[(size_t)col * 128 + lane] = xr; XB[(size_t)col * 128 + 64 + lane] = xi;
            const float zr = a16.x * xr - a16.y * xi + LB[(size_t)col * 128 + lane], zi = a16.x * xi + a16.y * xr + LB[(size_t)col * 128 + 64 + lane];
            a.out[O_S5R_S + so] = zr * i8r - zi * i8i; a.out[O_S5I_S + so] = zr * i8i + zi * i8r; }
    }
    __syncthreads();
    }
    for (int rep_3 = 0; rep_3 < (S5MM_REP == 4 ? 2 : 1); ++rep_3) {
    for (int cb = wave; cb < 20; cb += NWAVES) {
        bf16x8 Uf[8], Xf[4]; s5_load_u(a, g, hb, cb, lane, Uf);
        const int col = 16 * cb + r; const bool samp = col >= 256;
#pragma unroll
        for (int ks = 0; ks < 4; ++ks) { float x[8]; ld_f8(XB + (size_t)col * 128 + 32 * ks + 8 * q, x); Xf[ks] = pack8(x); }
#pragma unroll
        for (int t = 0; t < 16; ++t) { f32x4 acc = {0.f, 0.f, 0.f, 0.f};
            bf16x8 Fk[8], Fw[4];
#pragma unroll
            for (int ks = 0; ks <= t / 2; ++ks) { const int d = t - 2 * ks - (q >> 1);
                Fk[ks] = *(const LAS bf16x8*)(lds + SM_KT + (((d < 0 ? 0 : d) * 16 + r) * 16 + 8 * (q & 1)) * 2); if (d < 0) Fk[ks] = (bf16x8){0, 0, 0, 0, 0, 0, 0, 0}; }
#pragma unroll
            for (int ks = 0; ks < 4; ++ks) Fw[ks] = *(const LAS bf16x8*)(lds + SM_WC + addr256(16 * t + r, 4 * ks + q));
            __builtin_amdgcn_sched_barrier(0);
#pragma unroll
            for (int ks = 0; ks <= t / 2; ++ks) acc = MFMA16(Fk[ks], Uf[ks], acc);
#pragma unroll
            for (int ks = 0; ks < 4; ++ks) acc = MFMA16(Fw[ks], Xf[ks], acc);
            if (!samp || t < 8) { u32x2 o; o.x = cvtpk(gelu_tanh_fast(acc[0]), gelu_tanh_fast(acc[1])); o.y = cvtpk(gelu_tanh_fast(acc[2]), gelu_tanh_fast(acc[3]));
                *(u32x2*)(G2 + (size_t)s5_row(hb, col, t) * DM + g * 16 + 4 * q) = o; }
            asm volatile("" ::: "memory"); }
    }
    }
}

constexpr int N_PHASES = 21;
constexpr unsigned DUPMASK = 0u;
constexpr int P3PROBE = 0;
__global__ void __launch_bounds__(NTHR, 2) fwd_kernel(Args a) {
    extern __shared__ __attribute__((aligned(16))) unsigned char lds_raw[];
    LAS unsigned char* lds = (LAS unsigned char*)lds_raw;
    const int tid = threadIdx.x, lane = tid & 63, wave = __builtin_amdgcn_readfirstlane(tid >> 6);
    constexpr int G = 256;
    const int gw = blockIdx.x * NWAVES + wave, NGW = G * NWAVES;
    unsigned char* ws = a.ws;
    const int lo = a.ph_lo, hi = a.ph_hi;
    volatile LAS unsigned* MISC = (volatile LAS unsigned*)(lds + MISC_OFF);
    if (tid < 64) MISC[tid] = 0u;
    __syncthreads();
    XcdBarrier bar = xcd_barrier_post((unsigned*)(ws + WS_CTL) + CW_BAR, MISC + 8);
#define IN(k) (lo <= (k) && (k) < hi)
#define SEAM(k) do { if (IN(k) && IN((k) + 1)) xcd_barrier(bar); } while (0)
#define PHASE(k, ...) if (IN(k)) { __VA_ARGS__ if ((DUPMASK >> (k)) & 1u) { xcd_barrier(bar); __VA_ARGS__ } } SEAM(k);
#define GEMM_PHASE(EPI, Aop, Bop, N_, K_, E_) do { pg8::Gemm g{(const pg8::bf16_t*)(Aop), (const pg8::bf16_t*)(Bop), MTOT, (N_), (K_), (K_)}; pg8::StaticOrder S; S.init(MTOT, (N_), G, (int)blockIdx.x); \
        pg8::gemm_phase<EPI, pg8::StaticOrder, true, true>(lds, g, S, E_); } while (0)
#define SS ((float*)(ws + WS_SS))
#define X ((float*)(ws + WS_X))
#define H ((bf16*)(ws + WS_H))
#define G2 ((bf16*)(ws + WS_G2))
#define BIG ((bf16*)(ws + WS_BIG))
#define ACT ((bf16*)(ws + WS_ACT))

    PHASE(0, ph_prologue(a, lds, tid, lane, wave, gw, NGW, G);)
    PHASE(1, pg8::EpiBf16Plain E{BIG, NPROJ}; GEMM_PHASE(pg8::EpiBf16Plain, H, ws + WS_WIN, NPROJ, 2048, E);)
    PHASE(2, ph_mix_prep(a, lds, tid, lane, wave, gw, NGW, G);)
    if (IN(3)) { ph_scans(a, lds, tid, lane, wave, G); if (P3PROBE) { xcd_barrier(bar); ph_scans(a, lds, tid, lane, wave, G, P3PROBE); } } SEAM(3);
    PHASE(4, ph_mix_norm(a, lane, gw, NGW);)
    PHASE(5, pg8::EpiResNorm E{X, H, SS, DM, a.in[I_XP], a.in[I_XS]}; GEMM_PHASE(pg8::EpiResNorm, G2, ws + WS_WOUT, 2048, 2048, E);
             if (G == 256 && blockIdx.x >= 32) convert_group(a, 3, (LAS float*)(lds + wave * 8704), lane, ((int)blockIdx.x - 32) * NWAVES + wave, 224 * NWAVES);)
    PHASE(7, if (G == 256) { pg8::EpiBf16Rstd E{BIG, NUP, SS};
                    if (((int)blockIdx.x & 7) < 4) { convert_group(a, 2, (LAS float*)(lds + wave * 8704), lane, (int)blockIdx.x * NWAVES + wave, 256 * NWAVES); __syncthreads(); }
                    { const int L = (int)blockIdx.x - 128; pg8::Gemm g{(const pg8::bf16_t*)H, (const pg8::bf16_t*)(ws + WS_WUP), MTOT, NUP, 2048, 2048}; pg8::PlusOne S; S.init(MP, NUP, G, (int)blockIdx.x); S.extra = pg8::Unit{32 + (L & 3), L >> 2}; S.has_extra = L >= 0;
                      pg8::gemm_phase<pg8::EpiBf16Rstd, pg8::PlusOne, true, true>(lds, g, S, E); }
                    if (((int)blockIdx.x & 7) >= 4) convert_group(a, 2, (LAS float*)(lds + wave * 8704), lane, (int)blockIdx.x * NWAVES + wave, 256 * NWAVES); }
                  else { pg8::EpiBf16Rstd E{BIG, NUP, SS}; GEMM_PHASE(pg8::EpiBf16Rstd, H, ws + WS_WUP, NUP, 2048, E); })
    PHASE(18, if (G == 256) { if (blockIdx.x < 48) { pg8::EpiBf16Rstd E{BIG, NUP, SS};
                        const int L = 128 + (int)blockIdx.x; pg8::Gemm g{(const pg8::bf16_t*)H, (const pg8::bf16_t*)(ws + WS_WUP), MTOT, NUP, 2048, 2048}; pg8::OneUnit S{{32 + (L & 3), L >> 2}, true}; pg8::gemm_phase<pg8::EpiBf16Rstd, pg8::OneUnit, true, true>(lds, g, S, E); }
                      else ffn_conv_prompt(a, 0, lane, ((int)blockIdx.x - 48) * NWAVES + wave, 208 * NWAVES); }
                  else ffn_conv_prompt(a, 0, lane, gw, NGW);)
    PHASE(8, ffn_conv_sample(a, 0, lane, gw, NGW);)
    PHASE(9, { pg8::EpiResNorm E{X, H, SS + MTOT, DM, X, X + (size_t)8192 * DM};
                 pg8::Gemm g{(const pg8::bf16_t*)ACT, (const pg8::bf16_t*)(ws + WS_WDN), MP, 2048, DFF, DFF}; pg8::StaticOrder S; S.init(MP, 2048, G, (int)blockIdx.x);
                 pg8::gemm_phase<pg8::EpiResNorm, pg8::StaticOrder, true, true>(lds, g, S, E); }
               { const int p = (int)blockIdx.x, kq = p & 3, un = p >> 2;
                 pg8::EpiSlab E{(float*)BIG + (size_t)kq * MS * DM, DM};
                 pg8::Gemm g{(const pg8::bf16_t*)ACT + kq * 1408, (const pg8::bf16_t*)(ws + WS_WDN) + kq * 1408, MTOT, 2048, 1408, DFF};
                 pg8::OneUnit S{{32 + (un & 3), un >> 2}, p < 128};
                 pg8::gemm_phase<pg8::EpiSlab, pg8::OneUnit, true, true>(lds, g, S, E); }
               )
    PHASE(10, ph_combine<false>(X, H, SS + MTOT, (const float*)BIG, lane, gw, NGW, (bf16*)(ws + WS_UG0), a.in[I_NMIX] + DM);
              ph_ug_prompt(H, SS + MTOT, a.in[I_NMIX] + DM, (bf16*)(ws + WS_UG0), lane, gw, NGW);)
    PHASE(11, if (G == 256) ph_s5_mm(a, lds, (int)blockIdx.x, tid, lane, wave); else { for (int task = (int)blockIdx.x; task < 256; task += G) ph_s5_mm(a, lds, task, tid, lane, wave); })
    PHASE(12, { pg8::EpiGluRes E{X, H, SS + 2 * MTOT, DM};
                  pg8::Gemm g{(const pg8::bf16_t*)G2, (const pg8::bf16_t*)(ws + WS_WGLU), MP, NGLU, 2048, 2048}; pg8::StaticOrder S; S.init(MP, NGLU, G, (int)blockIdx.x);
                  pg8::gemm_phase<pg8::EpiGluRes, pg8::StaticOrder, true, true>(lds, g, S, E); }
                { const int p = (int)blockIdx.x, kq = p & 3, un = p >> 2;
                  pg8::EpiSlab E{(float*)BIG + (size_t)kq * MS * NGLU, NGLU};
                  pg8::Gemm g{(const pg8::bf16_t*)G2 + kq * 512, (const pg8::bf16_t*)(ws + WS_WGLU) + kq * 512, MTOT, NGLU, 512, 2048};
                  pg8::OneUnit S{{32 + (un & 3), un >> 2}, true};
                  pg8::gemm_phase<pg8::EpiSlab, pg8::OneUnit, true, true>(lds, g, S, E); })
    PHASE(13, ph_combine<true>(X, H, SS + 2 * MTOT, (const float*)BIG, lane, gw, NGW);)
    PHASE(14, if (G == 256) { pg8::EpiBf16Rstd E{BIG, NUP, SS + 2 * MTOT};
                    { const int L = (int)blockIdx.x - 128; pg8::Gemm g{(const pg8::bf16_t*)H, (const pg8::bf16_t*)(ws + WS_WUP + (size_t)NUP * 2048 * 2), MTOT, NUP, 2048, 2048}; pg8::PlusOne S; S.init(MP, NUP, G, (int)blockIdx.x); S.extra = pg8::Unit{32 + (L & 3), L >> 2}; S.has_extra = L >= 0;
                      pg8::gemm_phase<pg8::EpiBf16Rstd, pg8::PlusOne, true, true>(lds, g, S, E); } }
                  else { pg8::EpiBf16Rstd E{BIG, NUP, SS + 2 * MTOT}; GEMM_PHASE(pg8::EpiBf16Rstd, H, ws + WS_WUP + (size_t)NUP * 2048 * 2, NUP, 2048, E); })
    PHASE(19, if (G == 256) { if (blockIdx.x < 48) { pg8::EpiBf16Rstd E{BIG, NUP, SS + 2 * MTOT};
                        const int L = 128 + (int)blockIdx.x; pg8::Gemm g{(const pg8::bf16_t*)H, (const pg8::bf16_t*)(ws + WS_WUP + (size_t)NUP * 2048 * 2), MTOT, NUP, 2048, 2048}; pg8::OneUnit S{{32 + (L & 3), L >> 2}, true}; pg8::gemm_phase<pg8::EpiBf16Rstd, pg8::OneUnit, true, true>(lds, g, S, E); }
                      else ffn_conv_prompt(a, 1, lane, ((int)blockIdx.x - 48) * NWAVES + wave, 208 * NWAVES); }
                  else ffn_conv_prompt(a, 1, lane, gw, NGW);)
    PHASE(15, ffn_conv_sample(a, 1, lane, gw, NGW);)
    PHASE(16, { pg8::EpiResNorm E{X, H, SS + 3 * MTOT, DM, X, X + (size_t)8192 * DM};
                  pg8::Gemm g{(const pg8::bf16_t*)ACT, (const pg8::bf16_t*)(ws + WS_WDN + (size_t)2048 * DFF * 2), MP, 2048, DFF, DFF}; pg8::StaticOrder S; S.init(MP, 2048, G, (int)blockIdx.x);
                  pg8::gemm_phase<pg8::EpiResNorm, pg8::StaticOrder, true, true>(lds, g, S, E); }
                { const int p = (int)blockIdx.x, kq = p & 3, un = p >> 2;
                  pg8::EpiSlab E{(float*)BIG + (size_t)kq * MS * DM, DM};
                  pg8::Gemm g{(const pg8::bf16_t*)ACT + kq * 1408, (const pg8::bf16_t*)(ws + WS_WDN + (size_t)2048 * DFF * 2) + kq * 1408, MTOT, 2048, 1408, DFF};
                  pg8::OneUnit S{{32 + (un & 3), un >> 2}, p < 128};
                  pg8::gemm_phase<pg8::EpiSlab, pg8::OneUnit, true, true>(lds, g, S, E); })
    if (IN(17)) { int t17 = threadIdx.x; asm volatile("" : "+v"(t17));
                  ph_rms_out(X, SS + 3 * MTOT, (const float*)BIG, a.in[I_NFIN], a.out + O_Y, t17 & 63, (int)blockIdx.x * NWAVES + __builtin_amdgcn_readfirstlane(t17 >> 6), NGW); }
#undef IN
#undef SEAM
#undef GEMM_PHASE
#undef SS
#undef X
#undef H
#undef G2
#undef BIG
#undef ACT
}

#ifndef MK_PER_PHASE
#define MK_PER_PHASE 0
#endif
extern "C" void kernel_launch(void* const* d_in, const int* in_sizes, int n_in, void* d_out, int out_size, void* d_ws, size_t ws_size, hipStream_t stream) {
    static int grid = 0;
    if (grid == 0) {
        if (n_in != 32 || out_size != (int)O_END || ws_size < WS_END) { fprintf(stderr, "kernel_launch: unexpected shapes: n_in %d out %d (want %zu) ws %zu (want %zu); nothing launched\n", n_in, out_size, (size_t)O_END, ws_size, (size_t)WS_END); grid = -1; return; }
        int dev = 0, cus = 0, per_cu = 0;
        if (hipGetDevice(&dev) != hipSuccess || hipDeviceGetAttribute(&cus, hipDeviceAttributeMultiprocessorCount, dev) != hipSuccess) { fprintf(stderr, "kernel_launch: device query failed\n"); grid = -1; return; }
        if (hipFuncSetAttribute((const void*)fwd_kernel, hipFuncAttributeMaxDynamicSharedMemorySize, LDS_BYTES) != hipSuccess) { fprintf(stderr, "kernel_launch: hipFuncSetAttribute failed\n"); grid = -1; return; }
        if (hipOccupancyMaxActiveBlocksPerMultiprocessor(&per_cu, (const void*)fwd_kernel, NTHR, LDS_BYTES) != hipSuccess || per_cu < 1) { fprintf(stderr, "kernel_launch: occupancy query says %d blocks per CU\n", per_cu); per_cu = 1; }
        (void)hipGetLastError();
        if (cus < 256) { fprintf(stderr, "kernel_launch: this kernel needs 256 CUs (one resident workgroup each), the device has %d; nothing launched\n", cus); grid = -1; return; }
        grid = 256;
        fprintf(stderr, "kernel_launch: grid %d (occupancy query %d per CU)\n", grid, per_cu);
    }
    if (grid < 0) return;
    if (hipMemsetAsync((char*)d_ws + WS_CTL, 0, CTL_ZERO_BYTES, stream) != hipSuccess) { fprintf(stderr, "kernel_launch: hipMemsetAsync failed\n"); return; }
    Args a{};
    for (int i = 0; i < 32; ++i) a.in[i] = (const float*)d_in[i];
    a.out = (float*)d_out; a.ws = (unsigned char*)d_ws;
#if MK_PER_PHASE
    for (int ph = 0; ph < N_PHASES; ++ph) { a.ph_lo = ph; a.ph_hi = ph + 1; hipLaunchKernelGGL(fwd_kernel, dim3(grid), dim3(NTHR), LDS_BYTES, stream, a); }
#else
    a.ph_lo = 0; a.ph_hi = N_PHASES;
    void* args[] = {&a};
    hipError_t e = hipLaunchCooperativeKernel((const void*)fwd_kernel, dim3(grid), dim3(NTHR), args, LDS_BYTES, stream);
    if (e != hipSuccess) fprintf(stderr, "kernel_launch: cooperative launch failed: %s (grid %d)\n", hipGetErrorString(e), grid);
#endif
}
```

```cpp
#include <hip/hip_runtime.h>
#include <hip/hip_cooperative_groups.h>
#include <cstdio>
#include <cstdint>
#include <cmath>
namespace cg = cooperative_groups;
namespace pg8 {
#define PG8_LAS __attribute__((address_space(3)))
typedef unsigned short bf16_t;
typedef short bf16x8 __attribute__((ext_vector_type(8)));
typedef float f32x4 __attribute__((ext_vector_type(4)));
typedef unsigned u32x4 __attribute__((ext_vector_type(4)));
constexpr int BM = 256, BK = 64, HALF = 128, HTB = HALF * BK * 2  , STAGE_BYTES = 8 * HTB, NXCD = 8, WGM = 4;

__host__ __device__ __forceinline__ int lds_byte(int r, int c) { const int st = (r >> 4) * 2 + (c >> 5), rr = r & 15, cc = c & 31, ob = rr * 64 + cc * 2; return st * 1024 + (ob ^ (((ob >> 9) & 1) << 5)); }
__host__ __device__ __forceinline__ void stage_rc(int b, int& R, int& C) { const int st = b / 1024, sb = b % 1024, swz = sb ^ (((sb >> 9) & 1) << 5); R = (st >> 1) * 16 + swz / 64; C = (st & 1) * 32 + (swz % 64) / 2; }
__host__ __device__ __forceinline__ int perm32(int rho) { const int n = rho >> 4, i = rho & 15; return 8 * (i >> 2) + 4 * n + (i & 3); }

struct Unit { int pm, pn; };
struct Gemm { const bf16_t* A; const bf16_t* Bt; int M, N, K, ldk; };

struct StaticOrder {
    int nM, nN, nwg, G, c;
    __host__ __device__ void init(int M, int N, int G_, int c_) { nM = M / BM; nN = N / BM; nwg = nM * nN; G = G_; c = c_; }
    __host__ __device__ bool next(int i, Unit& u) const {
        const long L = (long)i * G + c; if (L >= nwg) return false;
        int wgid = (int)L; { const int q = nwg / NXCD, r = nwg % NXCD, xcd = wgid % NXCD, off = wgid / NXCD; wgid = (xcd < r ? xcd * (q + 1) : r * (q + 1) + (xcd - r) * q) + off; }
        const int nig = WGM * nN, gid = wgid / nig, fm = gid * WGM, gsz = (nM - fm) < WGM ? (nM - fm) : WGM;
        u.pm = fm + ((wgid % nig) % gsz); u.pn = (wgid % nig) / gsz; return true;
    }
    __device__ __forceinline__ void a_ready(const Unit&) const {}
    __device__ __forceinline__ void done(const Unit&) const {}
};

__device__ __forceinline__ unsigned cvt_pk_bf16(float lo, float hi) { unsigned r; asm volatile("v_cvt_pk_bf16_f32 %0, %1, %2" : "=v"(r) : "v"(lo), "v"(hi)); return r; }

struct EpiBf16Plain {
    static constexpr bool PERM = true, AFTER_DRAIN = false;
    bf16_t* O; int ldc;
    __device__ __forceinline__ void operator()(const f32x4 (&acc)[2][2][4][2], const Unit& u, int wr, int wc, int fr, int fq) const {
        const int row0 = u.pm * BM + wr * 64 + fr, col0 = u.pn * BM + wc * 32 + 8 * fq;
#pragma unroll
        for (int ai = 0; ai < 2; ++ai)
#pragma unroll
            for (int m = 0; m < 4; ++m) { bf16_t* rowp = O + (size_t)(row0 + ai * HALF + m * 16) * ldc + col0;
#pragma unroll
                for (int bj = 0; bj < 2; ++bj) { const f32x4 v0 = acc[ai][bj][m][0], v1 = acc[ai][bj][m][1];
                    u32x4 w; w.x = cvt_pk_bf16(v0[0], v0[1]); w.y = cvt_pk_bf16(v0[2], v0[3]); w.z = cvt_pk_bf16(v1[0], v1[1]); w.w = cvt_pk_bf16(v1[2], v1[3]);
                    *(u32x4*)(rowp + bj * HALF) = w; } }
    }
};
struct EpiResF32 {
    static constexpr bool PERM = false, AFTER_DRAIN = false;
    float* X; int ldc;
    __device__ __forceinline__ void operator()(const f32x4 (&acc)[2][2][4][2], const Unit& u, int wr, int wc, int fr, int fq) const {
        const int row0 = u.pm * BM + wr * 64 + fr, col0 = u.pn * BM + wc * 32 + 4 * fq;
#pragma unroll
        for (int ai = 0; ai < 2; ++ai)
#pragma unroll
            for (int m = 0; m < 4; ++m) { float* rowp = X + (size_t)(row0 + ai * HALF + m * 16) * ldc + col0;
#pragma unroll
                for (int bj = 0; bj < 2; ++bj)
#pragma unroll
                    for (int n = 0; n < 2; ++n) { f32x4* p = (f32x4*)(rowp + bj * HALF + n * 16); *p = *p + acc[ai][bj][m][n]; }
                asm volatile("" ::: "memory"); }
    }
};
struct PlusOne : StaticOrder {
    Unit extra; bool has_extra;
    __device__ bool next(int i, Unit& u) const {
        if (StaticOrder::next(i, u)) return true;
        const int np = (nwg - c + G - 1) / G;
        if (has_extra && i == np) { u = extra; return true; }
        return false;
    }
};
struct OneUnit {
    Unit u; bool valid;
    __device__ bool next(int i, Unit& o) const { if (i != 0 || !valid) return false; o = u; return true; }
    __device__ __forceinline__ void a_ready(const Unit&) const {}
    __device__ __forceinline__ void done(const Unit&) const {}
};
struct EpiSlab {
    static constexpr bool PERM = false, AFTER_DRAIN = false;
    float* S; int ldc;
    __device__ __forceinline__ void operator()(const f32x4 (&acc)[2][2][4][2], const Unit& u, int wr, int wc, int fr, int fq) const {
        const int row0 = (u.pm - 32) * BM + wr * 64 + fr, col0 = u.pn * BM + wc * 32 + 4 * fq;
#pragma unroll
        for (int ai = 0; ai < 2; ++ai)
#pragma unroll
            for (int m = 0; m < 4; ++m) { float* rowp = S + (size_t)(row0 + ai * HALF + m * 16) * ldc + col0;
#pragma unroll
                for (int bj = 0; bj < 2; ++bj)
#pragma unroll
                    for (int n = 0; n < 2; ++n) *(f32x4*)(rowp + bj * HALF + n * 16) = acc[ai][bj][m][n]; }
    }
};
struct EpiResNorm {
    static constexpr bool PERM = false, AFTER_DRAIN = false;
    float* X; bf16_t* XB; float* SS; int ldc; const float* R0; const float* R1;
    __device__ __forceinline__ void operator()(const f32x4 (&acc)[2][2][4][2], const Unit& u, int wr, int wc, int fr, int fq) const {
        const int row0 = u.pm * BM + wr * 64 + fr, col0 = u.pn * BM + wc * 32 + 4 * fq;
        const float* Rb = (u.pm < 32) ? R0 : R1 - (size_t)8192 * ldc;
#pragma unroll
        for (int ap = 0; ap < 4; ++ap) {
            const int ai = ap >> 1, m0 = (ap & 1) * 2;
            f32x4 res[2][4];
#pragma unroll
            for (int mm = 0; mm < 2; ++mm) { const float* rp = Rb + (size_t)(row0 + ai * HALF + (m0 + mm) * 16) * ldc + col0;
#pragma unroll
                for (int i = 0; i < 4; ++i) res[mm][i] = *(const f32x4*)(rp + (i >> 1) * HALF + (i & 1) * 16); }
#pragma unroll
            for (int mm = 0; mm < 2; ++mm) { const int m = m0 + mm, row = row0 + ai * HALF + m * 16; float* rowp = X + (size_t)row * ldc + col0; bf16_t* rowb = XB + (size_t)row * ldc + col0; float ss = 0.f;
#pragma unroll
                for (int i = 0; i < 4; ++i) { const int bj = i >> 1, n = i & 1; const f32x4 v = res[mm][i] + acc[ai][bj][m][n]; *(f32x4*)(rowp + bj * HALF + n * 16) = v;
                    ss += (v[0] * v[0] + v[1] * v[1]) + (v[2] * v[2] + v[3] * v[3]);
                    unsigned lo = cvt_pk_bf16(v[0], v[1]), hi = cvt_pk_bf16(v[2], v[3]); *(unsigned long long*)(rowb + bj * HALF + n * 16) = ((unsigned long long)hi << 32) | lo; }
                ss += __shfl_xor(ss, 16); ss += __shfl_xor(ss, 32);
                if (fq == 0) atomicAdd(SS + row, ss); }
            asm volatile("" ::: "memory"); }
    }
};
struct EpiBf16Rstd {
    static constexpr bool PERM = true, AFTER_DRAIN = false;
    bf16_t* O; int ldc; const float* SS;
    __device__ __forceinline__ void operator()(const f32x4 (&acc)[2][2][4][2], const Unit& u, int wr, int wc, int fr, int fq) const {
        const int row0 = u.pm * BM + wr * 64 + fr, col0 = u.pn * BM + wc * 32 + 8 * fq;
        float ssv[8];
#pragma unroll
        for (int g = 0; g < 8; ++g) ssv[g] = SS[row0 + (g >> 2) * HALF + (g & 3) * 16];
#pragma unroll
        for (int ai = 0; ai < 2; ++ai)
#pragma unroll
            for (int m = 0; m < 4; ++m) { const int row = row0 + ai * HALF + m * 16; bf16_t* rowp = O + (size_t)row * ldc + col0; const float rs = 1.0f / sqrtf(ssv[ai * 4 + m] * (1.0f / 2048.0f) + 1e-6f);
#pragma unroll
                for (int bj = 0; bj < 2; ++bj) { const f32x4 v0 = acc[ai][bj][m][0] * rs, v1 = acc[ai][bj][m][1] * rs;
                    u32x4 w; w.x = cvt_pk_bf16(v0[0], v0[1]); w.y = cvt_pk_bf16(v0[2], v0[3]); w.z = cvt_pk_bf16(v1[0], v1[1]); w.w = cvt_pk_bf16(v1[2], v1[3]);
                    *(u32x4*)(rowp + bj * HALF) = w; } }
    }
};
struct EpiGluRes {
    static constexpr bool PERM = false, AFTER_DRAIN = false;
    float* X; bf16_t* XB; float* SS; int ldc;
    __device__ __forceinline__ void operator()(const f32x4 (&acc)[2][2][4][2], const Unit& u, int wr, int wc, int fr, int fq) const {
        const int row0 = u.pm * BM + wr * 64 + fr, col0 = u.pn * HALF + wc * 32 + 4 * fq;
        f32x4 res[8][2];
#pragma unroll
        for (int g = 0; g < 8; ++g)
#pragma unroll
            for (int n = 0; n < 2; ++n) res[g][n] = *(const f32x4*)(X + (size_t)(row0 + (g >> 2) * HALF + (g & 3) * 16) * ldc + col0 + n * 16);
#pragma unroll
        for (int g = 0; g < 8; ++g) { const int ai = g >> 2, m = g & 3, row = row0 + ai * HALF + m * 16; float* rowp = X + (size_t)row * ldc + col0; bf16_t* rowb = XB + (size_t)row * ldc + col0; float ss = 0.f;
#pragma unroll
            for (int n = 0; n < 2; ++n) { const f32x4 v = acc[ai][0][m][n], gt = acc[ai][1][m][n]; f32x4 o = res[g][n];
#pragma unroll
                for (int j = 0; j < 4; ++j) o[j] += v[j] / (1.0f + __expf(-gt[j]));
                *(f32x4*)(rowp + n * 16) = o; ss += (o[0] * o[0] + o[1] * o[1]) + (o[2] * o[2] + o[3] * o[3]);
                unsigned lo = cvt_pk_bf16(o[0], o[1]), hi = cvt_pk_bf16(o[2], o[3]); *(unsigned long long*)(rowb + n * 16) = ((unsigned long long)hi << 32) | lo; }
            ss += __shfl_xor(ss, 16); ss += __shfl_xor(ss, 32);
            if (fq == 0) atomicAdd(SS + row, ss); }
    }
};

template <class Epi, class Sched, bool ALIGN_EPI = false, bool SP2 = false>
__device__ __forceinline__ void gemm_phase(PG8_LAS unsigned char* lds, const Gemm g, const Sched& S, const Epi& E) {
    const int tid = threadIdx.x, wid = __builtin_amdgcn_readfirstlane(tid >> 6), lane = tid & 63, wr = wid >> 2, wc = wid & 3, fr = lane & 15, fq = lane >> 4;
    const int K = g.ldk, nt = g.K / BK;
    unsigned voffA[2], voffB[2];
#pragma unroll
    for (int i = 0; i < 2; ++i) { int R, C; stage_rc(tid * 16 + i * 8192, R, C); const int Rb = Epi::PERM ? ((R & ~31) + perm32(R & 31)) : R;
        voffA[i] = (unsigned)(R * K + C) * 2u; voffB[i] = (unsigned)(Rb * K + C) * 2u; }
    const size_t kstep = (size_t)(BK * 2);
    const size_t hstep = (size_t)HALF * K * 2;
    const size_t tstep = 2 * hstep;
    const unsigned ldsw = (unsigned)wid * 1024u;
    const int aoff = lds_byte(wr * 64 + fr, fq * 8), boff = lds_byte(wc * 32 + fr, fq * 8);
#define PG8_SA(b, h) (((b) * 2 + (h)) * HTB)
#define PG8_SB(b, h) ((4 + (b) * 2 + (h)) * HTB)
#define PG8_STAGE(bufoff, gbase, voff) do { _Pragma("unroll") for (int _i = 0; _i < 2; ++_i) \
        __builtin_amdgcn_global_load_lds((const unsigned*)((const char*)(gbase) + (voff)[_i]), (PG8_LAS unsigned*)(lds + (bufoff) + ldsw + _i * 8192), 16, 0, 0); } while (0)
#define PG8_LDA(dst, b, h) do { _Pragma("unroll") for (int m = 0; m < 4; ++m) _Pragma("unroll") for (int k = 0; k < 2; ++k) dst[m][k] = *(const PG8_LAS bf16x8*)(lds + PG8_SA(b, h) + aoff + m * 2048 + k * 1024); } while (0)
#define PG8_LDB(dst, b, h) do { _Pragma("unroll") for (int n = 0; n < 2; ++n) _Pragma("unroll") for (int k = 0; k < 2; ++k) dst[n][k] = *(const PG8_LAS bf16x8*)(lds + PG8_SB(b, h) + boff + n * 2048 + k * 1024); } while (0)
#define PG8_MMA(ai, bj, At, Bt) do { __builtin_amdgcn_s_setprio(1); _Pragma("unroll") for (int m = 0; m < 4; ++m) _Pragma("unroll") for (int n = 0; n < 2; ++n) _Pragma("unroll") for (int k = 0; k < 2; ++k) \
        acc[ai][bj][m][n] = __builtin_amdgcn_mfma_f32_16x16x32_bf16(Bt[n][k], At[m][k], acc[ai][bj][m][n], 0, 0, 0); __builtin_amdgcn_s_setprio(0); } while (0)
#define PG8_WAIT_V(n) asm volatile("s_waitcnt vmcnt(" #n ")" ::: "memory")
#define PG8_WAIT_L(n) asm volatile("s_waitcnt lgkmcnt(" #n ")" ::: "memory")
#define PG8_BAR __builtin_amdgcn_s_barrier()
#define PG8_SCHED __builtin_amdgcn_sched_barrier(0)
    Unit cur, nxt; int ui = 0;
    if (!S.next(0, cur)) return;
    f32x4 acc[2][2][4][2];
#pragma unroll
    for (int a = 0; a < 2; ++a)
#pragma unroll
        for (int b = 0; b < 2; ++b)
#pragma unroll
            for (int m = 0; m < 4; ++m)
#pragma unroll
                for (int n = 0; n < 2; ++n) acc[a][b][m][n] = (f32x4){0.f, 0.f, 0.f, 0.f};
    bf16x8 At[4][2], B0[2][2], B1[2][2];
    const char* cA = (const char*)g.A + (size_t)cur.pm * tstep; const char* cB = (const char*)g.Bt + (size_t)cur.pn * tstep;
    S.a_ready(cur);
    if constexpr (SP2) {
        PG8_STAGE(PG8_SB(0, 0), cB, voffB); PG8_STAGE(PG8_SB(0, 1), cB + hstep, voffB); PG8_STAGE(PG8_SA(0, 0), cA, voffA); PG8_STAGE(PG8_SA(0, 1), cA + hstep, voffA);
        if (wr == 1) PG8_BAR;
        PG8_WAIT_V(2); PG8_BAR;
        PG8_STAGE(PG8_SB(1, 0), cB + kstep, voffB); PG8_STAGE(PG8_SA(1, 0), cA + kstep, voffA); PG8_STAGE(PG8_SB(1, 1), cB + hstep + kstep, voffB);
        PG8_WAIT_V(6); PG8_BAR;
    } else {
        PG8_STAGE(PG8_SB(0, 0), cB, voffB); PG8_STAGE(PG8_SA(0, 0), cA, voffA); PG8_STAGE(PG8_SB(0, 1), cB + hstep, voffB); PG8_STAGE(PG8_SA(0, 1), cA + hstep, voffA);
        if (wr == 1) PG8_BAR;
        PG8_WAIT_V(4); PG8_BAR;
        PG8_STAGE(PG8_SB(1, 0), cB + kstep, voffB); PG8_STAGE(PG8_SA(1, 0), cA + kstep, voffA); PG8_STAGE(PG8_SB(1, 1), cB + hstep + kstep, voffB);
        PG8_WAIT_V(6); PG8_BAR;
    }
    for (;;) {
        const bool has_next = S.next(ui + 1, nxt);
        const char* nA = has_next ? (const char*)g.A + (size_t)nxt.pm * tstep : cA; const char* nB = has_next ? (const char*)g.Bt + (size_t)nxt.pn * tstep : cB;
        for (int t = 0; t < nt; t += 2) {
            const bool last = (t == nt - 2);
            const char* a1 = cA + (size_t)(t + 1) * kstep;
            const char* a2 = last ? nA : cA + (size_t)(t + 2) * kstep; const char* b2 = last ? nB : cB + (size_t)(t + 2) * kstep;
            const char* a3 = a2 + kstep; const char* b3 = b2 + kstep;
            if (last && has_next) S.a_ready(nxt);
            if constexpr (SP2) {
            PG8_LDB(B0, 0, 0); PG8_LDB(B1, 0, 1); PG8_SCHED; PG8_LDA(At, 0, 0); PG8_STAGE(PG8_SA(1, 1), a1 + hstep, voffA);
            PG8_WAIT_V(8); PG8_WAIT_L(0); PG8_BAR; PG8_MMA(0, 0, At, B0); PG8_MMA(0, 1, At, B1); PG8_BAR; PG8_SCHED;
            PG8_LDA(At, 0, 1); PG8_STAGE(PG8_SB(0, 0), b2, voffB); PG8_STAGE(PG8_SB(0, 1), b2 + hstep, voffB); PG8_STAGE(PG8_SA(0, 0), a2, voffA);
            PG8_WAIT_V(8); PG8_WAIT_L(0); PG8_BAR; PG8_MMA(1, 0, At, B0); PG8_MMA(1, 1, At, B1); PG8_BAR; PG8_SCHED;
            PG8_LDB(B0, 1, 0); PG8_LDB(B1, 1, 1); PG8_SCHED; PG8_LDA(At, 1, 0); PG8_STAGE(PG8_SA(0, 1), a2 + hstep, voffA);
            PG8_WAIT_V(8); PG8_WAIT_L(0); PG8_BAR; PG8_MMA(0, 0, At, B0); PG8_MMA(0, 1, At, B1); PG8_BAR; PG8_SCHED;
            PG8_LDA(At, 1, 1); PG8_STAGE(PG8_SB(1, 0), b3, voffB); PG8_STAGE(PG8_SB(1, 1), b3 + hstep, voffB); PG8_STAGE(PG8_SA(1, 0), a3, voffA);
            PG8_WAIT_V(8); PG8_WAIT_L(0); PG8_BAR; PG8_MMA(1, 0, At, B0); PG8_MMA(1, 1, At, B1); PG8_BAR; PG8_SCHED;
            } else {
            PG8_LDB(B0, 0, 0); PG8_SCHED; PG8_LDA(At, 0, 0); PG8_STAGE(PG8_SA(1, 1), a1 + hstep, voffA);
            PG8_WAIT_L(8); PG8_BAR; PG8_WAIT_L(0); PG8_MMA(0, 0, At, B0); PG8_BAR; PG8_SCHED;
            PG8_LDB(B1, 0, 1); PG8_STAGE(PG8_SB(0, 0), b2, voffB);
            PG8_BAR; PG8_WAIT_L(0); PG8_MMA(0, 1, At, B1); PG8_BAR;
            PG8_LDA(At, 0, 1); PG8_STAGE(PG8_SA(0, 0), a2, voffA);
            PG8_BAR; PG8_WAIT_L(0); PG8_MMA(1, 0, At, B0); PG8_BAR; PG8_SCHED;
            PG8_STAGE(PG8_SB(0, 1), b2 + hstep, voffB);
            PG8_WAIT_V(6); PG8_BAR; PG8_MMA(1, 1, At, B1); PG8_BAR;
            PG8_LDB(B0, 1, 0); PG8_SCHED; PG8_LDA(At, 1, 0); PG8_STAGE(PG8_SA(0, 1), a2 + hstep, voffA);
            PG8_WAIT_L(8); PG8_BAR; PG8_WAIT_L(0); PG8_MMA(0, 0, At, B0); PG8_BAR; PG8_SCHED;
            PG8_LDB(B1, 1, 1); PG8_STAGE(PG8_SB(1, 0), b3, voffB);
            PG8_BAR; PG8_WAIT_L(0); PG8_MMA(0, 1, At, B1); PG8_BAR;
            PG8_LDA(At, 1, 1); PG8_STAGE(PG8_SA(1, 0), a3, voffA);
            PG8_BAR; PG8_WAIT_L(0); PG8_MMA(1, 0, At, B0); PG8_BAR; PG8_SCHED;
            PG8_STAGE(PG8_SB(1, 1), b3 + hstep, voffB);
            PG8_WAIT_V(6); PG8_BAR; PG8_MMA(1, 1, At, B1); PG8_BAR;
            }
        }
        if constexpr (ALIGN_EPI) { if (wr == 0) PG8_BAR; }
        if constexpr (!Epi::AFTER_DRAIN) { E(acc, cur, wr, wc, fr, fq); S.done(cur); }
        if (!has_next) break;
#pragma unroll
        for (int a = 0; a < 2; ++a)
#pragma unroll
            for (int b = 0; b < 2; ++b)
#pragma unroll
                for (int m = 0; m < 4; ++m)
#pragma unroll
                    for (int n = 0; n < 2; ++n) acc[a][b][m][n] = (f32x4){0.f, 0.f, 0.f, 0.f};
        cur = nxt; cA = nA; cB = nB; ++ui;
        if constexpr (ALIGN_EPI) { if (wr == 1) PG8_BAR; }
    }
    PG8_WAIT_V(0);
    if constexpr (!ALIGN_EPI) { if (wr == 0) PG8_BAR; }
    PG8_BAR;
    if constexpr (Epi::AFTER_DRAIN) { E.fused(acc, cur, wr, wc, fr, fq, lds, wid, lane); S.done(cur); }
#undef PG8_SA
#undef PG8_SB
#undef PG8_STAGE
#undef PG8_LDA
#undef PG8_LDB
#undef PG8_MMA
#undef PG8_WAIT_V
#undef PG8_WAIT_L
#undef PG8_BAR
#undef PG8_SCHED
}
}

constexpr int NWAVES = 8, NTHR = 512;
constexpr int MP = 8192, MS = 1024, MTOT = 9216, DM = 2048;
constexpr int SEQ = 2048, DECS = 8, DECB = 128;
constexpr int NPROJ = 7168, DIN = 7184, DFF = 5632, NUP = 11264, NGLU = 4096;
constexpr int C_QA = 0, C_KA = 1024, C_VA = 2048, C_ZA = 3072, C_QB = 4096, C_KB = 4608, C_VB = 5120, C_GB = 6144;
constexpr float EPS = 1e-6f;
constexpr size_t MiB = 1u << 20;
constexpr size_t WS_CTL = 0;
constexpr size_t WS_WIN = 1 * MiB;
constexpr size_t WS_WOUT = WS_WIN + 28 * MiB;
constexpr size_t WS_WUP = WS_WOUT + 8 * MiB;
constexpr size_t WS_WDN = WS_WUP + 88 * MiB;
constexpr size_t WS_WGLU = WS_WDN + 44 * MiB;
constexpr size_t WS_X = WS_WGLU + 16 * MiB;
constexpr size_t WS_H = WS_X + 72 * MiB;
constexpr size_t WS_G2 = WS_H + 36 * MiB;
constexpr size_t WS_GATE = WS_G2 + 36 * MiB;
constexpr size_t WS_TAB = WS_GATE + 1 * MiB;
constexpr size_t WS_BIG = WS_TAB + 2 * MiB;
constexpr size_t WS_OA = WS_BIG + 126 * MiB, WS_OB = WS_OA + 36 * MiB;
constexpr size_t WS_ACT = WS_BIG + 198 * MiB;
constexpr size_t WS_END = WS_ACT + 99 * MiB;
constexpr size_t WS_UG0 = WS_BIG + 64 * MiB;
constexpr size_t O_Y = 0, O_GDN_P = 18874368, O_GDN_S = O_GDN_P + 524288, O_GCB_P = O_GDN_S + 16777216, O_GCB_S = O_GCB_P + 36864,
                 O_RET_P = O_GCB_S + 1179648, O_RET_S = O_RET_P + 524288, O_S5R_P = O_RET_S + 16777216, O_S5R_S = O_S5R_P + 32768,
                 O_S5I_P = O_S5R_S + 1048576, O_S5I_S = O_S5I_P + 32768, O_FCB_P = O_S5I_S + 1048576, O_FCB_S = O_FCB_P + 180224, O_END = O_FCB_S + 5767168;

constexpr int LDS_BYTES = 148480 + 512;
constexpr int MISC_OFF = 148480;
#define LAS __attribute__((address_space(3)))
typedef unsigned short bf16;
typedef float f32x4 __attribute__((ext_vector_type(4)));
typedef unsigned u32x4 __attribute__((ext_vector_type(4)));
typedef unsigned u32x2 __attribute__((ext_vector_type(2)));
#define LDS_WAIT() asm volatile("s_waitcnt lgkmcnt(0)" ::: "memory")

struct Args { const float* in[32]; float* out; unsigned char* ws; int ph_lo, ph_hi; };
enum { I_XP = 0, I_XS, I_SGDN, I_SGCB, I_SRET, I_S5RE, I_S5IM, I_SFCB, I_NMIX, I_NFFN, I_NFIN, I_WIN, I_GCW, I_GALOG, I_GDTB, I_GNW, I_RGW, I_RGB, I_WOUT,
       I_LRE, I_LIM, I_LDT, I_BRE, I_BIM, I_CRE, I_CIM, I_S5D, I_WGLU, I_WUP, I_FCW, I_FCBIAS, I_WDN };

__device__ __forceinline__ float wave_sum(float v) {
#pragma unroll
    for (int o = 1; o < 64; o <<= 1) v += __shfl_xor(v, o);
    return v;
}
__device__ __forceinline__ unsigned f2bf(float f) { unsigned u = __builtin_bit_cast(unsigned, f); return (u + 0x7fffu + ((u >> 16) & 1u)) >> 16; }
__device__ __forceinline__ unsigned pk2(float lo, float hi) { return f2bf(lo) | (f2bf(hi) << 16); }
__device__ __forceinline__ float bf2f(unsigned short b) { return __builtin_bit_cast(float, (unsigned)b << 16); }
__device__ __forceinline__ void unpack8(const u32x4 w, float (&f)[8]) {
    f[0] = __builtin_bit_cast(float, w.x << 16); f[1] = __builtin_bit_cast(float, w.x & 0xffff0000u);
    f[2] = __builtin_bit_cast(float, w.y << 16); f[3] = __builtin_bit_cast(float, w.y & 0xffff0000u);
    f[4] = __builtin_bit_cast(float, w.z << 16); f[5] = __builtin_bit_cast(float, w.z & 0xffff0000u);
    f[6] = __builtin_bit_cast(float, w.w << 16); f[7] = __builtin_bit_cast(float, w.w & 0xffff0000u);
}
__device__ __forceinline__ void ld_bf8(const bf16* p, float (&f)[8]) { unpack8(*(const u32x4*)p, f); }
__device__ __forceinline__ void ld_f8(const float* p, float (&f)[8]) { const f32x4 a = *(const f32x4*)p, b = *(const f32x4*)(p + 4); f[0] = a[0]; f[1] = a[1]; f[2] = a[2]; f[3] = a[3]; f[4] = b[0]; f[5] = b[1]; f[6] = b[2]; f[7] = b[3]; }
__device__ __forceinline__ void st_bf8(bf16* p, const float (&f)[8]) { u32x4 w; w.x = pk2(f[0], f[1]); w.y = pk2(f[2], f[3]); w.z = pk2(f[4], f[5]); w.w = pk2(f[6], f[7]); *(u32x4*)p = w; }
__device__ __forceinline__ float silu_f(float x) { return x / (1.0f + expf(-x)); }
__device__ __forceinline__ float sigmoid_f(float x) { return 1.0f / (1.0f + expf(-x)); }
__device__ __forceinline__ float softplus_f(float x) { return x > 20.f ? x : log1pf(expf(x)); }
__device__ __forceinline__ float gelu_tanh_fast(float y) { const float z = 0.7978845608028654f * (y + 0.044715f * y * y * y); const float e = __builtin_amdgcn_exp2f(z * 2.8853900817779268f); return y * (1.0f - __builtin_amdgcn_rcpf(e + 1.0f)); }
__device__ __forceinline__ float gelu_tanh(float y) { const float z = 0.7978845608028654f * (y + 0.044715f * y * y * y); const float th = 1.0f - 2.0f / (expf(2.0f * z) + 1.0f); return 0.5f * y * (1.0f + th); }
__device__ __forceinline__ void sincos_d(double a, double& s, double& c) {
    const double n = rint(a * 0.63661977236758134308);
    double r = fma(-n, 1.57079632679489655800e+00, a); r = fma(-n, 6.12323399573676603587e-17, r);
    const double r2 = r * r;
    double ps = 1.0 / 6227020800.0; ps = fma(ps, r2, -1.0 / 39916800.0); ps = fma(ps, r2, 1.0 / 362880.0); ps = fma(ps, r2, -1.0 / 5040.0); ps = fma(ps, r2, 1.0 / 120.0); ps = fma(ps, r2, -1.0 / 6.0); ps = fma(ps * r2, r, r);
    double pc = 1.0 / 479001600.0; pc = fma(pc, r2, -1.0 / 3628800.0); pc = fma(pc, r2, 1.0 / 40320.0); pc = fma(pc, r2, -1.0 / 720.0); pc = fma(pc, r2, 1.0 / 24.0); pc = fma(pc, r2, -0.5); pc = fma(pc, r2, 1.0);
    const int q = (int)(long long)n & 3;
    s = (q == 0) ? ps : (q == 1) ? pc : (q == 2) ? -ps : -pc;
    c = (q == 0) ? pc : (q == 1) ? -ps : (q == 2) ? -pc : ps;
}

#define GAS __attribute__((address_space(1)))
constexpr int CW_BAR = 4096;
constexpr size_t CTL_ZERO_BYTES = 524288;
constexpr size_t WS_SS = WS_CTL + 262144;
#define XB_TMO      128
#define XB_XCNT(j)  (256  + 64 * (j))
#define XB_XSUB(j)  (1280 + 64 * (j))
#define XB_XGEN(j)  (2304 + 64 * (j))
#define XB_TOP      3328
#define XB_TOPGEN   3392
#define XCD_BAR_WORDS 3456
#define XB_SPIN_CAP (1u << 18)

__device__ __forceinline__ unsigned xb_ld(unsigned* p)              { return __hip_atomic_load(p, __ATOMIC_RELAXED, __HIP_MEMORY_SCOPE_AGENT); }
__device__ __forceinline__ unsigned xb_add(unsigned* p, unsigned v) { return __hip_atomic_fetch_add(p, v, __ATOMIC_RELAXED, __HIP_MEMORY_SCOPE_AGENT); }
__device__ __forceinline__ unsigned xb_xcc_id() { return (unsigned)__builtin_amdgcn_s_getreg((3 << 11) | 20) & 0xFu; }
#define XB_SPIN(cond, bar) do { unsigned _sp = 0; while (cond) { __builtin_amdgcn_s_sleep(1); \
    if ((++_sp & 255u) == 0u) { if (xb_ld(&(bar)[XB_TMO])) break; if (_sp > XB_SPIN_CAP) { atomicAdd(&(bar)[XB_TMO], 1u); break; } } } } while (0)

struct XcdBarrier {
    unsigned* bar; unsigned x;
    volatile LAS unsigned* st;
};

__device__ __forceinline__ XcdBarrier xcd_barrier_post(unsigned* bar, volatile LAS unsigned* st) {
    XcdBarrier b; b.bar = bar; b.x = xb_xcc_id(); b.st = st;
    if (threadIdx.x == 0) (void)xb_add(&bar[XB_XCNT(b.x)], 1u);
    return b;
}
__device__ __forceinline__ void xcd_barrier_complete(unsigned* bar, unsigned x, unsigned& nloc, unsigned& nx) {
    const unsigned G = gridDim.x * gridDim.y * gridDim.z;
    unsigned sum, cnt, mine, sp = 0u;
    for (;;) {
        sum = 0u; cnt = 0u; mine = 0u;
#pragma unroll
        for (unsigned j = 0; j < 16; ++j) { const unsigned c = xb_ld(&bar[XB_XCNT(j)]); sum += c; cnt += (c > 0u) ? 1u : 0u; mine = (j == x) ? c : mine; }
        if (sum == G) break;
        __builtin_amdgcn_s_sleep(1);
        if ((++sp & 255u) == 0u) { if (xb_ld(&bar[XB_TMO])) break; if (sp > XB_SPIN_CAP) { atomicAdd(&bar[XB_TMO], 1u); break; } }
    }
    nloc = mine > 0u ? mine : 1u; nx = cnt > 0u ? cnt : 1u;
}

__device__ __forceinline__ void xcd_barrier(const XcdBarrier& b) {
    asm volatile("s_waitcnt vmcnt(0)" ::: "memory");
    __syncthreads();
    if (threadIdx.x == 0) {
        unsigned* bar = b.bar;
        __builtin_amdgcn_s_waitcnt(0);
        unsigned nloc = b.st[0], nx = b.st[1];
        if (nloc == 0u) { xcd_barrier_complete(bar, b.x, nloc, nx); b.st[0] = nloc; b.st[1] = nx; }
        const unsigned old = xb_add(&bar[XB_XSUB(b.x)], 1u);
        const unsigned gen = old / nloc;
        if (old + 1u == (gen + 1u) * nloc) {
            __builtin_amdgcn_fence(__ATOMIC_RELEASE, "agent");
            asm volatile("s_waitcnt vmcnt(0)" ::: "memory");
            const unsigned og = xb_add(&bar[XB_TOP], 1u);
            const unsigned tg = og / nx;
            if (og + 1u == (tg + 1u) * nx) xb_add(&bar[XB_TOPGEN], 1u);
            else XB_SPIN(xb_ld(&bar[XB_TOPGEN]) == tg, bar);
            __builtin_amdgcn_fence(__ATOMIC_ACQUIRE, "agent");
            xb_add(&bar[XB_XGEN(b.x)], 1u);
            asm volatile("s_waitcnt vmcnt(0)" ::: "memory");
        } else {
            XB_SPIN(xb_ld(&bar[XB_XGEN(b.x)]) == gen, bar);
            __builtin_amdgcn_fence(__ATOMIC_ACQUIRE, "agent");
            asm volatile("s_waitcnt vmcnt(0)" ::: "memory");
        }
    }
    __syncthreads();
}


__device__ __forceinline__ void transpose_item(const float* W, int ldw, int src_col0, int k0, bf16* WT, int K, int dst_row0, LAS float* scr, int lane, const float* ksc = nullptr) {
    float wv[32];
    { const float* wp = W + (size_t)(k0 + (lane >> 5)) * ldw + src_col0 + (lane & 31);
#pragma unroll
      for (int i = 0; i < 32; ++i) wv[i] = __builtin_nontemporal_load(wp + (size_t)(2 * i) * ldw); }
#pragma unroll
    for (int i = 0; i < 32; ++i) scr[(2 * i + (lane >> 5)) * 33 + (lane & 31)] = wv[i];
    const int c = lane & 7;
    f32x4 s0 = {1.f, 1.f, 1.f, 1.f}, s1 = {1.f, 1.f, 1.f, 1.f};
    if (ksc) { s0 = *(const f32x4*)(ksc + k0 + 8 * c); s1 = *(const f32x4*)(ksc + k0 + 8 * c + 4); }
    LDS_WAIT(); asm volatile("" ::: "memory");
#pragma unroll
    for (int j = 0; j < 4; ++j) { const int n = (lane >> 3) + 8 * j; const LAS float* s = scr + (8 * c) * 33 + n;
        u32x4 o; o.x = pk2(s[0 * 33] * s0[0], s[1 * 33] * s0[1]); o.y = pk2(s[2 * 33] * s0[2], s[3 * 33] * s0[3]); o.z = pk2(s[4 * 33] * s1[0], s[5 * 33] * s1[1]); o.w = pk2(s[6 * 33] * s1[2], s[7 * 33] * s1[3]);
        *(u32x4*)(WT + (size_t)(dst_row0 + n) * K + k0 + 8 * c) = o; }
    LDS_WAIT(); asm volatile("" ::: "memory");
}
__device__ __forceinline__ int ileave_src(int n0, int half) { const int t = n0 >> 8, w = n0 & 255; return (w < 128) ? t * 128 + w : half + t * 128 + (w - 128); }

__device__ __forceinline__ void convert_group(const Args& a, int group, LAS float* scr, int lane, int w, int nw) {
    unsigned char* ws = a.ws;
    constexpr int I_IN = 32 * 224, I_OUT = 32 * 64, I_UP = 32 * 352, I_DN = 88 * 64, I_GLU = 32 * 128;
    if (group == 0) {
        for (int r = w; r < I_IN; r += nw) { const int kb = r / 224, n0 = 32 * (r % 224); transpose_item(a.in[I_WIN], DIN, n0 < 4096 ? n0 : n0 + 16, 64 * kb, (bf16*)(ws + WS_WIN), 2048, n0, scr, lane); }
    } else {
        const int l = (group == 2) ? 1 : 0, I_A = (l == 0) ? I_OUT : I_GLU;
        const int lo_ = (group == 3) ? I_A : 0, hi_ = (group == 1) ? I_A : I_A + I_UP + I_DN;
        for (int it = lo_ + w; it < hi_; it += nw) {
            int r = it;
            if (r < I_A) { if (l == 0) { const int kb = r / 64, n0 = 32 * (r % 64); transpose_item(a.in[I_WOUT], 2048, n0, 64 * kb, (bf16*)(ws + WS_WOUT), 2048, n0, scr, lane); }
                           else { const int kb = r / 128, n0 = 32 * (r % 128); transpose_item(a.in[I_WGLU], NGLU, ileave_src(n0, 2048), 64 * kb, (bf16*)(ws + WS_WGLU), 2048, n0, scr, lane); }
                           continue; } r -= I_A;
            if (r < I_UP) { const int kb = r / 352, n0 = 32 * (r % 352);
                transpose_item(a.in[I_WUP] + (size_t)l * 2048 * NUP, NUP, ileave_src(n0, DFF), 64 * kb, (bf16*)(ws + WS_WUP) + (size_t)l * NUP * 2048, 2048, n0, scr, lane, a.in[I_NFFN] + l * DM); continue; } r -= I_UP;
            { const int kb = r / 64, n0 = 32 * (r % 64); transpose_item(a.in[I_WDN] + (size_t)l * DFF * 2048, 2048, n0, 64 * kb, (bf16*)(ws + WS_WDN) + (size_t)l * 2048 * DFF, DFF, n0, scr, lane); }
        }
    }
}
constexpr int PRO_REP = 0;
__device__ __forceinline__ void ph_prologue(const Args& a, LAS unsigned char* lds, int tid, int lane, int wave, int gw, int NGW, int G) {
    unsigned char* ws = a.ws;
    for (int rp = 0; rp < (PRO_REP == 1 ? 2 : 1); ++rp)
    {   LAS float* scr = (LAS float*)(lds + wave * 8704);
        convert_group(a, 0, scr, lane, gw, NGW);
        if (G != 256) { convert_group(a, 1, scr, lane, gw, NGW); convert_group(a, 3, scr, lane, gw, NGW); convert_group(a, 2, scr, lane, gw, NGW); }
    }
    for (int rp = 0; rp < (PRO_REP == 2 ? 2 : 1); ++rp)
    {
        float* tab = (float*)(ws + WS_TAB);
        for (int idx = gw * 64 + lane; idx < 2056 * 64; idx += NGW * 64) { const int i = idx & 63, slot = idx >> 6; const int pos = slot < 2048 ? slot : 16384 + (slot - 2048);
            double s, c; sincos_d((double)pos * exp(-(double)i * (9.210340371976184 / 64.0)), s, c); tab[slot * 128 + i] = (float)c; tab[slot * 128 + 64 + i] = (float)s; }
    }
    __syncthreads();
    LAS float* WgT = (LAS float*)lds;
    {   f32x4 wg[4][4];
#pragma unroll
        for (int i = 0; i < 4; ++i)
#pragma unroll
            for (int j = 0; j < 4; ++j) wg[i][j] = *(const f32x4*)(a.in[I_WIN] + (size_t)(tid + 512 * i) * DIN + 4096 + 4 * j);
#pragma unroll
        for (int i = 0; i < 4; ++i)
#pragma unroll
            for (int j = 0; j < 4; ++j)
#pragma unroll
                for (int e = 0; e < 4; ++e) WgT[(4 * j + e) * 2048 + tid + 512 * i] = wg[i][j][e]; }
    __syncthreads();
    bf16* H = (bf16*)(ws + WS_H); float* GATE = (float*)(ws + WS_GATE);
    const float* nw = a.in[I_NMIX];
    const bool b5 = lane & 32, b4 = lane & 16, b3 = lane & 8, b2 = lane & 4;
    const int hme = (b5 ? 8 : 0) + (b4 ? 4 : 0) + (b3 ? 2 : 0) + (b2 ? 1 : 0);
    const float galog = a.in[I_GALOG][hme & 7], gdtb = a.in[I_GDTB][hme & 7];
    f32x4 nwr[8];
#pragma unroll
    for (int j = 0; j < 8; ++j) nwr[j] = ((const f32x4*)nw)[lane + 64 * j];
    for (int rp = 0; rp < (PRO_REP == 3 ? 2 : 1); ++rp) {
    f32x4 vn[8];
    { const int m = gw; const float* xr = (m < MP) ? a.in[I_XP] + (size_t)m * DM : a.in[I_XS] + (size_t)(m - MP) * DM;
#pragma unroll
      for (int j = 0; j < 8; ++j) vn[j] = ((const f32x4*)xr)[lane + 64 * j]; }
    for (int m = gw; m < MTOT; m += NGW) {
        f32x4 v[8]; float ss = 0.f;
#pragma unroll
        for (int j = 0; j < 8; ++j) { v[j] = vn[j]; ss += (v[j][0] * v[j][0] + v[j][1] * v[j][1]) + (v[j][2] * v[j][2] + v[j][3] * v[j][3]); }
        { const int mn = (m + NGW < MTOT) ? m + NGW : m;
          const float* xr = (mn < MP) ? a.in[I_XP] + (size_t)mn * DM : a.in[I_XS] + (size_t)(mn - MP) * DM;
#pragma unroll
          for (int j = 0; j < 8; ++j) vn[j] = ((const f32x4*)xr)[lane + 64 * j]; }
        const float rstd = 1.0f / sqrtf(wave_sum(ss) * (1.0f / DM) + EPS);
#pragma unroll
        for (int j = 0; j < 8; ++j) { v[j] = v[j] * rstd * nwr[j];
            u32x2 o; o.x = pk2(v[j][0], v[j][1]); o.y = pk2(v[j][2], v[j][3]); ((u32x2*)(H + (size_t)m * DM))[lane + 64 * j] = o; }
        float gs_[16];
#pragma unroll
        for (int h = 0; h < 16; ++h) { float s = 0.f;
#pragma unroll
            for (int j = 0; j < 8; ++j) { const f32x4 w4 = *(const LAS f32x4*)(WgT + h * 2048 + 4 * lane + 256 * j); s += (v[j][0] * w4[0] + v[j][1] * w4[1]) + (v[j][2] * w4[2] + v[j][3] * w4[3]); }
            gs_[h] = s; if (h & 1) asm volatile("" ::: "memory"); }
        {   float k8[8], k4[4], k2[2], y;
#pragma unroll
            for (int i = 0; i < 8; ++i) { const float send = b5 ? gs_[i] : gs_[8 + i], keep = b5 ? gs_[8 + i] : gs_[i]; k8[i] = keep + __shfl_xor(send, 32); }
#pragma unroll
            for (int i = 0; i < 4; ++i) { const float send = b4 ? k8[i] : k8[4 + i], keep = b4 ? k8[4 + i] : k8[i]; k4[i] = keep + __shfl_xor(send, 16); }
#pragma unroll
            for (int i = 0; i < 2; ++i) { const float send = b3 ? k4[i] : k4[2 + i], keep = b3 ? k4[2 + i] : k4[i]; k2[i] = keep + __shfl_xor(send, 8); }
            { const float send = b2 ? k2[0] : k2[1], keep = b2 ? k2[1] : k2[0]; y = keep + __shfl_xor(send, 4); }
            y += __shfl_xor(y, 2); y += __shfl_xor(y, 1);
            if ((lane & 3) == 0) { float o; if (hme < 8) o = -expf(galog) * softplus_f(y + gdtb); else o = sigmoid_f(y); GATE[m * 16 + hme] = o; } }
    }
    }
    __syncthreads();
}

__device__ __forceinline__ void ph_rms_rows(const float* X, const float* nw, bf16* H, int lane, int gw, int NGW) {
    for (int m = gw; m < MTOT; m += NGW) {
        f32x4 v[8]; float ss = 0.f;
#pragma unroll
        for (int j = 0; j < 8; ++j) { v[j] = ((const f32x4*)(X + (size_t)m * DM))[lane + 64 * j]; ss += (v[j][0] * v[j][0] + v[j][1] * v[j][1]) + (v[j][2] * v[j][2] + v[j][3] * v[j][3]); }
        const float rstd = 1.0f / sqrtf(wave_sum(ss) * (1.0f / DM) + EPS);
#pragma unroll
        for (int j = 0; j < 8; ++j) { const f32x4 w4 = ((const f32x4*)nw)[lane + 64 * j]; v[j] = v[j] * rstd * w4;
            u32x2 o; o.x = pk2(v[j][0], v[j][1]); o.y = pk2(v[j][2], v[j][3]); ((u32x2*)(H + (size_t)m * DM))[lane + 64 * j] = o; }
    }
}
__device__ __forceinline__ void ph_rms_out(const float* X, const float* SS, const float* SLAB, const float* nw, float* Y, int lane, int gw, int NGW) {
    f32x4 w[8];
#pragma unroll
    for (int j = 0; j < 8; ++j) w[j] = ((const f32x4*)nw)[lane + 64 * j];
    for (int m = gw; m < MTOT; m += NGW) {
        f32x4 v[8];
#pragma unroll
        for (int j = 0; j < 8; ++j) v[j] = ((const f32x4*)(X + (size_t)m * DM))[lane + 64 * j];
        float rstd;
        if (m < MP) rstd = 1.0f / sqrtf(SS[m] * (1.0f / DM) + EPS);
        else {
            f32x4 sl[8][4];
#pragma unroll
            for (int j = 0; j < 8; ++j)
#pragma unroll
                for (int k = 0; k < 4; ++k) sl[j][k] = ((const f32x4*)(SLAB + ((size_t)k * MS + (m - MP)) * DM))[lane + 64 * j];
            float ss = 0.f;
#pragma unroll
            for (int j = 0; j < 8; ++j) { v[j] = v[j] + ((sl[j][0] + sl[j][1]) + (sl[j][2] + sl[j][3]));
                ss += (v[j][0] * v[j][0] + v[j][1] * v[j][1]) + (v[j][2] * v[j][2] + v[j][3] * v[j][3]); }
            rstd = 1.0f / sqrtf(wave_sum(ss) * (1.0f / DM) + EPS);
        }
#pragma unroll
        for (int j = 0; j < 8; ++j) ((f32x4*)(Y + (size_t)m * DM))[lane + 64 * j] = v[j] * rstd * w[j];
    }
}

template <bool GLU>
__device__ __forceinline__ void ph_combine(float* X, bf16* XB, float* SS, const float* SLAB, int lane, int gw, int NGW, bf16* UGW = nullptr, const float* NW = nullptr) {
    constexpr int LDS_ = GLU ? NGLU : DM;
    for (int mr = gw; mr < MS; mr += NGW) {
        const size_t m = (size_t)MP + mr; float ss = 0.f;
        f32x4 xk[8];
#pragma unroll
        for (int jh = 0; jh < 2; ++jh) {
            f32x4 sv[4][4], sg[4][4];
#pragma unroll
            for (int jj = 0; jj < 4; ++jj) { const int j = 4 * jh + jj, c = 4 * (lane + 64 * j);
                xk[j] = *(const f32x4*)(X + m * DM + c);
                const int sc = GLU ? ((c >> 7) << 8) + (c & 127) : c;
#pragma unroll
                for (int k = 0; k < 4; ++k) { const float* sp = SLAB + ((size_t)k * MS + mr) * LDS_ + sc; sv[jj][k] = *(const f32x4*)sp; if (GLU) sg[jj][k] = *(const f32x4*)(sp + 128); } }
#pragma unroll
            for (int jj = 0; jj < 4; ++jj) { const int j = 4 * jh + jj, c = 4 * (lane + 64 * j);
                f32x4 x = xk[j];
                if (GLU) { const f32x4 v = (sv[jj][0] + sv[jj][1]) + (sv[jj][2] + sv[jj][3]), g = (sg[jj][0] + sg[jj][1]) + (sg[jj][2] + sg[jj][3]);
#pragma unroll
                    for (int e = 0; e < 4; ++e) x[e] += v[e] / (1.0f + __expf(-g[e]));
                } else x = x + ((sv[jj][0] + sv[jj][1]) + (sv[jj][2] + sv[jj][3]));
                xk[j] = x; ss += (x[0] * x[0] + x[1] * x[1]) + (x[2] * x[2] + x[3] * x[3]);
                *(f32x4*)(X + m * DM + c) = x;
                u32x2 o; o.x = pk2(x[0], x[1]); o.y = pk2(x[2], x[3]); *(u32x2*)(XB + m * DM + c) = o; }
        }
        ss = wave_sum(ss);
        if (lane == 0) SS[m] = ss;
        if (UGW) {
            const float rs = __builtin_amdgcn_rsqf(ss * (1.0f / DM) + EPS);
            f32x4 w4[8];
#pragma unroll
            for (int j = 0; j < 8; ++j) w4[j] = *(const f32x4*)(NW + 4 * (lane + 64 * j));
#pragma unroll
            for (int j = 0; j < 8; ++j) { const int c = 4 * (lane + 64 * j); const f32x4 x = xk[j];
                u32x2 o; o.x = pk2(x[0] * rs * w4[j][0], x[1] * rs * w4[j][1]); o.y = pk2(x[2] * rs * w4[j][2], x[3] * rs * w4[j][3]);
                *(u32x2*)(UGW + ((size_t)(c >> 4) * MTOT + m) * 16 + (c & 15)) = o; }
        }
    }
}
__device__ __forceinline__ void ph_ug_prompt(const bf16* XB, const float* SS, const float* NW, bf16* UG, int lane, int gw, int NGW) {
    float wv[32];
#pragma unroll
    for (int i = 0; i < 8; ++i) { const f32x4 w4 = *(const f32x4*)(NW + 32 * lane + 4 * i); wv[4 * i] = w4[0]; wv[4 * i + 1] = w4[1]; wv[4 * i + 2] = w4[2]; wv[4 * i + 3] = w4[3]; }
    for (int m = gw; m < MP; m += NGW) {
        u32x4 raw[4];
#pragma unroll
        for (int i = 0; i < 4; ++i) raw[i] = *(const u32x4*)(XB + (size_t)m * DM + 32 * lane + 8 * i);
        const float rs = __builtin_amdgcn_rsqf(SS[m] * (1.0f / DM) + EPS);
#pragma unroll
        for (int i = 0; i < 4; ++i) { float x[8]; unpack8(raw[i], x);
#pragma unroll
            for (int j = 0; j < 8; ++j) x[j] = x[j] * rs * wv[8 * i + j];
            st_bf8(UG + ((size_t)(2 * lane + (i >> 1)) * MTOT + m) * 16 + 8 * (i & 1), x); }
    }
}

typedef short bf16x8 __attribute__((ext_vector_type(8)));
constexpr int GREC_WN = 0, GREC_QD = 16384, GREC_QK = 32768, GREC_KD = 40960, GREC_IMG = 57344, GREC_UT = 57344, GREC_BYTES = 90112;
constexpr int RREC_QD = 0, RREC_QK = 16384, RREC_KD = 24576, RREC_IMG = 40960, RREC_VT = 40960, RREC_BYTES = 73728;
constexpr size_t WS_GREC = WS_ACT, WS_RREC = WS_G2, WS_GL = WS_CTL + 131072;
constexpr size_t WS_QKS = WS_H, WS_VAS = WS_H + 8 * MiB;
__device__ __forceinline__ int kpos(int k) { return (k & ~31) | (((k >> 2) & 3) << 3) | (((k >> 4) & 1) << 2) | (k & 3); }
__device__ __forceinline__ int addr256(int row, int chunk) { return row * 256 + ((chunk ^ (row & 15)) << 4); }
__device__ __forceinline__ int addr128(int row, int chunk) { return row * 128 + ((chunk ^ ((row >> 1) & 7)) << 4); }
__device__ __forceinline__ unsigned cvtpk(float lo, float hi) { unsigned r; asm volatile("v_cvt_pk_bf16_f32 %0, %1, %2" : "=v"(r) : "v"(lo), "v"(hi)); return r; }
__device__ __forceinline__ bf16x8 pack_tiles(const f32x4 lo, const f32x4 hi) { u32x4 w; w.x = cvtpk(lo[0], lo[1]); w.y = cvtpk(lo[2], lo[3]); w.z = cvtpk(hi[0], hi[1]); w.w = cvtpk(hi[2], hi[3]); return __builtin_bit_cast(bf16x8, w); }
#define MFMA16(a, b, c) __builtin_amdgcn_mfma_f32_16x16x32_bf16((a), (b), (c), 0, 0, 0)

__device__ __forceinline__ void img256_put8(unsigned char* img, int row, int grp, const float (&v)[8]) {
    const int s = grp >> 2, t = (grp >> 1) & 1, qq0 = (grp & 1) * 2;
    u32x2 p0, p1; p0.x = pk2(v[0], v[1]); p0.y = pk2(v[2], v[3]); p1.x = pk2(v[4], v[5]); p1.y = pk2(v[6], v[7]);
    *(u32x2*)(img + addr256(row, 4 * s + qq0) + 8 * t) = p0; *(u32x2*)(img + addr256(row, 4 * s + qq0 + 1) + 8 * t) = p1;
}

constexpr int GP_K32 = 0, GP_V32 = 33024, GP_QS = 66048, GP_KS = 82432, GP_LM = 98816, GP_G = 115200;
__device__ __forceinline__ void gdn_prep_chunk(const Args& a, LAS unsigned char* lds, int b, int h, int n, int tid, int lane, int wave) {
    unsigned char* ws = a.ws;
    const bf16* PROJ = (const bf16*)(ws + WS_BIG); const float* GATE = (const float*)(ws + WS_GATE);
    const int cid = (b * 8 + h) * 32 + n, row0 = b * SEQ + 64 * n;
    unsigned char* rec = ws + WS_GREC + (size_t)cid * GREC_BYTES;
    LAS float* K32 = (LAS float*)(lds + GP_K32); LAS float* V32 = (LAS float*)(lds + GP_V32); LAS float* Lm = (LAS float*)(lds + GP_LM);
    LAS float* gs = (LAS float*)(lds + GP_G);
    __syncthreads();
    if (wave == 0) {
        float v = GATE[(size_t)(row0 + lane) * 16 + h];
#pragma unroll
        for (int o = 1; o < 64; o <<= 1) { const float t = __shfl_up(v, o); if (lane >= o) v += t; }
        const float gl = __shfl(v, 63);
        const float be = GATE[(size_t)(row0 + lane) * 16 + 8 + h], ev = expf(v);
        gs[lane] = v; gs[64 + lane] = be; gs[128 + lane] = ev; gs[192 + lane] = expf(gl - v); gs[256 + lane] = be * ev; gs[320 + lane] = 1.0f;
        if (lane == 63) ((float*)(ws + WS_GL))[cid] = expf(gl);
    }
    __syncthreads();
    {
        const int c = tid >> 3, sub = tid & 7, t = 64 * n + c; const size_t m = (size_t)row0 + c;
        const float egc = gs[128 + c], bec = gs[64 + c];
        float qv[2][8], kv[2][8];
#pragma unroll
        for (int i = 0; i < 6; ++i) {
            const int grp = sub + 8 * (i & 1), typ = i >> 1, col = typ * 1024 + h * 128 + grp * 8;
            float acc[8];
#pragma unroll
            for (int e = 0; e < 8; ++e) acc[e] = 0.f;
            if (n > 0) {
                float x[4][8], w[4][8];
#pragma unroll
                for (int j = 0; j < 4; ++j) { ld_bf8(PROJ + (m - 3 + j) * NPROJ + col, x[j]); ld_f8(a.in[I_GCW] + (size_t)j * 3072 + col, w[j]); }
#pragma unroll
                for (int j = 0; j < 4; ++j)
#pragma unroll
                    for (int e = 0; e < 8; ++e) acc[e] += w[j][e] * x[j][e];
            } else {
#pragma unroll
                for (int j = 0; j < 4; ++j) if (t - 3 + j >= 0) { float x[8], w[8]; ld_bf8(PROJ + (m - 3 + j) * NPROJ + col, x); ld_f8(a.in[I_GCW] + (size_t)j * 3072 + col, w);
#pragma unroll
                    for (int e = 0; e < 8; ++e) acc[e] += w[e] * x[e]; }
            }
#pragma unroll
            for (int e = 0; e < 8; ++e) acc[e] = silu_f(acc[e]);
            if (typ == 0) {
#pragma unroll
                for (int e = 0; e < 8; ++e) qv[i & 1][e] = acc[e];
            } else if (typ == 1) {
#pragma unroll
                for (int e = 0; e < 8; ++e) kv[i & 1][e] = acc[e];
            } else {
#pragma unroll
                for (int e = 0; e < 8; ++e) V32[c * 129 + grp * 8 + e] = acc[e] * bec; }
            if (i & 1) asm volatile("" ::: "memory");
        }
        float sq = 0.f, sk = 0.f;
#pragma unroll
        for (int e = 0; e < 8; ++e) { sq += qv[0][e] * qv[0][e] + qv[1][e] * qv[1][e]; sk += kv[0][e] * kv[0][e] + kv[1][e] * kv[1][e]; }
        sq += __shfl_xor(sq, 1); sq += __shfl_xor(sq, 2); sq += __shfl_xor(sq, 4); sk += __shfl_xor(sk, 1); sk += __shfl_xor(sk, 2); sk += __shfl_xor(sk, 4);
        const float rq = (1.0f / sqrtf(sq + EPS)) * 0.08838834764831845f, rk = 1.0f / sqrtf(sk + EPS);
#pragma unroll
        for (int i = 0; i < 2; ++i) { const int grp = sub + 8 * i; float qd[8];
#pragma unroll
            for (int e = 0; e < 8; ++e) { qv[i][e] *= rq; kv[i][e] *= rk; qd[e] = qv[i][e] * egc; K32[c * 129 + grp * 8 + e] = kv[i][e]; }
            u32x4 wq, wk; wq.x = pk2(qv[i][0], qv[i][1]); wq.y = pk2(qv[i][2], qv[i][3]); wq.z = pk2(qv[i][4], qv[i][5]); wq.w = pk2(qv[i][6], qv[i][7]);
            wk.x = pk2(kv[i][0], kv[i][1]); wk.y = pk2(kv[i][2], kv[i][3]); wk.z = pk2(kv[i][4], kv[i][5]); wk.w = pk2(kv[i][6], kv[i][7]);
            *(LAS u32x4*)(lds + GP_QS + addr256(c, grp)) = wq; *(LAS u32x4*)(lds + GP_KS + addr256(c, grp)) = wk;
            img256_put8(rec + GREC_QD, c, grp, qd); }
    }
    __syncthreads();
    {
        const int r = lane & 15, q = lane >> 4;
#pragma unroll
        for (int ti = 0; ti < 2; ++ti) {
            const int tt = 2 * wave + ti, ct = tt >> 2, cu = tt & 3;
            f32x4 akk = {0.f, 0.f, 0.f, 0.f}, aqk = {0.f, 0.f, 0.f, 0.f};
#pragma unroll
            for (int ks = 0; ks < 4; ++ks) {
                const bf16x8 bk = *(const LAS bf16x8*)(lds + GP_KS + addr256(16 * cu + r, 4 * ks + q));
                const bf16x8 ak = *(const LAS bf16x8*)(lds + GP_KS + addr256(16 * ct + r, 4 * ks + q));
                const bf16x8 aq = *(const LAS bf16x8*)(lds + GP_QS + addr256(16 * ct + r, 4 * ks + q));
                akk = MFMA16(ak, bk, akk); aqk = MFMA16(aq, bk, aqk);
            }
            const int c2 = 16 * cu + r; const float g2 = gs[c2]; const int p2 = kpos(c2);
#pragma unroll
            for (int reg = 0; reg < 4; ++reg) { const int c = 16 * ct + 4 * q + reg; const float dec = (c2 <= c) ? expf(gs[c] - g2) : 0.f;
                Lm[c * 64 + c2] = (c2 < c) ? gs[64 + c] * akk[reg] * dec : 0.f;
                *(bf16*)(rec + GREC_QK + addr128(c, p2 >> 3) + (p2 & 7) * 2) = (bf16)f2bf(aqk[reg] * dec); }
        }
    }
    __syncthreads();
    if (tid < 256) {
        const bool isu = tid < 128; const int col = isu ? tid : tid - 128;
        const LAS float* rb = (const LAS float*)(lds + (isu ? GP_V32 : GP_K32)) + col; const LAS float* scp = gs + (isu ? 320 : 256);
        int zlane; asm volatile("v_mov_b32 %0, 0" : "=v"(zlane));
        const LAS float* Lz = Lm + zlane;
        float sol[64];
#pragma unroll
        for (int c = 0; c < 64; ++c) {
            float pa[4] = {rb[c * 129] * scp[c], 0.f, 0.f, 0.f};
#pragma unroll
            for (int c4 = 0; c4 < (c + 3) / 4; ++c4) { const f32x4 l4 = *(const LAS f32x4*)(Lz + c * 64 + 4 * c4);
#pragma unroll
                for (int j = 0; j < 4; ++j) if (4 * c4 + j < c) pa[j] -= l4[j] * sol[4 * c4 + j]; }
            sol[c] = (pa[0] + pa[1]) + (pa[2] + pa[3]);
            asm volatile("" ::: "memory");
        }
        if (isu) { float* ut = (float*)(rec + GREC_UT) + col * 64;
#pragma unroll
            for (int c4 = 0; c4 < 16; ++c4) *(f32x4*)(ut + 4 * c4) = (f32x4){sol[4 * c4], sol[4 * c4 + 1], sol[4 * c4 + 2], sol[4 * c4 + 3]}; }
        else { const int p = kpos(col), ch = p >> 3, wi = (p & 7) * 2;
            int xo[16];
#pragma unroll
            for (int k = 0; k < 16; ++k) xo[k] = ((ch ^ k) << 4) + wi;
#pragma unroll
            for (int c = 0; c < 64; ++c) *(LAS bf16*)(lds + GP_QS + c * 256 + xo[c & 15]) = (bf16)f2bf(-sol[c]); }
    } else {
        const int c = lane, p = kpos(c), ch = p >> 3, wi = (p & 7) * 2; const float sc = gs[192 + c];
#pragma unroll 2
        for (int i = 0; i < 32; ++i) { const int d = (wave - 4) * 32 + i; *(bf16*)(rec + GREC_KD + addr128(d, ch) + wi) = (bf16)f2bf(K32[c * 129 + d] * sc); }
    }
    __syncthreads();
#pragma unroll
    for (int i = 0; i < 2; ++i) *(u32x4*)(rec + GREC_WN + (i * NTHR + tid) * 16) = *(const LAS u32x4*)(lds + GP_QS + (i * NTHR + tid) * 16);
}

constexpr int RP_K32 = 0, RP_V16 = 33024, RP_QS = 66048, RP_KS = 82432;
__device__ __forceinline__ void ret_prep_chunk(const Args& a, LAS unsigned char* lds, int b, int h, int n, int tid, int lane, int wave) {
    unsigned char* ws = a.ws;
    const bf16* PROJ = (const bf16*)(ws + WS_BIG); const float* tab = (const float*)(ws + WS_TAB);
    const int cid = (b * 4 + h) * 32 + n, row0 = b * SEQ + 64 * n;
    unsigned char* rec = ws + WS_RREC + (size_t)cid * RREC_BYTES;
    LAS float* K32 = (LAS float*)(lds + RP_K32); LAS bf16* V16 = (LAS bf16*)(lds + RP_V16);
    const float l2g = log2f(1.0f - exp2f(-5.0f - (float)h));
    __syncthreads();
    {
        const int c = tid >> 3, sub = tid & 7; const size_t m = (size_t)row0 + c; const bf16* pr = PROJ + m * NPROJ;
        float ql[8], qh[8], kl[8], kh[8], cs[8], sn[8];
        ld_bf8(pr + C_QB + h * 128 + sub * 8, ql); ld_bf8(pr + C_QB + h * 128 + 64 + sub * 8, qh); ld_bf8(pr + C_KB + h * 128 + sub * 8, kl); ld_bf8(pr + C_KB + h * 128 + 64 + sub * 8, kh);
        ld_f8(tab + (size_t)(64 * n + c) * 128 + sub * 8, cs); ld_f8(tab + (size_t)(64 * n + c) * 128 + 64 + sub * 8, sn);
        float q0[8], q1[8], k0[8], k1[8], d0[8], d1[8]; const float qdec = exp2f(l2g * (float)(c + 1));
#pragma unroll
        for (int e = 0; e < 8; ++e) { q0[e] = ql[e] * cs[e] - qh[e] * sn[e]; q1[e] = ql[e] * sn[e] + qh[e] * cs[e];
            k0[e] = (kl[e] * cs[e] - kh[e] * sn[e]) * 0.08838834764831845f; k1[e] = (kl[e] * sn[e] + kh[e] * cs[e]) * 0.08838834764831845f;
            d0[e] = q0[e] * qdec; d1[e] = q1[e] * qdec; K32[c * 129 + sub * 8 + e] = k0[e]; K32[c * 129 + 64 + sub * 8 + e] = k1[e]; }
        u32x4 w; w.x = pk2(q0[0], q0[1]); w.y = pk2(q0[2], q0[3]); w.z = pk2(q0[4], q0[5]); w.w = pk2(q0[6], q0[7]); *(LAS u32x4*)(lds + RP_QS + addr256(c, sub)) = w;
        w.x = pk2(q1[0], q1[1]); w.y = pk2(q1[2], q1[3]); w.z = pk2(q1[4], q1[5]); w.w = pk2(q1[6], q1[7]); *(LAS u32x4*)(lds + RP_QS + addr256(c, 8 + sub)) = w;
        w.x = pk2(k0[0], k0[1]); w.y = pk2(k0[2], k0[3]); w.z = pk2(k0[4], k0[5]); w.w = pk2(k0[6], k0[7]); *(LAS u32x4*)(lds + RP_KS + addr256(c, sub)) = w;
        w.x = pk2(k1[0], k1[1]); w.y = pk2(k1[2], k1[3]); w.z = pk2(k1[4], k1[5]); w.w = pk2(k1[6], k1[7]); *(LAS u32x4*)(lds + RP_KS + addr256(c, 8 + sub)) = w;
        img256_put8(rec + RREC_QD, c, sub, d0); img256_put8(rec + RREC_QD, c, 8 + sub, d1);
#pragma unroll
        for (int i = 0; i < 4; ++i) { const u32x4 v = *(const u32x4*)(pr + C_VB + h * 256 + (sub + 8 * i) * 8); LAS unsigned* dst = (LAS unsigned*)(V16 + c * 258 + (sub + 8 * i) * 8); dst[0] = v.x; dst[1] = v.y; dst[2] = v.z; dst[3] = v.w; }
    }
    __syncthreads();
    {
        const int r = lane & 15, q = lane >> 4;
#pragma unroll
        for (int ti = 0; ti < 2; ++ti) {
            const int tt = 2 * wave + ti, ct = tt >> 2, cu = tt & 3;
            f32x4 aqk = {0.f, 0.f, 0.f, 0.f};
#pragma unroll
            for (int ks = 0; ks < 4; ++ks) {
                const bf16x8 bk = *(const LAS bf16x8*)(lds + RP_KS + addr256(16 * cu + r, 4 * ks + q));
                const bf16x8 aq = *(const LAS bf16x8*)(lds + RP_QS + addr256(16 * ct + r, 4 * ks + q));
                aqk = MFMA16(aq, bk, aqk);
            }
            const int c2 = 16 * cu + r, p2 = kpos(c2);
#pragma unroll
            for (int reg = 0; reg < 4; ++reg) { const int c = 16 * ct + 4 * q + reg; const float dec = (c2 <= c) ? exp2f(l2g * (float)(c - c2)) : 0.f;
                *(bf16*)(rec + RREC_QK + addr128(c, p2 >> 3) + (p2 & 7) * 2) = (bf16)f2bf(aqk[reg] * dec); }
        }
        const int c = lane, p = kpos(c), ch = p >> 3, wi = (p & 7) * 2; const float sc = exp2f(l2g * (float)(63 - c));
#pragma unroll 2
        for (int i = 0; i < 16; ++i) { const int d = wave * 16 + i; *(bf16*)(rec + RREC_KD + addr128(d, ch) + wi) = (bf16)f2bf(K32[c * 129 + d] * sc); }
#pragma unroll 2
        for (int i = 0; i < 32; ++i) { const int e = wave * 32 + i; *(bf16*)(rec + RREC_VT + e * 128 + p * 2) = V16[c * 258 + e]; }
    }
}

template <bool GDN>
__device__ __forceinline__ void chunk_scan(const Args& a, LAS unsigned char* lds, int task, int tid, int lane, int wave) {
    unsigned char* ws = a.ws;
    constexpr int IMG = GDN ? GREC_IMG : RREC_IMG, REC = GDN ? GREC_BYTES : RREC_BYTES, NP = IMG / 16 / NTHR;
    constexpr int O_WN = GREC_WN, O_QD = GDN ? GREC_QD : RREC_QD, O_QK = GDN ? GREC_QK : RREC_QK, O_KD = GDN ? GREC_KD : RREC_KD;
    const int r = lane & 15, q = lane >> 4;
    int b, h, e0, cid0;
    if (GDN) { b = task >> 3; h = task & 7; e0 = 16 * wave; cid0 = (b * 8 + h) * 32; }
    else { b = task >> 3; h = (task >> 1) & 3; e0 = 128 * (task & 1) + 16 * wave; cid0 = (b * 4 + h) * 32; }
    const unsigned char* rec = ws + (GDN ? WS_GREC : WS_RREC) + (size_t)cid0 * REC;
    const float* GL = (const float*)(ws + WS_GL) + cid0;
    float* O = (float*)(ws + (GDN ? WS_OA : WS_OB)) + (size_t)b * SEQ * 1024 + h * (GDN ? 128 : 256) + e0 + r;
    const float gch = GDN ? 0.f : exp2f(64.0f * log2f(1.0f - exp2f(-5.0f - (float)h)));
    f32x4 S[8];
#pragma unroll
    for (int dt = 0; dt < 8; ++dt) S[dt] = (f32x4){0.f, 0.f, 0.f, 0.f};
    __syncthreads();
    constexpr int SLICE = GDN ? 4096 : 2048, SL_OFF = 2 * GREC_IMG;
    LAS unsigned char* slot = lds + SL_OFF + wave * SLICE;
#define STAGE_IMG(recp, bufp) do { _Pragma("unroll") for (int i_ = 0; i_ < NP; ++i_) \
        __builtin_amdgcn_global_load_lds((const unsigned*)((recp) + (size_t)(i_ * NTHR + tid) * 16), (LAS unsigned*)((bufp) + (i_ * NTHR + wave * 64) * 16), 16, 0, 0); } while (0)
#define STAGE_SLICE(recp) do { _Pragma("unroll") for (int i_ = 0; i_ < SLICE / 1024; ++i_) \
        __builtin_amdgcn_global_load_lds((const unsigned*)((recp) + (GDN ? GREC_UT + e0 * 256 : RREC_VT + e0 * 128) + i_ * 1024 + lane * 16), (LAS unsigned*)(slot + i_ * 1024), 16, 0, 0); } while (0)
    STAGE_IMG(rec, lds); STAGE_SLICE(rec);
    for (int n = 0; n < 32; ++n) {
        const unsigned char* nrec = rec + (size_t)(n + 1 < 32 ? n + 1 : n) * REC;
        f32x4 uc[4]; bf16x8 bv[2];
        const float gl = GDN ? GL[n] : gch;
        if (n == 0) asm volatile("s_waitcnt vmcnt(0) lgkmcnt(0)" ::: "memory"); else asm volatile("s_waitcnt vmcnt(16) lgkmcnt(0)" ::: "memory");
        __builtin_amdgcn_s_barrier();
        asm volatile("" ::: "memory");
        if (GDN) {
#pragma unroll
            for (int ct = 0; ct < 4; ++ct) uc[ct] = *(const LAS f32x4*)(slot + r * 256 + (16 * ct + 4 * q) * 4);
        } else {
#pragma unroll
            for (int s = 0; s < 2; ++s) bv[s] = *(const LAS bf16x8*)(slot + r * 128 + (4 * s + q) * 16);
        }
        asm volatile("s_waitcnt lgkmcnt(0)" ::: "memory");
        if (n + 1 < 32) { STAGE_IMG(nrec, lds + ((n + 1) & 1) * IMG); STAGE_SLICE(nrec); }
        asm volatile("" ::: "memory"); __builtin_amdgcn_sched_barrier(0);
        LAS unsigned char* B = lds + (n & 1) * IMG;
        bf16x8 bs[4];
#pragma unroll
        for (int s = 0; s < 4; ++s) bs[s] = pack_tiles(S[2 * s], S[2 * s + 1]);
        f32x4 ao[4];
#pragma unroll
        for (int ct = 0; ct < 4; ++ct) ao[ct] = (f32x4){0.f, 0.f, 0.f, 0.f};
        bf16x8 FA[8], FB[8];
#define LD256(F, off, s0) do { _Pragma("unroll") for (int i_ = 0; i_ < 8; ++i_) F[i_] = *(const LAS bf16x8*)(B + (off) + addr256(16 * (i_ & 3) + r, 4 * ((s0) + (i_ >> 2)) + q)); } while (0)
#define LD128(F, off, t0) do { _Pragma("unroll") for (int i_ = 0; i_ < 8; ++i_) F[i_] = *(const LAS bf16x8*)(B + (off) + addr128(16 * ((t0) + (i_ & 3)) + r, 4 * (i_ >> 2) + q)); } while (0)
#define MM(F, ACC, BOP, s0) do { _Pragma("unroll") for (int i_ = 0; i_ < 8; ++i_) ACC[i_ & 3] = MFMA16(F[i_], BOP[(s0) + (i_ >> 2)], ACC[i_ & 3]); } while (0)
#define SB() __builtin_amdgcn_sched_barrier(0)
        if (GDN) {
            LD256(FA, O_WN, 0); SB();
            LD256(FB, O_WN, 2); SB(); MM(FA, uc, bs, 0); SB();
            LD256(FA, O_QD, 0); SB(); MM(FB, uc, bs, 2); SB();
            bv[0] = pack_tiles(uc[0], uc[1]); bv[1] = pack_tiles(uc[2], uc[3]);
        } else { LD256(FA, O_QD, 0); SB(); }
        LD256(FB, O_QD, 2); SB(); MM(FA, ao, bs, 0); SB();
        LD128(FA, O_QK, 0); SB(); MM(FB, ao, bs, 2); SB();
        LD128(FB, O_KD, 0); SB(); MM(FA, ao, bv, 0); SB();
#pragma unroll
        for (int dt = 0; dt < 8; ++dt) S[dt] = S[dt] * gl;
        LD128(FA, O_KD, 4); SB();
        { f32x4 (&S0)[8] = S; _Pragma("unroll") for (int i_ = 0; i_ < 8; ++i_) S0[i_ & 3] = MFMA16(FB[i_], bv[i_ >> 2], S0[i_ & 3]); } SB();
        { _Pragma("unroll") for (int i_ = 0; i_ < 8; ++i_) S[4 + (i_ & 3)] = MFMA16(FA[i_], bv[i_ >> 2], S[4 + (i_ & 3)]); } SB();
#undef LD256
#undef LD128
#undef MM
#undef SB
#pragma unroll
        for (int ct = 0; ct < 4; ++ct)
#pragma unroll
            for (int reg = 0; reg < 4; ++reg) O[(size_t)(64 * n + 16 * ct + 4 * q + reg) * 1024] = ao[ct][reg];
    }
#undef STAGE_IMG
#undef STAGE_SLICE
    float* so = a.out + (GDN ? O_GDN_P + (size_t)(b * 8 + h) * 128 * 128 : O_RET_P + (size_t)(b * 4 + h) * 128 * 256) + e0 + r;
#pragma unroll
    for (int dt = 0; dt < 8; ++dt)
#pragma unroll
        for (int reg = 0; reg < 4; ++reg) so[(size_t)(16 * dt + 4 * q + reg) * (GDN ? 128 : 256)] = S[dt][reg];
}

__device__ __forceinline__ void ph_gdn_prep(const Args& a, int lane, int gw, int NGW) {
    unsigned char* ws = a.ws;
    const bf16* PROJ = (const bf16*)(ws + WS_BIG);
    constexpr int NCH = (4 + DECB) * 3 * (3072 / 8);
    float xx[2][8]; int chs[2];
#pragma unroll
    for (int u = 0; u < 2; ++u) { const int ch = gw * 64 + lane + u * NGW * 64; chs[u] = ch; const int cc = ch < NCH ? ch : 0;
        const int c = 8 * (cc % 384), j = (cc / 384) % 3, sb = cc / (3 * 384);
        const size_t row = sb < 4 ? (size_t)(sb * SEQ + SEQ - 3 + j) : (size_t)(MP + (sb - 4) * DECS + DECS - 3 + j);
        ld_bf8(PROJ + row * NPROJ + c, xx[u]); }
#pragma unroll
    for (int u = 0; u < 2; ++u) { const int ch = chs[u]; if (ch < NCH) {
        const int c = 8 * (ch % 384), j = (ch / 384) % 3, sb = ch / (3 * 384);
        float* dst = sb < 4 ? a.out + O_GCB_P + ((size_t)sb * 3 + j) * 3072 + c : a.out + O_GCB_S + ((size_t)(sb - 4) * 3 + j) * 3072 + c;
        *(f32x4*)dst = (f32x4){xx[u][0], xx[u][1], xx[u][2], xx[u][3]}; *(f32x4*)(dst + 4) = (f32x4){xx[u][4], xx[u][5], xx[u][6], xx[u][7]}; } }
    static_assert(NCH <= 2 * 256 * NWAVES * 64, "two chunks per lane cover the conv states");
}

__device__ __forceinline__ void ph_mix_prep(const Args& a, LAS unsigned char* lds, int tid, int lane, int wave, int gw, int NGW, int G) {
    for (int t = blockIdx.x; t < 1024; t += G) gdn_prep_chunk(a, lds, t >> 8, (t >> 5) & 7, t & 31, tid, lane, wave);
    for (int r = blockIdx.x; r < 512; r += G) ret_prep_chunk(a, lds, r >> 7, (r >> 5) & 3, r & 31, tid, lane, wave);
    ph_gdn_prep(a, lane, gw, NGW);
}
constexpr int SB_Q = 0, SB_K = 4096, SB_V = 8192, SB_G = 12288;
#define LDS_BARRIER() asm volatile("s_waitcnt lgkmcnt(0)\n\ts_barrier" ::: "memory")
__device__ __forceinline__ float oct_sum(float v) {
    v += __builtin_bit_cast(float, __builtin_amdgcn_mov_dpp(__builtin_bit_cast(int, v), 0xB1, 0xF, 0xF, true));
    v += __builtin_bit_cast(float, __builtin_amdgcn_mov_dpp(__builtin_bit_cast(int, v), 0x4E, 0xF, 0xF, true));
    v += __builtin_bit_cast(float, __builtin_amdgcn_mov_dpp(__builtin_bit_cast(int, v), 0x141, 0xF, 0xF, true));
    return v;
}
__device__ __forceinline__ void gdn_sample_pair(const Args& a, LAS unsigned char* lds, int st, int lane, int wave) {
    unsigned char* ws = a.ws;
    const bf16* PROJ = (const bf16*)(ws + WS_BIG); const float* GATE = (const float*)(ws + WS_GATE); float* OA = (float*)(ws + WS_OA);
    const int hb = wave >> 2, w4 = wave & 3, b = st >> 3, h = st & 7;
    LAS unsigned char* L = lds + hb * 16384;
    LAS float* qs = (LAS float*)(L + SB_Q); LAS float* ks = (LAS float*)(L + SB_K); LAS float* vs = (LAS float*)(L + SB_V); LAS float* gt = (LAS float*)(L + SB_G);
    const int dg = lane & 7, ec = lane >> 3, wcol = 32 * w4 + 4 * ec;
    float2 wj[3][4], xs[3][5]; unsigned xp[3][5]; float g0[2], g1[2];
#pragma unroll
    for (int typ = 0; typ < 3; ++typ) { const int col = typ * 1024 + h * 128 + 2 * lane;
#pragma unroll
        for (int j = 0; j < 4; ++j) wj[typ][j] = *(const float2*)(a.in[I_GCW] + (size_t)j * 3072 + col);
#pragma unroll
        for (int jj = 0; jj < 5; ++jj) { const int tq = 2 * w4 + jj; xs[typ][jj] = *(const float2*)(a.in[I_SGCB] + ((size_t)b * 3 + (tq < 3 ? tq : 2)) * 3072 + col);
            xp[typ][jj] = *(const unsigned*)(PROJ + (size_t)(MP + b * DECS + (tq >= 3 ? tq - 3 : 0)) * NPROJ + col); } }
#pragma unroll
    for (int tt = 0; tt < 2; ++tt) { const size_t m = (size_t)MP + b * DECS + 2 * w4 + tt; g0[tt] = GATE[m * 16 + h]; g1[tt] = GATE[m * 16 + 8 + h]; }
    asm volatile("" ::: "memory");
    f32x4 S[16];
    { const float* sp = a.in[I_SGDN] + (((size_t)b * 8 + h) * 128 + dg * 16) * 128 + wcol;
#pragma unroll
      for (int i = 0; i < 16; ++i) S[i] = *(const f32x4*)(sp + (size_t)i * 128); }
    LDS_BARRIER();
#pragma unroll
    for (int typ = 0; typ < 3; ++typ) {
        asm volatile("" : "+v"(wj[typ][0].x), "+v"(wj[typ][0].y), "+v"(wj[typ][1].x), "+v"(wj[typ][1].y), "+v"(wj[typ][2].x), "+v"(wj[typ][2].y), "+v"(wj[typ][3].x), "+v"(wj[typ][3].y));
        asm volatile("" : "+v"(xs[typ][0].x), "+v"(xs[typ][0].y), "+v"(xs[typ][1].x), "+v"(xs[typ][1].y), "+v"(xs[typ][2].x), "+v"(xs[typ][2].y), "+v"(xs[typ][3].x), "+v"(xs[typ][3].y), "+v"(xs[typ][4].x), "+v"(xs[typ][4].y));
        asm volatile("" : "+v"(xp[typ][0]), "+v"(xp[typ][1]), "+v"(xp[typ][2]), "+v"(xp[typ][3]), "+v"(xp[typ][4])); }
    asm volatile("" : "+v"(g0[0]), "+v"(g0[1]), "+v"(g1[0]), "+v"(g1[1]));
#pragma unroll
    for (int tt = 0; tt < 2; ++tt) { const int c = 2 * w4 + tt;
#pragma unroll
        for (int typ = 0; typ < 3; ++typ) { float a0 = 0.f, a1 = 0.f;
#pragma unroll
            for (int j = 0; j < 4; ++j) { const bool st_ = (c + j) < 3; const unsigned w = xp[typ][tt + j]; const float x0 = st_ ? xs[typ][tt + j].x : __builtin_bit_cast(float, w << 16), x1 = st_ ? xs[typ][tt + j].y : __builtin_bit_cast(float, w & 0xffff0000u);
                a0 += wj[typ][j].x * x0; a1 += wj[typ][j].y * x1; }
            a0 = silu_f(a0); a1 = silu_f(a1);
            if (typ < 2) { const float rs = (1.0f / sqrtf(wave_sum(a0 * a0 + a1 * a1) + EPS)) * (typ == 0 ? 0.08838834764831845f : 1.0f); a0 *= rs; a1 *= rs; }
            LAS float* dst = (typ == 0 ? qs : typ == 1 ? ks : vs) + c * 128 + 2 * lane; dst[0] = a0; dst[1] = a1; }
        if (lane == 0) { gt[c] = g0[tt]; gt[8 + c] = g1[tt]; } }
    LDS_BARRIER();
#pragma unroll 1
    for (int c = 0; c < 8; ++c) {
        const float al = expf(gt[c]), be = gt[8 + c];
        float kk[16], qq[16];
#pragma unroll
        for (int i4 = 0; i4 < 4; ++i4) { const f32x4 k4 = *(const LAS f32x4*)(ks + c * 128 + dg * 16 + 4 * i4), q4 = *(const LAS f32x4*)(qs + c * 128 + dg * 16 + 4 * i4);
            kk[4 * i4] = k4[0]; kk[4 * i4 + 1] = k4[1]; kk[4 * i4 + 2] = k4[2]; kk[4 * i4 + 3] = k4[3]; qq[4 * i4] = q4[0]; qq[4 * i4 + 1] = q4[1]; qq[4 * i4 + 2] = q4[2]; qq[4 * i4 + 3] = q4[3]; }
        const f32x4 v4 = *(const LAS f32x4*)(vs + c * 128 + wcol);
        f32x4 r0 = {0.f, 0.f, 0.f, 0.f}, r1 = {0.f, 0.f, 0.f, 0.f};
#pragma unroll
        for (int i = 0; i < 16; i += 2) { r0 = r0 + S[i] * kk[i]; r1 = r1 + S[i + 1] * kk[i + 1]; }
        f32x4 rr = r0 + r1;
#pragma unroll
        for (int j = 0; j < 4; ++j) rr[j] = oct_sum(rr[j]);
        const f32x4 dl = (v4 - rr * al) * be;
        f32x4 o0 = {0.f, 0.f, 0.f, 0.f}, o1 = {0.f, 0.f, 0.f, 0.f};
#pragma unroll
        for (int i = 0; i < 16; i += 2) { S[i] = S[i] * al + dl * kk[i]; S[i + 1] = S[i + 1] * al + dl * kk[i + 1]; o0 = o0 + S[i] * qq[i]; o1 = o1 + S[i + 1] * qq[i + 1]; }
        f32x4 oo = o0 + o1;
#pragma unroll
        for (int j = 0; j < 4; ++j) oo[j] = oct_sum(oo[j]);
        if (dg == 0) *(f32x4*)(OA + (size_t)(MP + b * DECS + c) * 1024 + h * 128 + wcol) = oo;
    }
    { float* so = a.out + O_GDN_S + (((size_t)b * 8 + h) * 128 + dg * 16) * 128 + wcol;
#pragma unroll
      for (int i = 0; i < 16; ++i) *(f32x4*)(so + (size_t)i * 128) = S[i]; }
}
__device__ __forceinline__ void ret_sample_pair(const Args& a, LAS unsigned char* lds, int st, int lane, int wave) {
    unsigned char* ws = a.ws;
    const bf16* PROJ = (const bf16*)(ws + WS_BIG); const float* tab = (const float*)(ws + WS_TAB); float* OB = (float*)(ws + WS_OB);
    const int hb = wave >> 2, w4 = wave & 3, r_ = st - 1024, b = r_ >> 3, h = (r_ >> 1) & 3, half = r_ & 1;
    LAS unsigned char* L = lds + hb * 16384;
    LAS float* qs = (LAS float*)(L + SB_Q); LAS float* ks = (LAS float*)(L + SB_K); LAS float* vs = (LAS float*)(L + SB_V);
    const int dg = lane & 7, ec = lane >> 3, wcol = 32 * w4 + 4 * ec;
    const float gamma = 1.0f - exp2f(-5.0f - (float)h);
    float cs[2], sn[2]; unsigned rq[2][2], rk[2][2], vw[2];
#pragma unroll
    for (int tt = 0; tt < 2; ++tt) { const int c = 2 * w4 + tt; const unsigned short* pr = (const unsigned short*)(PROJ + (size_t)(MP + b * DECS + c) * NPROJ); const float* tp = tab + (size_t)(2048 + c) * 128;
        cs[tt] = tp[lane]; sn[tt] = tp[64 + lane];
        rq[tt][0] = pr[C_QB + h * 128 + lane]; rq[tt][1] = pr[C_QB + h * 128 + 64 + lane]; rk[tt][0] = pr[C_KB + h * 128 + lane]; rk[tt][1] = pr[C_KB + h * 128 + 64 + lane];
        vw[tt] = *(const unsigned*)(pr + C_VB + h * 256 + half * 128 + 2 * lane); }
    asm volatile("" ::: "memory");
    f32x4 S[16];
    { const float* sp = a.in[I_SRET] + (((size_t)b * 4 + h) * 128 + dg * 16) * 256 + half * 128 + wcol;
#pragma unroll
      for (int i = 0; i < 16; ++i) S[i] = *(const f32x4*)(sp + (size_t)i * 256); }
    LDS_BARRIER();
    asm volatile("" : "+v"(cs[0]), "+v"(sn[0]), "+v"(rq[0][0]), "+v"(rq[0][1]), "+v"(rk[0][0]), "+v"(rk[0][1]), "+v"(vw[0]), "+v"(cs[1]), "+v"(sn[1]), "+v"(rq[1][0]), "+v"(rq[1][1]), "+v"(rk[1][0]), "+v"(rk[1][1]), "+v"(vw[1]));
#pragma unroll
    for (int tt = 0; tt < 2; ++tt) { const int c = 2 * w4 + tt;
        const float ql = __builtin_bit_cast(float, rq[tt][0] << 16), qh = __builtin_bit_cast(float, rq[tt][1] << 16), kl = __builtin_bit_cast(float, rk[tt][0] << 16), kh = __builtin_bit_cast(float, rk[tt][1] << 16);
        qs[c * 128 + lane] = ql * cs[tt] - qh * sn[tt]; qs[c * 128 + 64 + lane] = ql * sn[tt] + qh * cs[tt];
        ks[c * 128 + lane] = (kl * cs[tt] - kh * sn[tt]) * 0.08838834764831845f; ks[c * 128 + 64 + lane] = (kl * sn[tt] + kh * cs[tt]) * 0.08838834764831845f;
        vs[c * 128 + 2 * lane] = __builtin_bit_cast(float, vw[tt] << 16); vs[c * 128 + 2 * lane + 1] = __builtin_bit_cast(float, vw[tt] & 0xffff0000u); }
    LDS_BARRIER();
#pragma unroll 1
    for (int c = 0; c < 8; ++c) {
        float kk[16], qq[16];
#pragma unroll
        for (int i4 = 0; i4 < 4; ++i4) { const f32x4 k4 = *(const LAS f32x4*)(ks + c * 128 + dg * 16 + 4 * i4), q4 = *(const LAS f32x4*)(qs + c * 128 + dg * 16 + 4 * i4);
            kk[4 * i4] = k4[0]; kk[4 * i4 + 1] = k4[1]; kk[4 * i4 + 2] = k4[2]; kk[4 * i4 + 3] = k4[3]; qq[4 * i4] = q4[0]; qq[4 * i4 + 1] = q4[1]; qq[4 * i4 + 2] = q4[2]; qq[4 * i4 + 3] = q4[3]; }
        const f32x4 v4 = *(const LAS f32x4*)(vs + c * 128 + wcol);
        f32x4 o0 = {0.f, 0.f, 0.f, 0.f}, o1 = {0.f, 0.f, 0.f, 0.f};
#pragma unroll
        for (int i = 0; i < 16; i += 2) { S[i] = S[i] * gamma + v4 * kk[i]; S[i + 1] = S[i + 1] * gamma + v4 * kk[i + 1]; o0 = o0 + S[i] * qq[i]; o1 = o1 + S[i + 1] * qq[i + 1]; }
        f32x4 oo = o0 + o1;
#pragma unroll
        for (int j = 0; j < 4; ++j) oo[j] = oct_sum(oo[j]);
        if (dg == 0) *(f32x4*)(OB + (size_t)(MP + b * DECS + c) * 1024 + h * 256 + half * 128 + wcol) = oo;
    }
    { float* so = a.out + O_RET_S + (((size_t)b * 4 + h) * 128 + dg * 16) * 256 + half * 128 + wcol;
#pragma unroll
      for (int i = 0; i < 16; ++i) *(f32x4*)(so + (size_t)i * 256) = S[i]; }
}
__device__ __forceinline__ void sample_pairs(const Args& a, LAS unsigned char* lds, int p0, int stride, int cnt, int lane, int wave) {
    const int hb = wave >> 2;
    __builtin_amdgcn_s_waitcnt(0);
#pragma unroll 1
    for (int k = 0; k < cnt; ++k) { const int pr = p0 + k * stride, st = 2 * pr + hb;
        if (pr < 512) gdn_sample_pair(a, lds, st, lane, wave); else ret_sample_pair(a, lds, st, lane, wave); }
}
__device__ __forceinline__ void ph_scans(const Args& a, LAS unsigned char* lds, int tid, int lane, int wave, int G, int mode = 3) {
    const int blk = blockIdx.x;
    if (mode & 1) { if (blk < 32) chunk_scan<true>(a, lds, blk, tid, lane, wave); else if (blk < 64) chunk_scan<false>(a, lds, blk - 32, tid, lane, wave); }
    if ((mode & 2) && blk >= 64) sample_pairs(a, lds, blk - 64, 192, (blk - 64) < 64 ? 6 : 5, lane, wave);
    if (mode == 3 && blk >= 64) convert_group(a, 1, (LAS float*)(lds + 32768 + wave * 8704), lane, (blk - 64) * NWAVES + wave, 192 * NWAVES);
}

__device__ __forceinline__ void ph_mix_norm(const Args& a, int lane, int gw, int NGW) {
    unsigned char* ws = a.ws;
    const bf16* PROJ = (const bf16*)(ws + WS_BIG); const float* OA = (const float*)(ws + WS_OA); const float* OB = (const float*)(ws + WS_OB); bf16* MIX = (bf16*)(ws + WS_G2);
    float wa[2][8], wb[2][8], bb[2][8];
#pragma unroll
    for (int i = 0; i < 2; ++i) { const int col = 8 * (lane + 64 * i); ld_f8(a.in[I_GNW] + (col & 127), wa[i]); ld_f8(a.in[I_RGW] + col, wb[i]); ld_f8(a.in[I_RGB] + col, bb[i]); }
    for (int m = gw; m < MTOT; m += NGW) {
        f32x4 oa[2][2], ob[2][2]; u32x4 zz[2], gg[2];
#pragma unroll
        for (int i = 0; i < 2; ++i) { const int col = 8 * (lane + 64 * i);
            oa[i][0] = *(const f32x4*)(OA + (size_t)m * 1024 + col); oa[i][1] = *(const f32x4*)(OA + (size_t)m * 1024 + col + 4);
            ob[i][0] = *(const f32x4*)(OB + (size_t)m * 1024 + col); ob[i][1] = *(const f32x4*)(OB + (size_t)m * 1024 + col + 4);
            zz[i] = *(const u32x4*)(PROJ + (size_t)m * NPROJ + C_ZA + col); gg[i] = *(const u32x4*)(PROJ + (size_t)m * NPROJ + C_GB + col); }
#pragma unroll
        for (int i = 0; i < 2; ++i) {
            const int col = 8 * (lane + 64 * i);
            float o[8] = {oa[i][0][0], oa[i][0][1], oa[i][0][2], oa[i][0][3], oa[i][1][0], oa[i][1][1], oa[i][1][2], oa[i][1][3]}, z[8]; unpack8(zz[i], z);
            float ss = 0.f;
#pragma unroll
            for (int e = 0; e < 8; ++e) ss += o[e] * o[e];
            ss += __shfl_xor(ss, 1); ss += __shfl_xor(ss, 2); ss += __shfl_xor(ss, 4); ss += __shfl_xor(ss, 8);
            const float rs = 1.0f / sqrtf(ss * (1.0f / 128.0f) + EPS);
#pragma unroll
            for (int e = 0; e < 8; ++e) o[e] = o[e] * rs * wa[i][e] * silu_f(z[e]);
            st_bf8(MIX + (size_t)m * 2048 + col, o);
        }
#pragma unroll
        for (int i = 0; i < 2; ++i) {
            const int col = 8 * (lane + 64 * i);
            float o[8] = {ob[i][0][0], ob[i][0][1], ob[i][0][2], ob[i][0][3], ob[i][1][0], ob[i][1][1], ob[i][1][2], ob[i][1][3]}, g[8]; unpack8(gg[i], g);
            float s_ = 0.f;
#pragma unroll
            for (int e = 0; e < 8; ++e) s_ += o[e];
            s_ += __shfl_xor(s_, 1); s_ += __shfl_xor(s_, 2); s_ += __shfl_xor(s_, 4); s_ += __shfl_xor(s_, 8); s_ += __shfl_xor(s_, 16);
            const float mu = s_ * (1.0f / 256.0f); float q = 0.f;
#pragma unroll
            for (int e = 0; e < 8; ++e) { o[e] -= mu; q += o[e] * o[e]; }
            q += __shfl_xor(q, 1); q += __shfl_xor(q, 2); q += __shfl_xor(q, 4); q += __shfl_xor(q, 8); q += __shfl_xor(q, 16);
            const float rs = 1.0f / sqrtf(q * (1.0f / 256.0f) + EPS);
#pragma unroll
            for (int e = 0; e < 8; ++e) o[e] = (o[e] * rs * wb[i][e] + bb[i][e]) * silu_f(g[e]);
            st_bf8(MIX + (size_t)m * 2048 + 1024 + col, o);
        }
    }
}

__device__ __forceinline__ void ffn_conv_prompt(const Args& a, int layer, int lane, int gw, int NGW) {
    unsigned char* ws = a.ws;
    const bf16* UP = (const bf16*)(ws + WS_BIG); bf16* ACT = (bf16*)(ws + WS_ACT);
    const float* cw = a.in[I_FCW] + (size_t)layer * 3 * NUP; const float* cb = a.in[I_FCBIAS] + (size_t)layer * NUP;
    for (int task = gw; task < 128 * 11; task += NGW) {
        const int run = task / 11, cblk = task % 11, m0 = run * 64, t0 = m0 % SEQ;
        const int j0 = 8 * (lane + 64 * cblk), ucol = ((j0 >> 7) << 8) + (j0 & 127);
        float wv[3][8], wg[3][8], bv_[8], bg_[8]; ld_f8(cb + j0, bv_); ld_f8(cb + DFF + j0, bg_);
#pragma unroll
        for (int jj = 0; jj < 3; ++jj) { ld_f8(cw + (size_t)jj * NUP + j0, wv[jj]); ld_f8(cw + (size_t)jj * NUP + DFF + j0, wg[jj]); }
        float p2v[8], p2g[8], p1v[8], p1g[8];
        if (t0 == 0) {
#pragma unroll
            for (int e = 0; e < 8; ++e) { p2v[e] = 0.f; p2g[e] = 0.f; p1v[e] = 0.f; p1g[e] = 0.f; }
        } else { const bf16* r2 = UP + (size_t)(m0 - 2) * NUP + ucol; ld_bf8(r2, p2v); ld_bf8(r2 + 128, p2g); ld_bf8(r2 + NUP, p1v); ld_bf8(r2 + NUP + 128, p1g); }
        const bf16* rp = UP + (size_t)m0 * NUP + ucol; bf16* op = ACT + (size_t)m0 * DFF + j0;
#pragma unroll 1
        for (int i8 = 0; i8 < 8; ++i8) {
            u32x4 lv[8], lg[8];
#pragma unroll
            for (int k = 0; k < 8; ++k) { lv[k] = *(const u32x4*)(rp + (size_t)k * NUP); lg[k] = *(const u32x4*)(rp + (size_t)k * NUP + 128); }
#pragma unroll
            for (int k = 0; k < 8; ++k) { float xv[8], xg[8], o[8]; unpack8(lv[k], xv); unpack8(lg[k], xg);
#pragma unroll
                for (int e = 0; e < 8; ++e) { const float va = bv_[e] + wv[0][e] * p2v[e] + wv[1][e] * p1v[e] + wv[2][e] * xv[e], ga = bg_[e] + wg[0][e] * p2g[e] + wg[1][e] * p1g[e] + wg[2][e] * xg[e];
                    o[e] = silu_f(ga) * va; p2v[e] = p1v[e]; p2g[e] = p1g[e]; p1v[e] = xv[e]; p1g[e] = xg[e]; }
                st_bf8(op + (size_t)k * DFF, o); }
            rp += (size_t)8 * NUP; op += (size_t)8 * DFF;
        }
    }
}
__device__ __forceinline__ void ffn_conv_sample(const Args& a, int layer, int lane, int gw, int NGW) {
    unsigned char* ws = a.ws;
    const bf16* UP = (const bf16*)(ws + WS_BIG); bf16* ACT = (bf16*)(ws + WS_ACT);
    const float* cw = a.in[I_FCW] + (size_t)layer * 3 * NUP; const float* cb = a.in[I_FCBIAS] + (size_t)layer * NUP; const float* cst = a.in[I_SFCB] + (size_t)layer * DECB * 2 * NUP;
    for (int task = gw; task < MS * 11; task += NGW) {
        const int m = MP + task / 11, i = task % 11;
        const int b = (m - MP) / DECS, t = (m - MP) % DECS;
        {
            const int j0 = 8 * (lane + 64 * i), ucol = ((j0 >> 7) << 8) + (j0 & 127);
            float va[8], ga[8]; ld_f8(cb + j0, va); ld_f8(cb + DFF + j0, ga);
#pragma unroll
            for (int jj = 0; jj < 3; ++jj) { float xv[8], xg[8], sv[8], sg[8], wv[8], wg[8]; const int tt = t + jj; const bool from_state = tt < 2;
                const bf16* r = UP + (size_t)(MP + b * DECS + (tt >= 2 ? tt - 2 : 0)) * NUP + ucol; ld_bf8(r, xv); ld_bf8(r + 128, xg);
                const float* rs_ = cst + ((size_t)b * 2 + (tt < 2 ? tt : 1)) * NUP + j0; ld_f8(rs_, sv); ld_f8(rs_ + DFF, sg);
                ld_f8(cw + (size_t)jj * NUP + j0, wv); ld_f8(cw + (size_t)jj * NUP + DFF + j0, wg);
#pragma unroll
                for (int e = 0; e < 8; ++e) { va[e] += wv[e] * (from_state ? sv[e] : xv[e]); ga[e] += wg[e] * (from_state ? sg[e] : xg[e]); } }
            float o[8];
#pragma unroll
            for (int e = 0; e < 8; ++e) o[e] = silu_f(ga[e]) * va[e];
            st_bf8(ACT + (size_t)m * DFF + j0, o);
        }
    }
    constexpr int NCH = (4 + DECB) * 2 * (NUP / 8);
    float xx[3][8]; int chs[3];
#pragma unroll
    for (int u = 0; u < 3; ++u) { const int ch = gw * 64 + lane + u * NGW * 64; chs[u] = ch; const int cc = ch < NCH ? ch : 0;
        const int c = 8 * (cc % (NUP / 8)), rr = cc / (NUP / 8), r = rr & 1, sb = rr >> 1;
        const int j = c < DFF ? c : c - DFF, ucol = ((j >> 7) << 8) + (j & 127) + (c < DFF ? 0 : 128);
        const size_t row = sb < 4 ? (size_t)(sb * SEQ + SEQ - 2 + r) : (size_t)(MP + (sb - 4) * DECS + DECS - 2 + r);
        ld_bf8(UP + row * NUP + ucol, xx[u]); }
#pragma unroll
    for (int u = 0; u < 3; ++u) { const int ch = chs[u]; if (ch < NCH) {
        const int c = 8 * (ch % (NUP / 8)), rr = ch / (NUP / 8), r = rr & 1, sb = rr >> 1;
        float* dst = sb < 4 ? a.out + O_FCB_P + ((size_t)(layer * 4 + sb) * 2 + r) * NUP + c : a.out + O_FCB_S + ((size_t)(layer * DECB + (sb - 4)) * 2 + r) * NUP + c;
        *(f32x4*)dst = (f32x4){xx[u][0], xx[u][1], xx[u][2], xx[u][3]}; *(f32x4*)(dst + 4) = (f32x4){xx[u][4], xx[u][5], xx[u][6], xx[u][7]}; } }
    static_assert(NCH <= 3 * 256 * NWAVES * 64, "three chunks per lane cover the conv states");
}

__device__ __forceinline__ void s5_task(const Args& a, bool prompt, int b, int g, int lane) {
    unsigned char* ws = a.ws;
    const bf16* H = (const bf16*)(ws + WS_H); bf16* G2 = (bf16*)(ws + WS_G2);
    const int p = lane, gp = g * 64 + p;
    const double lr = (double)a.in[I_LRE][gp], li = (double)a.in[I_LIM][gp], dt = exp((double)a.in[I_LDT][g]);
    const double mag = exp(lr * dt); double sn, cs; sincos_d(li * dt, sn, cs);
    const double abr = mag * cs, abi = mag * sn, den = lr * lr + li * li;
    const double cfr = ((abr - 1.0) * lr + abi * li) / den, cfi = (abi * lr - (abr - 1.0) * li) / den;
    float bbr[16], bbi[16], cr[16], ci[16];
#pragma unroll
    for (int c = 0; c < 16; ++c) { const double br = (double)a.in[I_BRE][(size_t)gp * 16 + c], bi = (double)a.in[I_BIM][(size_t)gp * 16 + c]; bbr[c] = (float)(cfr * br - cfi * bi); bbi[c] = (float)(cfr * bi + cfi * br);
        cr[c] = a.in[I_CRE][((size_t)g * 16 + c) * 64 + p]; ci[c] = a.in[I_CIM][((size_t)g * 16 + c) * 64 + p]; }
    const float ar = (float)abr, ai = (float)abi;
    float xr = 0.f, xi = 0.f;
    if (!prompt) { xr = a.in[I_S5RE][((size_t)b * 128 + g) * 64 + p]; xi = a.in[I_S5IM][((size_t)b * 128 + g) * 64 + p]; }
    const bool b5 = lane & 32, b4 = lane & 16, b3 = lane & 8, b2 = lane & 4;
    const int cme = (b5 ? 8 : 0) + (b4 ? 4 : 0) + (b3 ? 2 : 0) + (b2 ? 1 : 0);
    const float dme = a.in[I_S5D][g * 16 + cme];
    const int L = prompt ? SEQ : DECS, row0 = prompt ? b * SEQ : MP + b * DECS;
    const bf16* hp = H + (size_t)row0 * DM + g * 16;
    u32x4 nu0 = *(const u32x4*)hp, nu1 = *(const u32x4*)(hp + 8); unsigned short nume = hp[cme];
    for (int t = 0; t < L; ++t) {
        float u[16]; { float ua[8], ub[8]; unpack8(nu0, ua); unpack8(nu1, ub);
#pragma unroll
            for (int c = 0; c < 8; ++c) { u[c] = ua[c]; u[8 + c] = ub[c]; } }
        const float ume = bf2f(nume);
        if (t + 1 < L) { hp += DM; nu0 = *(const u32x4*)hp; nu1 = *(const u32x4*)(hp + 8); nume = hp[cme]; }
        float bur = 0.f, bui = 0.f;
#pragma unroll
        for (int c = 0; c < 16; ++c) { bur += bbr[c] * u[c]; bui += bbi[c] * u[c]; }
        const float nxr = ar * xr - ai * xi + bur, nxi = ar * xi + ai * xr + bui; xr = nxr; xi = nxi;
        float vals[16];
#pragma unroll
        for (int c = 0; c < 16; ++c) vals[c] = cr[c] * xr - ci[c] * xi;
        float k8[8], k4[4], k2[2], y;
#pragma unroll
        for (int i = 0; i < 8; ++i) { const float send = b5 ? vals[i] : vals[8 + i], keep = b5 ? vals[8 + i] : vals[i]; k8[i] = keep + __shfl_xor(send, 32); }
#pragma unroll
        for (int i = 0; i < 4; ++i) { const float send = b4 ? k8[i] : k8[4 + i], keep = b4 ? k8[4 + i] : k8[i]; k4[i] = keep + __shfl_xor(send, 16); }
#pragma unroll
        for (int i = 0; i < 2; ++i) { const float send = b3 ? k4[i] : k4[2 + i], keep = b3 ? k4[2 + i] : k4[i]; k2[i] = keep + __shfl_xor(send, 8); }
        { const float send = b2 ? k2[0] : k2[1], keep = b2 ? k2[1] : k2[0]; y = keep + __shfl_xor(send, 4); }
        y += __shfl_xor(y, 2); y += __shfl_xor(y, 1);
        y = gelu_tanh(y + dme * ume);
        if ((lane & 3) == 0) G2[(size_t)(row0 + t) * DM + g * 16 + cme] = (bf16)f2bf(y);
    }
    const size_t so = ((size_t)b * 128 + g) * 64 + p;
    a.out[(prompt ? O_S5R_P : O_S5R_S) + so] = xr; a.out[(prompt ? O_S5I_P : O_S5I_S) + so] = xi;
}
__device__ __forceinline__ bf16x8 pack8(const float (&v)[8]) { u32x4 w; w.x = cvtpk(v[0], v[1]); w.y = cvtpk(v[2], v[3]); w.z = cvtpk(v[4], v[5]); w.w = cvtpk(v[6], v[7]); return __builtin_bit_cast(bf16x8, w); }
__device__ __forceinline__ float bfround(float x) { return __builtin_bit_cast(float, f2bf(x) << 16); }
constexpr int S5_PITCH = 132, S5_WAVE_LDS = 16 * S5_PITCH * 4;
constexpr int S5_SEG = 128, S5_NSEG = SEQ / S5_SEG;
constexpr size_t WS_S5E = WS_ACT;
struct S5C {
    bf16x8 Bf[8];
    bf16x8 Ch[4], Cl[4], Df;
    float nwa[8];
    float ar, ai;
};
__device__ __forceinline__ void s5_first(const bf16* H, const float* SS, int g, int row0, int lane, u32x4& An, float& sn_) {
    const int r = lane & 15, q = lane >> 4, rlast = MTOT - 1 - row0, rr = r < rlast ? r : rlast;
    An = *(const u32x4*)(H + (size_t)(row0 + rr) * DM + g * 16 + 8 * (q & 1)); sn_ = SS[row0 + rr];
}
template <bool FULL>
__device__ __forceinline__ void s5_run(const S5C& C, const bf16* H, const float* SS, bf16* G2, LAS float* T, int g, int row0, int L, float& xr, float& xi, int lane, u32x4 An, float sn_) {
    const int r = lane & 15, q = lane >> 4;
    const bf16* hp = H + (size_t)row0 * DM + g * 16 + 8 * (q & 1);
    for (int t0 = 0; t0 < L; t0 += 16) {
        bf16x8 A; { float xa[8]; unpack8(An, xa); const float rs = 1.0f / sqrtf(sn_ * (1.0f / DM) + EPS);
#pragma unroll
            for (int j = 0; j < 8; ++j) xa[j] = xa[j] * rs * C.nwa[j];
            A = pack8(xa); }
        if (t0 + 16 < L) { An = *(const u32x4*)(hp + (size_t)(t0 + 16 + r) * DM); sn_ = SS[row0 + t0 + 16 + r]; }
#pragma unroll
        for (int nt = 0; nt < 8; ++nt) { const f32x4 d = MFMA16(A, C.Bf[nt], ((f32x4){0.f, 0.f, 0.f, 0.f}));
#pragma unroll
            for (int reg = 0; reg < 4; ++reg) T[(4 * q + reg) * S5_PITCH + 16 * nt + r] = d[reg]; }
        float bur[16], bui[16];
#pragma unroll
        for (int t = 0; t < 16; ++t) { bur[t] = T[t * S5_PITCH + lane]; bui[t] = T[t * S5_PITCH + 64 + lane]; }
#pragma unroll
        for (int t = 0; t < 16; ++t) { if (t0 + t < L) { const float nr = C.ar * xr - C.ai * xi + bur[t], ni = C.ar * xi + C.ai * xr + bui[t]; xr = nr; xi = ni; } bur[t] = xr; bui[t] = xi; }
        if (FULL) {
#pragma unroll
            for (int t = 0; t < 16; ++t) { T[t * S5_PITCH + lane] = bur[t]; T[t * S5_PITCH + 64 + lane] = bui[t]; }
            f32x4 y = MFMA16(A, C.Df, ((f32x4){0.f, 0.f, 0.f, 0.f}));
#pragma unroll
            for (int s = 0; s < 4; ++s) { const f32x4 x0 = *(const LAS f32x4*)(T + r * S5_PITCH + 32 * s + 8 * q), x1 = *(const LAS f32x4*)(T + r * S5_PITCH + 32 * s + 8 * q + 4);
                u32x4 wh; wh[0] = cvtpk(x0[0], x0[1]); wh[1] = cvtpk(x0[2], x0[3]); wh[2] = cvtpk(x1[0], x1[1]); wh[3] = cvtpk(x1[2], x1[3]);
                const bf16x8 xh = __builtin_bit_cast(bf16x8, wh);
                y = MFMA16(xh, C.Ch[s], y); y = MFMA16(xh, C.Cl[s], y); }
#pragma unroll
            for (int reg = 0; reg < 4; ++reg) { const int t = t0 + 4 * q + reg; if (t < L) G2[(size_t)(row0 + t) * DM + g * 16 + r] = (bf16)f2bf(gelu_tanh(y[reg])); }
        }
    }
}
__device__ __forceinline__ void s5_wave(const Args& a, LAS float* T, bool second, int g, int sub, int lane) {
    unsigned char* ws = a.ws;
    const bf16* H = (const bf16*)(ws + WS_H); bf16* G2 = (bf16*)(ws + WS_G2); const float* SS = (const float*)(ws + WS_SS) + MTOT;
    float* E = (float*)(ws + WS_S5E);
    const int r = lane & 15, q = lane >> 4;
    S5C C;
    float cfrf, cfif, a128r, a128i;
    {   const int gp = g * 64 + lane;
        const double lr = (double)a.in[I_LRE][gp], li = (double)a.in[I_LIM][gp], dt = exp((double)a.in[I_LDT][g]);
        const double mag = exp(lr * dt); double sn, cs; sincos_d(li * dt, sn, cs);
        const double abr = mag * cs, abi = mag * sn, den = lr * lr + li * li;
        C.ar = (float)abr; C.ai = (float)abi; cfrf = (float)(((abr - 1.0) * lr + abi * li) / den); cfif = (float)((abi * lr - (abr - 1.0) * li) / den);
        const double m128 = exp(lr * dt * (double)S5_SEG); sincos_d(li * dt * (double)S5_SEG, sn, cs); a128r = (float)(m128 * cs); a128i = (float)(m128 * sn); }
    ld_f8(a.in[I_NMIX] + DM + g * 16 + 8 * (q & 1), C.nwa);
#pragma unroll
    for (int nt = 0; nt < 8; ++nt) { const int p = (16 * nt + r) & 63; const float cr_ = __shfl(cfrf, p), ci_ = __shfl(cfif, p);
        float br[8], bi[8], v[8]; ld_f8(a.in[I_BRE] + ((size_t)g * 64 + p) * 16 + 8 * (q & 1), br); ld_f8(a.in[I_BIM] + ((size_t)g * 64 + p) * 16 + 8 * (q & 1), bi);
#pragma unroll
        for (int j = 0; j < 8; ++j) { const float val = (nt < 4) ? (cr_ * br[j] - ci_ * bi[j]) : (cr_ * bi[j] + ci_ * br[j]); const float hi = bfround(val); v[j] = (q < 2) ? hi : (val - hi); }
        C.Bf[nt] = pack8(v); }
#pragma unroll
    for (int s = 0; s < 4; ++s) { float cv[8], hi[8], lo[8]; ld_f8((s < 2 ? a.in[I_CRE] : a.in[I_CIM]) + ((size_t)g * 16 + r) * 64 + 32 * (s & 1) + 8 * q, cv);
#pragma unroll
        for (int j = 0; j < 8; ++j) { const float val = (s < 2) ? cv[j] : -cv[j]; hi[j] = bfround(val); lo[j] = val - hi[j]; }
        C.Ch[s] = pack8(hi); C.Cl[s] = pack8(lo); }
    {   const float dv = a.in[I_S5D][g * 16 + r], dh = bfround(dv), dl = dv - dh; float v[8];
#pragma unroll
        for (int j = 0; j < 8; ++j) v[j] = ((r & 7) == j && (r >> 3) == (q & 1)) ? (q < 2 ? dh : dl) : 0.f;
        C.Df = pack8(v); }
    const int NT = second ? 4 : 12;
    u32x4 Ap; float sp_, xpr = 0.f, xpi = 0.f;
    s5_first(H, SS, g, sub * S5_SEG, lane, Ap, sp_);
#pragma unroll 1
    for (int ti = 0; ti < NT; ++ti) {
        const u32x4 Ac = Ap; const float sc_ = sp_, xcr = xpr, xci = xpi;
        if (ti + 1 < NT) { const int tn = ti + 1;
            if (tn < 4) s5_first(H, SS, g, tn * SEQ + sub * S5_SEG, lane, Ap, sp_);
            else { const int bn = sub * 8 + (tn - 4); s5_first(H, SS, g, MP + bn * DECS, lane, Ap, sp_); const size_t so = ((size_t)bn * 128 + g) * 64 + lane; xpr = a.in[I_S5RE][so]; xpi = a.in[I_S5IM][so]; } }
        if (ti < 4) { const int b = ti, row0 = b * SEQ + sub * S5_SEG; float* Eb = E + (((size_t)b * 128 + g) * S5_NSEG) * 128;
            if (!second) { float xr = 0.f, xi = 0.f; s5_run<false>(C, H, SS, G2, T, g, row0, S5_SEG, xr, xi, lane, Ac, sc_); Eb[sub * 128 + lane] = xr; Eb[sub * 128 + 64 + lane] = xi; }
            else { float er[15], ei[15];
#pragma unroll
                for (int m = 0; m < 15; ++m) { const int mm = m < sub ? m : 0; er[m] = Eb[mm * 128 + lane]; ei[m] = Eb[mm * 128 + 64 + lane]; }
                float xr = 0.f, xi = 0.f;
#pragma unroll
                for (int m = 0; m < 15; ++m) if (m < sub) { const float nr = a128r * xr - a128i * xi + er[m], ni = a128r * xi + a128i * xr + ei[m]; xr = nr; xi = ni; }
                s5_run<true>(C, H, SS, G2, T, g, row0, S5_SEG, xr, xi, lane, Ac, sc_);
                if (sub == S5_NSEG - 1) { const size_t so = ((size_t)b * 128 + g) * 64 + lane; a.out[O_S5R_P + so] = xr; a.out[O_S5I_P + so] = xi; } }
        } else { const int b = sub * 8 + (ti - 4); const size_t so = ((size_t)b * 128 + g) * 64 + lane;
            float xr = xcr, xi = xci;
            s5_run<true>(C, H, SS, G2, T, g, MP + b * DECS, DECS, xr, xi, lane, Ac, sc_);
            a.out[O_S5R_S + so] = xr; a.out[O_S5I_S + so] = xi; }
    }
}
__device__ __forceinline__ void ph_s5(const Args& a, LAS unsigned char* lds, bool second, int lane, int wave, int gw, int NGW) {
    LAS float* T = (LAS float*)(lds + wave * S5_WAVE_LDS);
    for (int w = gw; w < 2048; w += NGW) s5_wave(a, T, second, w >> 4, w & 15, lane);
}

constexpr int S5MM_REP = 0;
constexpr int SM_WC = 0, SM_WST = 65536, SM_KT = 131072, SM_POW = 139264, SM_CF = 147968;
constexpr size_t WS_S5L = WS_ACT, WS_S5X = WS_ACT + 48 * MiB, WS_UG = WS_BIG + 64 * MiB;
typedef float f32x2_t __attribute__((ext_vector_type(2)));
__device__ __forceinline__ int s5_row(int hb, int col, int t) {
    return col < 256 ? (2 * hb + (col >> 7)) * SEQ + 16 * (col & 127) + t : MP + (64 * hb + (col - 256)) * DECS + t;
}
__device__ __forceinline__ void s5_load_u(const Args& a, int g, int hb, int cb, int lane, bf16x8 (&Uf)[8]) {
    const bf16* UG = (const bf16*)(a.ws + WS_UG0);
    const int r = lane & 15, q = lane >> 4, col = 16 * cb + r; const bool samp = col >= 256;
    const bf16* up = UG + ((size_t)g * MTOT + s5_row(hb, col, 0)) * 16 + 16 * (q >> 1) + 8 * (q & 1);
#pragma unroll
    for (int ks = 0; ks < 8; ++ks) { Uf[ks] = *(const bf16x8*)(up + ((samp && ks >= 4) ? 0 : 32 * ks)); if (samp && ks >= 4) Uf[ks] = (bf16x8){0, 0, 0, 0, 0, 0, 0, 0}; }
}
__device__ __forceinline__ void ph_s5_mm(const Args& a, LAS unsigned char* lds, int task, int tid, int lane, int wave) {
    unsigned char* ws = a.ws;
    const int g = task >> 1, hb = task & 1, r = lane & 15, q = lane >> 4;
    LAS f32x2_t* POW = (LAS f32x2_t*)(lds + SM_POW); LAS f32x2_t* CF = (LAS f32x2_t*)(lds + SM_CF);
    float* LB = (float*)(ws + WS_S5L) + (size_t)task * 320 * 128; float* XB = (float*)(ws + WS_S5X) + (size_t)task * 320 * 128;
    bf16* G2 = (bf16*)(ws + WS_G2);
    for (int rep_t = 0; rep_t < (S5MM_REP == 1 ? 2 : 1); ++rep_t) {
    __syncthreads();
    if (tid < 64) { const int gp = g * 64 + tid;
        const double lr = (double)a.in[I_LRE][gp], li = (double)a.in[I_LIM][gp], dt = exp((double)a.in[I_LDT][g]);
        const double mag = exp(lr * dt); double sn, cs; sincos_d(li * dt, sn, cs);
        const double abr = mag * cs, abi = mag * sn, den = lr * lr + li * li;
        CF[tid] = (f32x2_t){(float)(((abr - 1.0) * lr + abi * li) / den), (float)((abi * lr - (abr - 1.0) * li) / den)};
        double pr = 1.0, pi = 0.0;
#pragma unroll 1
        for (int e = 0; e <= 16; ++e) { POW[tid * 17 + e] = (f32x2_t){(float)pr, (float)pi}; const double nr = pr * abr - pi * abi, ni = pr * abi + pi * abr; pr = nr; pi = ni; } }
    __syncthreads();
    {
        const int kp = tid & 127, p = kp & 63, part = kp >> 6, s0 = 4 * (tid >> 7);
        const f32x2_t cf = CF[p]; float bbr[16], bbi[16];
#pragma unroll
        for (int c4 = 0; c4 < 4; ++c4) { const f32x4 br = *(const f32x4*)(a.in[I_BRE] + ((size_t)g * 64 + p) * 16 + 4 * c4), bi = *(const f32x4*)(a.in[I_BIM] + ((size_t)g * 64 + p) * 16 + 4 * c4);
#pragma unroll
            for (int j = 0; j < 4; ++j) { bbr[4 * c4 + j] = cf.x * br[j] - cf.y * bi[j]; bbi[4 * c4 + j] = cf.x * bi[j] + cf.y * br[j]; } }
#pragma unroll
        for (int si = 0; si < 4; ++si) { const int s = s0 + si; const f32x2_t pw = POW[p * 17 + 15 - s]; float v[16];
#pragma unroll
            for (int c = 0; c < 16; ++c) v[c] = part ? (pw.x * bbi[c] + pw.y * bbr[c]) : (pw.x * bbr[c] - pw.y * bbi[c]);
            u32x4 w0, w1; w0.x = pk2(v[0], v[1]); w0.y = pk2(v[2], v[3]); w0.z = pk2(v[4], v[5]); w0.w = pk2(v[6], v[7]); w1.x = pk2(v[8], v[9]); w1.y = pk2(v[10], v[11]); w1.z = pk2(v[12], v[13]); w1.w = pk2(v[14], v[15]);
            *(LAS u32x4*)(lds + SM_WST + kp * 512 + (((2 * s) ^ (kp & 15)) << 4)) = w0; *(LAS u32x4*)(lds + SM_WST + kp * 512 + (((2 * s + 1) ^ (kp & 15)) << 4)) = w1; }
    }
    {
        const int R = tid & 255, t = R >> 4, c = R & 15, half = tid >> 8;
#pragma unroll 4
        for (int i = 0; i < 8; ++i) { float v[8]; const f32x4 cr0 = *(const f32x4*)(a.in[I_CRE] + ((size_t)g * 16 + c) * 64 + 8 * i), cr1 = *(const f32x4*)(a.in[I_CRE] + ((size_t)g * 16 + c) * 64 + 8 * i + 4),
                                                         ci0 = *(const f32x4*)(a.in[I_CIM] + ((size_t)g * 16 + c) * 64 + 8 * i), ci1 = *(const f32x4*)(a.in[I_CIM] + ((size_t)g * 16 + c) * 64 + 8 * i + 4);
#pragma unroll
            for (int j = 0; j < 8; ++j) { const float cr = j < 4 ? cr0[j] : cr1[j - 4], ci = j < 4 ? ci0[j] : ci1[j - 4]; const f32x2_t pw = POW[(8 * i + j) * 17 + t + 1];
                v[j] = half ? -(cr * pw.y + ci * pw.x) : (cr * pw.x - ci * pw.y); }
            u32x4 w; w.x = pk2(v[0], v[1]); w.y = pk2(v[2], v[3]); w.z = pk2(v[4], v[5]); w.w = pk2(v[6], v[7]);
            *(LAS u32x4*)(lds + SM_WC + addr256(R, 8 * half + i)) = w; }
    }
    __syncthreads();
    {
        bf16x8 Bs[4];
        {   float re8[2][8], im8[2][8];
#pragma unroll
            for (int ks = 0; ks < 2; ++ks)
#pragma unroll
                for (int j = 0; j < 8; ++j) { const int p = 32 * ks + 8 * q + j; const float br = a.in[I_BRE][((size_t)g * 64 + p) * 16 + r], bi = a.in[I_BIM][((size_t)g * 64 + p) * 16 + r]; const f32x2_t cf = CF[p];
                    re8[ks][j] = cf.x * br - cf.y * bi; im8[ks][j] = cf.x * bi + cf.y * br; }
            Bs[0] = pack8(re8[0]); Bs[1] = pack8(re8[1]); Bs[2] = pack8(im8[0]); Bs[3] = pack8(im8[1]); }
#pragma unroll
        for (int di = 0; di < 2; ++di) { const int d = 2 * wave + di; f32x4 acc = {0.f, 0.f, 0.f, 0.f};
            if (d == 0) {
#pragma unroll
                for (int ks = 0; ks < 4; ++ks) { float cv[8]; ld_f8((ks < 2 ? a.in[I_CRE] : a.in[I_CIM]) + ((size_t)g * 16 + r) * 64 + 32 * (ks & 1) + 8 * q, cv);
                    if (ks >= 2) {
#pragma unroll
                        for (int j = 0; j < 8; ++j) cv[j] = -cv[j]; }
                    acc = MFMA16(pack8(cv), Bs[ks], acc); }
#pragma unroll
                for (int reg = 0; reg < 4; ++reg) if (4 * q + reg == r) acc[reg] += a.in[I_S5D][g * 16 + r];
            } else {
#pragma unroll
                for (int ks = 0; ks < 4; ++ks) acc = MFMA16(*(const LAS bf16x8*)(lds + SM_WC + addr256(16 * (d - 1) + r, 4 * ks + q)), Bs[ks], acc); }
#pragma unroll
            for (int reg = 0; reg < 4; ++reg) *(LAS bf16*)(lds + SM_KT + ((d * 16 + 4 * q + reg) * 16 + r) * 2) = (bf16)f2bf(acc[reg]); }
    }
    __syncthreads();
    }
    for (int rep_1 = 0; rep_1 < (S5MM_REP == 2 ? 2 : 1); ++rep_1) {
    for (int cb = wave; cb < 20; cb += NWAVES) {
        bf16x8 Uf[8]; s5_load_u(a, g, hb, cb, lane, Uf);
        bf16x8 Fa[8], Fb[8];
#define LDW(F, mt_) do { _Pragma("unroll") for (int ks = 0; ks < 8; ++ks) { const int row = 16 * (mt_) + r; F[ks] = *(const LAS bf16x8*)(lds + SM_WST + row * 512 + (((4 * ks + q) ^ (row & 15)) << 4)); } } while (0)
#define MMW(F, mt_) do { f32x4 acc = {0.f, 0.f, 0.f, 0.f}; _Pragma("unroll") for (int ks = 0; ks < 8; ++ks) acc = MFMA16(F[ks], Uf[ks], acc); *(f32x4*)(LB + (size_t)(16 * cb + r) * 128 + 16 * (mt_) + 4 * q) = acc; } while (0)
        LDW(Fa, 0);
#pragma unroll
        for (int m2 = 0; m2 < 4; ++m2) { LDW(Fb, 2 * m2 + 1); __builtin_amdgcn_sched_barrier(0); MMW(Fa, 2 * m2); __builtin_amdgcn_sched_barrier(0);
            if (m2 < 3) LDW(Fa, 2 * m2 + 2); __builtin_amdgcn_sched_barrier(0); MMW(Fb, 2 * m2 + 1); __builtin_amdgcn_sched_barrier(0); }
#undef LDW
#undef MMW
    }
    __syncthreads();
    }
    for (int rep_2 = 0; rep_2 < (S5MM_REP == 3 ? 2 : 1); ++rep_2) {
    if (wave < 2) {
        const int b = 2 * hb + wave; const f32x2_t a16 = POW[lane * 17 + 16]; float xr = 0.f, xi = 0.f;
        const float* lp = LB + (size_t)(wave * 128) * 128; float* xp = XB + (size_t)(wave * 128) * 128;
        float lr_[8], li_[8], nr_[8], ni_[8];
#pragma unroll
        for (int k = 0; k < 8; ++k) { lr_[k] = lp[(size_t)k * 128 + lane]; li_[k] = lp[(size_t)k * 128 + 64 + lane]; }
#pragma unroll 1
        for (int n0 = 0; n0 < 128; n0 += 8) {
            const int nn = n0 + 8 < 128 ? n0 + 8 : n0;
#pragma unroll
            for (int k = 0; k < 8; ++k) { nr_[k] = lp[(size_t)(nn + k) * 128 + lane]; ni_[k] = lp[(size_t)(nn + k) * 128 + 64 + lane]; }
#pragma unroll
            for (int k = 0; k < 8; ++k) { xp[(size_t)(n0 + k) * 128 + lane] = xr; xp[(size_t)(n0 + k) * 128 + 64 + lane] = xi;
                const float nr = a16.x * xr - a16.y * xi + lr_[k], ni = a16.x * xi + a16.y * xr + li_[k]; xr = nr; xi = ni; }
#pragma unroll
            for (int k = 0; k < 8; ++k) { lr_[k] = nr_[k]; li_[k] = ni_[k]; } }
        const size_t so = ((size_t)b * 128 + g) * 64 + lane; a.out[O_S5R_P + so] = xr; a.out[O_S5I_P + so] = xi;
    } else if (wave < 6) {
        const f32x2_t a16 = POW[lane * 17 + 16], a8 = POW[lane * 17 + 8]; const float inv = 1.0f / (a8.x * a8.x + a8.y * a8.y), i8r = a8.x * inv, i8i = -a8.y * inv;
#pragma unroll 1
        for (int j = 0; j < 16; ++j) { const int sc = 16 * (wave - 2) + j, col = 256 + sc, bs = 64 * hb + sc; const size_t so = ((size_t)bs * 128 + g) * 64 + lane;
            const float xr = a.in[I_S5RE][so], xi = a.in[I_S5IM][so]; XB[(size_t)col * 128 + lane] = xr; XB[(size_t)col * 128 + 64 + lane] = xi;
            const float zr = a16.x * xr - a16.y * xi + LB[(size_t)col * 128 + lane], zi = a16.x * xi + a16.y * xr + LB[(size_t)col * 128 + 64 + lane];
            a.out[O_S5R_S + so] = zr * i8r - zi * i8i; a.out[O_S5I_S + so] = zr * i8i + zi * i8r; }
    }
    __syncthreads();
    }
    for (int rep_3 = 0; rep_3 < (S5MM_REP == 4 ? 2 : 1); ++rep_3) {
    for (int cb = wave; cb < 20; cb += NWAVES) {
        bf16x8 Uf[8], Xf[4]; s5_load_u(a, g, hb, cb, lane, Uf);
        const int col = 16 * cb + r; const bool samp = col >= 256;
#pragma unroll
        for (int ks = 0; ks < 4; ++ks) { float x[8]; ld_f8(XB + (size_t)col * 128 + 32 * ks + 8 * q, x); Xf[ks] = pack8(x); }
#pragma unroll
        for (int t = 0; t < 16; ++t) { f32x4 acc = {0.f, 0.f, 0.f, 0.f};
            bf16x8 Fk[8], Fw[4];
#pragma unroll
            for (int ks = 0; ks <= t / 2; ++ks) { const int d = t - 2 * ks - (q >> 1);
                Fk[ks] = *(const LAS bf16x8*)(lds + SM_KT + (((d < 0 ? 0 : d) * 16 + r) * 16 + 8 * (q & 1)) * 2); if (d < 0) Fk[ks] = (bf16x8){0, 0, 0, 0, 0, 0, 0, 0}; }
#pragma unroll
            for (int ks = 0; ks < 4; ++ks) Fw[ks] = *(const LAS bf16x8*)(lds + SM_WC + addr256(16 * t + r, 4 * ks + q));
            __builtin_amdgcn_sched_barrier(0);
#pragma unroll
            for (int ks = 0; ks <= t / 2; ++ks) acc = MFMA16(Fk[ks], Uf[ks], acc);
#pragma unroll
            for (int ks = 0; ks < 4; ++ks) acc = MFMA16(Fw[ks], Xf[ks], acc);
            if (!samp || t < 8) { u32x2 o; o.x = cvtpk(gelu_tanh_fast(acc[0]), gelu_tanh_fast(acc[1])); o.y = cvtpk(gelu_tanh_fast(acc[2]), gelu_tanh_fast(acc[3]));
                *(u32x2*)(G2 + (size_t)s5_row(hb, col, t) * DM + g * 16 + 4 * q) = o; }
            asm volatile("" ::: "memory"); }
    }
    }
}

constexpr int N_PHASES = 21;
constexpr unsigned DUPMASK = 0u;
constexpr int P3PROBE = 0;
__global__ void __launch_bounds__(NTHR, 2) fwd_kernel(Args a) {
    extern __shared__ __attribute__((aligned(16))) unsigned char lds_raw[];
    LAS unsigned char* lds = (LAS unsigned char*)lds_raw;
    const int tid = threadIdx.x, lane = tid & 63, wave = __builtin_amdgcn_readfirstlane(tid >> 6);
    constexpr int G = 256;
    const int gw = blockIdx.x * NWAVES + wave, NGW = G * NWAVES;
    unsigned char* ws = a.ws;
    const int lo = a.ph_lo, hi = a.ph_hi;
    volatile LAS unsigned* MISC = (volatile LAS unsigned*)(lds + MISC_OFF);
    if (tid < 64) MISC[tid] = 0u;
    __syncthreads();
    XcdBarrier bar = xcd_barrier_post((unsigned*)(ws + WS_CTL) + CW_BAR, MISC + 8);
#define IN(k) (lo <= (k) && (k) < hi)
#define SEAM(k) do { if (IN(k) && IN((k) + 1)) xcd_barrier(bar); } while (0)
#define PHASE(k, ...) if (IN(k)) { __VA_ARGS__ if ((DUPMASK >> (k)) & 1u) { xcd_barrier(bar); __VA_ARGS__ } } SEAM(k);
#define GEMM_PHASE(EPI, Aop, Bop, N_, K_, E_) do { pg8::Gemm g{(const pg8::bf16_t*)(Aop), (const pg8::bf16_t*)(Bop), MTOT, (N_), (K_), (K_)}; pg8::StaticOrder S; S.init(MTOT, (N_), G, (int)blockIdx.x); \
        pg8::gemm_phase<EPI, pg8::StaticOrder, true, true>(lds, g, S, E_); } while (0)
#define SS ((float*)(ws + WS_SS))
#define X ((float*)(ws + WS_X))
#define H ((bf16*)(ws + WS_H))
#define G2 ((bf16*)(ws + WS_G2))
#define BIG ((bf16*)(ws + WS_BIG))
#define ACT ((bf16*)(ws + WS_ACT))

    PHASE(0, ph_prologue(a, lds, tid, lane, wave, gw, NGW, G);)
    PHASE(1, pg8::EpiBf16Plain E{BIG, NPROJ}; GEMM_PHASE(pg8::EpiBf16Plain, H, ws + WS_WIN, NPROJ, 2048, E);)
    PHASE(2, ph_mix_prep(a, lds, tid, lane, wave, gw, NGW, G);)
    if (IN(3)) { ph_scans(a, lds, tid, lane, wave, G); if (P3PROBE) { xcd_barrier(bar); ph_scans(a, lds, tid, lane, wave, G, P3PROBE); } } SEAM(3);
    PHASE(4, ph_mix_norm(a, lane, gw, NGW);)
    PHASE(5, pg8::EpiResNorm E{X, H, SS, DM, a.in[I_XP], a.in[I_XS]}; GEMM_PHASE(pg8::EpiResNorm, G2, ws + WS_WOUT, 2048, 2048, E);
             if (G == 256 && blockIdx.x >= 32) convert_group(a, 3, (LAS float*)(lds + wave * 8704), lane, ((int)blockIdx.x - 32) * NWAVES + wave, 224 * NWAVES);)
    PHASE(7, if (G == 256) { pg8::EpiBf16Rstd E{BIG, NUP, SS};
                    if (((int)blockIdx.x & 7) < 4) { convert_group(a, 2, (LAS float*)(lds + wave * 8704), lane, (int)blockIdx.x * NWAVES + wave, 256 * NWAVES); __syncthreads(); }
                    { const int L = (int)blockIdx.x - 128; pg8::Gemm g{(const pg8::bf16_t*)H, (const pg8::bf16_t*)(ws + WS_WUP), MTOT, NUP, 2048, 2048}; pg8::PlusOne S; S.init(MP, NUP, G, (int)blockIdx.x); S.extra = pg8::Unit{32 + (L & 3), L >> 2}; S.has_extra = L >= 0;
                      pg8::gemm_phase<pg8::EpiBf16Rstd, pg8::PlusOne, true, true>(lds, g, S, E); }
                    if (((int)blockIdx.x & 7) >= 4) convert_group(a, 2, (LAS float*)(lds + wave * 8704), lane, (int)blockIdx.x * NWAVES + wave, 256 * NWAVES); }
                  else { pg8::EpiBf16Rstd E{BIG, NUP, SS}; GEMM_PHASE(pg8::EpiBf16Rstd, H, ws + WS_WUP, NUP, 2048, E); })
    PHASE(18, if (G == 256) { if (blockIdx.x < 48) { pg8::EpiBf16Rstd E{BIG, NUP, SS};
                        const int L = 128 + (int)blockIdx.x; pg8::Gemm g{(const pg8::bf16_t*)H, (const pg8::bf16_t*)(ws + WS_WUP), MTOT, NUP, 2048, 2048}; pg8::OneUnit S{{32 + (L & 3), L >> 2}, true}; pg8::gemm_phase<pg8::EpiBf16Rstd, pg8::OneUnit, true, true>(lds, g, S, E); }
                      else ffn_conv_prompt(a, 0, lane, ((int)blockIdx.x - 48) * NWAVES + wave, 208 * NWAVES); }
                  else ffn_conv_prompt(a, 0, lane, gw, NGW);)
    PHASE(8, ffn_conv_sample(a, 0, lane, gw, NGW);)
    PHASE(9, { pg8::EpiResNorm E{X, H, SS + MTOT, DM, X, X + (size_t)8192 * DM};
                 pg8::Gemm g{(const pg8::bf16_t*)ACT, (const pg8::bf16_t*)(ws + WS_WDN), MP, 2048, DFF, DFF}; pg8::StaticOrder S; S.init(MP, 2048, G, (int)blockIdx.x);
                 pg8::gemm_phase<pg8::EpiResNorm, pg8::StaticOrder, true, true>(lds, g, S, E); }
               { const int p = (int)blockIdx.x, kq = p & 3, un = p >> 2;
                 pg8::EpiSlab E{(float*)BIG + (size_t)kq * MS * DM, DM};
                 pg8::Gemm g{(const pg8::bf16_t*)ACT + kq * 1408, (const pg8::bf16_t*)(ws + WS_WDN) + kq * 1408, MTOT, 2048, 1408, DFF};
                 pg8::OneUnit S{{32 + (un & 3), un >> 2}, p < 128};
                 pg8::gemm_phase<pg8::EpiSlab, pg8::OneUnit, true, true>(lds, g, S, E); }
               )
    PHASE(10, ph_combine<false>(X, H, SS + MTOT, (const float*)BIG, lane, gw, NGW, (bf16*)(ws + WS_UG0), a.in[I_NMIX] + DM);
              ph_ug_prompt(H, SS + MTOT, a.in[I_NMIX] + DM, (bf16*)(ws + WS_UG0), lane, gw, NGW);)
    PHASE(11, if (G == 256) ph_s5_mm(a, lds, (int)blockIdx.x, tid, lane, wave); else { for (int task = (int)blockIdx.x; task < 256; task += G) ph_s5_mm(a, lds, task, tid, lane, wave); })
    PHASE(12, { pg8::EpiGluRes E{X, H, SS + 2 * MTOT, DM};
                  pg8::Gemm g{(const pg8::bf16_t*)G2, (const pg8::bf16_t*)(ws + WS_WGLU), MP, NGLU, 2048, 2048}; pg8::StaticOrder S; S.init(MP, NGLU, G, (int)blockIdx.x);
                  pg8::gemm_phase<pg8::EpiGluRes, pg8::StaticOrder, true, true>(lds, g, S, E); }
                { const int p = (int)blockIdx.x, kq = p & 3, un = p >> 2;
                  pg8::EpiSlab E{(float*)BIG + (size_t)kq * MS * NGLU, NGLU};
                  pg8::Gemm g{(const pg8::bf16_t*)G2 + kq * 512, (const pg8::bf16_t*)(ws + WS_WGLU) + kq * 512, MTOT, NGLU, 512, 2048};
                  pg8::OneUnit S{{32 + (un & 3), un >> 2}, true};
                  pg8::gemm_phase<pg8::EpiSlab, pg8::OneUnit, true, true>(lds, g, S, E); })
    PHASE(13, ph_combine<true>(X, H, SS + 2 * MTOT, (const float*)BIG, lane, gw, NGW);)
    PHASE(14, if (G == 256) { pg8::EpiBf16Rstd E{BIG, NUP, SS + 2 * MTOT};
                    { const int L = (int)blockIdx.x - 128; pg8::Gemm g{(const pg8::bf16_t*)H, (const pg8::bf16_t*)(ws + WS_WUP + (size_t)NUP * 2048 * 2), MTOT, NUP, 2048, 2048}; pg8::PlusOne S; S.init(MP, NUP, G, (int)blockIdx.x); S.extra = pg8::Unit{32 + (L & 3), L >> 2}; S.has_extra = L >= 0;
                      pg8::gemm_phase<pg8::EpiBf16Rstd, pg8::PlusOne, true, true>(lds, g, S, E); } }
                  else { pg8::EpiBf16Rstd E{BIG, NUP, SS + 2 * MTOT}; GEMM_PHASE(pg8::EpiBf16Rstd, H, ws + WS_WUP + (size_t)NUP * 2048 * 2, NUP, 2048, E); })
    PHASE(19, if (G == 256) { if (blockIdx.x < 48) { pg8::EpiBf16Rstd E{BIG, NUP, SS + 2 * MTOT};
                        const int L = 128 + (int)blockIdx.x; pg8::Gemm g{(const pg8::bf16_t*)H, (const pg8::bf16_t*)(ws + WS_WUP + (size_t)NUP * 2048 * 2), MTOT, NUP, 2048, 2048}; pg8::OneUnit S{{32 + (L & 3), L >> 2}, true}; pg8::gemm_phase<pg8::EpiBf16Rstd, pg8::OneUnit, true, true>(lds, g, S, E); }
                      else ffn_conv_prompt(a, 1, lane, ((int)blockIdx.x - 48) * NWAVES + wave, 208 * NWAVES); }
                  else ffn_conv_prompt(a, 1, lane, gw, NGW);)
    PHASE(15, ffn_conv_sample(a, 1, lane, gw, NGW);)
    PHASE(16, { pg8::EpiResNorm E{X, H, SS + 3 * MTOT, DM, X, X + (size_t)8192 * DM};
                  pg8::Gemm g{(const pg8::bf16_t*)ACT, (const pg8::bf16_t*)(ws + WS_WDN + (size_t)2048 * DFF * 2), MP, 2048, DFF, DFF}; pg8::StaticOrder S; S.init(MP, 2048, G, (int)blockIdx.x);
                  pg8::gemm_phase<pg8::EpiResNorm, pg8::StaticOrder, true, true>(lds, g, S, E); }
                { const int p = (int)blockIdx.x, kq = p & 3, un = p >> 2;
                  pg8::EpiSlab E{(float*)BIG + (size_t)kq * MS * DM, DM};
                  pg8::Gemm g{(const pg8::bf16_t*)ACT + kq * 1408, (const pg8::bf16_t*)(ws + WS_WDN + (size_t)2048 * DFF * 2) + kq * 1408, MTOT, 2048, 1408, DFF};
                  pg8::OneUnit S{{32 + (un & 3), un >> 2}, p < 128};
                  pg8::gemm_phase<pg8::EpiSlab, pg8::OneUnit, true, true>(lds, g, S, E); })
    if (IN(17)) { int t17 = threadIdx.x; asm volatile("" : "+v"(t17));
                  ph_rms_out(X, SS + 3 * MTOT, (const float*)BIG, a.in[I_NFIN], a.out + O_Y, t17 & 63, (int)blockIdx.x * NWAVES + __builtin_amdgcn_readfirstlane(t17 >> 6), NGW); }
#undef IN
#undef SEAM
#undef GEMM_PHASE
#undef SS
#undef X
#undef H
#undef G2
#undef BIG
#undef ACT
}

#ifndef MK_PER_PHASE
#define MK_PER_PHASE 0
#endif
extern "C" void kernel_launch(void* const* d_in, const int* in_sizes, int n_in, void* d_out, int out_size, void* d_ws, size_t ws_size, hipStream_t stream) {
    static int grid = 0;
    if (grid == 0) {
        if (n_in != 32 || out_size != (int)O_END || ws_size < WS_END) { fprintf(stderr, "kernel_launch: unexpected shapes: n_in %d out %d (want %zu) ws %zu (want %zu); nothing launched\n", n_in, out_size, (size_t)O_END, ws_size, (size_t)WS_END); grid = -1; return; }
        int dev = 0, cus = 0, per_cu = 0;
        if (hipGetDevice(&dev) != hipSuccess || hipDeviceGetAttribute(&cus, hipDeviceAttributeMultiprocessorCount, dev) != hipSuccess) { fprintf(stderr, "kernel_launch: device query failed\n"); grid = -1; return; }
        if (hipFuncSetAttribute((const void*)fwd_kernel, hipFuncAttributeMaxDynamicSharedMemorySize, LDS_BYTES) != hipSuccess) { fprintf(stderr, "kernel_launch: hipFuncSetAttribute failed\n"); grid = -1; return; }
        if (hipOccupancyMaxActiveBlocksPerMultiprocessor(&per_cu, (const void*)fwd_kernel, NTHR, LDS_BYTES) != hipSuccess || per_cu < 1) { fprintf(stderr, "kernel_launch: occupancy query says %d blocks per CU\n", per_cu); per_cu = 1; }
        (void)hipGetLastError();
        if (cus < 256) { fprintf(stderr, "kernel_launch: this kernel needs 256 CUs (one resident workgroup each), the device has %d; nothing launched\n", cus); grid = -1; return; }
        grid = 256;
        fprintf(stderr, "kernel_launch: grid %d (occupancy query %d per CU)\n", grid, per_cu);
    }
    if (grid < 0) return;
    if (hipMemsetAsync((char*)d_ws + WS_CTL, 0, CTL_ZERO_BYTES, stream) != hipSuccess) { fprintf(stderr, "kernel_launch: hipMemsetAsync failed\n"); return; }
    Args a{};
    for (int i = 0; i < 32; ++i) a.in[i] = (const float*)d_in[i];
    a.out = (float*)d_out; a.ws = (unsigned char*)d_ws;
#if MK_PER_PHASE
    for (int ph = 0; ph < N_PHASES; ++ph) { a.ph_lo = ph; a.ph_hi = ph + 1; hipLaunchKernelGGL(fwd_kernel, dim3(grid), dim3(NTHR), LDS_BYTES, stream, a); }
#else
    a.ph_lo = 0; a.ph_hi = N_PHASES;
    void* args[] = {&a};
    hipError_t e = hipLaunchCooperativeKernel((const void*)fwd_kernel, dim3(grid), dim3(NTHR), args, LDS_BYTES, stream);
    if (e != hipSuccess) fprintf(stderr, "kernel_launch: cooperative launch failed: %s (grid %d)\n", hipGetErrorString(e), grid);
#endif
}
```

```cpp
#include <hip/hip_runtime.h>
#include <hip/hip_cooperative_groups.h>
#include <cstdio>
#include <cstdint>
#include <cmath>
namespace cg = cooperative_groups;
namespace pg8 {
#define PG8_LAS __attribute__((address_space(3)))
typedef unsigned short bf16_t;
typedef short bf16x8 __attribute__((ext_vector_type(8)));
typedef float f32x4 __attribute__((ext_vector_type(4)));
typedef unsigned u32x4 __attribute__((ext_vector_type(4)));
constexpr int BM = 256, BK = 64, HALF = 128, HTB = HALF * BK * 2  , STAGE_BYTES = 8 * HTB, NXCD = 8, WGM = 4;

__host__ __device__ __forceinline__ int lds_byte(int r, int c) { const int st = (r >> 4) * 2 + (c >> 5), rr = r & 15, cc = c & 31, ob = rr * 64 + cc * 2; return st * 1024 + (ob ^ (((ob >> 9) & 1) << 5)); }
__host__ __device__ __forceinline__ void stage_rc(int b, int& R, int& C) { const int st = b / 1024, sb = b % 1024, swz = sb ^ (((sb >> 9) & 1) << 5); R = (st >> 1) * 16 + swz / 64; C = (st & 1) * 32 + (swz % 64) / 2; }
__host__ __device__ __forceinline__ int perm32(int rho) { const int n = rho >> 4, i = rho & 15; return 8 * (i >> 2) + 4 * n + (i & 3); }

struct Unit { int pm, pn; };
struct Gemm { const bf16_t* A; const bf16_t* Bt; int M, N, K, ldk; };

struct StaticOrder {
    int nM, nN, nwg, G, c;
    __host__ __device__ void init(int M, int N, int G_, int c_) { nM = M / BM; nN = N / BM; nwg = nM * nN; G = G_; c = c_; }
    __host__ __device__ bool next(int i, Unit& u) const {
        const long L = (long)i * G + c; if (L >= nwg) return false;
        int wgid = (int)L; { const int q = nwg / NXCD, r = nwg % NXCD, xcd = wgid % NXCD, off = wgid / NXCD; wgid = (xcd < r ? xcd * (q + 1) : r * (q + 1) + (xcd - r) * q) + off; }
        const int nig = WGM * nN, gid = wgid / nig, fm = gid * WGM, gsz = (nM - fm) < WGM ? (nM - fm) : WGM;
        u.pm = fm + ((wgid % nig) % gsz); u.pn = (wgid % nig) / gsz; return true;
    }
    __device__ __forceinline__ void a_ready(const Unit&) const {}
    __device__ __forceinline__ void done(const Unit&) const {}
};

__device__ __forceinline__ unsigned cvt_pk_bf16(float lo, float hi) { unsigned r; asm volatile("v_cvt_pk_bf16_f32 %0, %1, %2" : "=v"(r) : "v"(lo), "v"(hi)); return r; }

struct EpiBf16Plain {
    static constexpr bool PERM = true, AFTER_DRAIN = false;
    bf16_t* O; int ldc;
    __device__ __forceinline__ void operator()(const f32x4 (&acc)[2][2][4][2], const Unit& u, int wr, int wc, int fr, int fq) const {
        const int row0 = u.pm * BM + wr * 64 + fr, col0 = u.pn * BM + wc * 32 + 8 * fq;
#pragma unroll
        for (int ai = 0; ai < 2; ++ai)
#pragma unroll
            for (int m = 0; m < 4; ++m) { bf16_t* rowp = O + (size_t)(row0 + ai * HALF + m * 16) * ldc + col0;
#pragma unroll
                for (int bj = 0; bj < 2; ++bj) { const f32x4 v0 = acc[ai][bj][m][0], v1 = acc[ai][bj][m][1];
                    u32x4 w; w.x = cvt_pk_bf16(v0[0], v0[1]); w.y = cvt_pk_bf16(v0[2], v0[3]); w.z = cvt_pk_bf16(v1[0], v1[1]); w.w = cvt_pk_bf16(v1[2], v1[3]);
                    *(u32x4*)(rowp + bj * HALF) = w; } }
    }
};
struct EpiResF32 {
    static constexpr bool PERM = false, AFTER_DRAIN = false;
    float* X; int ldc;
    __device__ __forceinline__ void operator()(const f32x4 (&acc)[2][2][4][2], const Unit& u, int wr, int wc, int fr, int fq) const {
        const int row0 = u.pm * BM + wr * 64 + fr, col0 = u.pn * BM + wc * 32 + 4 * fq;
#pragma unroll
        for (int ai = 0; ai < 2; ++ai)
#pragma unroll
            for (int m = 0; m < 4; ++m) { float* rowp = X + (size_t)(row0 + ai * HALF + m * 16) * ldc + col0;
#pragma unroll
                for (int bj = 0; bj < 2; ++bj)
#pragma unroll
                    for (int n = 0; n < 2; ++n) { f32x4* p = (f32x4*)(rowp + bj * HALF + n * 16); *p = *p + acc[ai][bj][m][n]; }
                asm volatile("" ::: "memory"); }
    }
};
struct PlusOne : StaticOrder {
    Unit extra; bool has_extra;
    __device__ bool next(int i, Unit& u) const {
        if (StaticOrder::next(i, u)) return true;
        const int np = (nwg - c + G - 1) / G;
        if (has_extra && i == np) { u = extra; return true; }
        return false;
    }
};
struct OneUnit {
    Unit u; bool valid;
    __device__ bool next(int i, Unit& o) const { if (i != 0 || !valid) return false; o = u; return true; }
    __device__ __forceinline__ void a_ready(const Unit&) const {}
    __device__ __forceinline__ void done(const Unit&) const {}
};
struct EpiSlab {
    static constexpr bool PERM = false, AFTER_DRAIN = false;
    float* S; int ldc;
    __device__ __forceinline__ void operator()(const f32x4 (&acc)[2][2][4][2], const Unit& u, int wr, int wc, int fr, int fq) const {
        const int row0 = (u.pm - 32) * BM + wr * 64 + fr, col0 = u.pn * BM + wc * 32 + 4 * fq;
#pragma unroll
        for (int ai = 0; ai < 2; ++ai)
#pragma unroll
            for (int m = 0; m < 4; ++m) { float* rowp = S + (size_t)(row0 + ai * HALF + m * 16) * ldc + col0;
#pragma unroll
                for (int bj = 0; bj < 2; ++bj)
#pragma unroll
                    for (int n = 0; n < 2; ++n) *(f32x4*)(rowp + bj * HALF + n * 16) = acc[ai][bj][m][n]; }
    }
};
template <bool WXB>
struct EpiResNormT {
    static constexpr bool PERM = false, AFTER_DRAIN = false;
    float* X; bf16_t* XB; float* SS; int ldc; const float* R0; const float* R1;
    __device__ __forceinline__ void operator()(const f32x4 (&acc)[2][2][4][2], const Unit& u, int wr, int wc, int fr, int fq) const {
        const int row0 = u.pm * BM + wr * 64 + fr, col0 = u.pn * BM + wc * 32 + 4 * fq;
        const float* Rb = (u.pm < 32) ? R0 : R1 - (size_t)8192 * ldc;
#pragma unroll
        for (int ap = 0; ap < 4; ++ap) {
            const int ai = ap >> 1, m0 = (ap & 1) * 2;
            f32x4 res[2][4];
#pragma unroll
            for (int mm = 0; mm < 2; ++mm) { const float* rp = Rb + (size_t)(row0 + ai * HALF + (m0 + mm) * 16) * ldc + col0;
#pragma unroll
                for (int i = 0; i < 4; ++i) res[mm][i] = *(const f32x4*)(rp + (i >> 1) * HALF + (i & 1) * 16); }
#pragma unroll
            for (int mm = 0; mm < 2; ++mm) { const int m = m0 + mm, row = row0 + ai * HALF + m * 16; float* rowp = X + (size_t)row * ldc + col0; bf16_t* rowb = XB + (size_t)row * ldc + col0; float ss = 0.f;
#pragma unroll
                for (int i = 0; i < 4; ++i) { const int bj = i >> 1, n = i & 1; const f32x4 v = res[mm][i] + acc[ai][bj][m][n]; *(f32x4*)(rowp + bj * HALF + n * 16) = v;
                    ss += (v[0] * v[0] + v[1] * v[1]) + (v[2] * v[2] + v[3] * v[3]);
                    if constexpr (WXB) { unsigned lo = cvt_pk_bf16(v[0], v[1]), hi = cvt_pk_bf16(v[2], v[3]); *(unsigned long long*)(rowb + bj * HALF + n * 16) = ((unsigned long long)hi << 32) | lo; } }
                ss += __shfl_xor(ss, 16); ss += __shfl_xor(ss, 32);
                if (fq == 0) atomicAdd(SS + row, ss); }
            asm volatile("" ::: "memory"); }
    }
};
typedef EpiResNormT<true> EpiResNorm;
struct EpiBf16Rstd {
    static constexpr bool PERM = true, AFTER_DRAIN = false;
    bf16_t* O; int ldc; const float* SS;
    __device__ __forceinline__ void operator()(const f32x4 (&acc)[2][2][4][2], const Unit& u, int wr, int wc, int fr, int fq) const {
        const int row0 = u.pm * BM + wr * 64 + fr, col0 = u.pn * BM + wc * 32 + 8 * fq;
        float ssv[8];
#pragma unroll
        for (int g = 0; g < 8; ++g) ssv[g] = SS[row0 + (g >> 2) * HALF + (g & 3) * 16];
#pragma unroll
        for (int ai = 0; ai < 2; ++ai)
#pragma unroll
            for (int m = 0; m < 4; ++m) { const int row = row0 + ai * HALF + m * 16; bf16_t* rowp = O + (size_t)row * ldc + col0; const float rs = 1.0f / sqrtf(ssv[ai * 4 + m] * (1.0f / 2048.0f) + 1e-6f);
#pragma unroll
                for (int bj = 0; bj < 2; ++bj) { const f32x4 v0 = acc[ai][bj][m][0] * rs, v1 = acc[ai][bj][m][1] * rs;
                    u32x4 w; w.x = cvt_pk_bf16(v0[0], v0[1]); w.y = cvt_pk_bf16(v0[2], v0[3]); w.z = cvt_pk_bf16(v1[0], v1[1]); w.w = cvt_pk_bf16(v1[2], v1[3]);
                    *(u32x4*)(rowp + bj * HALF) = w; } }
    }
};
struct EpiGluRes {
    static constexpr bool PERM = false, AFTER_DRAIN = false;
    float* X; bf16_t* XB; float* SS; int ldc;
    __device__ __forceinline__ void operator()(const f32x4 (&acc)[2][2][4][2], const Unit& u, int wr, int wc, int fr, int fq) const {
        const int row0 = u.pm * BM + wr * 64 + fr, col0 = u.pn * HALF + wc * 32 + 4 * fq;
        f32x4 res[8][2];
#pragma unroll
        for (int g = 0; g < 8; ++g)
#pragma unroll
            for (int n = 0; n < 2; ++n) res[g][n] = *(const f32x4*)(X + (size_t)(row0 + (g >> 2) * HALF + (g & 3) * 16) * ldc + col0 + n * 16);
#pragma unroll
        for (int g = 0; g < 8; ++g) { const int ai = g >> 2, m = g & 3, row = row0 + ai * HALF + m * 16; float* rowp = X + (size_t)row * ldc + col0; bf16_t* rowb = XB + (size_t)row * ldc + col0; float ss = 0.f;
#pragma unroll
            for (int n = 0; n < 2; ++n) { const f32x4 v = acc[ai][0][m][n], gt = acc[ai][1][m][n]; f32x4 o = res[g][n];
#pragma unroll
                for (int j = 0; j < 4; ++j) o[j] += v[j] / (1.0f + __expf(-gt[j]));
                *(f32x4*)(rowp + n * 16) = o; ss += (o[0] * o[0] + o[1] * o[1]) + (o[2] * o[2] + o[3] * o[3]);
                unsigned lo = cvt_pk_bf16(o[0], o[1]), hi = cvt_pk_bf16(o[2], o[3]); *(unsigned long long*)(rowb + n * 16) = ((unsigned long long)hi << 32) | lo; }
            ss += __shfl_xor(ss, 16); ss += __shfl_xor(ss, 32);
            if (fq == 0) atomicAdd(SS + row, ss); }
    }
};

template <class Epi, class Sched, bool ALIGN_EPI = false, bool SP2 = false>
__device__ __forceinline__ void gemm_phase(PG8_LAS unsigned char* lds, const Gemm g, const Sched& S, const Epi& E) {
    const int tid = threadIdx.x, wid = __builtin_amdgcn_readfirstlane(tid >> 6), lane = tid & 63, wr = wid >> 2, wc = wid & 3, fr = lane & 15, fq = lane >> 4;
    const int K = g.ldk, nt = g.K / BK;
    unsigned voffA[2], voffB[2];
#pragma unroll
    for (int i = 0; i < 2; ++i) { int R, C; stage_rc(tid * 16 + i * 8192, R, C); const int Rb = Epi::PERM ? ((R & ~31) + perm32(R & 31)) : R;
        voffA[i] = (unsigned)(R * K + C) * 2u; voffB[i] = (unsigned)(Rb * K + C) * 2u; }
    const size_t kstep = (size_t)(BK * 2);
    const size_t hstep = (size_t)HALF * K * 2;
    const size_t tstep = 2 * hstep;
    const unsigned ldsw = (unsigned)wid * 1024u;
    const int aoff = lds_byte(wr * 64 + fr, fq * 8), boff = lds_byte(wc * 32 + fr, fq * 8);
#define PG8_SA(b, h) (((b) * 2 + (h)) * HTB)
#define PG8_SB(b, h) ((4 + (b) * 2 + (h)) * HTB)
#define PG8_STAGE(bufoff, gbase, voff) do { _Pragma("unroll") for (int _i = 0; _i < 2; ++_i) \
        __builtin_amdgcn_global_load_lds((const unsigned*)((const char*)(gbase) + (voff)[_i]), (PG8_LAS unsigned*)(lds + (bufoff) + ldsw + _i * 8192), 16, 0, 0); } while (0)
#define PG8_LDA(dst, b, h) do { _Pragma("unroll") for (int m = 0; m < 4; ++m) _Pragma("unroll") for (int k = 0; k < 2; ++k) dst[m][k] = *(const PG8_LAS bf16x8*)(lds + PG8_SA(b, h) + aoff + m * 2048 + k * 1024); } while (0)
#define PG8_LDB(dst, b, h) do { _Pragma("unroll") for (int n = 0; n < 2; ++n) _Pragma("unroll") for (int k = 0; k < 2; ++k) dst[n][k] = *(const PG8_LAS bf16x8*)(lds + PG8_SB(b, h) + boff + n * 2048 + k * 1024); } while (0)
#define PG8_MMA(ai, bj, At, Bt) do { __builtin_amdgcn_s_setprio(1); _Pragma("unroll") for (int m = 0; m < 4; ++m) _Pragma("unroll") for (int n = 0; n < 2; ++n) _Pragma("unroll") for (int k = 0; k < 2; ++k) \
        acc[ai][bj][m][n] = __builtin_amdgcn_mfma_f32_16x16x32_bf16(Bt[n][k], At[m][k], acc[ai][bj][m][n], 0, 0, 0); __builtin_amdgcn_s_setprio(0); } while (0)
#define PG8_WAIT_V(n) asm volatile("s_waitcnt vmcnt(" #n ")" ::: "memory")
#define PG8_WAIT_L(n) asm volatile("s_waitcnt lgkmcnt(" #n ")" ::: "memory")
#define PG8_BAR __builtin_amdgcn_s_barrier()
#define PG8_SCHED __builtin_amdgcn_sched_barrier(0)
    Unit cur, nxt; int ui = 0;
    if (!S.next(0, cur)) return;
    f32x4 acc[2][2][4][2];
#pragma unroll
    for (int a = 0; a < 2; ++a)
#pragma unroll
        for (int b = 0; b < 2; ++b)
#pragma unroll
            for (int m = 0; m < 4; ++m)
#pragma unroll
                for (int n = 0; n < 2; ++n) acc[a][b][m][n] = (f32x4){0.f, 0.f, 0.f, 0.f};
    bf16x8 At[4][2], B0[2][2], B1[2][2];
    const char* cA = (const char*)g.A + (size_t)cur.pm * tstep; const char* cB = (const char*)g.Bt + (size_t)cur.pn * tstep;
    S.a_ready(cur);
    if constexpr (SP2) {
        PG8_STAGE(PG8_SB(0, 0), cB, voffB); PG8_STAGE(PG8_SB(0, 1), cB + hstep, voffB); PG8_STAGE(PG8_SA(0, 0), cA, voffA); PG8_STAGE(PG8_SA(0, 1), cA + hstep, voffA);
        if (wr == 1) PG8_BAR;
        PG8_WAIT_V(2); PG8_BAR;
        PG8_STAGE(PG8_SB(1, 0), cB + kstep, voffB); PG8_STAGE(PG8_SA(1, 0), cA + kstep, voffA); PG8_STAGE(PG8_SB(1, 1), cB + hstep + kstep, voffB);
        PG8_WAIT_V(6); PG8_BAR;
    } else {
        PG8_STAGE(PG8_SB(0, 0), cB, voffB); PG8_STAGE(PG8_SA(0, 0), cA, voffA); PG8_STAGE(PG8_SB(0, 1), cB + hstep, voffB); PG8_STAGE(PG8_SA(0, 1), cA + hstep, voffA);
        if (wr == 1) PG8_BAR;
        PG8_WAIT_V(4); PG8_BAR;
        PG8_STAGE(PG8_SB(1, 0), cB + kstep, voffB); PG8_STAGE(PG8_SA(1, 0), cA + kstep, voffA); PG8_STAGE(PG8_SB(1, 1), cB + hstep + kstep, voffB);
        PG8_WAIT_V(6); PG8_BAR;
    }
    for (;;) {
        const bool has_next = S.next(ui + 1, nxt);
        const char* nA = has_next ? (const char*)g.A + (size_t)nxt.pm * tstep : cA; const char* nB = has_next ? (const char*)g.Bt + (size_t)nxt.pn * tstep : cB;
        for (int t = 0; t < nt; t += 2) {
            const bool last = (t == nt - 2);
            const char* a1 = cA + (size_t)(t + 1) * kstep;
            const char* a2 = last ? nA : cA + (size_t)(t + 2) * kstep; const char* b2 = last ? nB : cB + (size_t)(t + 2) * kstep;
            const char* a3 = a2 + kstep; const char* b3 = b2 + kstep;
            if (last && has_next) S.a_ready(nxt);
            if constexpr (SP2) {
            PG8_LDB(B0, 0, 0); PG8_LDB(B1, 0, 1); PG8_SCHED; PG8_LDA(At, 0, 0); PG8_STAGE(PG8_SA(1, 1), a1 + hstep, voffA);
            PG8_WAIT_V(8); PG8_WAIT_L(0); PG8_BAR; PG8_MMA(0, 0, At, B0); PG8_MMA(0, 1, At, B1); PG8_BAR; PG8_SCHED;
            PG8_LDA(At, 0, 1); PG8_STAGE(PG8_SB(0, 0), b2, voffB); PG8_STAGE(PG8_SB(0, 1), b2 + hstep, voffB); PG8_STAGE(PG8_SA(0, 0), a2, voffA);
            PG8_WAIT_V(8); PG8_WAIT_L(0); PG8_BAR; PG8_MMA(1, 0, At, B0); PG8_MMA(1, 1, At, B1); PG8_BAR; PG8_SCHED;
            PG8_LDB(B0, 1, 0); PG8_LDB(B1, 1, 1); PG8_SCHED; PG8_LDA(At, 1, 0); PG8_STAGE(PG8_SA(0, 1), a2 + hstep, voffA);
            PG8_WAIT_V(8); PG8_WAIT_L(0); PG8_BAR; PG8_MMA(0, 0, At, B0); PG8_MMA(0, 1, At, B1); PG8_BAR; PG8_SCHED;
            PG8_LDA(At, 1, 1); PG8_STAGE(PG8_SB(1, 0), b3, voffB); PG8_STAGE(PG8_SB(1, 1), b3 + hstep, voffB); PG8_STAGE(PG8_SA(1, 0), a3, voffA);
            PG8_WAIT_V(8); PG8_WAIT_L(0); PG8_BAR; PG8_MMA(1, 0, At, B0); PG8_MMA(1, 1, At, B1); PG8_BAR; PG8_SCHED;
            } else {
            PG8_LDB(B0, 0, 0); PG8_SCHED; PG8_LDA(At, 0, 0); PG8_STAGE(PG8_SA(1, 1), a1 + hstep, voffA);
            PG8_WAIT_L(8); PG8_BAR; PG8_WAIT_L(0); PG8_MMA(0, 0, At, B0); PG8_BAR; PG8_SCHED;
            PG8_LDB(B1, 0, 1); PG8_STAGE(PG8_SB(0, 0), b2, voffB);
            PG8_BAR; PG8_WAIT_L(0); PG8_MMA(0, 1, At, B1); PG8_BAR;
            PG8_LDA(At, 0, 1); PG8_STAGE(PG8_SA(0, 0), a2, voffA);
            PG8_BAR; PG8_WAIT_L(0); PG8_MMA(1, 0, At, B0); PG8_BAR; PG8_SCHED;
            PG8_STAGE(PG8_SB(0, 1), b2 + hstep, voffB);
            PG8_WAIT_V(6); PG8_BAR; PG8_MMA(1, 1, At, B1); PG8_BAR;
            PG8_LDB(B0, 1, 0); PG8_SCHED; PG8_LDA(At, 1, 0); PG8_STAGE(PG8_SA(0, 1), a2 + hstep, voffA);
            PG8_WAIT_L(8); PG8_BAR; PG8_WAIT_L(0); PG8_MMA(0, 0, At, B0); PG8_BAR; PG8_SCHED;
            PG8_LDB(B1, 1, 1); PG8_STAGE(PG8_SB(1, 0), b3, voffB);
            PG8_BAR; PG8_WAIT_L(0); PG8_MMA(0, 1, At, B1); PG8_BAR;
            PG8_LDA(At, 1, 1); PG8_STAGE(PG8_SA(1, 0), a3, voffA);
            PG8_BAR; PG8_WAIT_L(0); PG8_MMA(1, 0, At, B0); PG8_BAR; PG8_SCHED;
            PG8_STAGE(PG8_SB(1, 1), b3 + hstep, voffB);
            PG8_WAIT_V(6); PG8_BAR; PG8_MMA(1, 1, At, B1); PG8_BAR;
            }
        }
        if constexpr (ALIGN_EPI) { if (wr == 0) PG8_BAR; }
        if constexpr (!Epi::AFTER_DRAIN) { E(acc, cur, wr, wc, fr, fq); S.done(cur); }
        if (!has_next) break;
#pragma unroll
        for (int a = 0; a < 2; ++a)
#pragma unroll
            for (int b = 0; b < 2; ++b)
#pragma unroll
                for (int m = 0; m < 4; ++m)
#pragma unroll
                    for (int n = 0; n < 2; ++n) acc[a][b][m][n] = (f32x4){0.f, 0.f, 0.f, 0.f};
        cur = nxt; cA = nA; cB = nB; ++ui;
        if constexpr (ALIGN_EPI) { if (wr == 1) PG8_BAR; }
    }
    PG8_WAIT_V(0);
    if constexpr (!ALIGN_EPI) { if (wr == 0) PG8_BAR; }
    PG8_BAR;
    if constexpr (Epi::AFTER_DRAIN) { E.fused(acc, cur, wr, wc, fr, fq, lds, wid, lane); S.done(cur); }
#undef PG8_SA
#undef PG8_SB
#undef PG8_STAGE
#undef PG8_LDA
#undef PG8_LDB
#undef PG8_MMA
#undef PG8_WAIT_V
#undef PG8_WAIT_L
#undef PG8_BAR
#undef PG8_SCHED
}
}

constexpr int NWAVES = 8, NTHR = 512;
constexpr int MP = 8192, MS = 1024, MTOT = 9216, DM = 2048;
constexpr int SEQ = 2048, DECS = 8, DECB = 128;
constexpr int NPROJ = 7168, DIN = 7184, DFF = 5632, NUP = 11264, NGLU = 4096;
constexpr int C_QA = 0, C_KA = 1024, C_VA = 2048, C_ZA = 3072, C_QB = 4096, C_KB = 4608, C_VB = 5120, C_GB = 6144;
constexpr float EPS = 1e-6f;
constexpr size_t MiB = 1u << 20;
constexpr size_t WS_CTL = 0;
constexpr size_t WS_WIN = 1 * MiB;
constexpr size_t WS_WOUT = WS_WIN + 28 * MiB;
constexpr size_t WS_WUP = WS_WOUT + 8 * MiB;
constexpr size_t WS_WDN = WS_WUP + 88 * MiB;
constexpr size_t WS_WGLU = WS_WDN + 44 * MiB;
constexpr size_t WS_X = WS_WGLU + 16 * MiB;
constexpr size_t WS_H = WS_X + 72 * MiB;
constexpr size_t WS_G2 = WS_H + 36 * MiB;
constexpr size_t WS_GATE = WS_G2 + 36 * MiB;
constexpr size_t WS_TAB = WS_GATE + 1 * MiB;
constexpr size_t WS_BIG = WS_TAB + 2 * MiB;
constexpr size_t WS_OA = WS_BIG + 126 * MiB, WS_OB = WS_OA + 36 * MiB;
constexpr size_t WS_ACT = WS_BIG + 198 * MiB;
constexpr size_t WS_END = WS_ACT + 99 * MiB;
constexpr size_t WS_UG0 = WS_BIG + 64 * MiB;
constexpr size_t O_Y = 0, O_GDN_P = 18874368, O_GDN_S = O_GDN_P + 524288, O_GCB_P = O_GDN_S + 16777216, O_GCB_S = O_GCB_P + 36864,
                 O_RET_P = O_GCB_S + 1179648, O_RET_S = O_RET_P + 524288, O_S5R_P = O_RET_S + 16777216, O_S5R_S = O_S5R_P + 32768,
                 O_S5I_P = O_S5R_S + 1048576, O_S5I_S = O_S5I_P + 32768, O_FCB_P = O_S5I_S + 1048576, O_FCB_S = O_FCB_P + 180224, O_END = O_FCB_S + 5767168;

constexpr int LDS_BYTES = 148480 + 512;
constexpr int MISC_OFF = 148480;
#define LAS __attribute__((address_space(3)))
typedef unsigned short bf16;
typedef float f32x4 __attribute__((ext_vector_type(4)));
typedef unsigned u32x4 __attribute__((ext_vector_type(4)));
typedef unsigned u32x2 __attribute__((ext_vector_type(2)));
#define LDS_WAIT() asm volatile("s_waitcnt lgkmcnt(0)" ::: "memory")

struct Args { const float* in[32]; float* out; unsigned char* ws; int ph_lo, ph_hi; };
enum { I_XP = 0, I_XS, I_SGDN, I_SGCB, I_SRET, I_S5RE, I_S5IM, I_SFCB, I_NMIX, I_NFFN, I_NFIN, I_WIN, I_GCW, I_GALOG, I_GDTB, I_GNW, I_RGW, I_RGB, I_WOUT,
       I_LRE, I_LIM, I_LDT, I_BRE, I_BIM, I_CRE, I_CIM, I_S5D, I_WGLU, I_WUP, I_FCW, I_FCBIAS, I_WDN };

__device__ __forceinline__ float wave_sum(float v) {
#pragma unroll
    for (int o = 1; o < 64; o <<= 1) v += __shfl_xor(v, o);
    return v;
}
__device__ __forceinline__ unsigned f2bf(float f) { unsigned u = __builtin_bit_cast(unsigned, f); return (u + 0x7fffu + ((u >> 16) & 1u)) >> 16; }
__device__ __forceinline__ unsigned pk2(float lo, float hi) { return f2bf(lo) | (f2bf(hi) << 16); }
__device__ __forceinline__ float bf2f(unsigned short b) { return __builtin_bit_cast(float, (unsigned)b << 16); }
__device__ __forceinline__ void unpack8(const u32x4 w, float (&f)[8]) {
    f[0] = __builtin_bit_cast(float, w.x << 16); f[1] = __builtin_bit_cast(float, w.x & 0xffff0000u);
    f[2] = __builtin_bit_cast(float, w.y << 16); f[3] = __builtin_bit_cast(float, w.y & 0xffff0000u);
    f[4] = __builtin_bit_cast(float, w.z << 16); f[5] = __builtin_bit_cast(float, w.z & 0xffff0000u);
    f[6] = __builtin_bit_cast(float, w.w << 16); f[7] = __builtin_bit_cast(float, w.w & 0xffff0000u);
}
__device__ __forceinline__ void ld_bf8(const bf16* p, float (&f)[8]) { unpack8(*(const u32x4*)p, f); }
__device__ __forceinline__ void ld_f8(const float* p, float (&f)[8]) { const f32x4 a = *(const f32x4*)p, b = *(const f32x4*)(p + 4); f[0] = a[0]; f[1] = a[1]; f[2] = a[2]; f[3] = a[3]; f[4] = b[0]; f[5] = b[1]; f[6] = b[2]; f[7] = b[3]; }
__device__ __forceinline__ void st_bf8(bf16* p, const float (&f)[8]) { u32x4 w; w.x = pk2(f[0], f[1]); w.y = pk2(f[2], f[3]); w.z = pk2(f[4], f[5]); w.w = pk2(f[6], f[7]); *(u32x4*)p = w; }
__device__ __forceinline__ float silu_f(float x) { return x / (1.0f + expf(-x)); }
__device__ __forceinline__ float sigmoid_f(float x) { return 1.0f / (1.0f + expf(-x)); }
__device__ __forceinline__ float softplus_f(float x) { return x > 20.f ? x : log1pf(expf(x)); }
__device__ __forceinline__ float gelu_tanh_fast(float y) { const float z = 0.7978845608028654f * (y + 0.044715f * y * y * y); const float e = __builtin_amdgcn_exp2f(z * 2.8853900817779268f); return y * (1.0f - __builtin_amdgcn_rcpf(e + 1.0f)); }
__device__ __forceinline__ float gelu_tanh(float y) { const float z = 0.7978845608028654f * (y + 0.044715f * y * y * y); const float th = 1.0f - 2.0f / (expf(2.0f * z) + 1.0f); return 0.5f * y * (1.0f + th); }
__device__ __forceinline__ void sincos_d(double a, double& s, double& c) {
    const double n = rint(a * 0.63661977236758134308);
    double r = fma(-n, 1.57079632679489655800e+00, a); r = fma(-n, 6.12323399573676603587e-17, r);
    const double r2 = r * r;
    double ps = 1.0 / 6227020800.0; ps = fma(ps, r2, -1.0 / 39916800.0); ps = fma(ps, r2, 1.0 / 362880.0); ps = fma(ps, r2, -1.0 / 5040.0); ps = fma(ps, r2, 1.0 / 120.0); ps = fma(ps, r2, -1.0 / 6.0); ps = fma(ps * r2, r, r);
    double pc = 1.0 / 479001600.0; pc = fma(pc, r2, -1.0 / 3628800.0); pc = fma(pc, r2, 1.0 / 40320.0); pc = fma(pc, r2, -1.0 / 720.0); pc = fma(pc, r2, 1.0 / 24.0); pc = fma(pc, r2, -0.5); pc = fma(pc, r2, 1.0);
    const int q = (int)(long long)n & 3;
    s = (q == 0) ? ps : (q == 1) ? pc : (q == 2) ? -ps : -pc;
    c = (q == 0) ? pc : (q == 1) ? -ps : (q == 2) ? -pc : ps;
}

#define GAS __attribute__((address_space(1)))
constexpr int CW_BAR = 4096;
constexpr size_t CTL_ZERO_BYTES = 524288;
constexpr size_t WS_SS = WS_CTL + 262144;
#define XB_TMO      128
#define XB_XCNT(j)  (256  + 64 * (j))
#define XB_XSUB(j)  (1280 + 64 * (j))
#define XB_XGEN(j)  (2304 + 64 * (j))
#define XB_TOP      3328
#define XB_TOPGEN   3392
#define XCD_BAR_WORDS 3456
#define XB_SPIN_CAP (1u << 18)

__device__ __forceinline__ unsigned xb_ld(unsigned* p)              { return __hip_atomic_load(p, __ATOMIC_RELAXED, __HIP_MEMORY_SCOPE_AGENT); }
__device__ __forceinline__ unsigned xb_add(unsigned* p, unsigned v) { return __hip_atomic_fetch_add(p, v, __ATOMIC_RELAXED, __HIP_MEMORY_SCOPE_AGENT); }
__device__ __forceinline__ unsigned xb_xcc_id() { return (unsigned)__builtin_amdgcn_s_getreg((3 << 11) | 20) & 0xFu; }
#define XB_SPIN(cond, bar) do { unsigned _sp = 0; while (cond) { __builtin_amdgcn_s_sleep(1); \
    if ((++_sp & 255u) == 0u) { if (xb_ld(&(bar)[XB_TMO])) break; if (_sp > XB_SPIN_CAP) { atomicAdd(&(bar)[XB_TMO], 1u); break; } } } } while (0)

struct XcdBarrier {
    unsigned* bar; unsigned x;
    volatile LAS unsigned* st;
};

__device__ __forceinline__ XcdBarrier xcd_barrier_post(unsigned* bar, volatile LAS unsigned* st) {
    XcdBarrier b; b.bar = bar; b.x = xb_xcc_id(); b.st = st;
    if (threadIdx.x == 0) (void)xb_add(&bar[XB_XCNT(b.x)], 1u);
    return b;
}
__device__ __forceinline__ void xcd_barrier_complete(unsigned* bar, unsigned x, unsigned& nloc, unsigned& nx) {
    const unsigned G = gridDim.x * gridDim.y * gridDim.z;
    unsigned sum, cnt, mine, sp = 0u;
    for (;;) {
        sum = 0u; cnt = 0u; mine = 0u;
#pragma unroll
        for (unsigned j = 0; j < 16; ++j) { const unsigned c = xb_ld(&bar[XB_XCNT(j)]); sum += c; cnt += (c > 0u) ? 1u : 0u; mine = (j == x) ? c : mine; }
        if (sum == G) break;
        __builtin_amdgcn_s_sleep(1);
        if ((++sp & 255u) == 0u) { if (xb_ld(&bar[XB_TMO])) break; if (sp > XB_SPIN_CAP) { atomicAdd(&bar[XB_TMO], 1u); break; } }
    }
    nloc = mine > 0u ? mine : 1u; nx = cnt > 0u ? cnt : 1u;
}

__device__ __forceinline__ void xcd_barrier(const XcdBarrier& b) {
    asm volatile("s_waitcnt vmcnt(0)" ::: "memory");
    __syncthreads();
    if (threadIdx.x == 0) {
        unsigned* bar = b.bar;
        __builtin_amdgcn_s_waitcnt(0);
        unsigned nloc = b.st[0], nx = b.st[1];
        if (nloc == 0u) { xcd_barrier_complete(bar, b.x, nloc, nx); b.st[0] = nloc; b.st[1] = nx; }
        const unsigned old = xb_add(&bar[XB_XSUB(b.x)], 1u);
        const unsigned gen = old / nloc;
        if (old + 1u == (gen + 1u) * nloc) {
            __builtin_amdgcn_fence(__ATOMIC_RELEASE, "agent");
            asm volatile("s_waitcnt vmcnt(0)" ::: "memory");
            const unsigned og = xb_add(&bar[XB_TOP], 1u);
            const unsigned tg = og / nx;
            if (og + 1u == (tg + 1u) * nx) xb_add(&bar[XB_TOPGEN], 1u);
            else XB_SPIN(xb_ld(&bar[XB_TOPGEN]) == tg, bar);
            __builtin_amdgcn_fence(__ATOMIC_ACQUIRE, "agent");
            xb_add(&bar[XB_XGEN(b.x)], 1u);
            asm volatile("s_waitcnt vmcnt(0)" ::: "memory");
        } else {
            XB_SPIN(xb_ld(&bar[XB_XGEN(b.x)]) == gen, bar);
            __builtin_amdgcn_fence(__ATOMIC_ACQUIRE, "agent");
            asm volatile("s_waitcnt vmcnt(0)" ::: "memory");
        }
    }
    __syncthreads();
}


__device__ __forceinline__ void transpose_item(const float* W, int ldw, int src_col0, int k0, bf16* WT, int K, int dst_row0, LAS float* scr, int lane, const float* ksc = nullptr) {
    float wv[32];
    { const float* wp = W + (size_t)(k0 + (lane >> 5)) * ldw + src_col0 + (lane & 31);
#pragma unroll
      for (int i = 0; i < 32; ++i) wv[i] = __builtin_nontemporal_load(wp + (size_t)(2 * i) * ldw); }
#pragma unroll
    for (int i = 0; i < 32; ++i) scr[(2 * i + (lane >> 5)) * 33 + (lane & 31)] = wv[i];
    const int c = lane & 7;
    f32x4 s0 = {1.f, 1.f, 1.f, 1.f}, s1 = {1.f, 1.f, 1.f, 1.f};
    if (ksc) { s0 = *(const f32x4*)(ksc + k0 + 8 * c); s1 = *(const f32x4*)(ksc + k0 + 8 * c + 4); }
    LDS_WAIT(); asm volatile("" ::: "memory");
#pragma unroll
    for (int j = 0; j < 4; ++j) { const int n = (lane >> 3) + 8 * j; const LAS float* s = scr + (8 * c) * 33 + n;
        u32x4 o; o.x = pk2(s[0 * 33] * s0[0], s[1 * 33] * s0[1]); o.y = pk2(s[2 * 33] * s0[2], s[3 * 33] * s0[3]); o.z = pk2(s[4 * 33] * s1[0], s[5 * 33] * s1[1]); o.w = pk2(s[6 * 33] * s1[2], s[7 * 33] * s1[3]);
        *(u32x4*)(WT + (size_t)(dst_row0 + n) * K + k0 + 8 * c) = o; }
    LDS_WAIT(); asm volatile("" ::: "memory");
}
__device__ __forceinline__ int ileave_src(int n0, int half) { const int t = n0 >> 8, w = n0 & 255; return (w < 128) ? t * 128 + w : half + t * 128 + (w - 128); }

__device__ __forceinline__ void convert_group(const Args& a, int group, LAS float* scr, int lane, int w, int nw) {
    unsigned char* ws = a.ws;
    constexpr int I_IN = 32 * 224, I_OUT = 32 * 64, I_UP = 32 * 352, I_DN = 88 * 64, I_GLU = 32 * 128;
    if (group == 0) {
        for (int r = w; r < I_IN; r += nw) { const int kb = r / 224, n0 = 32 * (r % 224); transpose_item(a.in[I_WIN], DIN, n0 < 4096 ? n0 : n0 + 16, 64 * kb, (bf16*)(ws + WS_WIN), 2048, n0, scr, lane); }
    } else {
        const int l = (group == 2) ? 1 : 0, I_A = (l == 0) ? I_OUT : I_GLU;
        const int lo_ = (group == 3) ? I_A : 0, hi_ = (group == 1) ? I_A : I_A + I_UP + I_DN;
        for (int it = lo_ + w; it < hi_; it += nw) {
            int r = it;
            if (r < I_A) { if (l == 0) { const int kb = r / 64, n0 = 32 * (r % 64); transpose_item(a.in[I_WOUT], 2048, n0, 64 * kb, (bf16*)(ws + WS_WOUT), 2048, n0, scr, lane); }
                           else { const int kb = r / 128, n0 = 32 * (r % 128); transpose_item(a.in[I_WGLU], NGLU, ileave_src(n0, 2048), 64 * kb, (bf16*)(ws + WS_WGLU), 2048, n0, scr, lane); }
                           continue; } r -= I_A;
            if (r < I_UP) { const int kb = r / 352, n0 = 32 * (r % 352);
                transpose_item(a.in[I_WUP] + (size_t)l * 2048 * NUP, NUP, ileave_src(n0, DFF), 64 * kb, (bf16*)(ws + WS_WUP) + (size_t)l * NUP * 2048, 2048, n0, scr, lane, a.in[I_NFFN] + l * DM); continue; } r -= I_UP;
            { const int kb = r / 64, n0 = 32 * (r % 64); transpose_item(a.in[I_WDN] + (size_t)l * DFF * 2048, 2048, n0, 64 * kb, (bf16*)(ws + WS_WDN) + (size_t)l * 2048 * DFF, DFF, n0, scr, lane); }
        }
    }
}
constexpr int PRO_REP = 0;
__device__ __forceinline__ void ph_prologue(const Args& a, LAS unsigned char* lds, int tid, int lane, int wave, int gw, int NGW, int G) {
    unsigned char* ws = a.ws;
    for (int rp = 0; rp < (PRO_REP == 1 ? 2 : 1); ++rp)
    {   LAS float* scr = (LAS float*)(lds + wave * 8704);
        convert_group(a, 0, scr, lane, gw, NGW);
        if (G != 256) { convert_group(a, 1, scr, lane, gw, NGW); convert_group(a, 3, scr, lane, gw, NGW); convert_group(a, 2, scr, lane, gw, NGW); }
    }
    for (int rp = 0; rp < (PRO_REP == 2 ? 2 : 1); ++rp)
    {
        float* tab = (float*)(ws + WS_TAB);
        for (int idx = gw * 64 + lane; idx < 2056 * 64; idx += NGW * 64) { const int i = idx & 63, slot = idx >> 6; const int pos = slot < 2048 ? slot : 16384 + (slot - 2048);
            double s, c; sincos_d((double)pos * exp(-(double)i * (9.210340371976184 / 64.0)), s, c); tab[slot * 128 + i] = (float)c; tab[slot * 128 + 64 + i] = (float)s; }
    }
    __syncthreads();
    LAS float* WgT = (LAS float*)lds;
    {   f32x4 wg[4][4];
#pragma unroll
        for (int i = 0; i < 4; ++i)
#pragma unroll
            for (int j = 0; j < 4; ++j) wg[i][j] = *(const f32x4*)(a.in[I_WIN] + (size_t)(tid + 512 * i) * DIN + 4096 + 4 * j);
#pragma unroll
        for (int i = 0; i < 4; ++i)
#pragma unroll
            for (int j = 0; j < 4; ++j)
#pragma unroll
                for (int e = 0; e < 4; ++e) WgT[(4 * j + e) * 2048 + tid + 512 * i] = wg[i][j][e]; }
    __syncthreads();
    bf16* H = (bf16*)(ws + WS_H); float* GATE = (float*)(ws + WS_GATE);
    const float* nw = a.in[I_NMIX];
    const bool b5 = lane & 32, b4 = lane & 16, b3 = lane & 8, b2 = lane & 4;
    const int hme = (b5 ? 8 : 0) + (b4 ? 4 : 0) + (b3 ? 2 : 0) + (b2 ? 1 : 0);
    const float galog = a.in[I_GALOG][hme & 7], gdtb = a.in[I_GDTB][hme & 7];
    f32x4 nwr[8];
#pragma unroll
    for (int j = 0; j < 8; ++j) nwr[j] = ((const f32x4*)nw)[lane + 64 * j];
    for (int rp = 0; rp < (PRO_REP == 3 ? 2 : 1); ++rp) {
    f32x4 vn[8];
    { const int m = gw; const float* xr = (m < MP) ? a.in[I_XP] + (size_t)m * DM : a.in[I_XS] + (size_t)(m - MP) * DM;
#pragma unroll
      for (int j = 0; j < 8; ++j) vn[j] = ((const f32x4*)xr)[lane + 64 * j]; }
    for (int m = gw; m < MTOT; m += NGW) {
        f32x4 v[8]; float ss = 0.f;
#pragma unroll
        for (int j = 0; j < 8; ++j) { v[j] = vn[j]; ss += (v[j][0] * v[j][0] + v[j][1] * v[j][1]) + (v[j][2] * v[j][2] + v[j][3] * v[j][3]); }
        { const int mn = (m + NGW < MTOT) ? m + NGW : m;
          const float* xr = (mn < MP) ? a.in[I_XP] + (size_t)mn * DM : a.in[I_XS] + (size_t)(mn - MP) * DM;
#pragma unroll
          for (int j = 0; j < 8; ++j) vn[j] = ((const f32x4*)xr)[lane + 64 * j]; }
        const float rstd = 1.0f / sqrtf(wave_sum(ss) * (1.0f / DM) + EPS);
#pragma unroll
        for (int j = 0; j < 8; ++j) { v[j] = v[j] * rstd * nwr[j];
            u32x2 o; o.x = pk2(v[j][0], v[j][1]); o.y = pk2(v[j][2], v[j][3]); ((u32x2*)(H + (size_t)m * DM))[lane + 64 * j] = o; }
        float gs_[16];
#pragma unroll
        for (int h = 0; h < 16; ++h) { float s = 0.f;
#pragma unroll
            for (int j = 0; j < 8; ++j) { const f32x4 w4 = *(const LAS f32x4*)(WgT + h * 2048 + 4 * lane + 256 * j); s += (v[j][0] * w4[0] + v[j][1] * w4[1]) + (v[j][2] * w4[2] + v[j][3] * w4[3]); }
            gs_[h] = s; if (h & 1) asm volatile("" ::: "memory"); }
        {   float k8[8], k4[4], k2[2], y;
#pragma unroll
            for (int i = 0; i < 8; ++i) { const float send = b5 ? gs_[i] : gs_[8 + i], keep = b5 ? gs_[8 + i] : gs_[i]; k8[i] = keep + __shfl_xor(send, 32); }
#pragma unroll
            for (int i = 0; i < 4; ++i) { const float send = b4 ? k8[i] : k8[4 + i], keep = b4 ? k8[4 + i] : k8[i]; k4[i] = keep + __shfl_xor(send, 16); }
#pragma unroll
            for (int i = 0; i < 2; ++i) { const float send = b3 ? k4[i] : k4[2 + i], keep = b3 ? k4[2 + i] : k4[i]; k2[i] = keep + __shfl_xor(send, 8); }
            { const float send = b2 ? k2[0] : k2[1], keep = b2 ? k2[1] : k2[0]; y = keep + __shfl_xor(send, 4); }
            y += __shfl_xor(y, 2); y += __shfl_xor(y, 1);
            if ((lane & 3) == 0) { float o; if (hme < 8) o = -expf(galog) * softplus_f(y + gdtb); else o = sigmoid_f(y); GATE[m * 16 + hme] = o; } }
    }
    }
    __syncthreads();
}

__device__ __forceinline__ void ph_rms_rows(const float* X, const float* nw, bf16* H, int lane, int gw, int NGW) {
    for (int m = gw; m < MTOT; m += NGW) {
        f32x4 v[8]; float ss = 0.f;
#pragma unroll
        for (int j = 0; j < 8; ++j) { v[j] = ((const f32x4*)(X + (size_t)m * DM))[lane + 64 * j]; ss += (v[j][0] * v[j][0] + v[j][1] * v[j][1]) + (v[j][2] * v[j][2] + v[j][3] * v[j][3]); }
        const float rstd = 1.0f / sqrtf(wave_sum(ss) * (1.0f / DM) + EPS);
#pragma unroll
        for (int j = 0; j < 8; ++j) { const f32x4 w4 = ((const f32x4*)nw)[lane + 64 * j]; v[j] = v[j] * rstd * w4;
            u32x2 o; o.x = pk2(v[j][0], v[j][1]); o.y = pk2(v[j][2], v[j][3]); ((u32x2*)(H + (size_t)m * DM))[lane + 64 * j] = o; }
    }
}
__device__ __forceinline__ void ph_rms_out(const float* X, const float* SS, const float* SLAB, const float* nw, float* Y, int lane, int gw, int NGW) {
    f32x4 w[8];
#pragma unroll
    for (int j = 0; j < 8; ++j) w[j] = ((const f32x4*)nw)[lane + 64 * j];
    for (int m = gw; m < MTOT; m += NGW) {
        f32x4 v[8];
#pragma unroll
        for (int j = 0; j < 8; ++j) v[j] = ((const f32x4*)(X + (size_t)m * DM))[lane + 64 * j];
        float rstd;
        if (m < MP) rstd = 1.0f / sqrtf(SS[m] * (1.0f / DM) + EPS);
        else {
            f32x4 sl[8][4];
#pragma unroll
            for (int j = 0; j < 8; ++j)
#pragma unroll
                for (int k = 0; k < 4; ++k) sl[j][k] = ((const f32x4*)(SLAB + ((size_t)k * MS + (m - MP)) * DM))[lane + 64 * j];
            float ss = 0.f;
#pragma unroll
            for (int j = 0; j < 8; ++j) { v[j] = v[j] + ((sl[j][0] + sl[j][1]) + (sl[j][2] + sl[j][3]));
                ss += (v[j][0] * v[j][0] + v[j][1] * v[j][1]) + (v[j][2] * v[j][2] + v[j][3] * v[j][3]); }
            rstd = 1.0f / sqrtf(wave_sum(ss) * (1.0f / DM) + EPS);
        }
#pragma unroll
        for (int j = 0; j < 8; ++j) ((f32x4*)(Y + (size_t)m * DM))[lane + 64 * j] = v[j] * rstd * w[j];
    }
}

template <bool GLU>
__device__ __forceinline__ void ph_combine(float* X, bf16* XB, float* SS, const float* SLAB, int lane, int gw, int NGW, bf16* UGW = nullptr, const float* NW = nullptr) {
    constexpr int LDS_ = GLU ? NGLU : DM;
    for (int mr = gw; mr < MS; mr += NGW) {
        const size_t m = (size_t)MP + mr; float ss = 0.f;
        f32x4 xk[8];
#pragma unroll
        for (int jh = 0; jh < 2; ++jh) {
            f32x4 sv[4][4], sg[4][4];
#pragma unroll
            for (int jj = 0; jj < 4; ++jj) { const int j = 4 * jh + jj, c = 4 * (lane + 64 * j);
                xk[j] = *(const f32x4*)(X + m * DM + c);
                const int sc = GLU ? ((c >> 7) << 8) + (c & 127) : c;
#pragma unroll
                for (int k = 0; k < 4; ++k) { const float* sp = SLAB + ((size_t)k * MS + mr) * LDS_ + sc; sv[jj][k] = *(const f32x4*)sp; if (GLU) sg[jj][k] = *(const f32x4*)(sp + 128); } }
#pragma unroll
            for (int jj = 0; jj < 4; ++jj) { const int j = 4 * jh + jj, c = 4 * (lane + 64 * j);
                f32x4 x = xk[j];
                if (GLU) { const f32x4 v = (sv[jj][0] + sv[jj][1]) + (sv[jj][2] + sv[jj][3]), g = (sg[jj][0] + sg[jj][1]) + (sg[jj][2] + sg[jj][3]);
#pragma unroll
                    for (int e = 0; e < 4; ++e) x[e] += v[e] / (1.0f + __expf(-g[e]));
                } else x = x + ((sv[jj][0] + sv[jj][1]) + (sv[jj][2] + sv[jj][3]));
                xk[j] = x; ss += (x[0] * x[0] + x[1] * x[1]) + (x[2] * x[2] + x[3] * x[3]);
                *(f32x4*)(X + m * DM + c) = x;
                u32x2 o; o.x = pk2(x[0], x[1]); o.y = pk2(x[2], x[3]); *(u32x2*)(XB + m * DM + c) = o; }
        }
        ss = wave_sum(ss);
        if (lane == 0) SS[m] = ss;
        if (UGW) {
            const float rs = __builtin_amdgcn_rsqf(ss * (1.0f / DM) + EPS);
            f32x4 w4[8];
#pragma unroll
            for (int j = 0; j < 8; ++j) w4[j] = *(const f32x4*)(NW + 4 * (lane + 64 * j));
#pragma unroll
            for (int j = 0; j < 8; ++j) { const int c = 4 * (lane + 64 * j); const f32x4 x = xk[j];
                u32x2 o; o.x = pk2(x[0] * rs * w4[j][0], x[1] * rs * w4[j][1]); o.y = pk2(x[2] * rs * w4[j][2], x[3] * rs * w4[j][3]);
                *(u32x2*)(UGW + ((size_t)(c >> 4) * MTOT + m) * 16 + (c & 15)) = o; }
        }
    }
}
__device__ __forceinline__ void ph_ug_prompt(const bf16* XB, const float* SS, const float* NW, bf16* UG, int lane, int gw, int NGW) {
    float wv[32];
#pragma unroll
    for (int i = 0; i < 8; ++i) { const f32x4 w4 = *(const f32x4*)(NW + 32 * lane + 4 * i); wv[4 * i] = w4[0]; wv[4 * i + 1] = w4[1]; wv[4 * i + 2] = w4[2]; wv[4 * i + 3] = w4[3]; }
    for (int m = gw; m < MP; m += NGW) {
        u32x4 raw[4];
#pragma unroll
        for (int i = 0; i < 4; ++i) raw[i] = *(const u32x4*)(XB + (size_t)m * DM + 32 * lane + 8 * i);
        const float rs = __builtin_amdgcn_rsqf(SS[m] * (1.0f / DM) + EPS);
#pragma unroll
        for (int i = 0; i < 4; ++i) { float x[8]; unpack8(raw[i], x);
#pragma unroll
            for (int j = 0; j < 8; ++j) x[j] = x[j] * rs * wv[8 * i + j];
            st_bf8(UG + ((size_t)(2 * lane + (i >> 1)) * MTOT + m) * 16 + 8 * (i & 1), x); }
    }
}

typedef short bf16x8 __attribute__((ext_vector_type(8)));
constexpr int GREC_WN = 0, GREC_QD = 16384, GREC_QK = 32768, GREC_KD = 40960, GREC_IMG = 57344, GREC_UT = 57344, GREC_BYTES = 90112;
constexpr int RREC_QD = 0, RREC_QK = 16384, RREC_KD = 24576, RREC_IMG = 40960, RREC_VT = 40960, RREC_BYTES = 73728;
constexpr size_t WS_GREC = WS_ACT, WS_RREC = WS_G2, WS_GL = WS_CTL + 131072;
constexpr size_t WS_QKS = WS_H, WS_VAS = WS_H + 8 * MiB;
__device__ __forceinline__ int kpos(int k) { return (k & ~31) | (((k >> 2) & 3) << 3) | (((k >> 4) & 1) << 2) | (k & 3); }
__device__ __forceinline__ int addr256(int row, int chunk) { return row * 256 + ((chunk ^ (row & 15)) << 4); }
__device__ __forceinline__ int addr128(int row, int chunk) { return row * 128 + ((chunk ^ ((row >> 1) & 7)) << 4); }
__device__ __forceinline__ unsigned cvtpk(float lo, float hi) { unsigned r; asm volatile("v_cvt_pk_bf16_f32 %0, %1, %2" : "=v"(r) : "v"(lo), "v"(hi)); return r; }
__device__ __forceinline__ bf16x8 pack_tiles(const f32x4 lo, const f32x4 hi) { u32x4 w; w.x = cvtpk(lo[0], lo[1]); w.y = cvtpk(lo[2], lo[3]); w.z = cvtpk(hi[0], hi[1]); w.w = cvtpk(hi[2], hi[3]); return __builtin_bit_cast(bf16x8, w); }
#define MFMA16(a, b, c) __builtin_amdgcn_mfma_f32_16x16x32_bf16((a), (b), (c), 0, 0, 0)

__device__ __forceinline__ void img256_put8(unsigned char* img, int row, int grp, const float (&v)[8]) {
    const int s = grp >> 2, t = (grp >> 1) & 1, qq0 = (grp & 1) * 2;
    u32x2 p0, p1; p0.x = pk2(v[0], v[1]); p0.y = pk2(v[2], v[3]); p1.x = pk2(v[4], v[5]); p1.y = pk2(v[6], v[7]);
    *(u32x2*)(img + addr256(row, 4 * s + qq0) + 8 * t) = p0; *(u32x2*)(img + addr256(row, 4 * s + qq0 + 1) + 8 * t) = p1;
}

constexpr int GP_K32 = 0, GP_V32 = 33024, GP_QS = 66048, GP_KS = 82432, GP_LM = 98816, GP_G = 115200;
__device__ __forceinline__ void gdn_prep_chunk(const Args& a, LAS unsigned char* lds, int b, int h, int n, int tid, int lane, int wave) {
    unsigned char* ws = a.ws;
    const bf16* PROJ = (const bf16*)(ws + WS_BIG); const float* GATE = (const float*)(ws + WS_GATE);
    const int cid = (b * 8 + h) * 32 + n, row0 = b * SEQ + 64 * n;
    unsigned char* rec = ws + WS_GREC + (size_t)cid * GREC_BYTES;
    LAS float* K32 = (LAS float*)(lds + GP_K32); LAS float* V32 = (LAS float*)(lds + GP_V32); LAS float* Lm = (LAS float*)(lds + GP_LM);
    LAS float* gs = (LAS float*)(lds + GP_G);
    __syncthreads();
    if (wave == 0) {
        float v = GATE[(size_t)(row0 + lane) * 16 + h];
#pragma unroll
        for (int o = 1; o < 64; o <<= 1) { const float t = __shfl_up(v, o); if (lane >= o) v += t; }
        const float gl = __shfl(v, 63);
        const float be = GATE[(size_t)(row0 + lane) * 16 + 8 + h], ev = expf(v);
        gs[lane] = v; gs[64 + lane] = be; gs[128 + lane] = ev; gs[192 + lane] = expf(gl - v); gs[256 + lane] = be * ev; gs[320 + lane] = 1.0f;
        if (lane == 63) ((float*)(ws + WS_GL))[cid] = expf(gl);
    }
    __syncthreads();
    {
        const int c = tid >> 3, sub = tid & 7, t = 64 * n + c; const size_t m = (size_t)row0 + c;
        const float egc = gs[128 + c], bec = gs[64 + c];
        float qv[2][8], kv[2][8];
#pragma unroll
        for (int i = 0; i < 6; ++i) {
            const int grp = sub + 8 * (i & 1), typ = i >> 1, col = typ * 1024 + h * 128 + grp * 8;
            float acc[8];
#pragma unroll
            for (int e = 0; e < 8; ++e) acc[e] = 0.f;
            if (n > 0) {
                float x[4][8], w[4][8];
#pragma unroll
                for (int j = 0; j < 4; ++j) { ld_bf8(PROJ + (m - 3 + j) * NPROJ + col, x[j]); ld_f8(a.in[I_GCW] + (size_t)j * 3072 + col, w[j]); }
#pragma unroll
                for (int j = 0; j < 4; ++j)
#pragma unroll
                    for (int e = 0; e < 8; ++e) acc[e] += w[j][e] * x[j][e];
            } else {
#pragma unroll
                for (int j = 0; j < 4; ++j) if (t - 3 + j >= 0) { float x[8], w[8]; ld_bf8(PROJ + (m - 3 + j) * NPROJ + col, x); ld_f8(a.in[I_GCW] + (size_t)j * 3072 + col, w);
#pragma unroll
                    for (int e = 0; e < 8; ++e) acc[e] += w[e] * x[e]; }
            }
#pragma unroll
            for (int e = 0; e < 8; ++e) acc[e] = silu_f(acc[e]);
            if (typ == 0) {
#pragma unroll
                for (int e = 0; e < 8; ++e) qv[i & 1][e] = acc[e];
            } else if (typ == 1) {
#pragma unroll
                for (int e = 0; e < 8; ++e) kv[i & 1][e] = acc[e];
            } else {
#pragma unroll
                for (int e = 0; e < 8; ++e) V32[c * 129 + grp * 8 + e] = acc[e] * bec; }
            if (i & 1) asm volatile("" ::: "memory");
        }
        float sq = 0.f, sk = 0.f;
#pragma unroll
        for (int e = 0; e < 8; ++e) { sq += qv[0][e] * qv[0][e] + qv[1][e] * qv[1][e]; sk += kv[0][e] * kv[0][e] + kv[1][e] * kv[1][e]; }
        sq += __shfl_xor(sq, 1); sq += __shfl_xor(sq, 2); sq += __shfl_xor(sq, 4); sk += __shfl_xor(sk, 1); sk += __shfl_xor(sk, 2); sk += __shfl_xor(sk, 4);
        const float rq = (1.0f / sqrtf(sq + EPS)) * 0.08838834764831845f, rk = 1.0f / sqrtf(sk + EPS);
#pragma unroll
        for (int i = 0; i < 2; ++i) { const int grp = sub + 8 * i; float qd[8];
#pragma unroll
            for (int e = 0; e < 8; ++e) { qv[i][e] *= rq; kv[i][e] *= rk; qd[e] = qv[i][e] * egc; K32[c * 129 + grp * 8 + e] = kv[i][e]; }
            u32x4 wq, wk; wq.x = pk2(qv[i][0], qv[i][1]); wq.y = pk2(qv[i][2], qv[i][3]); wq.z = pk2(qv[i][4], qv[i][5]); wq.w = pk2(qv[i][6], qv[i][7]);
            wk.x = pk2(kv[i][0], kv[i][1]); wk.y = pk2(kv[i][2], kv[i][3]); wk.z = pk2(kv[i][4], kv[i][5]); wk.w = pk2(kv[i][6], kv[i][7]);
            *(LAS u32x4*)(lds + GP_QS + addr256(c, grp)) = wq; *(LAS u32x4*)(lds + GP_KS + addr256(c, grp)) = wk;
            img256_put8(rec + GREC_QD, c, grp, qd); }
    }
    __syncthreads();
    {
        const int r = lane & 15, q = lane >> 4;
#pragma unroll
        for (int ti = 0; ti < 2; ++ti) {
            const int tt = 2 * wave + ti, ct = tt >> 2, cu = tt & 3;
            f32x4 akk = {0.f, 0.f, 0.f, 0.f}, aqk = {0.f, 0.f, 0.f, 0.f};
#pragma unroll
            for (int ks = 0; ks < 4; ++ks) {
                const bf16x8 bk = *(const LAS bf16x8*)(lds + GP_KS + addr256(16 * cu + r, 4 * ks + q));
                const bf16x8 ak = *(const LAS bf16x8*)(lds + GP_KS + addr256(16 * ct + r, 4 * ks + q));
                const bf16x8 aq = *(const LAS bf16x8*)(lds + GP_QS + addr256(16 * ct + r, 4 * ks + q));
                akk = MFMA16(ak, bk, akk); aqk = MFMA16(aq, bk, aqk);
            }
            const int c2 = 16 * cu + r; const float g2 = gs[c2]; const int p2 = kpos(c2);
#pragma unroll
            for (int reg = 0; reg < 4; ++reg) { const int c = 16 * ct + 4 * q + reg; const float dec = (c2 <= c) ? expf(gs[c] - g2) : 0.f;
                Lm[c * 64 + c2] = (c2 < c) ? gs[64 + c] * akk[reg] * dec : 0.f;
                *(bf16*)(rec + GREC_QK + addr128(c, p2 >> 3) + (p2 & 7) * 2) = (bf16)f2bf(aqk[reg] * dec); }
        }
    }
    __syncthreads();
    if (tid < 256) {
        const bool isu = tid < 128; const int col = isu ? tid : tid - 128;
        const LAS float* rb = (const LAS float*)(lds + (isu ? GP_V32 : GP_K32)) + col; const LAS float* scp = gs + (isu ? 320 : 256);
        int zlane; asm volatile("v_mov_b32 %0, 0" : "=v"(zlane));
        const LAS float* Lz = Lm + zlane;
        float sol[64];
#pragma unroll
        for (int c = 0; c < 64; ++c) {
            float pa[4] = {rb[c * 129] * scp[c], 0.f, 0.f, 0.f};
#pragma unroll
            for (int c4 = 0; c4 < (c + 3) / 4; ++c4) { const f32x4 l4 = *(const LAS f32x4*)(Lz + c * 64 + 4 * c4);
#pragma unroll
                for (int j = 0; j < 4; ++j) if (4 * c4 + j < c) pa[j] -= l4[j] * sol[4 * c4 + j]; }
            sol[c] = (pa[0] + pa[1]) + (pa[2] + pa[3]);
            asm volatile("" ::: "memory");
        }
        if (isu) { float* ut = (float*)(rec + GREC_UT) + col * 64;
#pragma unroll
            for (int c4 = 0; c4 < 16; ++c4) *(f32x4*)(ut + 4 * c4) = (f32x4){sol[4 * c4], sol[4 * c4 + 1], sol[4 * c4 + 2], sol[4 * c4 + 3]}; }
        else { const int p = kpos(col), ch = p >> 3, wi = (p & 7) * 2;
            int xo[16];
#pragma unroll
            for (int k = 0; k < 16; ++k) xo[k] = ((ch ^ k) << 4) + wi;
#pragma unroll
            for (int c = 0; c < 64; ++c) *(LAS bf16*)(lds + GP_QS + c * 256 + xo[c & 15]) = (bf16)f2bf(-sol[c]); }
    } else {
        const int c = lane, p = kpos(c), ch = p >> 3, wi = (p & 7) * 2; const float sc = gs[192 + c];
#pragma unroll 2
        for (int i = 0; i < 32; ++i) { const int d = (wave - 4) * 32 + i; *(bf16*)(rec + GREC_KD + addr128(d, ch) + wi) = (bf16)f2bf(K32[c * 129 + d] * sc); }
    }
    __syncthreads();
#pragma unroll
    for (int i = 0; i < 2; ++i) *(u32x4*)(rec + GREC_WN + (i * NTHR + tid) * 16) = *(const LAS u32x4*)(lds + GP_QS + (i * NTHR + tid) * 16);
}

constexpr int RP_K32 = 0, RP_V16 = 33024, RP_QS = 66048, RP_KS = 82432;
__device__ __forceinline__ void ret_prep_chunk(const Args& a, LAS unsigned char* lds, int b, int h, int n, int tid, int lane, int wave) {
    unsigned char* ws = a.ws;
    const bf16* PROJ = (const bf16*)(ws + WS_BIG); const float* tab = (const float*)(ws + WS_TAB);
    const int cid = (b * 4 + h) * 32 + n, row0 = b * SEQ + 64 * n;
    unsigned char* rec = ws + WS_RREC + (size_t)cid * RREC_BYTES;
    LAS float* K32 = (LAS float*)(lds + RP_K32); LAS bf16* V16 = (LAS bf16*)(lds + RP_V16);
    const float l2g = log2f(1.0f - exp2f(-5.0f - (float)h));
    __syncthreads();
    {
        const int c = tid >> 3, sub = tid & 7; const size_t m = (size_t)row0 + c; const bf16* pr = PROJ + m * NPROJ;
        float ql[8], qh[8], kl[8], kh[8], cs[8], sn[8];
        u32x4 vraw[4];
#pragma unroll
        for (int i = 0; i < 4; ++i) vraw[i] = *(const u32x4*)(pr + C_VB + h * 256 + (sub + 8 * i) * 8);
        ld_bf8(pr + C_QB + h * 128 + sub * 8, ql); ld_bf8(pr + C_QB + h * 128 + 64 + sub * 8, qh); ld_bf8(pr + C_KB + h * 128 + sub * 8, kl); ld_bf8(pr + C_KB + h * 128 + 64 + sub * 8, kh);
        ld_f8(tab + (size_t)(64 * n + c) * 128 + sub * 8, cs); ld_f8(tab + (size_t)(64 * n + c) * 128 + 64 + sub * 8, sn);
        float q0[8], q1[8], k0[8], k1[8], d0[8], d1[8]; const float qdec = exp2f(l2g * (float)(c + 1));
#pragma unroll
        for (int e = 0; e < 8; ++e) { q0[e] = ql[e] * cs[e] - qh[e] * sn[e]; q1[e] = ql[e] * sn[e] + qh[e] * cs[e];
            k0[e] = (kl[e] * cs[e] - kh[e] * sn[e]) * 0.08838834764831845f; k1[e] = (kl[e] * sn[e] + kh[e] * cs[e]) * 0.08838834764831845f;
            d0[e] = q0[e] * qdec; d1[e] = q1[e] * qdec; K32[c * 129 + sub * 8 + e] = k0[e]; K32[c * 129 + 64 + sub * 8 + e] = k1[e]; }
        u32x4 w; w.x = pk2(q0[0], q0[1]); w.y = pk2(q0[2], q0[3]); w.z = pk2(q0[4], q0[5]); w.w = pk2(q0[6], q0[7]); *(LAS u32x4*)(lds + RP_QS + addr256(c, sub)) = w;
        w.x = pk2(q1[0], q1[1]); w.y = pk2(q1[2], q1[3]); w.z = pk2(q1[4], q1[5]); w.w = pk2(q1[6], q1[7]); *(LAS u32x4*)(lds + RP_QS + addr256(c, 8 + sub)) = w;
        w.x = pk2(k0[0], k0[1]); w.y = pk2(k0[2], k0[3]); w.z = pk2(k0[4], k0[5]); w.w = pk2(k0[6], k0[7]); *(LAS u32x4*)(lds + RP_KS + addr256(c, sub)) = w;
        w.x = pk2(k1[0], k1[1]); w.y = pk2(k1[2], k1[3]); w.z = pk2(k1[4], k1[5]); w.w = pk2(k1[6], k1[7]); *(LAS u32x4*)(lds + RP_KS + addr256(c, 8 + sub)) = w;
        img256_put8(rec + RREC_QD, c, sub, d0); img256_put8(rec + RREC_QD, c, 8 + sub, d1);
#pragma unroll
        for (int i = 0; i < 4; ++i) { const u32x4 v = vraw[i]; LAS unsigned* dst = (LAS unsigned*)(V16 + c * 258 + (sub + 8 * i) * 8); dst[0] = v.x; dst[1] = v.y; dst[2] = v.z; dst[3] = v.w; }
    }
    __syncthreads();
    {
        const int r = lane & 15, q = lane >> 4;
#pragma unroll
        for (int ti = 0; ti < 2; ++ti) {
            const int tt = 2 * wave + ti, ct = tt >> 2, cu = tt & 3;
            f32x4 aqk = {0.f, 0.f, 0.f, 0.f};
#pragma unroll
            for (int ks = 0; ks < 4; ++ks) {
                const bf16x8 bk = *(const LAS bf16x8*)(lds + RP_KS + addr256(16 * cu + r, 4 * ks + q));
                const bf16x8 aq = *(const LAS bf16x8*)(lds + RP_QS + addr256(16 * ct + r, 4 * ks + q));
                aqk = MFMA16(aq, bk, aqk);
            }
            const int c2 = 16 * cu + r, p2 = kpos(c2);
#pragma unroll
            for (int reg = 0; reg < 4; ++reg) { const int c = 16 * ct + 4 * q + reg; const float dec = (c2 <= c) ? exp2f(l2g * (float)(c - c2)) : 0.f;
                *(bf16*)(rec + RREC_QK + addr128(c, p2 >> 3) + (p2 & 7) * 2) = (bf16)f2bf(aqk[reg] * dec); }
        }
        const int c = lane, p = kpos(c), ch = p >> 3, wi = (p & 7) * 2; const float sc = exp2f(l2g * (float)(63 - c));
#pragma unroll 2
        for (int i = 0; i < 16; ++i) { const int d = wave * 16 + i; *(bf16*)(rec + RREC_KD + addr128(d, ch) + wi) = (bf16)f2bf(K32[c * 129 + d] * sc); }
#pragma unroll 2
        for (int i = 0; i < 32; ++i) { const int e = wave * 32 + i; *(bf16*)(rec + RREC_VT + e * 128 + p * 2) = V16[c * 258 + e]; }
    }
}

template <bool GDN>
__device__ __forceinline__ void chunk_scan(const Args& a, LAS unsigned char* lds, int task, int tid, int lane, int wave) {
    unsigned char* ws = a.ws;
    constexpr int IMG = GDN ? GREC_IMG : RREC_IMG, REC = GDN ? GREC_BYTES : RREC_BYTES, NP = IMG / 16 / NTHR;
    constexpr int O_WN = GREC_WN, O_QD = GDN ? GREC_QD : RREC_QD, O_QK = GDN ? GREC_QK : RREC_QK, O_KD = GDN ? GREC_KD : RREC_KD;
    const int r = lane & 15, q = lane >> 4;
    int b, h, e0, cid0;
    if (GDN) { b = task >> 3; h = task & 7; e0 = 16 * wave; cid0 = (b * 8 + h) * 32; }
    else { b = task >> 3; h = (task >> 1) & 3; e0 = 128 * (task & 1) + 16 * wave; cid0 = (b * 4 + h) * 32; }
    const unsigned char* rec = ws + (GDN ? WS_GREC : WS_RREC) + (size_t)cid0 * REC;
    const float* GL = (const float*)(ws + WS_GL) + cid0;
    float* O = (float*)(ws + (GDN ? WS_OA : WS_OB)) + (size_t)b * SEQ * 1024 + h * (GDN ? 128 : 256) + e0 + r;
    const float gch = GDN ? 0.f : exp2f(64.0f * log2f(1.0f - exp2f(-5.0f - (float)h)));
    f32x4 S[8];
#pragma unroll
    for (int dt = 0; dt < 8; ++dt) S[dt] = (f32x4){0.f, 0.f, 0.f, 0.f};
    __syncthreads();
    constexpr int SLICE = GDN ? 4096 : 2048, SL_OFF = 2 * GREC_IMG;
    LAS unsigned char* slot = lds + SL_OFF + wave * SLICE;
#define STAGE_IMG(recp, bufp) do { _Pragma("unroll") for (int i_ = 0; i_ < NP; ++i_) \
        __builtin_amdgcn_global_load_lds((const unsigned*)((recp) + (size_t)(i_ * NTHR + tid) * 16), (LAS unsigned*)((bufp) + (i_ * NTHR + wave * 64) * 16), 16, 0, 0); } while (0)
#define STAGE_SLICE(recp) do { _Pragma("unroll") for (int i_ = 0; i_ < SLICE / 1024; ++i_) \
        __builtin_amdgcn_global_load_lds((const unsigned*)((recp) + (GDN ? GREC_UT + e0 * 256 : RREC_VT + e0 * 128) + i_ * 1024 + lane * 16), (LAS unsigned*)(slot + i_ * 1024), 16, 0, 0); } while (0)
    STAGE_IMG(rec, lds); STAGE_SLICE(rec);
    for (int n = 0; n < 32; ++n) {
        const unsigned char* nrec = rec + (size_t)(n + 1 < 32 ? n + 1 : n) * REC;
        f32x4 uc[4]; bf16x8 bv[2];
        const float gl = GDN ? GL[n] : gch;
        if (n == 0) asm volatile("s_waitcnt vmcnt(0) lgkmcnt(0)" ::: "memory"); else asm volatile("s_waitcnt vmcnt(16) lgkmcnt(0)" ::: "memory");
        __builtin_amdgcn_s_barrier();
        asm volatile("" ::: "memory");
        if (GDN) {
#pragma unroll
            for (int ct = 0; ct < 4; ++ct) uc[ct] = *(const LAS f32x4*)(slot + r * 256 + (16 * ct + 4 * q) * 4);
        } else {
#pragma unroll
            for (int s = 0; s < 2; ++s) bv[s] = *(const LAS bf16x8*)(slot + r * 128 + (4 * s + q) * 16);
        }
        asm volatile("s_waitcnt lgkmcnt(0)" ::: "memory");
        if (n + 1 < 32) { STAGE_IMG(nrec, lds + ((n + 1) & 1) * IMG); STAGE_SLICE(nrec); }
        asm volatile("" ::: "memory"); __builtin_amdgcn_sched_barrier(0);
        LAS unsigned char* B = lds + (n & 1) * IMG;
        bf16x8 bs[4];
#pragma unroll
        for (int s = 0; s < 4; ++s) bs[s] = pack_tiles(S[2 * s], S[2 * s + 1]);
        f32x4 ao[4];
#pragma unroll
        for (int ct = 0; ct < 4; ++ct) ao[ct] = (f32x4){0.f, 0.f, 0.f, 0.f};
        bf16x8 FA[8], FB[8];
#define LD256(F, off, s0) do { _Pragma("unroll") for (int i_ = 0; i_ < 8; ++i_) F[i_] = *(const LAS bf16x8*)(B + (off) + addr256(16 * (i_ & 3) + r, 4 * ((s0) + (i_ >> 2)) + q)); } while (0)
#define LD128(F, off, t0) do { _Pragma("unroll") for (int i_ = 0; i_ < 8; ++i_) F[i_] = *(const LAS bf16x8*)(B + (off) + addr128(16 * ((t0) + (i_ & 3)) + r, 4 * (i_ >> 2) + q)); } while (0)
#define MM(F, ACC, BOP, s0) do { _Pragma("unroll") for (int i_ = 0; i_ < 8; ++i_) ACC[i_ & 3] = MFMA16(F[i_], BOP[(s0) + (i_ >> 2)], ACC[i_ & 3]); } while (0)
#define SB() __builtin_amdgcn_sched_barrier(0)
        if (GDN) {
            LD256(FA, O_WN, 0); SB();
            LD256(FB, O_WN, 2); SB(); MM(FA, uc, bs, 0); SB();
            LD256(FA, O_QD, 0); SB(); MM(FB, uc, bs, 2); SB();
            bv[0] = pack_tiles(uc[0], uc[1]); bv[1] = pack_tiles(uc[2], uc[3]);
        } else { LD256(FA, O_QD, 0); SB(); }
        LD256(FB, O_QD, 2); SB(); MM(FA, ao, bs, 0); SB();
        LD128(FA, O_QK, 0); SB(); MM(FB, ao, bs, 2); SB();
        LD128(FB, O_KD, 0); SB(); MM(FA, ao, bv, 0); SB();
#pragma unroll
        for (int dt = 0; dt < 8; ++dt) S[dt] = S[dt] * gl;
        LD128(FA, O_KD, 4); SB();
        { f32x4 (&S0)[8] = S; _Pragma("unroll") for (int i_ = 0; i_ < 8; ++i_) S0[i_ & 3] = MFMA16(FB[i_], bv[i_ >> 2], S0[i_ & 3]); } SB();
        { _Pragma("unroll") for (int i_ = 0; i_ < 8; ++i_) S[4 + (i_ & 3)] = MFMA16(FA[i_], bv[i_ >> 2], S[4 + (i_ & 3)]); } SB();
#undef LD256
#undef LD128
#undef MM
#undef SB
#pragma unroll
        for (int ct = 0; ct < 4; ++ct)
#pragma unroll
            for (int reg = 0; reg < 4; ++reg) O[(size_t)(64 * n + 16 * ct + 4 * q + reg) * 1024] = ao[ct][reg];
    }
#undef STAGE_IMG
#undef STAGE_SLICE
    float* so = a.out + (GDN ? O_GDN_P + (size_t)(b * 8 + h) * 128 * 128 : O_RET_P + (size_t)(b * 4 + h) * 128 * 256) + e0 + r;
#pragma unroll
    for (int dt = 0; dt < 8; ++dt)
#pragma unroll
        for (int reg = 0; reg < 4; ++reg) so[(size_t)(16 * dt + 4 * q + reg) * (GDN ? 128 : 256)] = S[dt][reg];
}

__device__ __forceinline__ void ph_gdn_prep(const Args& a, int lane, int gw, int NGW) {
    unsigned char* ws = a.ws;
    const bf16* PROJ = (const bf16*)(ws + WS_BIG);
    constexpr int NCH = (4 + DECB) * 3 * (3072 / 8);
    float xx[2][8]; int chs[2];
#pragma unroll
    for (int u = 0; u < 2; ++u) { const int ch = gw * 64 + lane + u * NGW * 64; chs[u] = ch; const int cc = ch < NCH ? ch : 0;
        const int c = 8 * (cc % 384), j = (cc / 384) % 3, sb = cc / (3 * 384);
        const size_t row = sb < 4 ? (size_t)(sb * SEQ + SEQ - 3 + j) : (size_t)(MP + (sb - 4) * DECS + DECS - 3 + j);
        ld_bf8(PROJ + row * NPROJ + c, xx[u]); }
#pragma unroll
    for (int u = 0; u < 2; ++u) { const int ch = chs[u]; if (ch < NCH) {
        const int c = 8 * (ch % 384), j = (ch / 384) % 3, sb = ch / (3 * 384);
        float* dst = sb < 4 ? a.out + O_GCB_P + ((size_t)sb * 3 + j) * 3072 + c : a.out + O_GCB_S + ((size_t)(sb - 4) * 3 + j) * 3072 + c;
        *(f32x4*)dst = (f32x4){xx[u][0], xx[u][1], xx[u][2], xx[u][3]}; *(f32x4*)(dst + 4) = (f32x4){xx[u][4], xx[u][5], xx[u][6], xx[u][7]}; } }
    static_assert(NCH <= 2 * 256 * NWAVES * 64, "two chunks per lane cover the conv states");
}

__device__ __forceinline__ void ph_mix_prep(const Args& a, LAS unsigned char* lds, int tid, int lane, int wave, int gw, int NGW, int G) {
    for (int t = blockIdx.x; t < 1024; t += G) gdn_prep_chunk(a, lds, t >> 8, (t >> 5) & 7, t & 31, tid, lane, wave);
    for (int r = blockIdx.x; r < 512; r += G) ret_prep_chunk(a, lds, r >> 7, (r >> 5) & 3, r & 31, tid, lane, wave);
    ph_gdn_prep(a, lane, gw, NGW);
}
constexpr int SB_Q = 0, SB_K = 4096, SB_V = 8192, SB_G = 12288;
#define LDS_BARRIER() asm volatile("s_waitcnt lgkmcnt(0)\n\ts_barrier" ::: "memory")
__device__ __forceinline__ float oct_sum(float v) {
    v += __builtin_bit_cast(float, __builtin_amdgcn_mov_dpp(__builtin_bit_cast(int, v), 0xB1, 0xF, 0xF, true));
    v += __builtin_bit_cast(float, __builtin_amdgcn_mov_dpp(__builtin_bit_cast(int, v), 0x4E, 0xF, 0xF, true));
    v += __builtin_bit_cast(float, __builtin_amdgcn_mov_dpp(__builtin_bit_cast(int, v), 0x141, 0xF, 0xF, true));
    return v;
}
__device__ __forceinline__ void gdn_sample_pair(const Args& a, LAS unsigned char* lds, int st, int lane, int wave) {
    unsigned char* ws = a.ws;
    const bf16* PROJ = (const bf16*)(ws + WS_BIG); const float* GATE = (const float*)(ws + WS_GATE); float* OA = (float*)(ws + WS_OA);
    const int hb = wave >> 2, w4 = wave & 3, b = st >> 3, h = st & 7;
    LAS unsigned char* L = lds + hb * 16384;
    LAS float* qs = (LAS float*)(L + SB_Q); LAS float* ks = (LAS float*)(L + SB_K); LAS float* vs = (LAS float*)(L + SB_V); LAS float* gt = (LAS float*)(L + SB_G);
    const int dg = lane & 7, ec = lane >> 3, wcol = 32 * w4 + 4 * ec;
    float2 wj[3][4], xs[3][5]; unsigned xp[3][5]; float g0[2], g1[2];
#pragma unroll
    for (int typ = 0; typ < 3; ++typ) { const int col = typ * 1024 + h * 128 + 2 * lane;
#pragma unroll
        for (int j = 0; j < 4; ++j) wj[typ][j] = *(const float2*)(a.in[I_GCW] + (size_t)j * 3072 + col);
#pragma unroll
        for (int jj = 0; jj < 5; ++jj) { const int tq = 2 * w4 + jj; xs[typ][jj] = *(const float2*)(a.in[I_SGCB] + ((size_t)b * 3 + (tq < 3 ? tq : 2)) * 3072 + col);
            xp[typ][jj] = *(const unsigned*)(PROJ + (size_t)(MP + b * DECS + (tq >= 3 ? tq - 3 : 0)) * NPROJ + col); } }
#pragma unroll
    for (int tt = 0; tt < 2; ++tt) { const size_t m = (size_t)MP + b * DECS + 2 * w4 + tt; g0[tt] = GATE[m * 16 + h]; g1[tt] = GATE[m * 16 + 8 + h]; }
    asm volatile("" ::: "memory");
    f32x4 S[16];
    { const float* sp = a.in[I_SGDN] + (((size_t)b * 8 + h) * 128 + dg * 16) * 128 + wcol;
#pragma unroll
      for (int i = 0; i < 16; ++i) S[i] = *(const f32x4*)(sp + (size_t)i * 128); }
    LDS_BARRIER();
#pragma unroll
    for (int typ = 0; typ < 3; ++typ) {
        asm volatile("" : "+v"(wj[typ][0].x), "+v"(wj[typ][0].y), "+v"(wj[typ][1].x), "+v"(wj[typ][1].y), "+v"(wj[typ][2].x), "+v"(wj[typ][2].y), "+v"(wj[typ][3].x), "+v"(wj[typ][3].y));
        asm volatile("" : "+v"(xs[typ][0].x), "+v"(xs[typ][0].y), "+v"(xs[typ][1].x), "+v"(xs[typ][1].y), "+v"(xs[typ][2].x), "+v"(xs[typ][2].y), "+v"(xs[typ][3].x), "+v"(xs[typ][3].y), "+v"(xs[typ][4].x), "+v"(xs[typ][4].y));
        asm volatile("" : "+v"(xp[typ][0]), "+v"(xp[typ][1]), "+v"(xp[typ][2]), "+v"(xp[typ][3]), "+v"(xp[typ][4])); }
    asm volatile("" : "+v"(g0[0]), "+v"(g0[1]), "+v"(g1[0]), "+v"(g1[1]));
#pragma unroll
    for (int tt = 0; tt < 2; ++tt) { const int c = 2 * w4 + tt;
#pragma unroll
        for (int typ = 0; typ < 3; ++typ) { float a0 = 0.f, a1 = 0.f;
#pragma unroll
            for (int j = 0; j < 4; ++j) { const bool st_ = (c + j) < 3; const unsigned w = xp[typ][tt + j]; const float x0 = st_ ? xs[typ][tt + j].x : __builtin_bit_cast(float, w << 16), x1 = st_ ? xs[typ][tt + j].y : __builtin_bit_cast(float, w & 0xffff0000u);
                a0 += wj[typ][j].x * x0; a1 += wj[typ][j].y * x1; }
            a0 = silu_f(a0); a1 = silu_f(a1);
            if (typ < 2) { const float rs = (1.0f / sqrtf(wave_sum(a0 * a0 + a1 * a1) + EPS)) * (typ == 0 ? 0.08838834764831845f : 1.0f); a0 *= rs; a1 *= rs; }
            LAS float* dst = (typ == 0 ? qs : typ == 1 ? ks : vs) + c * 128 + 2 * lane; dst[0] = a0; dst[1] = a1; }
        if (lane == 0) { gt[c] = g0[tt]; gt[8 + c] = g1[tt]; } }
    LDS_BARRIER();
#pragma unroll 1
    for (int c = 0; c < 8; ++c) {
        const float al = expf(gt[c]), be = gt[8 + c];
        float kk[16], qq[16];
#pragma unroll
        for (int i4 = 0; i4 < 4; ++i4) { const f32x4 k4 = *(const LAS f32x4*)(ks + c * 128 + dg * 16 + 4 * i4), q4 = *(const LAS f32x4*)(qs + c * 128 + dg * 16 + 4 * i4);
            kk[4 * i4] = k4[0]; kk[4 * i4 + 1] = k4[1]; kk[4 * i4 + 2] = k4[2]; kk[4 * i4 + 3] = k4[3]; qq[4 * i4] = q4[0]; qq[4 * i4 + 1] = q4[1]; qq[4 * i4 + 2] = q4[2]; qq[4 * i4 + 3] = q4[3]; }
        const f32x4 v4 = *(const LAS f32x4*)(vs + c * 128 + wcol);
        f32x4 r0 = {0.f, 0.f, 0.f, 0.f}, r1 = {0.f, 0.f, 0.f, 0.f};
#pragma unroll
        for (int i = 0; i < 16; i += 2) { r0 = r0 + S[i] * kk[i]; r1 = r1 + S[i + 1] * kk[i + 1]; }
        f32x4 rr = r0 + r1;
#pragma unroll
        for (int j = 0; j < 4; ++j) rr[j] = oct_sum(rr[j]);
        const f32x4 dl = (v4 - rr * al) * be;
        f32x4 o0 = {0.f, 0.f, 0.f, 0.f}, o1 = {0.f, 0.f, 0.f, 0.f};
#pragma unroll
        for (int i = 0; i < 16; i += 2) { S[i] = S[i] * al + dl * kk[i]; S[i + 1] = S[i + 1] * al + dl * kk[i + 1]; o0 = o0 + S[i] * qq[i]; o1 = o1 + S[i + 1] * qq[i + 1]; }
        f32x4 oo = o0 + o1;
#pragma unroll
        for (int j = 0; j < 4; ++j) oo[j] = oct_sum(oo[j]);
        if (dg == 0) *(f32x4*)(OA + (size_t)(MP + b * DECS + c) * 1024 + h * 128 + wcol) = oo;
    }
    { float* so = a.out + O_GDN_S + (((size_t)b * 8 + h) * 128 + dg * 16) * 128 + wcol;
#pragma unroll
      for (int i = 0; i < 16; ++i) *(f32x4*)(so + (size_t)i * 128) = S[i]; }
}
__device__ __forceinline__ void ret_sample_pair(const Args& a, LAS unsigned char* lds, int st, int lane, int wave) {
    unsigned char* ws = a.ws;
    const bf16* PROJ = (const bf16*)(ws + WS_BIG); const float* tab = (const float*)(ws + WS_TAB); float* OB = (float*)(ws + WS_OB);
    const int hb = wave >> 2, w4 = wave & 3, r_ = st - 1024, b = r_ >> 3, h = (r_ >> 1) & 3, half = r_ & 1;
    LAS unsigned char* L = lds + hb * 16384;
    LAS float* qs = (LAS float*)(L + SB_Q); LAS float* ks = (LAS float*)(L + SB_K); LAS float* vs = (LAS float*)(L + SB_V);
    const int dg = lane & 7, ec = lane >> 3, wcol = 32 * w4 + 4 * ec;
    const float gamma = 1.0f - exp2f(-5.0f - (float)h);
    float cs[2], sn[2]; unsigned rq[2][2], rk[2][2], vw[2];
#pragma unroll
    for (int tt = 0; tt < 2; ++tt) { const int c = 2 * w4 + tt; const unsigned short* pr = (const unsigned short*)(PROJ + (size_t)(MP + b * DECS + c) * NPROJ); const float* tp = tab + (size_t)(2048 + c) * 128;
        cs[tt] = tp[lane]; sn[tt] = tp[64 + lane];
        rq[tt][0] = pr[C_QB + h * 128 + lane]; rq[tt][1] = pr[C_QB + h * 128 + 64 + lane]; rk[tt][0] = pr[C_KB + h * 128 + lane]; rk[tt][1] = pr[C_KB + h * 128 + 64 + lane];
        vw[tt] = *(const unsigned*)(pr + C_VB + h * 256 + half * 128 + 2 * lane); }
    asm volatile("" ::: "memory");
    f32x4 S[16];
    { const float* sp = a.in[I_SRET] + (((size_t)b * 4 + h) * 128 + dg * 16) * 256 + half * 128 + wcol;
#pragma unroll
      for (int i = 0; i < 16; ++i) S[i] = *(const f32x4*)(sp + (size_t)i * 256); }
    LDS_BARRIER();
    asm volatile("" : "+v"(cs[0]), "+v"(sn[0]), "+v"(rq[0][0]), "+v"(rq[0][1]), "+v"(rk[0][0]), "+v"(rk[0][1]), "+v"(vw[0]), "+v"(cs[1]), "+v"(sn[1]), "+v"(rq[1][0]), "+v"(rq[1][1]), "+v"(rk[1][0]), "+v"(rk[1][1]), "+v"(vw[1]));
#pragma unroll
    for (int tt = 0; tt < 2; ++tt) { const int c = 2 * w4 + tt;
        const float ql = __builtin_bit_cast(float, rq[tt][0] << 16), qh = __builtin_bit_cast(float, rq[tt][1] << 16), kl = __builtin_bit_cast(float, rk[tt][0] << 16), kh = __builtin_bit_cast(float, rk[tt][1] << 16);
        qs[c * 128 + lane] = ql * cs[tt] - qh * sn[tt]; qs[c * 128 + 64 + lane] = ql * sn[tt] + qh * cs[tt];
        ks[c * 128 + lane] = (kl * cs[tt] - kh * sn[tt]) * 0.08838834764831845f; ks[c * 128 + 64 + lane] = (kl * sn[tt] + kh * cs[tt]) * 0.08838834764831845f;
        vs[c * 128 + 2 * lane] = __builtin_bit_cast(float, vw[tt] << 16); vs[c * 128 + 2 * lane + 1] = __builtin_bit_cast(float, vw[tt] & 0xffff0000u); }
    LDS_BARRIER();
#pragma unroll 1
    for (int c = 0; c < 8; ++c) {
        float kk[16], qq[16];
#pragma unroll
        for (int i4 = 0; i4 < 4; ++i4) { const f32x4 k4 = *(const LAS f32x4*)(ks + c * 128 + dg * 16 + 4 * i4), q4 = *(const LAS f32x4*)(qs + c * 128 + dg * 16 + 4 * i4);
            kk[4 * i4] = k4[0]; kk[4 * i4 + 1] = k4[1]; kk[4 * i4 + 2] = k4[2]; kk[4 * i4 + 3] = k4[3]; qq[4 * i4] = q4[0]; qq[4 * i4 + 1] = q4[1]; qq[4 * i4 + 2] = q4[2]; qq[4 * i4 + 3] = q4[3]; }
        const f32x4 v4 = *(const LAS f32x4*)(vs + c * 128 + wcol);
        f32x4 o0 = {0.f, 0.f, 0.f, 0.f}, o1 = {0.f, 0.f, 0.f, 0.f};
#pragma unroll
        for (int i = 0; i < 16; i += 2) { S[i] = S[i] * gamma + v4 * kk[i]; S[i + 1] = S[i + 1] * gamma + v4 * kk[i + 1]; o0 = o0 + S[i] * qq[i]; o1 = o1 + S[i + 1] * qq[i + 1]; }
        f32x4 oo = o0 + o1;
#pragma unroll
        for (int j = 0; j < 4; ++j) oo[j] = oct_sum(oo[j]);
        if (dg == 0) *(f32x4*)(OB + (size_t)(MP + b * DECS + c) * 1024 + h * 256 + half * 128 + wcol) = oo;
    }
    { float* so = a.out + O_RET_S + (((size_t)b * 4 + h) * 128 + dg * 16) * 256 + half * 128 + wcol;
#pragma unroll
      for (int i = 0; i < 16; ++i) *(f32x4*)(so + (size_t)i * 256) = S[i]; }
}
__device__ __forceinline__ void sample_pairs(const Args& a, LAS unsigned char* lds, int p0, int stride, int cnt, int lane, int wave) {
    const int hb = wave >> 2;
    __builtin_amdgcn_s_waitcnt(0);
#pragma unroll 1
    for (int k = 0; k < cnt; ++k) { const int pr = p0 + k * stride, st = 2 * pr + hb;
        if (pr < 512) gdn_sample_pair(a, lds, st, lane, wave); else ret_sample_pair(a, lds, st, lane, wave); }
}
__device__ __forceinline__ void ph_scans(const Args& a, LAS unsigned char* lds, int tid, int lane, int wave, int G, int mode = 3) {
    const int blk = blockIdx.x;
    if (mode & 1) { if (blk < 32) chunk_scan<true>(a, lds, blk, tid, lane, wave); else if (blk < 64) chunk_scan<false>(a, lds, blk - 32, tid, lane, wave); }
    if ((mode & 2) && blk >= 64) {
        const int bi = blk - 64;
        sample_pairs(a, lds, bi, 192, 5, lane, wave);
        if (bi < 128) { if ((wave >> 2) == 0) ret_sample_pair(a, lds, 1920 + bi, lane, wave); else { LDS_BARRIER(); LDS_BARRIER(); } } }
    if (mode == 3 && blk >= 64) convert_group(a, 1, (LAS float*)(lds + 32768 + wave * 8704), lane, (blk - 64) * NWAVES + wave, 192 * NWAVES);
}

__device__ __forceinline__ void ph_mix_norm(const Args& a, int lane, int gw, int NGW) {
    unsigned char* ws = a.ws;
    const bf16* PROJ = (const bf16*)(ws + WS_BIG); const float* OA = (const float*)(ws + WS_OA); const float* OB = (const float*)(ws + WS_OB); bf16* MIX = (bf16*)(ws + WS_G2);
    float wa[2][8], wb[2][8], bb[2][8];
#pragma unroll
    for (int i = 0; i < 2; ++i) { const int col = 8 * (lane + 64 * i); ld_f8(a.in[I_GNW] + (col & 127), wa[i]); ld_f8(a.in[I_RGW] + col, wb[i]); ld_f8(a.in[I_RGB] + col, bb[i]); }
    f32x4 noa[2][2], nob[2][2]; u32x4 nzz[2], ngg[2];
#define MIXN_LOAD(mm) do { _Pragma("unroll") for (int i = 0; i < 2; ++i) { const int col = 8 * (lane + 64 * i); \
            noa[i][0] = *(const f32x4*)(OA + (size_t)(mm) * 1024 + col); noa[i][1] = *(const f32x4*)(OA + (size_t)(mm) * 1024 + col + 4); \
            nob[i][0] = *(const f32x4*)(OB + (size_t)(mm) * 1024 + col); nob[i][1] = *(const f32x4*)(OB + (size_t)(mm) * 1024 + col + 4); \
            nzz[i] = *(const u32x4*)(PROJ + (size_t)(mm) * NPROJ + C_ZA + col); ngg[i] = *(const u32x4*)(PROJ + (size_t)(mm) * NPROJ + C_GB + col); } } while (0)
    MIXN_LOAD(gw);
    for (int m = gw; m < MTOT; m += NGW) {
        f32x4 oa[2][2], ob[2][2]; u32x4 zz[2], gg[2];
#pragma unroll
        for (int i = 0; i < 2; ++i) { oa[i][0] = noa[i][0]; oa[i][1] = noa[i][1]; ob[i][0] = nob[i][0]; ob[i][1] = nob[i][1]; zz[i] = nzz[i]; gg[i] = ngg[i]; }
        { const int mn = (m + NGW < MTOT) ? m + NGW : m; MIXN_LOAD(mn); }
#pragma unroll
        for (int i = 0; i < 2; ++i) {
            const int col = 8 * (lane + 64 * i);
            float o[8] = {oa[i][0][0], oa[i][0][1], oa[i][0][2], oa[i][0][3], oa[i][1][0], oa[i][1][1], oa[i][1][2], oa[i][1][3]}, z[8]; unpack8(zz[i], z);
            float ss = 0.f;
#pragma unroll
            for (int e = 0; e < 8; ++e) ss += o[e] * o[e];
            ss += __shfl_xor(ss, 1); ss += __shfl_xor(ss, 2); ss += __shfl_xor(ss, 4); ss += __shfl_xor(ss, 8);
            const float rs = 1.0f / sqrtf(ss * (1.0f / 128.0f) + EPS);
#pragma unroll
            for (int e = 0; e < 8; ++e) o[e] = o[e] * rs * wa[i][e] * silu_f(z[e]);
            st_bf8(MIX + (size_t)m * 2048 + col, o);
        }
#pragma unroll
        for (int i = 0; i < 2; ++i) {
            const int col = 8 * (lane + 64 * i);
            float o[8] = {ob[i][0][0], ob[i][0][1], ob[i][0][2], ob[i][0][3], ob[i][1][0], ob[i][1][1], ob[i][1][2], ob[i][1][3]}, g[8]; unpack8(gg[i], g);
            float s_ = 0.f;
#pragma unroll
            for (int e = 0; e < 8; ++e) s_ += o[e];
            s_ += __shfl_xor(s_, 1); s_ += __shfl_xor(s_, 2); s_ += __shfl_xor(s_, 4); s_ += __shfl_xor(s_, 8); s_ += __shfl_xor(s_, 16);
            const float mu = s_ * (1.0f / 256.0f); float q = 0.f;
#pragma unroll
            for (int e = 0; e < 8; ++e) { o[e] -= mu; q += o[e] * o[e]; }
            q += __shfl_xor(q, 1); q += __shfl_xor(q, 2); q += __shfl_xor(q, 4); q += __shfl_xor(q, 8); q += __shfl_xor(q, 16);
            const float rs = 1.0f / sqrtf(q * (1.0f / 256.0f) + EPS);
#pragma unroll
            for (int e = 0; e < 8; ++e) o[e] = (o[e] * rs * wb[i][e] + bb[i][e]) * silu_f(g[e]);
            st_bf8(MIX + (size_t)m * 2048 + 1024 + col, o);
        }
    }
}

#undef MIXN_LOAD
__device__ __forceinline__ void ffn_conv_prompt(const Args& a, int layer, int lane, int gw, int NGW) {
    unsigned char* ws = a.ws;
    const bf16* UP = (const bf16*)(ws + WS_BIG); bf16* ACT = (bf16*)(ws + WS_ACT);
    const float* cw = a.in[I_FCW] + (size_t)layer * 3 * NUP; const float* cb = a.in[I_FCBIAS] + (size_t)layer * NUP;
    for (int task = gw; task < 128 * 11; task += NGW) {
        const int run = task / 11, cblk = task % 11, m0 = run * 64, t0 = m0 % SEQ;
        const int j0 = 8 * (lane + 64 * cblk), ucol = ((j0 >> 7) << 8) + (j0 & 127);
        float wv[3][8], wg[3][8], bv_[8], bg_[8]; ld_f8(cb + j0, bv_); ld_f8(cb + DFF + j0, bg_);
#pragma unroll
        for (int jj = 0; jj < 3; ++jj) { ld_f8(cw + (size_t)jj * NUP + j0, wv[jj]); ld_f8(cw + (size_t)jj * NUP + DFF + j0, wg[jj]); }
        float p2v[8], p2g[8], p1v[8], p1g[8];
        if (t0 == 0) {
#pragma unroll
            for (int e = 0; e < 8; ++e) { p2v[e] = 0.f; p2g[e] = 0.f; p1v[e] = 0.f; p1g[e] = 0.f; }
        } else { const bf16* r2 = UP + (size_t)(m0 - 2) * NUP + ucol; ld_bf8(r2, p2v); ld_bf8(r2 + 128, p2g); ld_bf8(r2 + NUP, p1v); ld_bf8(r2 + NUP + 128, p1g); }
        const bf16* rp = UP + (size_t)m0 * NUP + ucol; bf16* op = ACT + (size_t)m0 * DFF + j0;
#pragma unroll 1
        for (int i8 = 0; i8 < 8; ++i8) {
            u32x4 lv[8], lg[8];
#pragma unroll
            for (int k = 0; k < 8; ++k) { lv[k] = *(const u32x4*)(rp + (size_t)k * NUP); lg[k] = *(const u32x4*)(rp + (size_t)k * NUP + 128); }
#pragma unroll
            for (int k = 0; k < 8; ++k) { float xv[8], xg[8], o[8]; unpack8(lv[k], xv); unpack8(lg[k], xg);
#pragma unroll
                for (int e = 0; e < 8; ++e) { const float va = bv_[e] + wv[0][e] * p2v[e] + wv[1][e] * p1v[e] + wv[2][e] * xv[e], ga = bg_[e] + wg[0][e] * p2g[e] + wg[1][e] * p1g[e] + wg[2][e] * xg[e];
                    o[e] = silu_f(ga) * va; p2v[e] = p1v[e]; p2g[e] = p1g[e]; p1v[e] = xv[e]; p1g[e] = xg[e]; }
                st_bf8(op + (size_t)k * DFF, o); }
            rp += (size_t)8 * NUP; op += (size_t)8 * DFF;
        }
    }
}
__device__ __forceinline__ void ffn_conv_sample(const Args& a, int layer, int lane, int gw, int NGW, int i_lo = 0, int i_hi = 11, bool states = true) {
    unsigned char* ws = a.ws;
    const bf16* UP = (const bf16*)(ws + WS_BIG); bf16* ACT = (bf16*)(ws + WS_ACT);
    const float* cw = a.in[I_FCW] + (size_t)layer * 3 * NUP; const float* cb = a.in[I_FCBIAS] + (size_t)layer * NUP; const float* cst = a.in[I_SFCB] + (size_t)layer * DECB * 2 * NUP;
    const int ni = i_hi - i_lo;
    for (int task = gw; task < MS * ni; task += NGW) {
        const int m = MP + task / ni, i = i_lo + task % ni;
        const int b = (m - MP) / DECS, t = (m - MP) % DECS;
        {
            const int j0 = 8 * (lane + 64 * i), ucol = ((j0 >> 7) << 8) + (j0 & 127);
            float va[8], ga[8]; ld_f8(cb + j0, va); ld_f8(cb + DFF + j0, ga);
#pragma unroll
            for (int jj = 0; jj < 3; ++jj) { float xv[8], xg[8], sv[8], sg[8], wv[8], wg[8]; const int tt = t + jj; const bool from_state = tt < 2;
                const bf16* r = UP + (size_t)(MP + b * DECS + (tt >= 2 ? tt - 2 : 0)) * NUP + ucol; ld_bf8(r, xv); ld_bf8(r + 128, xg);
                const float* rs_ = cst + ((size_t)b * 2 + (tt < 2 ? tt : 1)) * NUP + j0; ld_f8(rs_, sv); ld_f8(rs_ + DFF, sg);
                ld_f8(cw + (size_t)jj * NUP + j0, wv); ld_f8(cw + (size_t)jj * NUP + DFF + j0, wg);
#pragma unroll
                for (int e = 0; e < 8; ++e) { va[e] += wv[e] * (from_state ? sv[e] : xv[e]); ga[e] += wg[e] * (from_state ? sg[e] : xg[e]); } }
            float o[8];
#pragma unroll
            for (int e = 0; e < 8; ++e) o[e] = silu_f(ga[e]) * va[e];
            st_bf8(ACT + (size_t)m * DFF + j0, o);
        }
    }
    if (!states) return;
    constexpr int NCH = (4 + DECB) * 2 * (NUP / 8);
    float xx[3][8]; int chs[3];
#pragma unroll
    for (int u = 0; u < 3; ++u) { const int ch = gw * 64 + lane + u * NGW * 64; chs[u] = ch; const int cc = ch < NCH ? ch : 0;
        const int c = 8 * (cc % (NUP / 8)), rr = cc / (NUP / 8), r = rr & 1, sb = rr >> 1;
        const int j = c < DFF ? c : c - DFF, ucol = ((j >> 7) << 8) + (j & 127) + (c < DFF ? 0 : 128);
        const size_t row = sb < 4 ? (size_t)(sb * SEQ + SEQ - 2 + r) : (size_t)(MP + (sb - 4) * DECS + DECS - 2 + r);
        ld_bf8(UP + row * NUP + ucol, xx[u]); }
#pragma unroll
    for (int u = 0; u < 3; ++u) { const int ch = chs[u]; if (ch < NCH) {
        const int c = 8 * (ch % (NUP / 8)), rr = ch / (NUP / 8), r = rr & 1, sb = rr >> 1;
        float* dst = sb < 4 ? a.out + O_FCB_P + ((size_t)(layer * 4 + sb) * 2 + r) * NUP + c : a.out + O_FCB_S + ((size_t)(layer * DECB + (sb - 4)) * 2 + r) * NUP + c;
        *(f32x4*)dst = (f32x4){xx[u][0], xx[u][1], xx[u][2], xx[u][3]}; *(f32x4*)(dst + 4) = (f32x4){xx[u][4], xx[u][5], xx[u][6], xx[u][7]}; } }
    static_assert(NCH <= 3 * 256 * NWAVES * 64, "three chunks per lane cover the conv states");
}

__device__ __forceinline__ void s5_task(const Args& a, bool prompt, int b, int g, int lane) {
    unsigned char* ws = a.ws;
    const bf16* H = (const bf16*)(ws + WS_H); bf16* G2 = (bf16*)(ws + WS_G2);
    const int p = lane, gp = g * 64 + p;
    const double lr = (double)a.in[I_LRE][gp], li = (double)a.in[I_LIM][gp], dt = exp((double)a.in[I_LDT][g]);
    const double mag = exp(lr * dt); double sn, cs; sincos_d(li * dt, sn, cs);
    const double abr = mag * cs, abi = mag * sn, den = lr * lr + li * li;
    const double cfr = ((abr - 1.0) * lr + abi * li) / den, cfi = (abi * lr - (abr - 1.0) * li) / den;
    float bbr[16], bbi[16], cr[16], ci[16];
#pragma unroll
    for (int c = 0; c < 16; ++c) { const double br = (double)a.in[I_BRE][(size_t)gp * 16 + c], bi = (double)a.in[I_BIM][(size_t)gp * 16 + c]; bbr[c] = (float)(cfr * br - cfi * bi); bbi[c] = (float)(cfr * bi + cfi * br);
        cr[c] = a.in[I_CRE][((size_t)g * 16 + c) * 64 + p]; ci[c] = a.in[I_CIM][((size_t)g * 16 + c) * 64 + p]; }
    const float ar = (float)abr, ai = (float)abi;
    float xr = 0.f, xi = 0.f;
    if (!prompt) { xr = a.in[I_S5RE][((size_t)b * 128 + g) * 64 + p]; xi = a.in[I_S5IM][((size_t)b * 128 + g) * 64 + p]; }
    const bool b5 = lane & 32, b4 = lane & 16, b3 = lane & 8, b2 = lane & 4;
    const int cme = (b5 ? 8 : 0) + (b4 ? 4 : 0) + (b3 ? 2 : 0) + (b2 ? 1 : 0);
    const float dme = a.in[I_S5D][g * 16 + cme];
    const int L = prompt ? SEQ : DECS, row0 = prompt ? b * SEQ : MP + b * DECS;
    const bf16* hp = H + (size_t)row0 * DM + g * 16;
    u32x4 nu0 = *(const u32x4*)hp, nu1 = *(const u32x4*)(hp + 8); unsigned short nume = hp[cme];
    for (int t = 0; t < L; ++t) {
        float u[16]; { float ua[8], ub[8]; unpack8(nu0, ua); unpack8(nu1, ub);
#pragma unroll
            for (int c = 0; c < 8; ++c) { u[c] = ua[c]; u[8 + c] = ub[c]; } }
        const float ume = bf2f(nume);
        if (t + 1 < L) { hp += DM; nu0 = *(const u32x4*)hp; nu1 = *(const u32x4*)(hp + 8); nume = hp[cme]; }
        float bur = 0.f, bui = 0.f;
#pragma unroll
        for (int c = 0; c < 16; ++c) { bur += bbr[c] * u[c]; bui += bbi[c] * u[c]; }
        const float nxr = ar * xr - ai * xi + bur, nxi = ar * xi + ai * xr + bui; xr = nxr; xi = nxi;
        float vals[16];
#pragma unroll
        for (int c = 0; c < 16; ++c) vals[c] = cr[c] * xr - ci[c] * xi;
        float k8[8], k4[4], k2[2], y;
#pragma unroll
        for (int i = 0; i < 8; ++i) { const float send = b5 ? vals[i] : vals[8 + i], keep = b5 ? vals[8 + i] : vals[i]; k8[i] = keep + __shfl_xor(send, 32); }
#pragma unroll
        for (int i = 0; i < 4; ++i) { const float send = b4 ? k8[i] : k8[4 + i], keep = b4 ? k8[4 + i] : k8[i]; k4[i] = keep + __shfl_xor(send, 16); }
#pragma unroll
        for (int i = 0; i < 2; ++i) { const float send = b3 ? k4[i] : k4[2 + i], keep = b3 ? k4[2 + i] : k4[i]; k2[i] = keep + __shfl_xor(send, 8); }
        { const float send = b2 ? k2[0] : k2[1], keep = b2 ? k2[1] : k2[0]; y = keep + __shfl_xor(send, 4); }
        y += __shfl_xor(y, 2); y += __shfl_xor(y, 1);
        y = gelu_tanh(y + dme * ume);
        if ((lane & 3) == 0) G2[(size_t)(row0 + t) * DM + g * 16 + cme] = (bf16)f2bf(y);
    }
    const size_t so = ((size_t)b * 128 + g) * 64 + p;
    a.out[(prompt ? O_S5R_P : O_S5R_S) + so] = xr; a.out[(prompt ? O_S5I_P : O_S5I_S) + so] = xi;
}
__device__ __forceinline__ bf16x8 pack8(const float (&v)[8]) { u32x4 w; w.x = cvtpk(v[0], v[1]); w.y = cvtpk(v[2], v[3]); w.z = cvtpk(v[4], v[5]); w.w = cvtpk(v[6], v[7]); return __builtin_bit_cast(bf16x8, w); }
__device__ __forceinline__ float bfround(float x) { return __builtin_bit_cast(float, f2bf(x) << 16); }
constexpr int S5_PITCH = 132, S5_WAVE_LDS = 16 * S5_PITCH * 4;
constexpr int S5_SEG = 128, S5_NSEG = SEQ / S5_SEG;
constexpr size_t WS_S5E = WS_ACT;
struct S5C {
    bf16x8 Bf[8];
    bf16x8 Ch[4], Cl[4], Df;
    float nwa[8];
    float ar, ai;
};
__device__ __forceinline__ void s5_first(const bf16* H, const float* SS, int g, int row0, int lane, u32x4& An, float& sn_) {
    const int r = lane & 15, q = lane >> 4, rlast = MTOT - 1 - row0, rr = r < rlast ? r : rlast;
    An = *(const u32x4*)(H + (size_t)(row0 + rr) * DM + g * 16 + 8 * (q & 1)); sn_ = SS[row0 + rr];
}
template <bool FULL>
__device__ __forceinline__ void s5_run(const S5C& C, const bf16* H, const float* SS, bf16* G2, LAS float* T, int g, int row0, int L, float& xr, float& xi, int lane, u32x4 An, float sn_) {
    const int r = lane & 15, q = lane >> 4;
    const bf16* hp = H + (size_t)row0 * DM + g * 16 + 8 * (q & 1);
    for (int t0 = 0; t0 < L; t0 += 16) {
        bf16x8 A; { float xa[8]; unpack8(An, xa); const float rs = 1.0f / sqrtf(sn_ * (1.0f / DM) + EPS);
#pragma unroll
            for (int j = 0; j < 8; ++j) xa[j] = xa[j] * rs * C.nwa[j];
            A = pack8(xa); }
        if (t0 + 16 < L) { An = *(const u32x4*)(hp + (size_t)(t0 + 16 + r) * DM); sn_ = SS[row0 + t0 + 16 + r]; }
#pragma unroll
        for (int nt = 0; nt < 8; ++nt) { const f32x4 d = MFMA16(A, C.Bf[nt], ((f32x4){0.f, 0.f, 0.f, 0.f}));
#pragma unroll
            for (int reg = 0; reg < 4; ++reg) T[(4 * q + reg) * S5_PITCH + 16 * nt + r] = d[reg]; }
        float bur[16], bui[16];
#pragma unroll
        for (int t = 0; t < 16; ++t) { bur[t] = T[t * S5_PITCH + lane]; bui[t] = T[t * S5_PITCH + 64 + lane]; }
#pragma unroll
        for (int t = 0; t < 16; ++t) { if (t0 + t < L) { const float nr = C.ar * xr - C.ai * xi + bur[t], ni = C.ar * xi + C.ai * xr + bui[t]; xr = nr; xi = ni; } bur[t] = xr; bui[t] = xi; }
        if (FULL) {
#pragma unroll
            for (int t = 0; t < 16; ++t) { T[t * S5_PITCH + lane] = bur[t]; T[t * S5_PITCH + 64 + lane] = bui[t]; }
            f32x4 y = MFMA16(A, C.Df, ((f32x4){0.f, 0.f, 0.f, 0.f}));
#pragma unroll
            for (int s = 0; s < 4; ++s) { const f32x4 x0 = *(const LAS f32x4*)(T + r * S5_PITCH + 32 * s + 8 * q), x1 = *(const LAS f32x4*)(T + r * S5_PITCH + 32 * s + 8 * q + 4);
                u32x4 wh; wh[0] = cvtpk(x0[0], x0[1]); wh[1] = cvtpk(x0[2], x0[3]); wh[2] = cvtpk(x1[0], x1[1]); wh[3] = cvtpk(x1[2], x1[3]);
                const bf16x8 xh = __builtin_bit_cast(bf16x8, wh);
                y = MFMA16(xh, C.Ch[s], y); y = MFMA16(xh, C.Cl[s], y); }
#pragma unroll
            for (int reg = 0; reg < 4; ++reg) { const int t = t0 + 4 * q + reg; if (t < L) G2[(size_t)(row0 + t) * DM + g * 16 + r] = (bf16)f2bf(gelu_tanh(y[reg])); }
        }
    }
}
__device__ __forceinline__ void s5_wave(const Args& a, LAS float* T, bool second, int g, int sub, int lane) {
    unsigned char* ws = a.ws;
    const bf16* H = (const bf16*)(ws + WS_H); bf16* G2 = (bf16*)(ws + WS_G2); const float* SS = (const float*)(ws + WS_SS) + MTOT;
    float* E = (float*)(ws + WS_S5E);
    const int r = lane & 15, q = lane >> 4;
    S5C C;
    float cfrf, cfif, a128r, a128i;
    {   const int gp = g * 64 + lane;
        const double lr = (double)a.in[I_LRE][gp], li = (double)a.in[I_LIM][gp], dt = exp((double)a.in[I_LDT][g]);
        const double mag = exp(lr * dt); double sn, cs; sincos_d(li * dt, sn, cs);
        const double abr = mag * cs, abi = mag * sn, den = lr * lr + li * li;
        C.ar = (float)abr; C.ai = (float)abi; cfrf = (float)(((abr - 1.0) * lr + abi * li) / den); cfif = (float)((abi * lr - (abr - 1.0) * li) / den);
        const double m128 = exp(lr * dt * (double)S5_SEG); sincos_d(li * dt * (double)S5_SEG, sn, cs); a128r = (float)(m128 * cs); a128i = (float)(m128 * sn); }
    ld_f8(a.in[I_NMIX] + DM + g * 16 + 8 * (q & 1), C.nwa);
#pragma unroll
    for (int nt = 0; nt < 8; ++nt) { const int p = (16 * nt + r) & 63; const float cr_ = __shfl(cfrf, p), ci_ = __shfl(cfif, p);
        float br[8], bi[8], v[8]; ld_f8(a.in[I_BRE] + ((size_t)g * 64 + p) * 16 + 8 * (q & 1), br); ld_f8(a.in[I_BIM] + ((size_t)g * 64 + p) * 16 + 8 * (q & 1), bi);
#pragma unroll
        for (int j = 0; j < 8; ++j) { const float val = (nt < 4) ? (cr_ * br[j] - ci_ * bi[j]) : (cr_ * bi[j] + ci_ * br[j]); const float hi = bfround(val); v[j] = (q < 2) ? hi : (val - hi); }
        C.Bf[nt] = pack8(v); }
#pragma unroll
    for (int s = 0; s < 4; ++s) { float cv[8], hi[8], lo[8]; ld_f8((s < 2 ? a.in[I_CRE] : a.in[I_CIM]) + ((size_t)g * 16 + r) * 64 + 32 * (s & 1) + 8 * q, cv);
#pragma unroll
        for (int j = 0; j < 8; ++j) { const float val = (s < 2) ? cv[j] : -cv[j]; hi[j] = bfround(val); lo[j] = val - hi[j]; }
        C.Ch[s] = pack8(hi); C.Cl[s] = pack8(lo); }
    {   const float dv = a.in[I_S5D][g * 16 + r], dh = bfround(dv), dl = dv - dh; float v[8];
#pragma unroll
        for (int j = 0; j < 8; ++j) v[j] = ((r & 7) == j && (r >> 3) == (q & 1)) ? (q < 2 ? dh : dl) : 0.f;
        C.Df = pack8(v); }
    const int NT = second ? 4 : 12;
    u32x4 Ap; float sp_, xpr = 0.f, xpi = 0.f;
    s5_first(H, SS, g, sub * S5_SEG, lane, Ap, sp_);
#pragma unroll 1
    for (int ti = 0; ti < NT; ++ti) {
        const u32x4 Ac = Ap; const float sc_ = sp_, xcr = xpr, xci = xpi;
        if (ti + 1 < NT) { const int tn = ti + 1;
            if (tn < 4) s5_first(H, SS, g, tn * SEQ + sub * S5_SEG, lane, Ap, sp_);
            else { const int bn = sub * 8 + (tn - 4); s5_first(H, SS, g, MP + bn * DECS, lane, Ap, sp_); const size_t so = ((size_t)bn * 128 + g) * 64 + lane; xpr = a.in[I_S5RE][so]; xpi = a.in[I_S5IM][so]; } }
        if (ti < 4) { const int b = ti, row0 = b * SEQ + sub * S5_SEG; float* Eb = E + (((size_t)b * 128 + g) * S5_NSEG) * 128;
            if (!second) { float xr = 0.f, xi = 0.f; s5_run<false>(C, H, SS, G2, T, g, row0, S5_SEG, xr, xi, lane, Ac, sc_); Eb[sub * 128 + lane] = xr; Eb[sub * 128 + 64 + lane] = xi; }
            else { float er[15], ei[15];
#pragma unroll
                for (int m = 0; m < 15; ++m) { const int mm = m < sub ? m : 0; er[m] = Eb[mm * 128 + lane]; ei[m] = Eb[mm * 128 + 64 + lane]; }
                float xr = 0.f, xi = 0.f;
#pragma unroll
                for (int m = 0; m < 15; ++m) if (m < sub) { const float nr = a128r * xr - a128i * xi + er[m], ni = a128r * xi + a128i * xr + ei[m]; xr = nr; xi = ni; }
                s5_run<true>(C, H, SS, G2, T, g, row0, S5_SEG, xr, xi, lane, Ac, sc_);
                if (sub == S5_NSEG - 1) { const size_t so = ((size_t)b * 128 + g) * 64 + lane; a.out[O_S5R_P + so] = xr; a.out[O_S5I_P + so] = xi; } }
        } else { const int b = sub * 8 + (ti - 4); const size_t so = ((size_t)b * 128 + g) * 64 + lane;
            float xr = xcr, xi = xci;
            s5_run<true>(C, H, SS, G2, T, g, MP + b * DECS, DECS, xr, xi, lane, Ac, sc_);
            a.out[O_S5R_S + so] = xr; a.out[O_S5I_S + so] = xi; }
    }
}
__device__ __forceinline__ void ph_s5(const Args& a, LAS unsigned char* lds, bool second, int lane, int wave, int gw, int NGW) {
    LAS float* T = (LAS float*)(lds + wave * S5_WAVE_LDS);
    for (int w = gw; w < 2048; w += NGW) s5_wave(a, T, second, w >> 4, w & 15, lane);
}

constexpr int S5MM_REP = 0;
constexpr int SM_WC = 0, SM_WST = 65536, SM_KT = 131072, SM_POW = 139264, SM_CF = 147968;
constexpr size_t WS_S5L = WS_ACT, WS_S5X = WS_ACT + 48 * MiB, WS_UG = WS_BIG + 64 * MiB;
typedef float f32x2_t __attribute__((ext_vector_type(2)));
__device__ __forceinline__ int s5_row(int hb, int col, int t) {
    return col < 256 ? (2 * hb + (col >> 7)) * SEQ + 16 * (col & 127) + t : MP + (64 * hb + (col - 256)) * DECS + t;
}
__device__ __forceinline__ void s5_load_u(const Args& a, int g, int hb, int cb, int lane, bf16x8 (&Uf)[8]) {
    const bf16* UG = (const bf16*)(a.ws + WS_UG0);
    const int r = lane & 15, q = lane >> 4, col = 16 * cb + r; const bool samp = col >= 256;
    const bf16* up = UG + ((size_t)g * MTOT + s5_row(hb, col, 0)) * 16 + 16 * (q >> 1) + 8 * (q & 1);
#pragma unroll
    for (int ks = 0; ks < 8; ++ks) { Uf[ks] = *(const bf16x8*)(up + ((samp && ks >= 4) ? 0 : 32 * ks)); if (samp && ks >= 4) Uf[ks] = (bf16x8){0, 0, 0, 0, 0, 0, 0, 0}; }
}
__device__ __forceinline__ void ph_s5_mm(const Args& a, LAS unsigned char* lds, int task, int tid, int lane, int wave) {
    unsigned char* ws = a.ws;
    const int g = task >> 1, hb = task & 1, r = lane & 15, q = lane >> 4;
    LAS f32x2_t* POW = (LAS f32x2_t*)(lds + SM_POW); LAS f32x2_t* CF = (LAS f32x2_t*)(lds + SM_CF);
    float* LB = (float*)(ws + WS_S5L) + (size_t)task * 320 * 128; float* XB = (float*)(ws + WS_S5X) + (size_t)task * 320 * 128;
    bf16* G2 = (bf16*)(ws + WS_G2);
    for (int rep_t = 0; rep_t < (S5MM_REP == 1 ? 2 : 1); ++rep_t) {
    __syncthreads();
    if (tid < 64) { const int gp = g * 64 + tid;
        const double lr = (double)a.in[I_LRE][gp], li = (double)a.in[I_LIM][gp], dt = exp((double)a.in[I_LDT][g]);
        const double mag = exp(lr * dt); double sn, cs; sincos_d(li * dt, sn, cs);
        const double abr = mag * cs, abi = mag * sn, den = lr * lr + li * li;
        CF[tid] = (f32x2_t){(float)(((abr - 1.0) * lr + abi * li) / den), (float)((abi * lr - (abr - 1.0) * li) / den)};
        double pr = 1.0, pi = 0.0;
#pragma unroll 1
        for (int e = 0; e <= 16; ++e) { POW[tid * 17 + e] = (f32x2_t){(float)pr, (float)pi}; const double nr = pr * abr - pi * abi, ni = pr * abi + pi * abr; pr = nr; pi = ni; } }
    __syncthreads();
    {
        const int kp = tid & 127, p = kp & 63, part = kp >> 6, s0 = 4 * (tid >> 7);
        const f32x2_t cf = CF[p]; float bbr[16], bbi[16];
#pragma unroll
        for (int c4 = 0; c4 < 4; ++c4) { const f32x4 br = *(const f32x4*)(a.in[I_BRE] + ((size_t)g * 64 + p) * 16 + 4 * c4), bi = *(const f32x4*)(a.in[I_BIM] + ((size_t)g * 64 + p) * 16 + 4 * c4);
#pragma unroll
            for (int j = 0; j < 4; ++j) { bbr[4 * c4 + j] = cf.x * br[j] - cf.y * bi[j]; bbi[4 * c4 + j] = cf.x * bi[j] + cf.y * br[j]; } }
#pragma unroll
        for (int si = 0; si < 4; ++si) { const int s = s0 + si; const f32x2_t pw = POW[p * 17 + 15 - s]; float v[16];
#pragma unroll
            for (int c = 0; c < 16; ++c) v[c] = part ? (pw.x * bbi[c] + pw.y * bbr[c]) : (pw.x * bbr[c] - pw.y * bbi[c]);
            u32x4 w0, w1; w0.x = pk2(v[0], v[1]); w0.y = pk2(v[2], v[3]); w0.z = pk2(v[4], v[5]); w0.w = pk2(v[6], v[7]); w1.x = pk2(v[8], v[9]); w1.y = pk2(v[10], v[11]); w1.z = pk2(v[12], v[13]); w1.w = pk2(v[14], v[15]);
            *(LAS u32x4*)(lds + SM_WST + kp * 512 + (((2 * s) ^ (kp & 15)) << 4)) = w0; *(LAS u32x4*)(lds + SM_WST + kp * 512 + (((2 * s + 1) ^ (kp & 15)) << 4)) = w1; }
    }
    {
        const int R = tid & 255, t = R >> 4, c = R & 15, half = tid >> 8;
#pragma unroll 4
        for (int i = 0; i < 8; ++i) { float v[8]; const f32x4 cr0 = *(const f32x4*)(a.in[I_CRE] + ((size_t)g * 16 + c) * 64 + 8 * i), cr1 = *(const f32x4*)(a.in[I_CRE] + ((size_t)g * 16 + c) * 64 + 8 * i + 4),
                                                         ci0 = *(const f32x4*)(a.in[I_CIM] + ((size_t)g * 16 + c) * 64 + 8 * i), ci1 = *(const f32x4*)(a.in[I_CIM] + ((size_t)g * 16 + c) * 64 + 8 * i + 4);
#pragma unroll
            for (int j = 0; j < 8; ++j) { const float cr = j < 4 ? cr0[j] : cr1[j - 4], ci = j < 4 ? ci0[j] : ci1[j - 4]; const f32x2_t pw = POW[(8 * i + j) * 17 + t + 1];
                v[j] = half ? -(cr * pw.y + ci * pw.x) : (cr * pw.x - ci * pw.y); }
            u32x4 w; w.x = pk2(v[0], v[1]); w.y = pk2(v[2], v[3]); w.z = pk2(v[4], v[5]); w.w = pk2(v[6], v[7]);
            *(LAS u32x4*)(lds + SM_WC + addr256(R, 8 * half + i)) = w; }
    }
    __syncthreads();
    {
        bf16x8 Bs[4];
        {   float re8[2][8], im8[2][8];
#pragma unroll
            for (int ks = 0; ks < 2; ++ks)
#pragma unroll
                for (int j = 0; j < 8; ++j) { const int p = 32 * ks + 8 * q + j; const float br = a.in[I_BRE][((size_t)g * 64 + p) * 16 + r], bi = a.in[I_BIM][((size_t)g * 64 + p) * 16 + r]; const f32x2_t cf = CF[p];
                    re8[ks][j] = cf.x * br - cf.y * bi; im8[ks][j] = cf.x * bi + cf.y * br; }
            Bs[0] = pack8(re8[0]); Bs[1] = pack8(re8[1]); Bs[2] = pack8(im8[0]); Bs[3] = pack8(im8[1]); }
#pragma unroll
        for (int di = 0; di < 2; ++di) { const int d = 2 * wave + di; f32x4 acc = {0.f, 0.f, 0.f, 0.f};
            if (d == 0) {
#pragma unroll
                for (int ks = 0; ks < 4; ++ks) { float cv[8]; ld_f8((ks < 2 ? a.in[I_CRE] : a.in[I_CIM]) + ((size_t)g * 16 + r) * 64 + 32 * (ks & 1) + 8 * q, cv);
                    if (ks >= 2) {
#pragma unroll
                        for (int j = 0; j < 8; ++j) cv[j] = -cv[j]; }
                    acc = MFMA16(pack8(cv), Bs[ks], acc); }
#pragma unroll
                for (int reg = 0; reg < 4; ++reg) if (4 * q + reg == r) acc[reg] += a.in[I_S5D][g * 16 + r];
            } else {
#pragma unroll
                for (int ks = 0; ks < 4; ++ks) acc = MFMA16(*(const LAS bf16x8*)(lds + SM_WC + addr256(16 * (d - 1) + r, 4 * ks + q)), Bs[ks], acc); }
#pragma unroll
            for (int reg = 0; reg < 4; ++reg) *(LAS bf16*)(lds + SM_KT + ((d * 16 + 4 * q + reg) * 16 + r) * 2) = (bf16)f2bf(acc[reg]); }
    }
    __syncthreads();
    }
    for (int rep_1 = 0; rep_1 < (S5MM_REP == 2 ? 2 : 1); ++rep_1) {
    for (int cb = wave; cb < 20; cb += NWAVES) {
        bf16x8 Uf[8]; s5_load_u(a, g, hb, cb, lane, Uf);
        bf16x8 Fa[8], Fb[8];
#define LDW(F, mt_) do { _Pragma("unroll") for (int ks = 0; ks < 8; ++ks) { const int row = 16 * (mt_) + r; F[ks] = *(const LAS bf16x8*)(lds + SM_WST + row * 512 + (((4 * ks + q) ^ (row & 15)) << 4)); } } while (0)
#define MMW(F, mt_) do { f32x4 acc = {0.f, 0.f, 0.f, 0.f}; _Pragma("unroll") for (int ks = 0; ks < 8; ++ks) acc = MFMA16(F[ks], Uf[ks], acc); *(f32x4*)(LB + (size_t)(16 * cb + r) * 128 + 16 * (mt_) + 4 * q) = acc; } while (0)
        LDW(Fa, 0);
#pragma unroll
        for (int m2 = 0; m2 < 4; ++m2) { LDW(Fb, 2 * m2 + 1); __builtin_amdgcn_sched_barrier(0); MMW(Fa, 2 * m2); __builtin_amdgcn_sched_barrier(0);
            if (m2 < 3) LDW(Fa, 2 * m2 + 2); __builtin_amdgcn_sched_barrier(0); MMW(Fb, 2 * m2 + 1); __builtin_amdgcn_sched_barrier(0); }
#undef LDW
#undef MMW
    }
    __syncthreads();
    }
    for (int rep_2 = 0; rep_2 < (S5MM_REP == 3 ? 2 : 1); ++rep_2) {
    __builtin_amdgcn_s_waitcnt(0);
    if (wave < 2) {
        const int b = 2 * hb + wave; const f32x2_t a16 = POW[lane * 17 + 16]; float xr = 0.f, xi = 0.f;
        const float* lp = LB + (size_t)(wave * 128) * 128; float* xp = XB + (size_t)(wave * 128) * 128;
        float lr_[8], li_[8], nr_[8], ni_[8];
#pragma unroll
        for (int k = 0; k < 8; ++k) { lr_[k] = lp[(size_t)k * 128 + lane]; li_[k] = lp[(size_t)k * 128 + 64 + lane]; }
#pragma unroll 1
        for (int n0 = 0; n0 < 128; n0 += 8) {
            const int nn = n0 + 8 < 128 ? n0 + 8 : n0;
#pragma unroll
            for (int k = 0; k < 8; ++k) { nr_[k] = lp[(size_t)(nn + k) * 128 + lane]; ni_[k] = lp[(size_t)(nn + k) * 128 + 64 + lane]; }
#pragma unroll
            for (int k = 0; k < 8; ++k) { xp[(size_t)(n0 + k) * 128 + lane] = xr; xp[(size_t)(n0 + k) * 128 + 64 + lane] = xi;
                const float nr = a16.x * xr - a16.y * xi + lr_[k], ni = a16.x * xi + a16.y * xr + li_[k]; xr = nr; xi = ni; }
#pragma unroll
            for (int k = 0; k < 8; ++k) { lr_[k] = nr_[k]; li_[k] = ni_[k]; } }
        const size_t so = ((size_t)b * 128 + g) * 64 + lane; a.out[O_S5R_P + so] = xr; a.out[O_S5I_P + so] = xi;
    } else if (wave < 6) {
        const f32x2_t a16 = POW[lane * 17 + 16], a8 = POW[lane * 17 + 8]; const float inv = 1.0f / (a8.x * a8.x + a8.y * a8.y), i8r = a8.x * inv, i8i = -a8.y * inv;
        float xr_[16], xi_[16], lr2[16], li2[16];
#pragma unroll
        for (int j = 0; j < 16; ++j) { const int sc = 16 * (wave - 2) + j, col = 256 + sc, bs = 64 * hb + sc; const size_t so = ((size_t)bs * 128 + g) * 64 + lane;
            xr_[j] = a.in[I_S5RE][so]; xi_[j] = a.in[I_S5IM][so]; lr2[j] = LB[(size_t)col * 128 + lane]; li2[j] = LB[(size_t)col * 128 + 64 + lane]; }
#pragma unroll
        for (int j = 0; j < 16; ++j) { const int sc = 16 * (wave - 2) + j, col = 256 + sc, bs = 64 * hb + sc; const size_t so = ((size_t)bs * 128 + g) * 64 + lane;
            const float xr = xr_[j], xi = xi_[j]; XB[(size_t)col * 128 + lane] = xr; XB[(size_t)col * 128 + 64 + lane] = xi;
            const float zr = a16.x * xr - a16.y * xi + lr2[j], zi = a16.x * xi + a16.y * xr + li2[j];
            a.out[O_S5R_S + so] = zr * i8r - zi * i8i; a.out[O_S5I_S + so] = zr * i8i + zi * i8r; }
    }
    __syncthreads();
    }
    for (int rep_3 = 0; rep_3 < (S5MM_REP == 4 ? 2 : 1); ++rep_3) {
    for (int cb = wave; cb < 20; cb += NWAVES) {
        bf16x8 Uf[8], Xf[4]; s5_load_u(a, g, hb, cb, lane, Uf);
        const int col = 16 * cb + r; const bool samp = col >= 256;
#pragma unroll
        for (int ks = 0; ks < 4; ++ks) { float x[8]; ld_f8(XB + (size_t)col * 128 + 32 * ks + 8 * q, x); Xf[ks] = pack8(x); }
        bf16x8 Fka[8], Fwa[4], Fkb[8], Fwb[4];
#define LDF3(Fk, Fw, t) do { _Pragma("unroll") for (int ks = 0; ks <= (t) / 2; ++ks) { const int d = (t) - 2 * ks - (q >> 1);        \
                Fk[ks] = *(const LAS bf16x8*)(lds + SM_KT + (((d < 0 ? 0 : d) * 16 + r) * 16 + 8 * (q & 1)) * 2); if (d < 0) Fk[ks] = (bf16x8){0, 0, 0, 0, 0, 0, 0, 0}; } \
            _Pragma("unroll") for (int ks = 0; ks < 4; ++ks) Fw[ks] = *(const LAS bf16x8*)(lds + SM_WC + addr256(16 * (t) + r, 4 * ks + q)); } while (0)
#define MM3(Fk, Fw, t) do { f32x4 acc = {0.f, 0.f, 0.f, 0.f}, acc2 = {0.f, 0.f, 0.f, 0.f}; \
            _Pragma("unroll") for (int ks = 0; ks <= (t) / 2; ++ks) { if (ks & 1) acc2 = MFMA16(Fk[ks], Uf[ks], acc2); else acc = MFMA16(Fk[ks], Uf[ks], acc); } \
            _Pragma("unroll") for (int ks = 0; ks < 4; ++ks) { if (ks & 1) acc = MFMA16(Fw[ks], Xf[ks], acc); else acc2 = MFMA16(Fw[ks], Xf[ks], acc2); } \
            acc = acc + acc2; \
            if (!samp || (t) < 8) { u32x2 o; o.x = cvtpk(gelu_tanh_fast(acc[0]), gelu_tanh_fast(acc[1])); o.y = cvtpk(gelu_tanh_fast(acc[2]), gelu_tanh_fast(acc[3])); \
                *(u32x2*)(G2 + (size_t)s5_row(hb, col, (t)) * DM + g * 16 + 4 * q) = o; } } while (0)
        LDF3(Fka, Fwa, 0);
#pragma unroll
        for (int t2 = 0; t2 < 8; ++t2) { LDF3(Fkb, Fwb, 2 * t2 + 1); __builtin_amdgcn_sched_barrier(0); MM3(Fka, Fwa, 2 * t2); __builtin_amdgcn_sched_barrier(0);
            if (t2 < 7) LDF3(Fka, Fwa, 2 * t2 + 2); __builtin_amdgcn_sched_barrier(0); MM3(Fkb, Fwb, 2 * t2 + 1); __builtin_amdgcn_sched_barrier(0); }
#undef LDF3
#undef MM3
    }
    }
}

constexpr int N_PHASES = 21;
constexpr unsigned DUPMASK = 0u;
constexpr int P3PROBE = 0;
__global__ void __launch_bounds__(NTHR, 2) fwd_kernel(Args a) {
    extern __shared__ __attribute__((aligned(16))) unsigned char lds_raw[];
    LAS unsigned char* lds = (LAS unsigned char*)lds_raw;
    const int tid = threadIdx.x, lane = tid & 63, wave = __builtin_amdgcn_readfirstlane(tid >> 6);
    constexpr int G = 256;
    const int gw = blockIdx.x * NWAVES + wave, NGW = G * NWAVES;
    unsigned char* ws = a.ws;
    const int lo = a.ph_lo, hi = a.ph_hi;
    volatile LAS unsigned* MISC = (volatile LAS unsigned*)(lds + MISC_OFF);
    if (tid < 64) MISC[tid] = 0u;
    __syncthreads();
    XcdBarrier bar = xcd_barrier_post((unsigned*)(ws + WS_CTL) + CW_BAR, MISC + 8);
#define IN(k) (lo <= (k) && (k) < hi)
#define SEAM(k) do { if (IN(k) && IN((k) + 1)) xcd_barrier(bar); } while (0)
#define PHASE(k, ...) if (IN(k)) { __VA_ARGS__ if ((DUPMASK >> (k)) & 1u) { xcd_barrier(bar); __VA_ARGS__ } } SEAM(k);
#define GEMM_PHASE(EPI, Aop, Bop, N_, K_, E_) do { pg8::Gemm g{(const pg8::bf16_t*)(Aop), (const pg8::bf16_t*)(Bop), MTOT, (N_), (K_), (K_)}; pg8::StaticOrder S; S.init(MTOT, (N_), G, (int)blockIdx.x); \
        pg8::gemm_phase<EPI, pg8::StaticOrder, true, true>(lds, g, S, E_); } while (0)
#define SS ((float*)(ws + WS_SS))
#define X ((float*)(ws + WS_X))
#define H ((bf16*)(ws + WS_H))
#define G2 ((bf16*)(ws + WS_G2))
#define BIG ((bf16*)(ws + WS_BIG))
#define ACT ((bf16*)(ws + WS_ACT))

    PHASE(0, ph_prologue(a, lds, tid, lane, wave, gw, NGW, G);)
    PHASE(1, pg8::EpiBf16Plain E{BIG, NPROJ}; GEMM_PHASE(pg8::EpiBf16Plain, H, ws + WS_WIN, NPROJ, 2048, E);)
    PHASE(2, ph_mix_prep(a, lds, tid, lane, wave, gw, NGW, G);)
    if (IN(3)) { ph_scans(a, lds, tid, lane, wave, G); if (P3PROBE) { xcd_barrier(bar); ph_scans(a, lds, tid, lane, wave, G, P3PROBE); } } SEAM(3);
    PHASE(4, ph_mix_norm(a, lane, gw, NGW);)
    PHASE(5, pg8::EpiResNorm E{X, H, SS, DM, a.in[I_XP], a.in[I_XS]}; GEMM_PHASE(pg8::EpiResNorm, G2, ws + WS_WOUT, 2048, 2048, E);
             if (G == 256 && blockIdx.x >= 32) convert_group(a, 3, (LAS float*)(lds + wave * 8704), lane, ((int)blockIdx.x - 32) * NWAVES + wave, 224 * NWAVES);)
    PHASE(7, if (G == 256) { pg8::EpiBf16Rstd E{BIG, NUP, SS};
                    if (((int)blockIdx.x & 7) < 4) { convert_group(a, 2, (LAS float*)(lds + wave * 8704), lane, (int)blockIdx.x * NWAVES + wave, 256 * NWAVES); __syncthreads(); }
                    { const int L = (int)blockIdx.x - 128; pg8::Gemm g{(const pg8::bf16_t*)H, (const pg8::bf16_t*)(ws + WS_WUP), MTOT, NUP, 2048, 2048}; pg8::PlusOne S; S.init(MP, NUP, G, (int)blockIdx.x); S.extra = pg8::Unit{32 + (L & 3), L >> 2}; S.has_extra = L >= 0;
                      pg8::gemm_phase<pg8::EpiBf16Rstd, pg8::PlusOne, true, true>(lds, g, S, E); }
                    if (((int)blockIdx.x & 7) >= 4) convert_group(a, 2, (LAS float*)(lds + wave * 8704), lane, (int)blockIdx.x * NWAVES + wave, 256 * NWAVES); }
                  else { pg8::EpiBf16Rstd E{BIG, NUP, SS}; GEMM_PHASE(pg8::EpiBf16Rstd, H, ws + WS_WUP, NUP, 2048, E); })
    PHASE(18, if (G == 256) { if (blockIdx.x < 48) { pg8::EpiBf16Rstd E{BIG, NUP, SS};
                        const int L = 128 + (int)blockIdx.x; pg8::Gemm g{(const pg8::bf16_t*)H, (const pg8::bf16_t*)(ws + WS_WUP), MTOT, NUP, 2048, 2048}; pg8::OneUnit S{{32 + (L & 3), L >> 2}, true}; pg8::gemm_phase<pg8::EpiBf16Rstd, pg8::OneUnit, true, true>(lds, g, S, E); }
                      else { ffn_conv_prompt(a, 0, lane, ((int)blockIdx.x - 48) * NWAVES + wave, 208 * NWAVES); ffn_conv_sample(a, 0, lane, ((int)blockIdx.x - 48) * NWAVES + wave, 208 * NWAVES, 0, 8, false); } }
                  else ffn_conv_prompt(a, 0, lane, gw, NGW);)
    PHASE(8, if (G == 256) ffn_conv_sample(a, 0, lane, gw, NGW, 8, 11, true); else ffn_conv_sample(a, 0, lane, gw, NGW);)
    PHASE(9, { pg8::EpiResNorm E{X, H, SS + MTOT, DM, X, X + (size_t)8192 * DM};
                 pg8::Gemm g{(const pg8::bf16_t*)ACT, (const pg8::bf16_t*)(ws + WS_WDN), MP, 2048, DFF, DFF}; pg8::StaticOrder S; S.init(MP, 2048, G, (int)blockIdx.x);
                 pg8::gemm_phase<pg8::EpiResNorm, pg8::StaticOrder, true, true>(lds, g, S, E); }
               { const int p = (int)blockIdx.x, kq = p & 3, un = p >> 2;
                 pg8::EpiSlab E{(float*)BIG + (size_t)kq * MS * DM, DM};
                 pg8::Gemm g{(const pg8::bf16_t*)ACT + kq * 1408, (const pg8::bf16_t*)(ws + WS_WDN) + kq * 1408, MTOT, 2048, 1408, DFF};
                 pg8::OneUnit S{{32 + (un & 3), un >> 2}, p < 128};
                 pg8::gemm_phase<pg8::EpiSlab, pg8::OneUnit, true, true>(lds, g, S, E); }
               )
    PHASE(10, ph_combine<false>(X, H, SS + MTOT, (const float*)BIG, lane, gw, NGW, (bf16*)(ws + WS_UG0), a.in[I_NMIX] + DM);
              ph_ug_prompt(H, SS + MTOT, a.in[I_NMIX] + DM, (bf16*)(ws + WS_UG0), lane, gw, NGW);)
    PHASE(11, if (G == 256) {
                              const int b_ = (int)blockIdx.x, xcd = b_ & 7, j_ = b_ >> 3, quad = xcd * 4 + (j_ >> 3);
                              ph_s5_mm(a, lds, (4 * quad + ((j_ & 7) >> 1)) * 2 + (j_ & 1), tid, lane, wave); }
              else { for (int task = (int)blockIdx.x; task < 256; task += G) ph_s5_mm(a, lds, task, tid, lane, wave); })
    PHASE(12, { pg8::EpiGluRes E{X, H, SS + 2 * MTOT, DM};
                  pg8::Gemm g{(const pg8::bf16_t*)G2, (const pg8::bf16_t*)(ws + WS_WGLU), MP, NGLU, 2048, 2048}; pg8::StaticOrder S; S.init(MP, NGLU, G, (int)blockIdx.x);
                  pg8::gemm_phase<pg8::EpiGluRes, pg8::StaticOrder, true, true>(lds, g, S, E); }
                { const int p = (int)blockIdx.x, kq = p & 3, un = p >> 2;
                  pg8::EpiSlab E{(float*)BIG + (size_t)kq * MS * NGLU, NGLU};
                  pg8::Gemm g{(const pg8::bf16_t*)G2 + kq * 512, (const pg8::bf16_t*)(ws + WS_WGLU) + kq * 512, MTOT, NGLU, 512, 2048};
                  pg8::OneUnit S{{32 + (un & 3), un >> 2}, true};
                  pg8::gemm_phase<pg8::EpiSlab, pg8::OneUnit, true, true>(lds, g, S, E); })
    PHASE(13, ph_combine<true>(X, H, SS + 2 * MTOT, (const float*)BIG, lane, gw, NGW);)
    PHASE(14, if (G == 256) { pg8::EpiBf16Rstd E{BIG, NUP, SS + 2 * MTOT};
                    { const int L = (int)blockIdx.x - 128; pg8::Gemm g{(const pg8::bf16_t*)H, (const pg8::bf16_t*)(ws + WS_WUP + (size_t)NUP * 2048 * 2), MTOT, NUP, 2048, 2048}; pg8::PlusOne S; S.init(MP, NUP, G, (int)blockIdx.x); S.extra = pg8::Unit{32 + (L & 3), L >> 2}; S.has_extra = L >= 0;
                      pg8::gemm_phase<pg8::EpiBf16Rstd, pg8::PlusOne, true, true>(lds, g, S, E); } }
                  else { pg8::EpiBf16Rstd E{BIG, NUP, SS + 2 * MTOT}; GEMM_PHASE(pg8::EpiBf16Rstd, H, ws + WS_WUP + (size_t)NUP * 2048 * 2, NUP, 2048, E); })
    PHASE(19, if (G == 256) { if (blockIdx.x < 48) { pg8::EpiBf16Rstd E{BIG, NUP, SS + 2 * MTOT};
                        const int L = 128 + (int)blockIdx.x; pg8::Gemm g{(const pg8::bf16_t*)H, (const pg8::bf16_t*)(ws + WS_WUP + (size_t)NUP * 2048 * 2), MTOT, NUP, 2048, 2048}; pg8::OneUnit S{{32 + (L & 3), L >> 2}, true}; pg8::gemm_phase<pg8::EpiBf16Rstd, pg8::OneUnit, true, true>(lds, g, S, E); }
                      else { ffn_conv_prompt(a, 1, lane, ((int)blockIdx.x - 48) * NWAVES + wave, 208 * NWAVES); ffn_conv_sample(a, 1, lane, ((int)blockIdx.x - 48) * NWAVES + wave, 208 * NWAVES, 0, 8, false); } }
                  else ffn_conv_prompt(a, 1, lane, gw, NGW);)
    PHASE(15, if (G == 256) ffn_conv_sample(a, 1, lane, gw, NGW, 8, 11, true); else ffn_conv_sample(a, 1, lane, gw, NGW);)
    PHASE(16, { pg8::EpiResNormT<false> E{X, H, SS + 3 * MTOT, DM, X, X + (size_t)8192 * DM};
                  pg8::Gemm g{(const pg8::bf16_t*)ACT, (const pg8::bf16_t*)(ws + WS_WDN + (size_t)2048 * DFF * 2), MP, 2048, DFF, DFF}; pg8::StaticOrder S; S.init(MP, 2048, G, (int)blockIdx.x);
                  pg8::gemm_phase<pg8::EpiResNormT<false>, pg8::StaticOrder, true, true>(lds, g, S, E); }
                { const int p = (int)blockIdx.x, kq = p & 3, un = p >> 2;
                  pg8::EpiSlab E{(float*)BIG + (size_t)kq * MS * DM, DM};
                  pg8::Gemm g{(const pg8::bf16_t*)ACT + kq * 1408, (const pg8::bf16_t*)(ws + WS_WDN + (size_t)2048 * DFF * 2) + kq * 1408, MTOT, 2048, 1408, DFF};
                  pg8::OneUnit S{{32 + (un & 3), un >> 2}, p < 128};
                  pg8::gemm_phase<pg8::EpiSlab, pg8::OneUnit, true, true>(lds, g, S, E); })
    if (IN(17)) { int t17 = threadIdx.x; asm volatile("" : "+v"(t17));
                  ph_rms_out(X, SS + 3 * MTOT, (const float*)BIG, a.in[I_NFIN], a.out + O_Y, t17 & 63, (int)blockIdx.x * NWAVES + __builtin_amdgcn_readfirstlane(t17 >> 6), NGW); }
#undef IN
#undef SEAM
#undef GEMM_PHASE
#undef SS
#undef X
#undef H
#undef G2
#undef BIG
#undef ACT
}

#ifndef MK_PER_PHASE
#define MK_PER_PHASE 0
#endif
extern "C" void kernel_launch(void* const* d_in, const int* in_sizes, int n_in, void* d_out, int out_size, void* d_ws, size_t ws_size, hipStream_t stream) {
    static int grid = 0;
    if (grid == 0) {
        if (n_in != 32 || out_size != (int)O_END || ws_size < WS_END) { fprintf(stderr, "kernel_launch: unexpected shapes: n_in %d out %d (want %zu) ws %zu (want %zu); nothing launched\n", n_in, out_size, (size_t)O_END, ws_size, (size_t)WS_END); grid = -1; return; }
        int dev = 0, cus = 0, per_cu = 0;
        if (hipGetDevice(&dev) != hipSuccess || hipDeviceGetAttribute(&cus, hipDeviceAttributeMultiprocessorCount, dev) != hipSuccess) { fprintf(stderr, "kernel_launch: device query failed\n"); grid = -1; return; }
        if (hipFuncSetAttribute((const void*)fwd_kernel, hipFuncAttributeMaxDynamicSharedMemorySize, LDS_BYTES) != hipSuccess) { fprintf(stderr, "kernel_launch: hipFuncSetAttribute failed\n"); grid = -1; return; }
        if (hipOccupancyMaxActiveBlocksPerMultiprocessor(&per_cu, (const void*)fwd_kernel, NTHR, LDS_BYTES) != hipSuccess || per_cu < 1) { fprintf(stderr, "kernel_launch: occupancy query says %d blocks per CU\n", per_cu); per_cu = 1; }
        (void)hipGetLastError();
        if (cus < 256) { fprintf(stderr, "kernel_launch: this kernel needs 256 CUs (one resident workgroup each), the device has %d; nothing launched\n", cus); grid = -1; return; }
        grid = 256;
        fprintf(stderr, "kernel_launch: grid %d (occupancy query %d per CU)\n", grid, per_cu);
    }
    if (grid < 0) return;
    if (hipMemsetAsync((char*)d_ws + WS_CTL, 0, CTL_ZERO_BYTES, stream) != hipSuccess) { fprintf(stderr, "kernel_launch: hipMemsetAsync failed\n"); return; }
    Args a{};
    for (int i = 0; i < 32; ++i) a.in[i] = (const float*)d_in[i];
    a.out = (float*)d_out; a.ws = (unsigned char*)d_ws;
#if MK_PER_PHASE
    for (int ph = 0; ph < N_PHASES; ++ph) { a.ph_lo = ph; a.ph_hi = ph + 1; hipLaunchKernelGGL(fwd_kernel, dim3(grid), dim3(NTHR), LDS_BYTES, stream, a); }
#else
    a.ph_lo = 0; a.ph_hi = N_PHASES;
    void* args[] = {&a};
    hipError_t e = hipLaunchCooperativeKernel((const void*)fwd_kernel, dim3(grid), dim3(NTHR), args, LDS_BYTES, stream);
    if (e != hipSuccess) fprintf(stderr, "kernel_launch: cooperative launch failed: %s (grid %d)\n", hipGetErrorString(e), grid);
#endif
}
```
